# Optimizing an MI355X kernel written in HIP

```python
import jax, jax.numpy as jnp
from jax import lax
import numpy as np

D_MODEL = 1024
BATCH = 2
SEQ = 8192
DEPTH = 1

D_CONV = D_MODEL
CONV_A_WIDTH = 3
GDN_HEADS = D_MODEL // 128
HEAD_K = 128
HEAD_V = 128
KEY_DIM = GDN_HEADS * HEAD_K
VAL_DIM = GDN_HEADS * HEAD_V
CONV_QKV_WIDTH = 5
N_DIR = 2
CHUNK = 64
NORM_EPS = 1e-6
L2_EPS = 1e-6
SPLITS = (D_CONV, D_CONV, D_CONV, D_CONV,
          KEY_DIM, KEY_DIM, VAL_DIM, VAL_DIM,
          N_DIR * GDN_HEADS, N_DIR * GDN_HEADS,
          D_MODEL, D_MODEL)
N_IN = sum(SPLITS)

kernel_name = "hybrid_conv_gdn_bidir_adaln"


def rmsnorm(x, w):
    xf = x.astype(jnp.float32)
    y = xf * lax.rsqrt(jnp.mean(xf * xf, axis=-1, keepdims=True) + NORM_EPS)
    return (y * w.astype(jnp.float32)).astype(x.dtype)


def l2norm(x):
    return x * lax.rsqrt(jnp.sum(x * x, axis=-1, keepdims=True) + L2_EPS)


def dwconv_centred(x, w):
    k = w.shape[0]
    return lax.conv_general_dilated(
        x, w[:, None, :].astype(x.dtype), window_strides=(1,),
        padding=[(k // 2, k // 2)], dimension_numbers=('NWC', 'WIO', 'NWC'),
        feature_group_count=x.shape[-1])


def gated_delta_chunked(q, k, v, g, beta):
    bsz, nh, slen, dk = q.shape
    dv = v.shape[-1]
    nc = slen // CHUNK
    q = q * (dk ** -0.5)
    q = q.reshape(bsz, nh, nc, CHUNK, dk)
    k = k.reshape(bsz, nh, nc, CHUNK, dk)
    v = v.reshape(bsz, nh, nc, CHUNK, dv)
    beta = beta.reshape(bsz, nh, nc, CHUNK)
    g = jnp.cumsum(g.reshape(bsz, nh, nc, CHUNK), axis=-1)
    idx = jnp.arange(CHUNK)
    incl = idx[:, None] >= idx[None, :]
    strict = idx[:, None] > idx[None, :]
    diff = g[..., :, None] - g[..., None, :]
    decay = jnp.where(incl, jnp.exp(jnp.where(incl, diff, 0.0)), 0.0)
    kk = jnp.einsum('bhnid,bhnjd->bhnij', k, k)
    lower = jnp.where(strict, beta[..., :, None] * kk * decay, 0.0)
    eye = jnp.eye(CHUNK, dtype=q.dtype)
    tmat = lax.linalg.triangular_solve(eye + lower, jnp.broadcast_to(eye, lower.shape),
                                       left_side=True, lower=True, unit_diagonal=True)
    eg = jnp.exp(g)
    u = jnp.einsum('bhnij,bhnjd->bhnid', tmat, v * beta[..., None])
    w = jnp.einsum('bhnij,bhnjd->bhnid', tmat, k * (beta * eg)[..., None])
    a_qk = jnp.einsum('bhnid,bhnjd->bhnij', q, k) * decay
    q_dec = q * eg[..., None]
    g_last = g[..., -1]
    k_dec = k * jnp.exp(g_last[..., None] - g)[..., None]
    gl = jnp.exp(g_last)
    xs = tuple(jnp.moveaxis(t, 2, 0) for t in (q_dec, k_dec, u, w, a_qk, gl))

    def step(state, inp):
        qd, kd, uu, ww, aqk, gll = inp
        v_new = uu - jnp.einsum('bhcd,bhde->bhce', ww, state)
        o = jnp.einsum('bhcd,bhde->bhce', qd, state) + jnp.einsum('bhij,bhje->bhie', aqk, v_new)
        state = state * gll[..., None, None] + jnp.einsum('bhcd,bhce->bhde', kd, v_new)
        return state, o

    state0 = jnp.zeros((bsz, nh, dk, dv), jnp.float32)
    _, o = lax.scan(step, state0, xs)
    return jnp.moveaxis(o, 0, 2).reshape(bsz, nh, slen, dv)


def setup_inputs(seed: int = 0) -> dict:
    key = jax.random.key(seed)
    ks = jax.random.split(key, 16)
    f32 = jnp.float32
    x = jax.random.normal(ks[0], (BATCH, SEQ, D_MODEL), f32)
    c = jax.random.normal(ks[1], (BATCH, D_MODEL), f32)
    w_ada = jax.random.normal(ks[2], (DEPTH, D_MODEL, 3 * D_MODEL), f32) * D_MODEL ** -0.5
    b_ada = jax.random.normal(ks[3], (DEPTH, 3 * D_MODEL), f32) * 0.02
    norm_w = 1.0 + 0.01 * jax.random.normal(ks[4], (DEPTH, D_MODEL), f32)
    w_in = jax.random.normal(ks[5], (DEPTH, D_MODEL, N_IN), f32) * D_MODEL ** -0.5
    conv_a_w = jax.random.normal(ks[6], (DEPTH, CONV_A_WIDTH, D_CONV), f32) * CONV_A_WIDTH ** -0.5
    conv_qkv_w = jax.random.normal(ks[7], (DEPTH, CONV_QKV_WIDTH, 2 * KEY_DIM + VAL_DIM), f32) * CONV_QKV_WIDTH ** -0.5
    a_log = jnp.log(jax.random.uniform(ks[8], (DEPTH, N_DIR, GDN_HEADS), f32, 1.0, 16.0))
    dt = jnp.exp(jax.random.uniform(ks[9], (DEPTH, N_DIR, GDN_HEADS), f32,
                                    float(np.log(1e-3)), float(np.log(1e-1))))
    dt_bias = dt + jnp.log(-jnp.expm1(-dt))
    gdn_norm_w = 1.0 + 0.01 * jax.random.normal(ks[10], (DEPTH, HEAD_V), f32)
    w_pa = jax.random.normal(ks[11], (DEPTH, D_CONV, D_MODEL), f32) * D_CONV ** -0.5
    w_pb = jax.random.normal(ks[12], (DEPTH, VAL_DIM, D_MODEL), f32) * VAL_DIM ** -0.5
    w_o = jax.random.normal(ks[13], (DEPTH, D_MODEL, D_MODEL), f32) * D_MODEL ** -0.5
    final_norm_w = 1.0 + 0.01 * jax.random.normal(ks[14], (D_MODEL,), f32)
    return {"x": x, "c": c, "w_ada": w_ada, "b_ada": b_ada, "norm_w": norm_w, "w_in": w_in,
            "conv_a_w": conv_a_w, "conv_qkv_w": conv_qkv_w, "a_log": a_log, "dt_bias": dt_bias,
            "gdn_norm_w": gdn_norm_w, "w_pa": w_pa, "w_pb": w_pb, "w_o": w_o,
            "final_norm_w": final_norm_w}


def reference(x, c, w_ada, b_ada, norm_w, w_in, conv_a_w, conv_qkv_w, a_log, dt_bias,
              gdn_norm_w, w_pa, w_pb, w_o, final_norm_w):
    bsz, slen, _ = x.shape
    dt_ = x.dtype
    split_pts = [int(p) for p in np.cumsum(SPLITS)[:-1]]
    for l in range(DEPTH):
        mod = jax.nn.silu(c) @ w_ada[l] + b_ada[l]
        shift, scale, gate = jnp.split(mod, 3, axis=-1)
        h = rmsnorm(x, norm_w[l]) * (1.0 + scale[:, None, :]) + shift[:, None, :]

        proj = h @ w_in[l]
        (a_bg, a_cg, a_x, a_z, q, k, v, z_b, a_raw, b_raw,
         gate_a_raw, gate_b_raw) = jnp.split(proj, split_pts, axis=-1)

        ya = a_cg * dwconv_centred(a_bg * a_x, conv_a_w[l])
        ya = ya * jax.nn.silu(a_z)
        ya = ya @ w_pa[l]

        qkv = jax.nn.silu(dwconv_centred(jnp.concatenate([q, k, v], axis=-1), conv_qkv_w[l]))
        q, k, v = jnp.split(qkv, [KEY_DIM, 2 * KEY_DIM], axis=-1)
        q = l2norm(q.astype(jnp.float32).reshape(bsz, slen, GDN_HEADS, HEAD_K))
        k = l2norm(k.astype(jnp.float32).reshape(bsz, slen, GDN_HEADS, HEAD_K))
        v = v.astype(jnp.float32).reshape(bsz, slen, GDN_HEADS, HEAD_V)
        a_raw = a_raw.astype(jnp.float32).reshape(bsz, slen, N_DIR, GDN_HEADS)
        b_raw = b_raw.astype(jnp.float32).reshape(bsz, slen, N_DIR, GDN_HEADS)
        g = -jnp.exp(a_log[l].astype(jnp.float32)) * jax.nn.softplus(a_raw + dt_bias[l].astype(jnp.float32))
        beta = jax.nn.sigmoid(b_raw)
        q2 = jnp.concatenate([q, jnp.flip(q, 1)], axis=2)
        k2 = jnp.concatenate([k, jnp.flip(k, 1)], axis=2)
        v2 = jnp.concatenate([v, jnp.flip(v, 1)], axis=2)
        g2 = jnp.concatenate([g[:, :, 0], jnp.flip(g[:, :, 1], 1)], axis=2)
        b2 = jnp.concatenate([beta[:, :, 0], jnp.flip(beta[:, :, 1], 1)], axis=2)
        o = gated_delta_chunked(jnp.swapaxes(q2, 1, 2), jnp.swapaxes(k2, 1, 2),
                                jnp.swapaxes(v2, 1, 2), jnp.swapaxes(g2, 1, 2),
                                jnp.swapaxes(b2, 1, 2))
        o = o[:, :GDN_HEADS] + jnp.flip(o[:, GDN_HEADS:], axis=2)
        o = jnp.swapaxes(o, 1, 2)
        o = o * lax.rsqrt(jnp.mean(o * o, axis=-1, keepdims=True) + NORM_EPS) * gdn_norm_w[l].astype(jnp.float32)
        z = z_b.astype(jnp.float32).reshape(bsz, slen, GDN_HEADS, HEAD_V)
        yb = (o * jax.nn.silu(z)).reshape(bsz, slen, VAL_DIM).astype(dt_)
        yb = yb @ w_pb[l]

        merged = jax.nn.sigmoid(gate_a_raw) * ya + jax.nn.sigmoid(gate_b_raw) * yb
        x = x + gate[:, None, :] * (merged @ w_o[l])
    return rmsnorm(x, final_norm_w)
```

```cpp
#include <hip/hip_runtime.h>
#include <hip/hip_cooperative_groups.h>
#include <cstdio>
#include <cstdint>
namespace cg = cooperative_groups;

#define DI __device__ __forceinline__
#define PG8_LAS __attribute__((address_space(3)))
typedef unsigned short bf16_t;
typedef short bf16x8 __attribute__((ext_vector_type(8)));
typedef float f32x4 __attribute__((ext_vector_type(4)));
typedef float f32x2 __attribute__((ext_vector_type(2)));
typedef unsigned u32x4 __attribute__((ext_vector_type(4)));
typedef unsigned u32x2 __attribute__((ext_vector_type(2)));

namespace pg8 {
constexpr int BM = 256, BK = 64, HALF = 128, HTB = HALF * BK * 2, STAGE_BYTES = 8 * HTB, NXCD = 8, WGM = 8;
__host__ __device__ __forceinline__ int lds_byte(int r, int c) { const int st = (r >> 4) * 2 + (c >> 5), rr = r & 15, cc = c & 31, ob = rr * 64 + cc * 2; return st * 1024 + (ob ^ (((ob >> 9) & 1) << 5)); }
__host__ __device__ __forceinline__ void stage_rc(int b, int& R, int& C) { const int st = b / 1024, sb = b % 1024, swz = sb ^ (((sb >> 9) & 1) << 5); R = (st >> 1) * 16 + swz / 64; C = (st & 1) * 32 + (swz % 64) / 2; }
__host__ __device__ __forceinline__ int perm32(int rho) { const int n = rho >> 4, i = rho & 15; return 8 * (i >> 2) + 4 * n + (i & 3); }
struct Unit { int pm, pn; };
struct Gemm { const bf16_t* A; const bf16_t* Bt; int M, N, K; };
struct StaticOrder {
    int nM, nN, nwg, G, c;
    __host__ __device__ void init(int M, int N, int G_, int c_) { nM = M / BM; nN = N / BM; nwg = nM * nN; G = G_; c = c_; }
    __host__ __device__ bool next(int i, Unit& u) const {
        const long L = (long)i * G + c; if (L >= nwg) return false;
        int wgid = (int)L; { const int q = nwg / NXCD, r = nwg % NXCD, xcd = wgid % NXCD, off = wgid / NXCD; wgid = (xcd < r ? xcd * (q + 1) : r * (q + 1) + (xcd - r) * q) + off; }
        const int nig = WGM * nN, gid = wgid / nig, fm = gid * WGM, gsz = (nM - fm) < WGM ? (nM - fm) : WGM;
        u.pm = fm + ((wgid % nig) % gsz); u.pn = (wgid % nig) / gsz; return true;
    }
    __device__ __forceinline__ void a_ready(const Unit&) const {}
    __device__ __forceinline__ void done(const Unit&) const {}
};
template <class Epi, class Sched, bool ALIGN_EPI = false, bool SP2 = false>
__device__ __forceinline__ void gemm_phase(PG8_LAS unsigned char* lds, const Gemm g, const Sched& S, const Epi& E) {
    int tid = threadIdx.x; asm volatile("" : "+v"(tid)); const int wid = __builtin_amdgcn_readfirstlane(tid >> 6), lane = tid & 63, wr = wid >> 2, wc = wid & 3, fr = lane & 15, fq = lane >> 4;
    const int K = g.K, nt = K / BK;
    unsigned voffA[2], voffB[2];
#pragma unroll
    for (int i = 0; i < 2; ++i) { int R, C; stage_rc(tid * 16 + i * 8192, R, C); const int Rb = Epi::PERM ? ((R & ~31) + perm32(R & 31)) : R;
        voffA[i] = (unsigned)(R * K + C) * 2u; voffB[i] = (unsigned)(Rb * K + C) * 2u; }
    const size_t kstep = (size_t)(BK * 2);
    const size_t hstep = (size_t)HALF * K * 2;
    const size_t tstep = 2 * hstep;
    const unsigned ldsw = (unsigned)wid * 1024u;
    const int aoff = lds_byte(wr * 64 + fr, fq * 8), boff = lds_byte(wc * 32 + fr, fq * 8);
#define PG8_SA(b, h) (((b) * 2 + (h)) * HTB)
#define PG8_SB(b, h) ((4 + (b) * 2 + (h)) * HTB)
#define PG8_STAGE(bufoff, gbase, voff) do { _Pragma("unroll") for (int _i = 0; _i < 2; ++_i) \
        __builtin_amdgcn_global_load_lds((const unsigned*)((const char*)(gbase) + (voff)[_i]), (PG8_LAS unsigned*)(lds + (bufoff) + ldsw + _i * 8192), 16, 0, 0); } while (0)
#define PG8_LDA(dst, b, h) do { _Pragma("unroll") for (int m = 0; m < 4; ++m) _Pragma("unroll") for (int k = 0; k < 2; ++k) dst[m][k] = *(const PG8_LAS bf16x8*)(lds + PG8_SA(b, h) + aoff + m * 2048 + k * 1024); } while (0)
#define PG8_LDB(dst, b, h) do { _Pragma("unroll") for (int n = 0; n < 2; ++n) _Pragma("unroll") for (int k = 0; k < 2; ++k) dst[n][k] = *(const PG8_LAS bf16x8*)(lds + PG8_SB(b, h) + boff + n * 2048 + k * 1024); } while (0)
#define PG8_MMA(ai, bj, At, Bt) do { __builtin_amdgcn_s_setprio(1); _Pragma("unroll") for (int m = 0; m < 4; ++m) _Pragma("unroll") for (int n = 0; n < 2; ++n) _Pragma("unroll") for (int k = 0; k < 2; ++k) \
        acc[ai][bj][m][n] = __builtin_amdgcn_mfma_f32_16x16x32_bf16(Bt[n][k], At[m][k], acc[ai][bj][m][n], 0, 0, 0); __builtin_amdgcn_s_setprio(0); } while (0)
#define PG8_WAIT_V(n) asm volatile("s_waitcnt vmcnt(" #n ")" ::: "memory")
#define PG8_WAIT_L(n) asm volatile("s_waitcnt lgkmcnt(" #n ")" ::: "memory")
#define PG8_BAR __builtin_amdgcn_s_barrier()
#define PG8_SCHED __builtin_amdgcn_sched_barrier(0)
    Unit cur, nxt; int ui = 0;
    if (!S.next(0, cur)) return;
    f32x4 acc[2][2][4][2];
#pragma unroll
    for (int a = 0; a < 2; ++a)
#pragma unroll
        for (int b = 0; b < 2; ++b)
#pragma unroll
            for (int m = 0; m < 4; ++m)
#pragma unroll
                for (int n = 0; n < 2; ++n) acc[a][b][m][n] = (f32x4){0.f, 0.f, 0.f, 0.f};
    bf16x8 At[4][2], B0[2][2], B1[2][2];
    const char* cA = (const char*)g.A + (size_t)cur.pm * tstep; const char* cB = (const char*)g.Bt + (size_t)cur.pn * tstep;
    S.a_ready(cur);
    if constexpr (SP2) {
        PG8_STAGE(PG8_SB(0, 0), cB, voffB); PG8_STAGE(PG8_SB(0, 1), cB + hstep, voffB); PG8_STAGE(PG8_SA(0, 0), cA, voffA); PG8_STAGE(PG8_SA(0, 1), cA + hstep, voffA);
        if (wr == 1) PG8_BAR;
        PG8_WAIT_V(2); PG8_BAR;
        PG8_STAGE(PG8_SB(1, 0), cB + kstep, voffB); PG8_STAGE(PG8_SA(1, 0), cA + kstep, voffA); PG8_STAGE(PG8_SB(1, 1), cB + hstep + kstep, voffB);
        PG8_WAIT_V(6); PG8_BAR;
    } else {
        PG8_STAGE(PG8_SB(0, 0), cB, voffB); PG8_STAGE(PG8_SA(0, 0), cA, voffA); PG8_STAGE(PG8_SB(0, 1), cB + hstep, voffB); PG8_STAGE(PG8_SA(0, 1), cA + hstep, voffA);
        if (wr == 1) PG8_BAR;
        PG8_WAIT_V(4); PG8_BAR;
        PG8_STAGE(PG8_SB(1, 0), cB + kstep, voffB); PG8_STAGE(PG8_SA(1, 0), cA + kstep, voffA); PG8_STAGE(PG8_SB(1, 1), cB + hstep + kstep, voffB);
        PG8_WAIT_V(6); PG8_BAR;
    }
    for (;;) {
        const bool has_next = S.next(ui + 1, nxt);
        const char* nA = has_next ? (const char*)g.A + (size_t)nxt.pm * tstep : cA; const char* nB = has_next ? (const char*)g.Bt + (size_t)nxt.pn * tstep : cB;
        for (int t = 0; t < nt; t += 2) {
            const bool last = (t == nt - 2);
            const char* a1 = cA + (size_t)(t + 1) * kstep;
            const char* a2 = last ? nA : cA + (size_t)(t + 2) * kstep; const char* b2 = last ? nB : cB + (size_t)(t + 2) * kstep;
            const char* a3 = a2 + kstep; const char* b3 = b2 + kstep;
            if (last && has_next) S.a_ready(nxt);
            if constexpr (SP2) {
            PG8_LDB(B0, 0, 0); PG8_LDB(B1, 0, 1); PG8_SCHED; PG8_LDA(At, 0, 0); PG8_STAGE(PG8_SA(1, 1), a1 + hstep, voffA);
            PG8_WAIT_V(8); PG8_WAIT_L(0); PG8_BAR; PG8_MMA(0, 0, At, B0); PG8_MMA(0, 1, At, B1); PG8_BAR; PG8_SCHED;
            PG8_LDA(At, 0, 1); PG8_STAGE(PG8_SB(0, 0), b2, voffB); PG8_STAGE(PG8_SB(0, 1), b2 + hstep, voffB); PG8_STAGE(PG8_SA(0, 0), a2, voffA);
            PG8_WAIT_V(8); PG8_WAIT_L(0); PG8_BAR; PG8_MMA(1, 0, At, B0); PG8_MMA(1, 1, At, B1); PG8_BAR; PG8_SCHED;
            PG8_LDB(B0, 1, 0); PG8_LDB(B1, 1, 1); PG8_SCHED; PG8_LDA(At, 1, 0); PG8_STAGE(PG8_SA(0, 1), a2 + hstep, voffA);
            PG8_WAIT_V(8); PG8_WAIT_L(0); PG8_BAR; PG8_MMA(0, 0, At, B0); PG8_MMA(0, 1, At, B1); PG8_BAR; PG8_SCHED;
            PG8_LDA(At, 1, 1); PG8_STAGE(PG8_SB(1, 0), b3, voffB); PG8_STAGE(PG8_SB(1, 1), b3 + hstep, voffB); PG8_STAGE(PG8_SA(1, 0), a3, voffA);
            PG8_WAIT_V(8); PG8_WAIT_L(0); PG8_BAR; PG8_MMA(1, 0, At, B0); PG8_MMA(1, 1, At, B1); PG8_BAR; PG8_SCHED;
            } else {
            PG8_LDB(B0, 0, 0); PG8_SCHED; PG8_LDA(At, 0, 0); PG8_STAGE(PG8_SA(1, 1), a1 + hstep, voffA);
            PG8_WAIT_L(8); PG8_BAR; PG8_WAIT_L(0); PG8_MMA(0, 0, At, B0); PG8_BAR; PG8_SCHED;
            PG8_LDB(B1, 0, 1); PG8_STAGE(PG8_SB(0, 0), b2, voffB);
            PG8_BAR; PG8_WAIT_L(0); PG8_MMA(0, 1, At, B1); PG8_BAR;
            PG8_LDA(At, 0, 1); PG8_STAGE(PG8_SA(0, 0), a2, voffA);
            PG8_BAR; PG8_WAIT_L(0); PG8_MMA(1, 0, At, B0); PG8_BAR; PG8_SCHED;
            PG8_STAGE(PG8_SB(0, 1), b2 + hstep, voffB);
            PG8_WAIT_V(6); PG8_BAR; PG8_MMA(1, 1, At, B1); PG8_BAR;
            PG8_LDB(B0, 1, 0); PG8_SCHED; PG8_LDA(At, 1, 0); PG8_STAGE(PG8_SA(0, 1), a2 + hstep, voffA);
            PG8_WAIT_L(8); PG8_BAR; PG8_WAIT_L(0); PG8_MMA(0, 0, At, B0); PG8_BAR; PG8_SCHED;
            PG8_LDB(B1, 1, 1); PG8_STAGE(PG8_SB(1, 0), b3, voffB);
            PG8_BAR; PG8_WAIT_L(0); PG8_MMA(0, 1, At, B1); PG8_BAR;
            PG8_LDA(At, 1, 1); PG8_STAGE(PG8_SA(1, 0), a3, voffA);
            PG8_BAR; PG8_WAIT_L(0); PG8_MMA(1, 0, At, B0); PG8_BAR; PG8_SCHED;
            PG8_STAGE(PG8_SB(1, 1), b3 + hstep, voffB);
            PG8_WAIT_V(6); PG8_BAR; PG8_MMA(1, 1, At, B1); PG8_BAR;
            }
        }
        if constexpr (ALIGN_EPI) { if (wr == 0) PG8_BAR; }
        if constexpr (!Epi::AFTER_DRAIN) { E(acc, cur, wr, wc, fr, fq); S.done(cur); }
        if (!has_next) break;
#pragma unroll
        for (int a = 0; a < 2; ++a)
#pragma unroll
            for (int b = 0; b < 2; ++b)
#pragma unroll
                for (int m = 0; m < 4; ++m)
#pragma unroll
                    for (int n = 0; n < 2; ++n) acc[a][b][m][n] = (f32x4){0.f, 0.f, 0.f, 0.f};
        cur = nxt; cA = nA; cB = nB; ++ui;
        if constexpr (ALIGN_EPI) { if (wr == 1) PG8_BAR; }
    }
    PG8_WAIT_V(0);
    if constexpr (!ALIGN_EPI) { if (wr == 0) PG8_BAR; }
    PG8_BAR;
    if constexpr (Epi::AFTER_DRAIN) { E.fused(acc, cur, wr, wc, fr, fq, lds, wid, lane); S.done(cur); }
#undef PG8_SA
#undef PG8_SB
#undef PG8_STAGE
#undef PG8_LDA
#undef PG8_LDB
#undef PG8_MMA
#undef PG8_WAIT_V
#undef PG8_WAIT_L
#undef PG8_BAR
#undef PG8_SCHED
}}

constexpr int SEQ = 8192, NB = 2, M = NB * SEQ, D = 1024, NIN = 10272, NPAD = 10496;
constexpr int NA_TILES = 28, NB_TILES = 12, ROWS_A = NA_TILES * 256;
constexpr size_t MiB = 1u << 20;
constexpr size_t UNIT = 32 * MiB;
constexpr size_t WS_WIN = 224 * MiB, WS_WPA = 245 * MiB, WS_WPB = 247 * MiB, WS_WO = 249 * MiB, WS_AB = 251 * MiB, WS_G = 253 * MiB, WS_BETA = 254 * MiB;
constexpr size_t WS_MODP = 255 * MiB, WS_MODF = 255 * MiB + 256 * 1024;
constexpr size_t WS_CSC = 239 * MiB;
constexpr int LDS_BYTES = 155648;
constexpr int NWAVES = 8, NTHREADS = 512;
constexpr float NORM_EPS = 1e-6f, L2_EPS = 1e-6f;

struct Params { const float* in[15]; float* out; unsigned char* ws; };

typedef __bf16 bf16v2_t __attribute__((ext_vector_type(2)));
DI unsigned cvt_pk_bf16(float lo, float hi) { const f32x2 v = {lo, hi}; const bf16v2_t r = __builtin_convertvector(v, bf16v2_t); return __builtin_bit_cast(unsigned, r); }
DI float bf_lo(unsigned u) { return __uint_as_float(u << 16); }
DI float bf_hi(unsigned u) { return __uint_as_float(u & 0xffff0000u); }
DI float bf1(bf16_t u) { return __uint_as_float(((unsigned)u) << 16); }
DI float sigmoidf_(float x) { return __builtin_amdgcn_rcpf(1.0f + __expf(-x)); }
DI float siluf_(float x) { return x * __builtin_amdgcn_rcpf(1.0f + __expf(-x)); }
DI float softplusf_(float x) { return fmaxf(x, 0.f) + log1pf(__expf(-fabsf(x))); }
#define DPP_F(v, ctrl) __builtin_bit_cast(float, __builtin_amdgcn_mov_dpp(__builtin_bit_cast(int, (v)), (ctrl), 0xF, 0xF, true))
DI float row16_sum(float v) {
    v += DPP_F(v, 0xB1);
    v += DPP_F(v, 0x4E);
    v += DPP_F(v, 0x141);
    v += DPP_F(v, 0x140);
    return v;
}
DI float wave_sum(float v) {
    v = row16_sum(v);
    return __builtin_bit_cast(float, __builtin_amdgcn_readlane(__builtin_bit_cast(int, v), 0)) + __builtin_bit_cast(float, __builtin_amdgcn_readlane(__builtin_bit_cast(int, v), 16))
         + __builtin_bit_cast(float, __builtin_amdgcn_readlane(__builtin_bit_cast(int, v), 32)) + __builtin_bit_cast(float, __builtin_amdgcn_readlane(__builtin_bit_cast(int, v), 48));
}
DI int permpos(int dk) { const int loc = dk & 31; return (dk & ~31) + 8 * ((loc >> 2) & 3) + 4 * (loc >> 4) + (loc & 3); }
DI int win_src_col(int d) {
    if (d < 2048) { const int i = d >> 8, w = d & 255; return w < 128 ? (128 * i + w) : (2048 + 128 * i + (w - 128)); }
    if (d < 4096) { const int i = (d - 2048) >> 8, w = d & 255; return w < 128 ? (1024 + 128 * i + w) : (3072 + 128 * i + (w - 128)); }
    if (d < 5120) return 8224 + (d - 4096);
    if (d < 6144) return 9248 + (d - 5120);
    if (d < 7168) return 7168 + (d - 6144);
    if (d < 10240) return 4096 + (d - 7168);
    if (d < 10272) return 8192 + (d - 10240);
    return -1;
}

struct EpiA {
    static constexpr bool PERM = true, AFTER_DRAIN = false;
    bf16_t *PR, *SG;
    DI void operator()(const f32x4 (&acc)[2][2][4][2], const pg8::Unit& u, int wr, int wc, int fr, int fq) const {
        const int row0 = u.pm * 256 + wr * 64 + fr, pn = u.pn;
        if (pn < 16) {
            bf16_t* O = PR + (size_t)(pn >> 3) * (UNIT / 2) + (size_t)(128 * (pn & 7) + 32 * wc + 8 * fq);
#pragma unroll
            for (int ai = 0; ai < 2; ++ai)
#pragma unroll
                for (int m = 0; m < 4; ++m) {
                    float o[8];
#pragma unroll
                    for (int n = 0; n < 2; ++n)
#pragma unroll
                        for (int j = 0; j < 4; ++j) { const float a = acc[ai][0][m][n][j], b = acc[ai][1][m][n][j]; o[4 * n + j] = pn < 8 ? a * b : a * siluf_(b); }
                    u32x4 w; w.x = cvt_pk_bf16(o[0], o[1]); w.y = cvt_pk_bf16(o[2], o[3]); w.z = cvt_pk_bf16(o[4], o[5]); w.w = cvt_pk_bf16(o[6], o[7]);
                    *(u32x4*)(O + (size_t)(row0 + ai * 128 + m * 16) * D) = w;
                }
        } else {
            const int g = (pn - 16) >> 2;
            bf16_t* O = SG + (size_t)g * (UNIT / 2) + (size_t)(256 * ((pn - 16) & 3) + 32 * wc + 8 * fq);
#pragma unroll
            for (int ai = 0; ai < 2; ++ai)
#pragma unroll
                for (int m = 0; m < 4; ++m)
#pragma unroll
                    for (int bj = 0; bj < 2; ++bj) {
                        float o[8];
#pragma unroll
                        for (int n = 0; n < 2; ++n)
#pragma unroll
                            for (int j = 0; j < 4; ++j) { const float a = acc[ai][bj][m][n][j]; o[4 * n + j] = g == 2 ? siluf_(a) : sigmoidf_(a); }
                        u32x4 w; w.x = cvt_pk_bf16(o[0], o[1]); w.y = cvt_pk_bf16(o[2], o[3]); w.z = cvt_pk_bf16(o[4], o[5]); w.w = cvt_pk_bf16(o[6], o[7]);
                        *(u32x4*)(O + (size_t)(row0 + ai * 128 + m * 16) * D + bj * 128) = w;
                    }
        }
    }
};
struct EpiB {
    static constexpr bool PERM = true, AFTER_DRAIN = false;
    bf16_t* QKV;
    DI void operator()(const f32x4 (&acc)[2][2][4][2], const pg8::Unit& u, int wr, int wc, int fr, int fq) const {
        const int row0 = u.pm * 256 + wr * 64 + fr, pn = u.pn;
        bf16_t* O = QKV + (size_t)(pn >> 2) * (UNIT / 2) + (size_t)(256 * (pn & 3) + 32 * wc + 8 * fq);
#pragma unroll
        for (int ai = 0; ai < 2; ++ai)
#pragma unroll
            for (int m = 0; m < 4; ++m)
#pragma unroll
                for (int bj = 0; bj < 2; ++bj) {
                    const f32x4 v0 = acc[ai][bj][m][0], v1 = acc[ai][bj][m][1];
                    u32x4 w; w.x = cvt_pk_bf16(v0[0], v0[1]); w.y = cvt_pk_bf16(v0[2], v0[3]); w.z = cvt_pk_bf16(v1[0], v1[1]); w.w = cvt_pk_bf16(v1[2], v1[3]);
                    *(u32x4*)(O + (size_t)(row0 + ai * 128 + m * 16) * D + bj * 128) = w;
                }
    }
};
struct EpiYa {
    static constexpr bool PERM = true, AFTER_DRAIN = false;
    bf16_t* SGA;
    DI void operator()(const f32x4 (&acc)[2][2][4][2], const pg8::Unit& u, int wr, int wc, int fr, int fq) const {
        const int row0 = u.pm * 256 + wr * 64 + fr; bf16_t* O = SGA + (size_t)(256 * u.pn + 32 * wc + 8 * fq);
#pragma unroll
        for (int ai = 0; ai < 2; ++ai)
#pragma unroll
            for (int m = 0; m < 4; ++m)
#pragma unroll
                for (int bj = 0; bj < 2; ++bj) {
                    u32x4* p = (u32x4*)(O + (size_t)(row0 + ai * 128 + m * 16) * D + bj * 128);
                    const u32x4 s = *p; const f32x4 v0 = acc[ai][bj][m][0], v1 = acc[ai][bj][m][1];
                    u32x4 w; w.x = cvt_pk_bf16(bf_lo(s.x) * v0[0], bf_hi(s.x) * v0[1]); w.y = cvt_pk_bf16(bf_lo(s.y) * v0[2], bf_hi(s.y) * v0[3]);
                    w.z = cvt_pk_bf16(bf_lo(s.z) * v1[0], bf_hi(s.z) * v1[1]); w.w = cvt_pk_bf16(bf_lo(s.w) * v1[2], bf_hi(s.w) * v1[3]);
                    *p = w;
                }
    }
};
struct EpiYb {
    static constexpr bool PERM = true, AFTER_DRAIN = false;
    bf16_t* MA; const bf16_t* SGB;
    DI void operator()(const f32x4 (&acc)[2][2][4][2], const pg8::Unit& u, int wr, int wc, int fr, int fq) const {
        const int row0 = u.pm * 256 + wr * 64 + fr; const size_t c0 = (size_t)(256 * u.pn + 32 * wc + 8 * fq);
#pragma unroll
        for (int ai = 0; ai < 2; ++ai)
#pragma unroll
            for (int m = 0; m < 4; ++m)
#pragma unroll
                for (int bj = 0; bj < 2; ++bj) {
                    const size_t off = (size_t)(row0 + ai * 128 + m * 16) * D + bj * 128 + c0;
                    u32x4* p = (u32x4*)(MA + off); const u32x4 a = *p; const u32x4 s = *(const u32x4*)(SGB + off);
                    const f32x4 v0 = acc[ai][bj][m][0], v1 = acc[ai][bj][m][1];
                    u32x4 w; w.x = cvt_pk_bf16(bf_lo(a.x) + bf_lo(s.x) * v0[0], bf_hi(a.x) + bf_hi(s.x) * v0[1]); w.y = cvt_pk_bf16(bf_lo(a.y) + bf_lo(s.y) * v0[2], bf_hi(a.y) + bf_hi(s.y) * v0[3]);
                    w.z = cvt_pk_bf16(bf_lo(a.z) + bf_lo(s.z) * v1[0], bf_hi(a.z) + bf_hi(s.z) * v1[1]); w.w = cvt_pk_bf16(bf_lo(a.w) + bf_lo(s.w) * v1[2], bf_hi(a.w) + bf_hi(s.w) * v1[3]);
                    *p = w;
                }
    }
};
struct EpiOut {
    static constexpr bool PERM = true, AFTER_DRAIN = false;
    const float* X; const float* GATE; float* XN;
    DI void operator()(const f32x4 (&acc)[2][2][4][2], const pg8::Unit& u, int wr, int wc, int fr, int fq) const {
        const int row0 = u.pm * 256 + wr * 64 + fr; const int c0 = 256 * u.pn + 32 * wc + 8 * fq;
        const float* gp = GATE + (size_t)((u.pm * 256) / SEQ) * D + c0;
        f32x4 gt[2][2];
#pragma unroll
        for (int bj = 0; bj < 2; ++bj) { gt[bj][0] = *(const f32x4*)(gp + bj * 128); gt[bj][1] = *(const f32x4*)(gp + bj * 128 + 4); }
#pragma unroll
        for (int ai = 0; ai < 2; ++ai)
#pragma unroll
            for (int m = 0; m < 4; ++m)
#pragma unroll
                for (int bj = 0; bj < 2; ++bj) {
                    const size_t off = (size_t)(row0 + ai * 128 + m * 16) * D + bj * 128 + c0;
                    const f32x4 x0 = *(const f32x4*)(X + off), x1 = *(const f32x4*)(X + off + 4);
                    *(f32x4*)(XN + off) = x0 + gt[bj][0] * acc[ai][bj][m][0]; *(f32x4*)(XN + off + 4) = x1 + gt[bj][1] * acc[ai][bj][m][1];
                }
    }
};

constexpr size_t WS_PCNT = 255 * MiB + 336 * 1024;
constexpr size_t WS_PSS = 255 * MiB + 512 * 1024;
struct EpiOutFused {
    static constexpr bool PERM = true, AFTER_DRAIN = true;
    const float* X; const float* GATE; const float* FW; float* OUT; float* PSS; unsigned* PCNT;
    DI void operator()(const f32x4 (&)[2][2][4][2], const pg8::Unit&, int, int, int, int) const {}
    DI void fused(f32x4 (&acc)[2][2][4][2], const pg8::Unit& u, int wr, int wc, int fr, int fq, PG8_LAS unsigned char* lds, int wid, int lane) const {
        PG8_LAS float* P = (PG8_LAS float*)lds;
        PG8_LAS float* S = (PG8_LAS float*)(lds + 4096);
        const int row0 = u.pm * 256 + wr * 64 + fr; const int c0 = 256 * u.pn + 32 * wc + 8 * fq;
        const float* gp = GATE + (size_t)((u.pm * 256) / SEQ) * D + c0;
        f32x4 gt[2][2];
#pragma unroll
        for (int bj = 0; bj < 2; ++bj) { gt[bj][0] = *(const f32x4*)(gp + bj * 128); gt[bj][1] = *(const f32x4*)(gp + bj * 128 + 4); }
#pragma unroll
        for (int ai = 0; ai < 2; ++ai)
#pragma unroll
            for (int m = 0; m < 4; ++m) {
                float s = 0.f;
#pragma unroll
                for (int bj = 0; bj < 2; ++bj) {
                    const size_t off = (size_t)(row0 + ai * 128 + m * 16) * D + bj * 128 + c0;
                    const f32x4 v0 = *(const f32x4*)(X + off) + gt[bj][0] * acc[ai][bj][m][0], v1 = *(const f32x4*)(X + off + 4) + gt[bj][1] * acc[ai][bj][m][1];
                    acc[ai][bj][m][0] = v0; acc[ai][bj][m][1] = v1;
                    s += (v0[0] * v0[0] + v0[1] * v0[1]) + (v0[2] * v0[2] + v0[3] * v0[3]) + (v1[0] * v1[0] + v1[1] * v1[1]) + (v1[2] * v1[2] + v1[3] * v1[3]);
                }
                s += __shfl_xor(s, 16); s += __shfl_xor(s, 32);
                if (fq == 0) P[(ai * 128 + wr * 64 + m * 16 + fr) * 4 + wc] = s;
                if (m & 1) __builtin_amdgcn_sched_barrier(0);
            }
        asm volatile("s_waitcnt lgkmcnt(0)" ::: "memory"); __builtin_amdgcn_s_barrier(); asm volatile("" ::: "memory");
        const int row = wid * 32 + (lane & 31);
        if (lane < 32) {
            const float t = (P[row * 4 + 0] + P[row * 4 + 1]) + (P[row * 4 + 2] + P[row * 4 + 3]);
            __hip_atomic_store(PSS + (size_t)(u.pm * 256 + row) * 4 + u.pn, t, __ATOMIC_RELAXED, __HIP_MEMORY_SCOPE_AGENT);
        }
        asm volatile("s_waitcnt vmcnt(0)" ::: "memory");
        if (lane == 0) __hip_atomic_fetch_add(PCNT + 64 * u.pm, 1u, __ATOMIC_RELAXED, __HIP_MEMORY_SCOPE_AGENT);
        if (wid == 0) {
            unsigned sp = 0;
            while ((unsigned)__builtin_amdgcn_readfirstlane(__hip_atomic_load(PCNT + 64 * u.pm, __ATOMIC_RELAXED, __HIP_MEMORY_SCOPE_AGENT)) < 32u) { __builtin_amdgcn_s_sleep(2); if (++sp > (1u << 22)) break; }
            __builtin_amdgcn_fence(__ATOMIC_ACQUIRE, "agent");
        }
        asm volatile("s_waitcnt vmcnt(0) lgkmcnt(0)" ::: "memory"); __builtin_amdgcn_s_barrier(); asm volatile("" ::: "memory");
        if (lane < 32) {
            const float* ps = PSS + (size_t)(u.pm * 256 + row) * 4; float t = 0.f;
#pragma unroll
            for (int k = 0; k < 4; ++k) t += __hip_atomic_load(ps + k, __ATOMIC_RELAXED, __HIP_MEMORY_SCOPE_AGENT);
            S[row] = rsqrtf(t * (1.f / D) + NORM_EPS);
        }
        asm volatile("s_waitcnt vmcnt(0) lgkmcnt(0)" ::: "memory"); __builtin_amdgcn_s_barrier(); asm volatile("" ::: "memory");
        f32x4 fw[2][2];
#pragma unroll
        for (int bj = 0; bj < 2; ++bj) { fw[bj][0] = *(const f32x4*)(FW + c0 + bj * 128); fw[bj][1] = *(const f32x4*)(FW + c0 + bj * 128 + 4); }
#pragma unroll
        for (int ai = 0; ai < 2; ++ai)
#pragma unroll
            for (int m = 0; m < 4; ++m) {
                const float rs = S[ai * 128 + wr * 64 + m * 16 + fr];
#pragma unroll
                for (int bj = 0; bj < 2; ++bj) {
                    const size_t off = (size_t)(row0 + ai * 128 + m * 16) * D + bj * 128 + c0;
                    *(f32x4*)(OUT + off) = acc[ai][bj][m][0] * rs * fw[bj][0]; *(f32x4*)(OUT + off + 4) = acc[ai][bj][m][1] * rs * fw[bj][1];
                }
            }
    }
};

struct TwoGemmOrder {
    pg8::StaticOrder so;
    DI bool next(int i, pg8::Unit& u) const { if (i >= 2) return false; if (!so.next(0, u)) return false; if (i == 1) { u.pm += 256; u.pn += 4; } return true; }
    DI void a_ready(const pg8::Unit&) const {}
    DI void done(const pg8::Unit&) const {}
};
struct EpiYaYb {
    static constexpr bool PERM = true, AFTER_DRAIN = false;
    bf16_t* MA; const bf16_t* SGB;
    DI void operator()(const f32x4 (&acc)[2][2][4][2], const pg8::Unit& u, int wr, int wc, int fr, int fq) const {
        if (u.pn < 4) { EpiYa e{MA}; e(acc, u, wr, wc, fr, fq); }
        else { EpiYb e{MA, SGB}; pg8::Unit v; v.pm = u.pm - 256; v.pn = u.pn - 4; e(acc, v, wr, wc, fr, fq); }
    }
};

DI void p0_transpose_item(const float* W, int N, bf16_t* WT, int rg, int kg, int lane, bool is_win) {
    const int d = rg * 64 + lane; const int s = is_win ? win_src_col(d) : d; const int k0 = kg * 64;
    bf16_t* o = WT + (size_t)d * D + k0;
    if (s < 0) {
#pragma unroll
        for (int kk = 0; kk < 8; ++kk) *(u32x4*)(o + 8 * kk) = (u32x4){0u, 0u, 0u, 0u};
        return;
    }
    const float* w = W + (size_t)k0 * N + s;
    float v[64];
#pragma unroll
    for (int j = 0; j < 64; ++j) v[j] = w[(size_t)j * N];
#pragma unroll
    for (int kk = 0; kk < 8; ++kk) {
        u32x4 p; p.x = cvt_pk_bf16(v[8 * kk], v[8 * kk + 1]); p.y = cvt_pk_bf16(v[8 * kk + 2], v[8 * kk + 3]); p.z = cvt_pk_bf16(v[8 * kk + 4], v[8 * kk + 5]); p.w = cvt_pk_bf16(v[8 * kk + 6], v[8 * kk + 7]);
        *(u32x4*)(o + 8 * kk) = p;
    }
}
DI void phase0(const Params& p, int gw, int NGW, int lane) {
    unsigned char* ws = p.ws;
    constexpr int I_WIN = (NPAD / 64) * 16, I_SQ = 16 * 16, I_MOD = 48 * 8, NITEMS = I_WIN + 3 * I_SQ + I_MOD;
    for (int it = gw; it < NITEMS; it += NGW) {
        int r = it;
        if (r < I_WIN) { p0_transpose_item(p.in[5], NIN, (bf16_t*)(ws + WS_WIN), r >> 4, r & 15, lane, true); continue; } r -= I_WIN;
        if (r < I_SQ) { p0_transpose_item(p.in[11], D, (bf16_t*)(ws + WS_WPA), r >> 4, r & 15, lane, false); continue; } r -= I_SQ;
        if (r < I_SQ) { p0_transpose_item(p.in[12], D, (bf16_t*)(ws + WS_WPB), r >> 4, r & 15, lane, false); continue; } r -= I_SQ;
        if (r < I_SQ) { p0_transpose_item(p.in[13], D, (bf16_t*)(ws + WS_WO), r >> 4, r & 15, lane, false); continue; } r -= I_SQ;
        const int cgp = r >> 3, ks = r & 7; const float* c = p.in[1]; const float* wa = p.in[2] + (size_t)(ks * 128) * 3072 + cgp * 64 + lane;
        float a0 = 0.f, a1 = 0.f;
#pragma unroll
        for (int k0 = 0; k0 < 128; k0 += 32) {
            float wv[32];
#pragma unroll
            for (int k = 0; k < 32; ++k) wv[k] = wa[(size_t)(k0 + k) * 3072];
#pragma unroll
            for (int k = 0; k < 32; ++k) { a0 += siluf_(c[ks * 128 + k0 + k]) * wv[k]; a1 += siluf_(c[D + ks * 128 + k0 + k]) * wv[k]; }
        }
        float* mp = (float*)(ws + WS_MODP) + (size_t)ks * 2 * 3072 + cgp * 64 + lane;
        mp[0] = a0; mp[3072] = a1;
    }
}
DI void phase1(const Params& p, float* ldsf, int gw, int NGW, int lane, int tid) {
    const float* modp = (const float*)(p.ws + WS_MODP); const float* b_ada = p.in[3]; const float* nw = p.in[4];
    float* s_tab = ldsf;
    float* a_tab = ldsf + 2048;
    for (int idx = tid; idx < 2 * 2048; idx += NTHREADS) {
        const int b = idx >> 11, j = idx & 2047; float s = b_ada[j];
#pragma unroll
        for (int q = 0; q < 8; ++q) s += modp[(size_t)q * 2 * 3072 + b * 3072 + j];
        if (j < 1024) s_tab[b * 1024 + j] = s; else a_tab[b * 1024 + j - 1024] = nw[j - 1024] * (1.f + s);
    }
    if (blockIdx.x == 0) {
        float* modf = (float*)(p.ws + WS_MODF);
        for (int idx = tid; idx < 2 * 1024; idx += NTHREADS) {
            const int b = idx >> 10, j = idx & 1023; float s = b_ada[2048 + j];
#pragma unroll
            for (int q = 0; q < 8; ++q) s += modp[(size_t)q * 2 * 3072 + b * 3072 + 2048 + j];
            modf[b * 1024 + j] = s;
        }
    }
    __syncthreads();
    bf16_t* H = (bf16_t*)(p.ws + 0 * UNIT);
    for (int m0 = gw; m0 < M; m0 += 2 * NGW) {
        const int m1 = m0 + NGW < M ? m0 + NGW : m0;
        f32x4 v[2][4]; float s[2] = {0.f, 0.f};
#pragma unroll
        for (int u = 0; u < 2; ++u) { const f32x4* xr = (const f32x4*)(p.in[0] + (size_t)(u ? m1 : m0) * D) + lane;
#pragma unroll
            for (int j = 0; j < 4; ++j) v[u][j] = xr[64 * j]; }
#pragma unroll
        for (int u = 0; u < 2; ++u) {
#pragma unroll
            for (int j = 0; j < 4; ++j) s[u] += (v[u][j].x * v[u][j].x + v[u][j].y * v[u][j].y) + (v[u][j].z * v[u][j].z + v[u][j].w * v[u][j].w);
            const int m = u ? m1 : m0; const int b = m / SEQ;
            const float rstd = rsqrtf(wave_sum(s[u]) * (1.f / D) + NORM_EPS);
            u32x2* o = (u32x2*)(H + (size_t)m * D) + lane;
#pragma unroll
            for (int j = 0; j < 4; ++j) {
                const f32x4 a = *(const f32x4*)(a_tab + b * 1024 + 4 * lane + 256 * j), sh = *(const f32x4*)(s_tab + b * 1024 + 4 * lane + 256 * j);
                const f32x4 hh = v[u][j] * rstd * a + sh;
                u32x2 w; w.x = cvt_pk_bf16(hh.x, hh.y); w.y = cvt_pk_bf16(hh.z, hh.w); o[64 * j] = w;
            }
        }
    }
    __syncthreads();
}
DI void ab_item(const Params& p, int item, int lane) {
    unsigned char* ws = p.ws; const int il = lane & 15, q = lane >> 4;
    const bf16_t* Hr = (const bf16_t*)(ws + 0 * UNIT) + (size_t)(item * 16 + il) * D + 8 * q;
    const bf16_t* W0 = (const bf16_t*)(ws + WS_WIN) + (size_t)(10240 + il) * D + 8 * q; const bf16_t* W1 = W0 + (size_t)16 * D;
    f32x4 a0 = {0.f, 0.f, 0.f, 0.f}, a1 = {0.f, 0.f, 0.f, 0.f};
#pragma unroll 8
    for (int ks = 0; ks < 32; ++ks) { const bf16x8 hf = *(const bf16x8*)(Hr + 32 * ks);
        a0 = __builtin_amdgcn_mfma_f32_16x16x32_bf16(hf, *(const bf16x8*)(W0 + 32 * ks), a0, 0, 0, 0); a1 = __builtin_amdgcn_mfma_f32_16x16x32_bf16(hf, *(const bf16x8*)(W1 + 32 * ks), a1, 0, 0, 0); }
    float* AB = (float*)(ws + WS_AB) + (size_t)(item * 16 + 4 * q) * 32 + il;
#pragma unroll
    for (int r = 0; r < 4; ++r) { AB[r * 32] = a0[r]; AB[r * 32 + 16] = a1[r]; }
}
DI void phase3_item(const Params& p, int item, int lane) {
    unsigned char* ws = p.ws;
    const bf16_t* Qr = (const bf16_t*)(ws + 1 * UNIT); const bf16_t* Kr = (const bf16_t*)(ws + 2 * UNIT); const bf16_t* Vr = (const bf16_t*)(ws + 3 * UNIT);
    bf16_t* Qn = (bf16_t*)(ws + 4 * UNIT); bf16_t* Kn = (bf16_t*)(ws + 5 * UNIT); bf16_t* Vc = (bf16_t*)p.out;
    const int tg = item & 255, h = (item >> 8) & 7, b = item >> 11; const int t_base = tg * 32; const size_t rb = (size_t)b * SEQ;
    const int col = h * 128 + 2 * lane; const int pcol = h * 128 + permpos(2 * lane);
    const float* cw = p.in[7];
    f32x2 wq[5], wk[5], wv[5];
#pragma unroll
    for (int j = 0; j < 5; ++j) { wq[j] = *(const f32x2*)(cw + j * 3072 + col); wk[j] = *(const f32x2*)(cw + j * 3072 + 1024 + col); wv[j] = *(const f32x2*)(cw + j * 3072 + 2048 + col); }
#pragma unroll
    for (int hf = 0; hf < 2; ++hf) {
        unsigned rq[20], rk[20], rv[20];
#pragma unroll
        for (int j = 0; j < 20; ++j) {
            const int t = t_base + 16 * hf - 2 + j; const bool ok = (t >= 0) && (t < SEQ); const int tc = t < 0 ? 0 : (t >= SEQ ? SEQ - 1 : t);
            const size_t off = (rb + tc) * D + col;
            const unsigned a0 = *(const unsigned*)(Qr + off), a1 = *(const unsigned*)(Kr + off), a2 = *(const unsigned*)(Vr + off);
            rq[j] = ok ? a0 : 0u; rk[j] = ok ? a1 : 0u; rv[j] = ok ? a2 : 0u;
        }
#pragma unroll
        for (int t16 = 0; t16 < 16; ++t16) {
            const int tt = 16 * hf + t16, t = t_base + tt;
            float q0 = 0.f, q1 = 0.f, k0 = 0.f, k1 = 0.f, v0 = 0.f, v1 = 0.f;
#pragma unroll
            for (int j = 0; j < 5; ++j) { q0 += wq[j].x * bf_lo(rq[t16 + j]); q1 += wq[j].y * bf_hi(rq[t16 + j]); k0 += wk[j].x * bf_lo(rk[t16 + j]); k1 += wk[j].y * bf_hi(rk[t16 + j]); v0 += wv[j].x * bf_lo(rv[t16 + j]); v1 += wv[j].y * bf_hi(rv[t16 + j]); }
            q0 = siluf_(q0); q1 = siluf_(q1); k0 = siluf_(k0); k1 = siluf_(k1); v0 = siluf_(v0); v1 = siluf_(v1);
            const float rq_ = rsqrtf(wave_sum(q0 * q0 + q1 * q1) + L2_EPS) * 0.08838834764831845f, rk_ = rsqrtf(wave_sum(k0 * k0 + k1 * k1) + L2_EPS);
            q0 *= rq_; q1 *= rq_; k0 *= rk_; k1 *= rk_;
            const size_t ro = (rb + t) * D;
            *(unsigned*)(Qn + ro + pcol) = cvt_pk_bf16(q0, q1); *(unsigned*)(Kn + ro + pcol) = cvt_pk_bf16(k0, k1); *(unsigned*)(Vc + ro + col) = cvt_pk_bf16(v0, v1);
        }
    }
    { const int i = lane & 31, dir = lane >> 5; const size_t row = rb + t_base + i; const float* AB = (const float*)(ws + WS_AB);
      const float a_raw = AB[row * 32 + dir * 8 + h], b_raw = AB[row * 32 + 16 + dir * 8 + h];
      const float g = -__expf(p.in[8][dir * 8 + h]) * softplusf_(a_raw + p.in[9][dir * 8 + h]);
      ((float*)(ws + WS_G))[row * 16 + dir * 8 + h] = g; ((float*)(ws + WS_BETA))[row * 16 + dir * 8 + h] = sigmoidf_(b_raw); }
}
DI void naive_scan(const Params& p, float* ldsw, int task, int lane) {
    unsigned char* ws = p.ws;
    const bf16_t* Qn = (const bf16_t*)(ws + 4 * UNIT); const bf16_t* Kn = (const bf16_t*)(ws + 5 * UNIT); const bf16_t* Vc = (const bf16_t*)p.out;
    const float* G = (const float*)(ws + WS_G); const float* BE = (const float*)(ws + WS_BETA);
    const int chain = task >> 1, b = chain >> 4, dir = (chain >> 3) & 1, h = chain & 7, e = (task & 1) * 64 + lane;
    bf16_t* O = (dir ? (bf16_t*)(p.out) + (size_t)M * D : (bf16_t*)(ws + 3 * UNIT));
    float* kb = ldsw; float* qb = ldsw + 128;
    float P[128];
#pragma unroll
    for (int d = 0; d < 128; ++d) P[d] = 0.f;
    for (int n = 0; n < SEQ; ++n) {
        const int t = dir ? SEQ - 1 - n : n; const size_t row = (size_t)b * SEQ + t;
        const unsigned ku = *(const unsigned*)(Kn + row * D + h * 128 + 2 * lane), qu = *(const unsigned*)(Qn + row * D + h * 128 + 2 * lane);
        const float v = bf1(Vc[row * D + h * 128 + e]); const float al = __expf(G[row * 16 + dir * 8 + h]), be = BE[row * 16 + dir * 8 + h];
        kb[2 * lane] = bf_lo(ku); kb[2 * lane + 1] = bf_hi(ku); qb[2 * lane] = bf_lo(qu); qb[2 * lane + 1] = bf_hi(qu);
        asm volatile("s_waitcnt lgkmcnt(0)" ::: "memory");
        float sk = 0.f;
#pragma unroll
        for (int d4 = 0; d4 < 32; ++d4) { if ((d4 & 3) == 0) __builtin_amdgcn_sched_barrier(0); const f32x4 k4 = *(const f32x4*)(kb + 4 * d4); sk += P[4 * d4] * k4.x + P[4 * d4 + 1] * k4.y + P[4 * d4 + 2] * k4.z + P[4 * d4 + 3] * k4.w; }
        const float vn = be * (v - al * sk); float o = 0.f;
#pragma unroll
        for (int d4 = 0; d4 < 32; ++d4) { if ((d4 & 3) == 0) __builtin_amdgcn_sched_barrier(0); const f32x4 k4 = *(const f32x4*)(kb + 4 * d4), q4 = *(const f32x4*)(qb + 4 * d4);
            P[4 * d4] = al * P[4 * d4] + k4.x * vn; P[4 * d4 + 1] = al * P[4 * d4 + 1] + k4.y * vn; P[4 * d4 + 2] = al * P[4 * d4 + 2] + k4.z * vn; P[4 * d4 + 3] = al * P[4 * d4 + 3] + k4.w * vn;
            o += P[4 * d4] * q4.x + P[4 * d4 + 1] * q4.y + P[4 * d4 + 2] * q4.z + P[4 * d4 + 3] * q4.w; }
        O[row * D + h * 128 + e] = (bf16_t)(cvt_pk_bf16(o, 0.f) & 0xffffu);
        asm volatile("s_waitcnt lgkmcnt(0)" ::: "memory");
    }
}
DI void ya_acc(float (&acc)[8], const u32x4& pv, const f32x4& wa, const f32x4& wb) {
    acc[0] += wa.x * bf_lo(pv.x); acc[1] += wa.y * bf_hi(pv.x); acc[2] += wa.z * bf_lo(pv.y); acc[3] += wa.w * bf_hi(pv.y);
    acc[4] += wb.x * bf_lo(pv.z); acc[5] += wb.y * bf_hi(pv.z); acc[6] += wb.z * bf_lo(pv.w); acc[7] += wb.w * bf_hi(pv.w);
}
DI void phase7(const Params& p, int gw, int NGW, int lane, int gtid, int NGT) {
    unsigned char* ws = p.ws;
    const bf16_t* Pb = (const bf16_t*)(ws + 1 * UNIT); bf16_t* R = (bf16_t*)(ws + 2 * UNIT); const float* cw = p.in[6];
    for (int it = gtid; it < (M / 4) * 128; it += NGT) {
        const int row0 = (it >> 7) * 4, c8 = (it & 127) * 8, t0 = row0 & (SEQ - 1);
        const u32x4 z = (u32x4){0u, 0u, 0u, 0u};
        u32x4 pv[6], rv[4];
        { const u32x4 t_ = *(const u32x4*)(Pb + (size_t)(t0 > 0 ? row0 - 1 : row0) * D + c8); pv[0] = t0 > 0 ? t_ : z; }
#pragma unroll
        for (int j = 0; j < 4; ++j) { pv[j + 1] = *(const u32x4*)(Pb + (size_t)(row0 + j) * D + c8); rv[j] = *(const u32x4*)(R + (size_t)(row0 + j) * D + c8); }
        { const u32x4 t_ = *(const u32x4*)(Pb + (size_t)(t0 + 4 < SEQ ? row0 + 4 : row0) * D + c8); pv[5] = t0 + 4 < SEQ ? t_ : z; }
        f32x4 wa[3], wb[3];
#pragma unroll
        for (int j = 0; j < 3; ++j) { wa[j] = *(const f32x4*)(cw + j * D + c8); wb[j] = *(const f32x4*)(cw + j * D + c8 + 4); }
#pragma unroll
        for (int j = 0; j < 4; ++j) {
            float acc[8] = {0.f, 0.f, 0.f, 0.f, 0.f, 0.f, 0.f, 0.f};
            ya_acc(acc, pv[j], wa[0], wb[0]); ya_acc(acc, pv[j + 1], wa[1], wb[1]); ya_acc(acc, pv[j + 2], wa[2], wb[2]);
            u32x4 o; const u32x4 r = rv[j];
            o.x = cvt_pk_bf16(bf_lo(r.x) * acc[0], bf_hi(r.x) * acc[1]); o.y = cvt_pk_bf16(bf_lo(r.y) * acc[2], bf_hi(r.y) * acc[3]);
            o.z = cvt_pk_bf16(bf_lo(r.z) * acc[4], bf_hi(r.z) * acc[5]); o.w = cvt_pk_bf16(bf_lo(r.w) * acc[6], bf_hi(r.w) * acc[7]);
            *(u32x4*)(R + (size_t)(row0 + j) * D + c8) = o;
        }
    }
    const bf16_t* Of = (const bf16_t*)(ws + 3 * UNIT); const bf16_t* Ob = (const bf16_t*)p.out + (size_t)M * D; bf16_t* SZ = (bf16_t*)(ws + 6 * UNIT);
    const f32x4 g0 = *(const f32x4*)(p.in[10] + (lane & 15) * 8), g1 = *(const f32x4*)(p.in[10] + (lane & 15) * 8 + 4);
    for (int rp = gw; rp < M / 2; rp += NGW) {
        u32x4 a[4], bb[4], zz[4];
#pragma unroll
        for (int u = 0; u < 4; ++u) { const size_t off = (size_t)(rp * 2 + (u >> 1)) * D + (u & 1) * 512 + lane * 8;
            a[u] = *(const u32x4*)(Of + off); bb[u] = *(const u32x4*)(Ob + off); zz[u] = *(const u32x4*)(SZ + off); }
#pragma unroll
        for (int u = 0; u < 4; ++u) { const size_t off = (size_t)(rp * 2 + (u >> 1)) * D + (u & 1) * 512 + lane * 8;
            float o[8];
            o[0] = bf_lo(a[u].x) + bf_lo(bb[u].x); o[1] = bf_hi(a[u].x) + bf_hi(bb[u].x); o[2] = bf_lo(a[u].y) + bf_lo(bb[u].y); o[3] = bf_hi(a[u].y) + bf_hi(bb[u].y);
            o[4] = bf_lo(a[u].z) + bf_lo(bb[u].z); o[5] = bf_hi(a[u].z) + bf_hi(bb[u].z); o[6] = bf_lo(a[u].w) + bf_lo(bb[u].w); o[7] = bf_hi(a[u].w) + bf_hi(bb[u].w);
            float ss = 0.f;
#pragma unroll
            for (int j = 0; j < 8; ++j) ss += o[j] * o[j];
            ss = row16_sum(ss);
            const float rs = rsqrtf(ss * (1.f / 128.f) + NORM_EPS);
            u32x4 w;
            w.x = cvt_pk_bf16(o[0] * rs * g0.x * bf_lo(zz[u].x), o[1] * rs * g0.y * bf_hi(zz[u].x)); w.y = cvt_pk_bf16(o[2] * rs * g0.z * bf_lo(zz[u].y), o[3] * rs * g0.w * bf_hi(zz[u].y));
            w.z = cvt_pk_bf16(o[4] * rs * g1.x * bf_lo(zz[u].z), o[5] * rs * g1.y * bf_hi(zz[u].z)); w.w = cvt_pk_bf16(o[6] * rs * g1.z * bf_lo(zz[u].w), o[7] * rs * g1.w * bf_hi(zz[u].w));
            *(u32x4*)(SZ + off) = w;
        }
    }
}
DI void phase10(const Params& p, int gw, int NGW, int lane) {
    const float* XN = (const float*)(p.ws + 0 * UNIT); const float* fw = p.in[14];
    f32x4 w[4];
#pragma unroll
    for (int j = 0; j < 4; ++j) w[j] = *((const f32x4*)fw + lane + 64 * j);
    for (int m = gw; m < M; m += NGW) {
        const f32x4* xr = (const f32x4*)(XN + (size_t)m * D) + lane; f32x4 v[4]; float s = 0.f;
#pragma unroll
        for (int j = 0; j < 4; ++j) { v[j] = xr[64 * j]; s += (v[j].x * v[j].x + v[j].y * v[j].y) + (v[j].z * v[j].z + v[j].w * v[j].w); }
        const float rstd = rsqrtf(wave_sum(s) * (1.f / D) + NORM_EPS);
        f32x4* o = (f32x4*)(p.out + (size_t)m * D) + lane;
#pragma unroll
        for (int j = 0; j < 4; ++j) o[64 * j] = v[j] * rstd * w[j];
    }
}
#define MFMA16(a, b, c) __builtin_amdgcn_mfma_f32_16x16x32_bf16((a), (b), (c), 0, 0, 0)
DI void chunk_prep_item(const Params& p, float* Lm, int item, int lane) {
    unsigned char* ws = p.ws;
    const bf16_t* Qn = (const bf16_t*)(ws + 4 * UNIT); const bf16_t* Kn = (const bf16_t*)(ws + 5 * UNIT);
    bf16_t* TF = (bf16_t*)(ws + 1 * UNIT) + (size_t)item * 4096; bf16_t* AF = (bf16_t*)(ws + 2 * UNIT) + (size_t)item * 4096;
    float* csc = (float*)(ws + WS_CSC) + (size_t)item * 192;
    const int c = item & 127, h = (item >> 7) & 7, dir = (item >> 10) & 1, b = item >> 11;
    const size_t rb = (size_t)b * SEQ + c * 64; const int il = lane & 15, q = lane >> 4;
    const int tl = dir ? 63 - lane : lane;
    const float g = ((const float*)(ws + WS_G))[(rb + tl) * 16 + dir * 8 + h], be = ((const float*)(ws + WS_BETA))[(rb + tl) * 16 + dir * 8 + h];
    float gc = g;
#pragma unroll
    for (int o = 1; o < 64; o <<= 1) { const float v = __shfl_up(gc, o); if (lane >= o) gc += v; }
    const float gl = __shfl(gc, 63);
    csc[tl] = __expf(gc); csc[64 + tl] = be; csc[128 + tl] = __expf(gl - gc);
    float gcr[4][4], ber[4][4], gcc[4];
#pragma unroll
    for (int t = 0; t < 4; ++t) { gcc[t] = __shfl(gc, 16 * t + il);
#pragma unroll
        for (int r = 0; r < 4; ++r) { gcr[t][r] = __shfl(gc, 16 * t + 4 * q + r); ber[t][r] = __shfl(be, 16 * t + 4 * q + r); } }
    bf16x8 Kf[4][4];
#pragma unroll
    for (int rt = 0; rt < 4; ++rt) { const int ip = 16 * rt + il; const size_t ro = (rb + (dir ? 63 - ip : ip)) * D + h * 128 + 8 * q;
#pragma unroll
        for (int ks = 0; ks < 4; ++ks) Kf[rt][ks] = *(const bf16x8*)(Kn + ro + 32 * ks); }
#pragma unroll
    for (int it = 0; it < 4; ++it)
#pragma unroll
        for (int jt = 0; jt <= it; ++jt) {
            f32x4 acc = {0.f, 0.f, 0.f, 0.f};
#pragma unroll
            for (int ks = 0; ks < 4; ++ks) acc = MFMA16(Kf[it][ks], Kf[jt][ks], acc);
#pragma unroll
            for (int r = 0; r < 4; ++r) { const int ip = 16 * it + 4 * q + r, jp = 16 * jt + il;
                Lm[ip * 64 + jp] = ip > jp ? ber[it][r] * acc[r] * __expf(gcr[it][r] - gcc[jt]) : 0.f; }
        }
    __builtin_amdgcn_sched_barrier(0);
    bf16x8 Qnext[4];
    { const int ip = il; const size_t ro = (rb + (dir ? 63 - ip : ip)) * D + h * 128 + 8 * q;
#pragma unroll
      for (int ks = 0; ks < 4; ++ks) Qnext[ks] = *(const bf16x8*)(Qn + ro + 32 * ks); }
#pragma unroll
    for (int mt = 0; mt < 4; ++mt) {
        bf16x8 Qf[4];
#pragma unroll
        for (int ks = 0; ks < 4; ++ks) Qf[ks] = Qnext[ks];
        if (mt < 3) { const int ip = 16 * (mt + 1) + il; const size_t ro = (rb + (dir ? 63 - ip : ip)) * D + h * 128 + 8 * q;
#pragma unroll
          for (int ks = 0; ks < 4; ++ks) Qnext[ks] = *(const bf16x8*)(Qn + ro + 32 * ks); }
#pragma unroll
        for (int ks2 = 0; ks2 < 2; ++ks2) {
            float vals[8];
#pragma unroll
            for (int a = 0; a < 2; ++a) { const int jt = 2 * ks2 + a; f32x4 acc = {0.f, 0.f, 0.f, 0.f};
#pragma unroll
                for (int ks = 0; ks < 4; ++ks) acc = MFMA16(Kf[jt][ks], Qf[ks], acc);
#pragma unroll
                for (int r = 0; r < 4; ++r) { const int jp = 16 * jt + 4 * q + r, ip = 16 * mt + il; vals[4 * a + r] = ip >= jp ? acc[r] * __expf(gcc[mt] - gcr[jt][r]) : 0.f; } }
            u32x4 w;
            if (dir) { w.x = cvt_pk_bf16(vals[7], vals[6]); w.y = cvt_pk_bf16(vals[5], vals[4]); w.z = cvt_pk_bf16(vals[3], vals[2]); w.w = cvt_pk_bf16(vals[1], vals[0]); }
            else { w.x = cvt_pk_bf16(vals[0], vals[1]); w.y = cvt_pk_bf16(vals[2], vals[3]); w.z = cvt_pk_bf16(vals[4], vals[5]); w.w = cvt_pk_bf16(vals[6], vals[7]); }
            const int fi = dir ? ((3 - mt) * 2 + (1 - ks2)) : (mt * 2 + ks2), ln = dir ? ((3 - q) * 16 + (15 - il)) : lane;
            *(u32x4*)(AF + (size_t)(fi * 64 + ln) * 8) = w;
        }
        __builtin_amdgcn_sched_barrier(0);
    }
    asm volatile("s_waitcnt lgkmcnt(0)" ::: "memory");
    __builtin_amdgcn_sched_barrier(0);
    float T[64];
#pragma unroll
    for (int i = 0; i < 64; ++i) {
        float s0 = (lane == i) ? 1.f : 0.f, s1 = 0.f;
#pragma unroll
        for (int m4 = 0; m4 < (i + 3) / 4; ++m4) {
            const f32x4 l4 = *(const f32x4*)(Lm + i * 64 + 4 * m4);
            if (4 * m4 + 0 < i) s0 -= l4.x * T[4 * m4 + 0];
            if (4 * m4 + 1 < i) s1 -= l4.y * T[4 * m4 + 1];
            if (4 * m4 + 2 < i) s0 -= l4.z * T[4 * m4 + 2];
            if (4 * m4 + 3 < i) s1 -= l4.w * T[4 * m4 + 3];
        }
        T[i] = s0 + s1;
        if ((i & 3) == 3) __builtin_amdgcn_sched_barrier(0);
    }
    asm volatile("s_waitcnt lgkmcnt(0)" ::: "memory");
    bf16_t* TL = (bf16_t*)Lm;
#pragma unroll
    for (int i = 0; i < 64; ++i) TL[i * 72 + lane] = (bf16_t)(cvt_pk_bf16(T[i], 0.f) & 0xffffu);
    asm volatile("s_waitcnt lgkmcnt(0)" ::: "memory");
#pragma unroll
    for (int mt = 0; mt < 4; ++mt)
#pragma unroll
        for (int ks2 = 0; ks2 < 2; ++ks2) {
            u32x4 w;
            if (dir) {
                const int row = 63 - 16 * mt - il;
                const u32x2 lo = *(const u32x2*)(TL + row * 72 + (60 - 32 * ks2 - 4 * q)), hi = *(const u32x2*)(TL + row * 72 + (44 - 32 * ks2 - 4 * q));
                w.x = (lo.y >> 16) | (lo.y << 16); w.y = (lo.x >> 16) | (lo.x << 16); w.z = (hi.y >> 16) | (hi.y << 16); w.w = (hi.x >> 16) | (hi.x << 16);
            } else {
                const int row = 16 * mt + il;
                const u32x2 lo = *(const u32x2*)(TL + row * 72 + (32 * ks2 + 4 * q)), hi = *(const u32x2*)(TL + row * 72 + (32 * ks2 + 16 + 4 * q));
                w.x = lo.x; w.y = lo.y; w.z = hi.x; w.w = hi.y;
            }
            *(u32x4*)(TF + (size_t)((mt * 2 + ks2) * 64 + lane) * 8) = w;
        }
    asm volatile("s_waitcnt lgkmcnt(0)" ::: "memory");
}
DI bf16x8 pack8(const f32x4& a, const f32x4& b) {
    u32x4 w; w.x = cvt_pk_bf16(a[0], a[1]); w.y = cvt_pk_bf16(a[2], a[3]); w.z = cvt_pk_bf16(b[0], b[1]); w.w = cvt_pk_bf16(b[2], b[3]);
    return __builtin_bit_cast(bf16x8, w);
}
DI void mfma_scan(const Params& p, int chain, int slice, int lane) {
    unsigned char* ws = p.ws;
    const bf16_t* Qn = (const bf16_t*)(ws + 4 * UNIT); const bf16_t* Kn = (const bf16_t*)(ws + 5 * UNIT); const bf16_t* KT = (const bf16_t*)(ws + 6 * UNIT); const bf16_t* Vc = (const bf16_t*)p.out;
    const bf16_t* TFb = (const bf16_t*)(ws + 1 * UNIT); const bf16_t* AFb = (const bf16_t*)(ws + 2 * UNIT); const float* cscb = (const float*)(ws + WS_CSC);
    const int b = chain >> 4, dir = (chain >> 3) & 1, h = chain & 7, il = lane & 15, q = lane >> 4;
    bf16_t* O = (dir ? (bf16_t*)(p.out) + (size_t)M * D : (bf16_t*)(ws + 3 * UNIT));
    f32x4 S[8];
#pragma unroll
    for (int dt = 0; dt < 8; ++dt) S[dt] = (f32x4){0.f, 0.f, 0.f, 0.f};
    for (int n = 0; n < 128; ++n) {
        const int c = dir ? 127 - n : n; const int item = chain * 128 + c; const size_t rowbase = (size_t)b * SEQ + c * 64;
        const bf16_t* TF = TFb + (size_t)item * 4096 + lane * 8; const bf16_t* AF = AFb + (size_t)item * 4096 + lane * 8; const float* csc = cscb + (size_t)item * 192;
        const float gl = csc[dir ? 0 : 63];
        f32x4 EG[4], BE[4], EK[4], V[4];
#pragma unroll
        for (int mt = 0; mt < 4; ++mt) { EG[mt] = *(const f32x4*)(csc + 16 * mt + 4 * q); BE[mt] = *(const f32x4*)(csc + 64 + 16 * mt + 4 * q); EK[mt] = *(const f32x4*)(csc + 128 + 16 * mt + 4 * q);
#pragma unroll
            for (int r = 0; r < 4; ++r) V[mt][r] = bf1(Vc[(rowbase + 16 * mt + 4 * q + r) * D + h * 128 + 16 * slice + il]); }
        bf16x8 Sb[4];
#pragma unroll
        for (int ks = 0; ks < 4; ++ks) Sb[ks] = pack8(S[2 * ks], S[2 * ks + 1]);
        f32x4 KS[4], QS[4];
#pragma unroll
        for (int mt = 0; mt < 4; ++mt) { const size_t ro = (rowbase + 16 * mt + il) * D + h * 128 + 8 * q;
            KS[mt] = (f32x4){0.f, 0.f, 0.f, 0.f}; QS[mt] = (f32x4){0.f, 0.f, 0.f, 0.f};
#pragma unroll
            for (int ks = 0; ks < 4; ++ks) { KS[mt] = MFMA16(*(const bf16x8*)(Kn + ro + 32 * ks), Sb[ks], KS[mt]); QS[mt] = MFMA16(*(const bf16x8*)(Qn + ro + 32 * ks), Sb[ks], QS[mt]); } }
        f32x4 X[4];
#pragma unroll
        for (int mt = 0; mt < 4; ++mt) X[mt] = BE[mt] * (V[mt] - EG[mt] * KS[mt]);
        bf16x8 Xb[2] = {pack8(X[0], X[1]), pack8(X[2], X[3])};
        f32x4 VN[4];
#pragma unroll
        for (int mt = 0; mt < 4; ++mt) { VN[mt] = (f32x4){0.f, 0.f, 0.f, 0.f};
#pragma unroll
            for (int ks2 = 0; ks2 < 2; ++ks2) VN[mt] = MFMA16(*(const bf16x8*)(TF + (size_t)((mt * 2 + ks2) * 64) * 8), Xb[ks2], VN[mt]); }
        bf16x8 VNb[2] = {pack8(VN[0], VN[1]), pack8(VN[2], VN[3])};
        bf16x8 VNs[2] = {pack8(VN[0] * EK[0], VN[1] * EK[1]), pack8(VN[2] * EK[2], VN[3] * EK[3])};
#pragma unroll
        for (int mt = 0; mt < 4; ++mt) { f32x4 o = EG[mt] * QS[mt];
#pragma unroll
            for (int ks2 = 0; ks2 < 2; ++ks2) o = MFMA16(*(const bf16x8*)(AF + (size_t)((mt * 2 + ks2) * 64) * 8), VNb[ks2], o);
#pragma unroll
            for (int r = 0; r < 4; ++r) O[(rowbase + 16 * mt + 4 * q + r) * D + h * 128 + 16 * slice + il] = (bf16_t)(cvt_pk_bf16(o[r], 0.f) & 0xffffu); }
#pragma unroll
        for (int dt = 0; dt < 8; ++dt) { const bf16_t* kt = KT + ((size_t)((b * 8 + h) * 128 + 16 * dt + il)) * SEQ + c * 64 + 8 * q; f32x4 s = S[dt] * gl;
#pragma unroll
            for (int ks2 = 0; ks2 < 2; ++ks2) s = MFMA16(*(const bf16x8*)(kt + 32 * ks2), VNs[ks2], s);
            S[dt] = s; }
    }
}
constexpr int SC_K = 0, SC_Q = 16384, SC_T = 32768, SC_A = 40960, SC_V = 49152, SC_C = 51200, SC_BUF = 52224, SC_NPIECE = 3248, SC_NLD = 384, SC_PPL = 9;
constexpr int SC_SB = 2 * SC_BUF, SC_VB = SC_SB + 2 * 4096, SC_END = SC_VB + 2 * 2048;
static_assert(SC_END <= LDS_BYTES - 256, "scan LDS");
typedef short s16x4_t __attribute__((ext_vector_type(4)));
#define SC_BAR() do { asm volatile("s_waitcnt lgkmcnt(0)" ::: "memory"); __builtin_amdgcn_s_barrier(); asm volatile("" ::: "memory"); } while (0)
DI void scan_task(const Params& p, PG8_LAS unsigned char* lds, int chain, int slice, int tid, int wave, int lane) {
    unsigned char* ws = p.ws;
    const int b = chain >> 4, dir = (chain >> 3) & 1, h = chain & 7, il = lane & 15, q = lane >> 4;
    const int c0 = dir ? 127 : 0; const long sgn = dir ? -1 : 1;
    if (wave >= 2) {
        const int lt = tid - 128; const int wbase = 64 * (wave - 2);
        const unsigned char* gp[SC_PPL]; int gstride[SC_PPL];
        const size_t rowbase0 = (size_t)b * SEQ + c0 * 64; const size_t item0 = (size_t)chain * 128 + c0;
#pragma unroll
        for (int k = 0; k < SC_PPL; ++k) {
            int pid = lt + SC_NLD * k; if (pid >= SC_NPIECE) pid -= 64;
            const unsigned char* g = ws; int st = 0;
            if (pid < 2048) { const int pp = pid & 1023, row = pp >> 4, ch = (pp & 15) ^ (row & 15);
                g = ws + (pid < 1024 ? 5 : 4) * UNIT + ((rowbase0 + row) * D + h * 128) * 2 + ch * 16; st = 64 * D * 2; }
            else if (pid < 3072) { const int pp = pid & 511; const bool isT = pid < 2560;
                g = ws + (isT ? 1 : 2) * UNIT + item0 * 8192 + pp * 16; st = 8192; }
            else if (pid < 3200) { const int pp = pid - 3072, row = pp >> 1, hf = pp & 1;
                g = (const unsigned char*)p.out + ((rowbase0 + row) * D + h * 128 + slice * 16) * 2 + hf * 16; st = 64 * D * 2; }
            else { const int pp = pid - 3200; g = ws + WS_CSC + item0 * 768 + pp * 16; st = 768; }
            gp[k] = g; gstride[k] = st;
        }
#define SC_DMA(bo) do { _Pragma("unroll") for (int k = 0; k < SC_PPL; ++k) { if (wbase + SC_NLD * k < SC_NPIECE) \
            __builtin_amdgcn_global_load_lds((const unsigned*)gp[k], (PG8_LAS unsigned*)(lds + (bo) + (wbase + SC_NLD * k) * 16), 16, 0, 0); gp[k] += sgn * gstride[k]; } } while (0)
        SC_DMA(0u);
        asm volatile("s_waitcnt vmcnt(0)" ::: "memory");
        SC_BAR();
        for (int n = 0; n < 128; ++n) {
            if (n + 1 < 128) SC_DMA((unsigned)(((n + 1) & 1) * SC_BUF));
            asm volatile("s_waitcnt vmcnt(0)" ::: "memory");
            SC_BAR();
        }
#undef SC_DMA
    } else if (wave == 0) {
        f32x4 S[8];
#pragma unroll
        for (int dt = 0; dt < 8; ++dt) S[dt] = (f32x4){0.f, 0.f, 0.f, 0.f};
        bf16x8 Sb[4];
#pragma unroll
        for (int ks = 0; ks < 4; ++ks) { Sb[ks] = pack8(S[2 * ks], S[2 * ks + 1]); *(PG8_LAS bf16x8*)(lds + SC_SB + (ks * 64 + lane) * 16) = Sb[ks]; }
        SC_BAR();
        for (int n = 0; n < 128; ++n) {
            PG8_LAS unsigned char* L = lds + (n & 1) * SC_BUF;
            bf16x8 Kf[4][4];
#pragma unroll
            for (int mt = 0; mt < 4; ++mt)
#pragma unroll
                for (int ks = 0; ks < 4; ++ks) Kf[mt][ks] = *(PG8_LAS bf16x8*)(L + SC_K + (16 * mt + il) * 256 + (((4 * ks + q) ^ il) << 4));
            f32x4 KS[4];
#pragma unroll
            for (int mt = 0; mt < 4; ++mt) KS[mt] = (f32x4){0.f, 0.f, 0.f, 0.f};
            __builtin_amdgcn_sched_barrier(0);
#pragma unroll
            for (int ks = 0; ks < 2; ++ks)
#pragma unroll
                for (int mt = 0; mt < 4; ++mt) KS[mt] = MFMA16(Kf[mt][ks], Sb[ks], KS[mt]);
            f32x4 EG[4], BE[4], V[4]; bf16x8 Tf[4][2];
#pragma unroll
            for (int mt = 0; mt < 4; ++mt) { EG[mt] = *(PG8_LAS f32x4*)(L + SC_C + (16 * mt + 4 * q) * 4); BE[mt] = *(PG8_LAS f32x4*)(L + SC_C + 256 + (16 * mt + 4 * q) * 4);
#pragma unroll
                for (int r = 0; r < 4; ++r) V[mt][r] = bf1(*(PG8_LAS bf16_t*)(L + SC_V + (16 * mt + 4 * q + r) * 32 + il * 2));
#pragma unroll
                for (int ks2 = 0; ks2 < 2; ++ks2) Tf[mt][ks2] = *(PG8_LAS bf16x8*)(L + SC_T + ((mt * 2 + ks2) * 64 + lane) * 16); }
            __builtin_amdgcn_sched_barrier(0);
#pragma unroll
            for (int ks = 2; ks < 4; ++ks)
#pragma unroll
                for (int mt = 0; mt < 4; ++mt) KS[mt] = MFMA16(Kf[mt][ks], Sb[ks], KS[mt]);
            __builtin_amdgcn_sched_barrier(0);
            bf16x8 KTf[8][2]; f32x4 EK[4];
            { const int rr = il >> 2, pc = il & 3;
              PG8_LAS unsigned char* kb = L + SC_K + (4 * q + rr) * 256;
#pragma unroll
              for (int dt = 0; dt < 8; ++dt) {
                const int cho = (((4 * (dt >> 1) + pc) ^ (4 * q + rr)) << 4) + 8 * (dt & 1);
#pragma unroll
                for (int ks2 = 0; ks2 < 2; ++ks2) {
                    const s16x4_t lo_ = __builtin_amdgcn_ds_read_tr16_b64_v4i16((PG8_LAS s16x4_t*)(kb + (32 * ks2) * 256 + cho));
                    const s16x4_t hi_ = __builtin_amdgcn_ds_read_tr16_b64_v4i16((PG8_LAS s16x4_t*)(kb + (32 * ks2 + 16) * 256 + cho));
                    KTf[dt][ks2] = __builtin_shufflevector(lo_, hi_, 0, 1, 2, 3, 4, 5, 6, 7);
                } } }
#pragma unroll
            for (int mt = 0; mt < 4; ++mt) EK[mt] = *(PG8_LAS f32x4*)(L + SC_C + 512 + (16 * mt + 4 * q) * 4);
            const float gl = *(PG8_LAS float*)(L + SC_C + (dir ? 0 : 63) * 4);
            f32x4 X[4];
#pragma unroll
            for (int mt = 0; mt < 4; ++mt) X[mt] = BE[mt] * (V[mt] - EG[mt] * KS[mt]);
            bf16x8 Xb[2] = {pack8(X[0], X[1]), pack8(X[2], X[3])};
            f32x4 VN[4];
#pragma unroll
            for (int mt = 0; mt < 4; ++mt) VN[mt] = (f32x4){0.f, 0.f, 0.f, 0.f};
#pragma unroll
            for (int ks2 = 0; ks2 < 2; ++ks2)
#pragma unroll
                for (int mt = 0; mt < 4; ++mt) VN[mt] = MFMA16(Tf[mt][ks2], Xb[ks2], VN[mt]);
            *(PG8_LAS bf16x8*)(lds + SC_VB + (n & 1) * 2048 + lane * 16) = pack8(VN[0], VN[1]); *(PG8_LAS bf16x8*)(lds + SC_VB + (n & 1) * 2048 + (64 + lane) * 16) = pack8(VN[2], VN[3]);
            bf16x8 VNs[2] = {pack8(VN[0] * EK[0], VN[1] * EK[1]), pack8(VN[2] * EK[2], VN[3] * EK[3])};
#pragma unroll
            for (int dt = 0; dt < 8; ++dt) S[dt] = S[dt] * gl;
#pragma unroll
            for (int ks2 = 0; ks2 < 2; ++ks2)
#pragma unroll
                for (int dt = 0; dt < 8; ++dt) S[dt] = MFMA16(KTf[dt][ks2], VNs[ks2], S[dt]);
#pragma unroll
            for (int ks = 0; ks < 4; ++ks) { Sb[ks] = pack8(S[2 * ks], S[2 * ks + 1]); *(PG8_LAS bf16x8*)(lds + SC_SB + ((n + 1) & 1) * 4096 + (ks * 64 + lane) * 16) = Sb[ks]; }
            SC_BAR();
        }
    } else {
        bf16_t* O = (dir ? (bf16_t*)(p.out) + (size_t)M * D : (bf16_t*)(ws + 3 * UNIT));
        f32x4 Oa[4]; bf16x8 Af[4][2];
#pragma unroll
        for (int mt = 0; mt < 4; ++mt) { Oa[mt] = (f32x4){0.f, 0.f, 0.f, 0.f}; Af[mt][0] = (bf16x8){0, 0, 0, 0, 0, 0, 0, 0}; Af[mt][1] = Af[mt][0]; }
        SC_BAR();
        for (int n = 0; n <= 128; ++n) {
            if (n > 0) {
                const int c = dir ? 128 - n : n - 1; const size_t rowbase = (size_t)b * SEQ + c * 64;
                PG8_LAS unsigned char* vb = lds + SC_VB + ((n - 1) & 1) * 2048;
                bf16x8 VNb[2] = {*(PG8_LAS bf16x8*)(vb + lane * 16), *(PG8_LAS bf16x8*)(vb + (64 + lane) * 16)};
#pragma unroll
                for (int ks2 = 0; ks2 < 2; ++ks2)
#pragma unroll
                    for (int mt = 0; mt < 4; ++mt) Oa[mt] = MFMA16(Af[mt][ks2], VNb[ks2], Oa[mt]);
#pragma unroll
                for (int mt = 0; mt < 4; ++mt)
#pragma unroll
                    for (int r = 0; r < 4; ++r) O[(rowbase + 16 * mt + 4 * q + r) * D + h * 128 + 16 * slice + il] = (bf16_t)(cvt_pk_bf16(Oa[mt][r], 0.f) & 0xffffu);
            }
            if (n < 128) {
                PG8_LAS unsigned char* L = lds + (n & 1) * SC_BUF;
                bf16x8 Qf[4][4], Sb[4]; f32x4 EG[4];
#pragma unroll
                for (int ks = 0; ks < 4; ++ks) Sb[ks] = *(PG8_LAS bf16x8*)(lds + SC_SB + (n & 1) * 4096 + (ks * 64 + lane) * 16);
#pragma unroll
                for (int mt = 0; mt < 4; ++mt) {
#pragma unroll
                    for (int ks = 0; ks < 4; ++ks) Qf[mt][ks] = *(PG8_LAS bf16x8*)(L + SC_Q + (16 * mt + il) * 256 + (((4 * ks + q) ^ il) << 4));
                    EG[mt] = *(PG8_LAS f32x4*)(L + SC_C + (16 * mt + 4 * q) * 4);
#pragma unroll
                    for (int ks2 = 0; ks2 < 2; ++ks2) Af[mt][ks2] = *(PG8_LAS bf16x8*)(L + SC_A + ((mt * 2 + ks2) * 64 + lane) * 16); }
                f32x4 QS[4];
#pragma unroll
                for (int mt = 0; mt < 4; ++mt) QS[mt] = (f32x4){0.f, 0.f, 0.f, 0.f};
#pragma unroll
                for (int ks = 0; ks < 4; ++ks)
#pragma unroll
                    for (int mt = 0; mt < 4; ++mt) QS[mt] = MFMA16(Qf[mt][ks], Sb[ks], QS[mt]);
#pragma unroll
                for (int mt = 0; mt < 4; ++mt) Oa[mt] = EG[mt] * QS[mt];
                SC_BAR();
            }
        }
    }
}


typedef const __attribute__((address_space(4))) Params* kparams_t;
#if defined(__HIP_DEVICE_COMPILE__)
DI Params load_params() { kparams_t pp = (kparams_t)__builtin_amdgcn_kernarg_segment_ptr(); asm volatile("" : "+s"(pp)); return *pp; }
#else
DI Params load_params() { return Params{}; }
#endif
#define PP() load_params()
#define XB_TMO      128
#define XB_XCNT(j)  (256  + 64 * (j))
#define XB_XSUB(j)  (1280 + 64 * (j))
#define XB_XGEN(j)  (2304 + 64 * (j))
#define XB_TOP      3328
#define XB_TOPGEN   3392
#define XCD_BAR_WORDS 3456
#define XB_SPIN_CAP (1u << 18)
#define LAS __attribute__((address_space(3)))

__device__ __forceinline__ unsigned xb_ld(unsigned* p)              { return __hip_atomic_load(p, __ATOMIC_RELAXED, __HIP_MEMORY_SCOPE_AGENT); }
__device__ __forceinline__ unsigned xb_add(unsigned* p, unsigned v) { return __hip_atomic_fetch_add(p, v, __ATOMIC_RELAXED, __HIP_MEMORY_SCOPE_AGENT); }
__device__ __forceinline__ unsigned xb_xcc_id() { return (unsigned)__builtin_amdgcn_s_getreg((3 << 11) | 20) & 0xFu; }
#define XB_SPIN(cond, bar) do { unsigned _sp = 0; while (cond) { __builtin_amdgcn_s_sleep(1); \
    if ((++_sp & 255u) == 0u) { if (xb_ld(&(bar)[XB_TMO])) break; if (_sp > XB_SPIN_CAP) { atomicAdd(&(bar)[XB_TMO], 1u); break; } } } } while (0)

struct XcdBarrier {
    unsigned* bar; unsigned x;
    volatile LAS unsigned* st;
};

__device__ __forceinline__ XcdBarrier xcd_barrier_post(unsigned* bar, volatile LAS unsigned* st) {
    XcdBarrier b; b.bar = bar; b.x = xb_xcc_id(); b.st = st;
    if (threadIdx.x == 0) (void)xb_add(&bar[XB_XCNT(b.x)], 1u);
    return b;
}
__device__ __forceinline__ void xcd_barrier_complete(unsigned* bar, unsigned x, unsigned& nloc, unsigned& nx) {
    const unsigned G = gridDim.x * gridDim.y * gridDim.z;
    unsigned sum, cnt, mine, sp = 0u;
    for (;;) {
        sum = 0u; cnt = 0u; mine = 0u;
#pragma unroll
        for (unsigned j = 0; j < 16; ++j) { const unsigned c = xb_ld(&bar[XB_XCNT(j)]); sum += c; cnt += (c > 0u) ? 1u : 0u; mine = (j == x) ? c : mine; }
        if (sum == G) break;
        __builtin_amdgcn_s_sleep(1);
        if ((++sp & 255u) == 0u) { if (xb_ld(&bar[XB_TMO])) break; if (sp > XB_SPIN_CAP) { atomicAdd(&bar[XB_TMO], 1u); break; } }
    }
    nloc = mine > 0u ? mine : 1u; nx = cnt > 0u ? cnt : 1u;
}

__device__ __forceinline__ void xcd_barrier(const XcdBarrier& b) {
    asm volatile("s_waitcnt vmcnt(0)" ::: "memory");
    __syncthreads();
    if (threadIdx.x == 0) {
        unsigned* bar = b.bar;
        __builtin_amdgcn_s_waitcnt(0);
        unsigned nloc = b.st[0], nx = b.st[1];
        if (nloc == 0u) { xcd_barrier_complete(bar, b.x, nloc, nx); b.st[0] = nloc; b.st[1] = nx; }
        const unsigned old = xb_add(&bar[XB_XSUB(b.x)], 1u);
        const unsigned gen = old / nloc;
        if (old + 1u == (gen + 1u) * nloc) {
            __builtin_amdgcn_fence(__ATOMIC_RELEASE, "agent");
            asm volatile("s_waitcnt vmcnt(0)" ::: "memory");
            const unsigned og = xb_add(&bar[XB_TOP], 1u);
            const unsigned tg = og / nx;
            if (og + 1u == (tg + 1u) * nx) xb_add(&bar[XB_TOPGEN], 1u);
            else XB_SPIN(xb_ld(&bar[XB_TOPGEN]) == tg, bar);
            __builtin_amdgcn_fence(__ATOMIC_ACQUIRE, "agent");
            xb_add(&bar[XB_XGEN(b.x)], 1u);
            asm volatile("s_waitcnt vmcnt(0)" ::: "memory");
        } else {
            XB_SPIN(xb_ld(&bar[XB_XGEN(b.x)]) == gen, bar);
            __builtin_amdgcn_fence(__ATOMIC_ACQUIRE, "agent");
            asm volatile("s_waitcnt vmcnt(0)" ::: "memory");
        }
    }
    __syncthreads();
}


constexpr size_t WS_BAR = 255 * MiB + 320 * 1024;
DI int fresh_tid() { int t = threadIdx.x; asm volatile("" : "+v"(t)); return t; }
#define IDS const int tid = fresh_tid(), lane = tid & 63, wave = __builtin_amdgcn_readfirstlane(tid >> 6); const int G = gridDim.x, bx = blockIdx.x; \
    const int gw = bx * NWAVES + wave, NGW = G * NWAVES, gtid = bx * NTHREADS + tid, NGT = G * NTHREADS; (void)lane; (void)gw; (void)NGW; (void)gtid; (void)NGT; (void)wave;
__global__ void __launch_bounds__(NTHREADS, 2) fwd_kernel(Params p) {
    extern __shared__ __attribute__((aligned(16))) unsigned char lds[];
    cg::grid_group grid = cg::this_grid();
    PG8_LAS unsigned char* ldsl = (PG8_LAS unsigned char*)lds;
    if (threadIdx.x < 4) ((PG8_LAS unsigned*)(ldsl + (LDS_BYTES - 256)))[threadIdx.x] = 0u;
    __syncthreads();
    const XcdBarrier bar = xcd_barrier_post((unsigned*)(PP().ws + WS_BAR), (volatile PG8_LAS unsigned*)(ldsl + (LDS_BYTES - 256)));

    { IDS phase0(PP(), gw, NGW, lane); }
    if (PP().ws == nullptr) grid.sync();
    xcd_barrier(bar);
    { IDS phase1(PP(), (float*)lds, gw, NGW, lane, tid); }
    xcd_barrier(bar);
    {
        const Params q = PP(); unsigned char* ws = q.ws; bf16_t* WIN = (bf16_t*)(ws + WS_WIN); const int G = gridDim.x, bx = blockIdx.x;
        pg8::Gemm g{(const bf16_t*)(ws + 0 * UNIT), WIN + (size_t)ROWS_A * D, M, NB_TILES * 256, D}; pg8::StaticOrder S; S.init(M, NB_TILES * 256, G, bx);
        EpiB E{(bf16_t*)(ws + 1 * UNIT)};
        pg8::gemm_phase<EpiB, pg8::StaticOrder, true, true>(ldsl, g, S, E);
    }
    { IDS for (int it = gw; it < M / 16; it += NGW) ab_item(PP(), it, lane); }
    xcd_barrier(bar);
    { IDS for (int it = gw; it < 4096; it += NGW) phase3_item(PP(), it, lane); }
    xcd_barrier(bar);
    { IDS for (int it = gw; it < 4096; it += NGW) chunk_prep_item(PP(), (float*)(lds + wave * 16384), it, lane); }
    xcd_barrier(bar);
    for (int tk = blockIdx.x; tk < 256; tk += gridDim.x) { const int t2 = fresh_tid(); scan_task(PP(), ldsl, (tk & 7) + 8 * (tk >> 6), (tk >> 3) & 7, t2, __builtin_amdgcn_readfirstlane(t2 >> 6), t2 & 63); __syncthreads(); }
    xcd_barrier(bar);
    {
        const Params q = PP(); unsigned char* ws = q.ws; bf16_t* WIN = (bf16_t*)(ws + WS_WIN); const int G = gridDim.x, bx = blockIdx.x;
        pg8::Gemm g{(const bf16_t*)(ws + 0 * UNIT), WIN, M, NA_TILES * 256, D}; pg8::StaticOrder S; S.init(M, NA_TILES * 256, G, bx);
        EpiA E{(bf16_t*)(ws + 1 * UNIT), (bf16_t*)(ws + 4 * UNIT)};
        pg8::gemm_phase<EpiA, pg8::StaticOrder, true, true>(ldsl, g, S, E);
    }
    xcd_barrier(bar);
    { IDS phase7(PP(), gw, NGW, lane, gtid, NGT); }
    xcd_barrier(bar);
    if (gridDim.x == 256) {
        const Params q = PP(); unsigned char* ws = q.ws; const int G = gridDim.x, bx = blockIdx.x;
        static_assert(6 * UNIT - 2 * UNIT == (size_t)256 * 256 * D * 2 && WS_WPB - WS_WPA == (size_t)4 * 256 * D * 2, "TwoGemmOrder address arithmetic");
        TwoGemmOrder S; S.so.init(M, D, G, bx);
        pg8::Gemm g{(const bf16_t*)(ws + 2 * UNIT), (const bf16_t*)(ws + WS_WPA), M, D, D}; EpiYaYb E{(bf16_t*)(ws + 4 * UNIT), (const bf16_t*)(ws + 5 * UNIT)};
        pg8::gemm_phase<EpiYaYb, TwoGemmOrder, true, true>(ldsl, g, S, E);
    } else {
        const Params q = PP(); unsigned char* ws = q.ws; const int G = gridDim.x, bx = blockIdx.x;
        pg8::StaticOrder S; S.init(M, D, G, bx);
        { pg8::Gemm g{(const bf16_t*)(ws + 2 * UNIT), (const bf16_t*)(ws + WS_WPA), M, D, D}; EpiYa E{(bf16_t*)(ws + 4 * UNIT)};
          pg8::gemm_phase<EpiYa, pg8::StaticOrder, true, true>(ldsl, g, S, E); }
        { pg8::Gemm g{(const bf16_t*)(ws + 6 * UNIT), (const bf16_t*)(ws + WS_WPB), M, D, D}; EpiYb E{(bf16_t*)(ws + 4 * UNIT), (const bf16_t*)(ws + 5 * UNIT)};
          pg8::gemm_phase<EpiYb, pg8::StaticOrder, true, true>(ldsl, g, S, E); }
    }
    xcd_barrier(bar);
    if (gridDim.x == 256) {
        const Params q = PP(); unsigned char* ws = q.ws; const int G = gridDim.x, bx = blockIdx.x;
        pg8::Gemm g{(const bf16_t*)(ws + 4 * UNIT), (const bf16_t*)(ws + WS_WO), M, D, D}; pg8::StaticOrder S; S.init(M, D, G, bx);
        EpiOutFused E{q.in[0], (const float*)(ws + WS_MODF), q.in[14], q.out, (float*)(ws + WS_PSS), (unsigned*)(ws + WS_PCNT)};
        pg8::gemm_phase<EpiOutFused, pg8::StaticOrder, true, true>(ldsl, g, S, E);
    } else {
        {
            const Params q = PP(); unsigned char* ws = q.ws; const int G = gridDim.x, bx = blockIdx.x;
            pg8::Gemm g{(const bf16_t*)(ws + 4 * UNIT), (const bf16_t*)(ws + WS_WO), M, D, D}; pg8::StaticOrder S; S.init(M, D, G, bx);
            EpiOut E{q.in[0], (const float*)(ws + WS_MODF), (float*)(ws + 0 * UNIT)};
            pg8::gemm_phase<EpiOut, pg8::StaticOrder, true, true>(ldsl, g, S, E);
        }
        xcd_barrier(bar);
        { IDS phase10(PP(), gw, NGW, lane); }
    }
}

extern "C" void kernel_launch(void* const* d_in, const int* in_sizes, int n_in, void* d_out, int out_size, void* d_ws, size_t ws_size, hipStream_t stream) {
    static int grid = 0;
    if (grid == 0) {
        int dev = 0, cus = 0, per_cu = 0;
        if (n_in != 15 || out_size != M * D || ws_size < 256 * MiB) { fprintf(stderr, "kernel_launch: unexpected shapes (n_in %d out %d ws %zu)\n", n_in, out_size, ws_size); grid = -1; return; }
        hipGetDevice(&dev); hipDeviceGetAttribute(&cus, hipDeviceAttributeMultiprocessorCount, dev);
        if (hipFuncSetAttribute((const void*)fwd_kernel, hipFuncAttributeMaxDynamicSharedMemorySize, LDS_BYTES) != hipSuccess) { fprintf(stderr, "kernel_launch: hipFuncSetAttribute failed\n"); grid = -1; return; }
        hipOccupancyMaxActiveBlocksPerMultiprocessor(&per_cu, (const void*)fwd_kernel, NTHREADS, LDS_BYTES);
        if (per_cu < 1) { fprintf(stderr, "kernel_launch: occupancy query says %d blocks/CU\n", per_cu); per_cu = 1; }
        (void)hipGetLastError();
        grid = cus;
    }
    if (grid < 0) return;
    if (hipMemsetAsync((char*)d_ws + WS_BAR, 0, 32768, stream) != hipSuccess) { fprintf(stderr, "kernel_launch: memset of barrier words failed\n"); return; }
    Params p{};
    for (int i = 0; i < 15; ++i) p.in[i] = (const float*)d_in[i];
    p.out = (float*)d_out; p.ws = (unsigned char*)d_ws;
    void* args[] = {&p};
    hipError_t e = hipLaunchCooperativeKernel((const void*)fwd_kernel, dim3(grid), dim3(NTHREADS), args, LDS_BYTES, stream);
    if (e != hipSuccess) fprintf(stderr, "cooperative launch failed: %s (grid %d)\n", hipGetErrorString(e), grid);
}
```

```cpp
#include <hip/hip_runtime.h>
#include <hip/hip_cooperative_groups.h>
#include <cstdio>
#include <cstdint>
namespace cg = cooperative_groups;

#define DI __device__ __forceinline__
#define PG8_LAS __attribute__((address_space(3)))
typedef unsigned short bf16_t;
typedef short bf16x8 __attribute__((ext_vector_type(8)));
typedef float f32x4 __attribute__((ext_vector_type(4)));
typedef float f32x2 __attribute__((ext_vector_type(2)));
typedef unsigned u32x4 __attribute__((ext_vector_type(4)));
typedef unsigned u32x2 __attribute__((ext_vector_type(2)));

namespace pg8 {
constexpr int BM = 256, BK = 64, HALF = 128, HTB = HALF * BK * 2, STAGE_BYTES = 8 * HTB, NXCD = 8, WGM = 8;
__host__ __device__ __forceinline__ int lds_byte(int r, int c) { const int st = (r >> 4) * 2 + (c >> 5), rr = r & 15, cc = c & 31, ob = rr * 64 + cc * 2; return st * 1024 + (ob ^ (((ob >> 9) & 1) << 5)); }
__host__ __device__ __forceinline__ void stage_rc(int b, int& R, int& C) { const int st = b / 1024, sb = b % 1024, swz = sb ^ (((sb >> 9) & 1) << 5); R = (st >> 1) * 16 + swz / 64; C = (st & 1) * 32 + (swz % 64) / 2; }
__host__ __device__ __forceinline__ int perm32(int rho) { const int n = rho >> 4, i = rho & 15; return 8 * (i >> 2) + 4 * n + (i & 3); }
struct Unit { int pm, pn; };
struct Gemm { const bf16_t* A; const bf16_t* Bt; int M, N, K; };
struct StaticOrder {
    int nM, nN, nwg, G, c;
    __host__ __device__ void init(int M, int N, int G_, int c_) { nM = M / BM; nN = N / BM; nwg = nM * nN; G = G_; c = c_; }
    __host__ __device__ bool next(int i, Unit& u) const {
        const long L = (long)i * G + c; if (L >= nwg) return false;
        int wgid = (int)L; { const int q = nwg / NXCD, r = nwg % NXCD, xcd = wgid % NXCD, off = wgid / NXCD; wgid = (xcd < r ? xcd * (q + 1) : r * (q + 1) + (xcd - r) * q) + off; }
        const int nig = WGM * nN, gid = wgid / nig, fm = gid * WGM, gsz = (nM - fm) < WGM ? (nM - fm) : WGM;
        u.pm = fm + ((wgid % nig) % gsz); u.pn = (wgid % nig) / gsz; return true;
    }
    __device__ __forceinline__ void a_ready(const Unit&) const {}
    __device__ __forceinline__ void done(const Unit&) const {}
};
template <class Epi, class Sched, bool ALIGN_EPI = false, bool SP2 = false>
__device__ __forceinline__ void gemm_phase(PG8_LAS unsigned char* lds, const Gemm g, const Sched& S, const Epi& E) {
    int tid = threadIdx.x; asm volatile("" : "+v"(tid)); const int wid = __builtin_amdgcn_readfirstlane(tid >> 6), lane = tid & 63, wr = wid >> 2, wc = wid & 3, fr = lane & 15, fq = lane >> 4;
    const int K = g.K, nt = K / BK;
    unsigned voffA[2], voffB[2];
#pragma unroll
    for (int i = 0; i < 2; ++i) { int R, C; stage_rc(tid * 16 + i * 8192, R, C); const int Rb = Epi::PERM ? ((R & ~31) + perm32(R & 31)) : R;
        voffA[i] = (unsigned)(R * K + C) * 2u; voffB[i] = (unsigned)(Rb * K + C) * 2u; }
    const size_t kstep = (size_t)(BK * 2);
    const size_t hstep = (size_t)HALF * K * 2;
    const size_t tstep = 2 * hstep;
    const unsigned ldsw = (unsigned)wid * 1024u;
    const int aoff = lds_byte(wr * 64 + fr, fq * 8), boff = lds_byte(wc * 32 + fr, fq * 8);
#define PG8_SA(b, h) (((b) * 2 + (h)) * HTB)
#define PG8_SB(b, h) ((4 + (b) * 2 + (h)) * HTB)
#define PG8_STAGE(bufoff, gbase, voff) do { _Pragma("unroll") for (int _i = 0; _i < 2; ++_i) \
        __builtin_amdgcn_global_load_lds((const unsigned*)((const char*)(gbase) + (voff)[_i]), (PG8_LAS unsigned*)(lds + (bufoff) + ldsw + _i * 8192), 16, 0, 0); } while (0)
#define PG8_LDA(dst, b, h) do { _Pragma("unroll") for (int m = 0; m < 4; ++m) _Pragma("unroll") for (int k = 0; k < 2; ++k) dst[m][k] = *(const PG8_LAS bf16x8*)(lds + PG8_SA(b, h) + aoff + m * 2048 + k * 1024); } while (0)
#define PG8_LDB(dst, b, h) do { _Pragma("unroll") for (int n = 0; n < 2; ++n) _Pragma("unroll") for (int k = 0; k < 2; ++k) dst[n][k] = *(const PG8_LAS bf16x8*)(lds + PG8_SB(b, h) + boff + n * 2048 + k * 1024); } while (0)
#define PG8_MMA(ai, bj, At, Bt) do { __builtin_amdgcn_s_setprio(1); _Pragma("unroll") for (int m = 0; m < 4; ++m) _Pragma("unroll") for (int n = 0; n < 2; ++n) _Pragma("unroll") for (int k = 0; k < 2; ++k) \
        acc[ai][bj][m][n] = __builtin_amdgcn_mfma_f32_16x16x32_bf16(Bt[n][k], At[m][k], acc[ai][bj][m][n], 0, 0, 0); __builtin_amdgcn_s_setprio(0); } while (0)
#define PG8_WAIT_V(n) asm volatile("s_waitcnt vmcnt(" #n ")" ::: "memory")
#define PG8_WAIT_L(n) asm volatile("s_waitcnt lgkmcnt(" #n ")" ::: "memory")
#define PG8_BAR __builtin_amdgcn_s_barrier()
#define PG8_SCHED __builtin_amdgcn_sched_barrier(0)
    Unit cur, nxt; int ui = 0;
    if (!S.next(0, cur)) return;
    f32x4 acc[2][2][4][2];
#pragma unroll
    for (int a = 0; a < 2; ++a)
#pragma unroll
        for (int b = 0; b < 2; ++b)
#pragma unroll
            for (int m = 0; m < 4; ++m)
#pragma unroll
                for (int n = 0; n < 2; ++n) acc[a][b][m][n] = (f32x4){0.f, 0.f, 0.f, 0.f};
    bf16x8 At[4][2], B0[2][2], B1[2][2];
    const char* cA = (const char*)g.A + (size_t)cur.pm * tstep; const char* cB = (const char*)g.Bt + (size_t)cur.pn * tstep;
    S.a_ready(cur);
    if constexpr (SP2) {
        PG8_STAGE(PG8_SB(0, 0), cB, voffB); PG8_STAGE(PG8_SB(0, 1), cB + hstep, voffB); PG8_STAGE(PG8_SA(0, 0), cA, voffA); PG8_STAGE(PG8_SA(0, 1), cA + hstep, voffA);
        if (wr == 1) PG8_BAR;
        PG8_WAIT_V(2); PG8_BAR;
        PG8_STAGE(PG8_SB(1, 0), cB + kstep, voffB); PG8_STAGE(PG8_SA(1, 0), cA + kstep, voffA); PG8_STAGE(PG8_SB(1, 1), cB + hstep + kstep, voffB);
        PG8_WAIT_V(6); PG8_BAR;
    } else {
        PG8_STAGE(PG8_SB(0, 0), cB, voffB); PG8_STAGE(PG8_SA(0, 0), cA, voffA); PG8_STAGE(PG8_SB(0, 1), cB + hstep, voffB); PG8_STAGE(PG8_SA(0, 1), cA + hstep, voffA);
        if (wr == 1) PG8_BAR;
        PG8_WAIT_V(4); PG8_BAR;
        PG8_STAGE(PG8_SB(1, 0), cB + kstep, voffB); PG8_STAGE(PG8_SA(1, 0), cA + kstep, voffA); PG8_STAGE(PG8_SB(1, 1), cB + hstep + kstep, voffB);
        PG8_WAIT_V(6); PG8_BAR;
    }
    for (;;) {
        const bool has_next = S.next(ui + 1, nxt);
        const char* nA = has_next ? (const char*)g.A + (size_t)nxt.pm * tstep : cA; const char* nB = has_next ? (const char*)g.Bt + (size_t)nxt.pn * tstep : cB;
        for (int t = 0; t < nt; t += 2) {
            const bool last = (t == nt - 2);
            const char* a1 = cA + (size_t)(t + 1) * kstep;
            const char* a2 = last ? nA : cA + (size_t)(t + 2) * kstep; const char* b2 = last ? nB : cB + (size_t)(t + 2) * kstep;
            const char* a3 = a2 + kstep; const char* b3 = b2 + kstep;
            if (last && has_next) S.a_ready(nxt);
            if constexpr (SP2) {
            PG8_LDB(B0, 0, 0); PG8_LDB(B1, 0, 1); PG8_SCHED; PG8_LDA(At, 0, 0); PG8_STAGE(PG8_SA(1, 1), a1 + hstep, voffA);
            PG8_WAIT_V(8); PG8_WAIT_L(0); PG8_BAR; PG8_MMA(0, 0, At, B0); PG8_MMA(0, 1, At, B1); PG8_BAR; PG8_SCHED;
            PG8_LDA(At, 0, 1); PG8_STAGE(PG8_SB(0, 0), b2, voffB); PG8_STAGE(PG8_SB(0, 1), b2 + hstep, voffB); PG8_STAGE(PG8_SA(0, 0), a2, voffA);
            PG8_WAIT_V(8); PG8_WAIT_L(0); PG8_BAR; PG8_MMA(1, 0, At, B0); PG8_MMA(1, 1, At, B1); PG8_BAR; PG8_SCHED;
            PG8_LDB(B0, 1, 0); PG8_LDB(B1, 1, 1); PG8_SCHED; PG8_LDA(At, 1, 0); PG8_STAGE(PG8_SA(0, 1), a2 + hstep, voffA);
            PG8_WAIT_V(8); PG8_WAIT_L(0); PG8_BAR; PG8_MMA(0, 0, At, B0); PG8_MMA(0, 1, At, B1); PG8_BAR; PG8_SCHED;
            PG8_LDA(At, 1, 1); PG8_STAGE(PG8_SB(1, 0), b3, voffB); PG8_STAGE(PG8_SB(1, 1), b3 + hstep, voffB); PG8_STAGE(PG8_SA(1, 0), a3, voffA);
            PG8_WAIT_V(8); PG8_WAIT_L(0); PG8_BAR; PG8_MMA(1, 0, At, B0); PG8_MMA(1, 1, At, B1); PG8_BAR; PG8_SCHED;
            } else {
            PG8_LDB(B0, 0, 0); PG8_SCHED; PG8_LDA(At, 0, 0); PG8_STAGE(PG8_SA(1, 1), a1 + hstep, voffA);
            PG8_WAIT_L(8); PG8_BAR; PG8_WAIT_L(0); PG8_MMA(0, 0, At, B0); PG8_BAR; PG8_SCHED;
            PG8_LDB(B1, 0, 1); PG8_STAGE(PG8_SB(0, 0), b2, voffB);
            PG8_BAR; PG8_WAIT_L(0); PG8_MMA(0, 1, At, B1); PG8_BAR;
            PG8_LDA(At, 0, 1); PG8_STAGE(PG8_SA(0, 0), a2, voffA);
            PG8_BAR; PG8_WAIT_L(0); PG8_MMA(1, 0, At, B0); PG8_BAR; PG8_SCHED;
            PG8_STAGE(PG8_SB(0, 1), b2 + hstep, voffB);
            PG8_WAIT_V(6); PG8_BAR; PG8_MMA(1, 1, At, B1); PG8_BAR;
            PG8_LDB(B0, 1, 0); PG8_SCHED; PG8_LDA(At, 1, 0); PG8_STAGE(PG8_SA(0, 1), a2 + hstep, voffA);
            PG8_WAIT_L(8); PG8_BAR; PG8_WAIT_L(0); PG8_MMA(0, 0, At, B0); PG8_BAR; PG8_SCHED;
            PG8_LDB(B1, 1, 1); PG8_STAGE(PG8_SB(1, 0), b3, voffB);
            PG8_BAR; PG8_WAIT_L(0); PG8_MMA(0, 1, At, B1); PG8_BAR;
            PG8_LDA(At, 1, 1); PG8_STAGE(PG8_SA(1, 0), a3, voffA);
            PG8_BAR; PG8_WAIT_L(0); PG8_MMA(1, 0, At, B0); PG8_BAR; PG8_SCHED;
            PG8_STAGE(PG8_SB(1, 1), b3 + hstep, voffB);
            PG8_WAIT_V(6); PG8_BAR; PG8_MMA(1, 1, At, B1); PG8_BAR;
            }
        }
        if constexpr (ALIGN_EPI) { if (wr == 0) PG8_BAR; }
        if constexpr (!Epi::AFTER_DRAIN) { E(acc, cur, wr, wc, fr, fq); S.done(cur); }
        if (!has_next) break;
#pragma unroll
        for (int a = 0; a < 2; ++a)
#pragma unroll
            for (int b = 0; b < 2; ++b)
#pragma unroll
                for (int m = 0; m < 4; ++m)
#pragma unroll
                    for (int n = 0; n < 2; ++n) acc[a][b][m][n] = (f32x4){0.f, 0.f, 0.f, 0.f};
        cur = nxt; cA = nA; cB = nB; ++ui;
        if constexpr (ALIGN_EPI) { if (wr == 1) PG8_BAR; }
    }
    PG8_WAIT_V(0);
    if constexpr (!ALIGN_EPI) { if (wr == 0) PG8_BAR; }
    PG8_BAR;
    if constexpr (Epi::AFTER_DRAIN) { E.fused(acc, cur, wr, wc, fr, fq, lds, wid, lane); S.done(cur); }
#undef PG8_SA
#undef PG8_SB
#undef PG8_STAGE
#undef PG8_LDA
#undef PG8_LDB
#undef PG8_MMA
#undef PG8_WAIT_V
#undef PG8_WAIT_L
#undef PG8_BAR
#undef PG8_SCHED
}}

constexpr int SEQ = 8192, NB = 2, M = NB * SEQ, D = 1024, NIN = 10272, NPAD = 10496;
constexpr int NA_TILES = 28, NB_TILES = 12, ROWS_A = NA_TILES * 256;
constexpr size_t MiB = 1u << 20;
constexpr size_t UNIT = 32 * MiB;
constexpr size_t WS_WIN = 224 * MiB, WS_WPA = 245 * MiB, WS_WPB = 247 * MiB, WS_WO = 249 * MiB, WS_AB = 251 * MiB, WS_G = 253 * MiB, WS_BETA = 254 * MiB;
constexpr size_t WS_MODP = 255 * MiB, WS_MODF = 255 * MiB + 256 * 1024;
constexpr size_t WS_CSC = 239 * MiB;
constexpr int LDS_BYTES = 155648;
constexpr int NWAVES = 8, NTHREADS = 512;
constexpr float NORM_EPS = 1e-6f, L2_EPS = 1e-6f;

struct Params { const float* in[15]; float* out; unsigned char* ws; };

typedef __bf16 bf16v2_t __attribute__((ext_vector_type(2)));
DI unsigned cvt_pk_bf16(float lo, float hi) { const f32x2 v = {lo, hi}; const bf16v2_t r = __builtin_convertvector(v, bf16v2_t); return __builtin_bit_cast(unsigned, r); }
DI float bf_lo(unsigned u) { return __uint_as_float(u << 16); }
DI float bf_hi(unsigned u) { return __uint_as_float(u & 0xffff0000u); }
DI float bf1(bf16_t u) { return __uint_as_float(((unsigned)u) << 16); }
DI float sigmoidf_(float x) { return __builtin_amdgcn_rcpf(1.0f + __expf(-x)); }
DI float siluf_(float x) { return x * __builtin_amdgcn_rcpf(1.0f + __expf(-x)); }
DI float softplusf_(float x) { return fmaxf(x, 0.f) + log1pf(__expf(-fabsf(x))); }
#define DPP_F(v, ctrl) __builtin_bit_cast(float, __builtin_amdgcn_mov_dpp(__builtin_bit_cast(int, (v)), (ctrl), 0xF, 0xF, true))
DI float row16_sum(float v) {
    v += DPP_F(v, 0xB1);
    v += DPP_F(v, 0x4E);
    v += DPP_F(v, 0x141);
    v += DPP_F(v, 0x140);
    return v;
}
DI float wave_sum(float v) {
    v = row16_sum(v);
    return __builtin_bit_cast(float, __builtin_amdgcn_readlane(__builtin_bit_cast(int, v), 0)) + __builtin_bit_cast(float, __builtin_amdgcn_readlane(__builtin_bit_cast(int, v), 16))
         + __builtin_bit_cast(float, __builtin_amdgcn_readlane(__builtin_bit_cast(int, v), 32)) + __builtin_bit_cast(float, __builtin_amdgcn_readlane(__builtin_bit_cast(int, v), 48));
}
DI int permpos(int dk) { const int loc = dk & 31; return (dk & ~31) + 8 * ((loc >> 2) & 3) + 4 * (loc >> 4) + (loc & 3); }
DI int win_src_col(int d) {
    if (d < 2048) { const int i = d >> 8, w = d & 255; return w < 128 ? (128 * i + w) : (2048 + 128 * i + (w - 128)); }
    if (d < 4096) { const int i = (d - 2048) >> 8, w = d & 255; return w < 128 ? (1024 + 128 * i + w) : (3072 + 128 * i + (w - 128)); }
    if (d < 5120) return 8224 + (d - 4096);
    if (d < 6144) return 9248 + (d - 5120);
    if (d < 7168) return 7168 + (d - 6144);
    if (d < 10240) return 4096 + (d - 7168);
    if (d < 10272) return 8192 + (d - 10240);
    return -1;
}

struct EpiA {
    static constexpr bool PERM = true, AFTER_DRAIN = false;
    bf16_t *PR, *SG;
    DI void operator()(const f32x4 (&acc)[2][2][4][2], const pg8::Unit& u, int wr, int wc, int fr, int fq) const {
        const int row0 = u.pm * 256 + wr * 64 + fr, pn = u.pn;
        if (pn < 16) {
            bf16_t* O = PR + (size_t)(pn >> 3) * (UNIT / 2) + (size_t)(128 * (pn & 7) + 32 * wc + 8 * fq);
#pragma unroll
            for (int ai = 0; ai < 2; ++ai)
#pragma unroll
                for (int m = 0; m < 4; ++m) {
                    float o[8];
#pragma unroll
                    for (int n = 0; n < 2; ++n)
#pragma unroll
                        for (int j = 0; j < 4; ++j) { const float a = acc[ai][0][m][n][j], b = acc[ai][1][m][n][j]; o[4 * n + j] = pn < 8 ? a * b : a * siluf_(b); }
                    u32x4 w; w.x = cvt_pk_bf16(o[0], o[1]); w.y = cvt_pk_bf16(o[2], o[3]); w.z = cvt_pk_bf16(o[4], o[5]); w.w = cvt_pk_bf16(o[6], o[7]);
                    *(u32x4*)(O + (size_t)(row0 + ai * 128 + m * 16) * D) = w;
                }
        } else {
            const int g = (pn - 16) >> 2;
            bf16_t* O = SG + (size_t)g * (UNIT / 2) + (size_t)(256 * ((pn - 16) & 3) + 32 * wc + 8 * fq);
#pragma unroll
            for (int ai = 0; ai < 2; ++ai)
#pragma unroll
                for (int m = 0; m < 4; ++m)
#pragma unroll
                    for (int bj = 0; bj < 2; ++bj) {
                        float o[8];
#pragma unroll
                        for (int n = 0; n < 2; ++n)
#pragma unroll
                            for (int j = 0; j < 4; ++j) { const float a = acc[ai][bj][m][n][j]; o[4 * n + j] = g == 2 ? siluf_(a) : sigmoidf_(a); }
                        u32x4 w; w.x = cvt_pk_bf16(o[0], o[1]); w.y = cvt_pk_bf16(o[2], o[3]); w.z = cvt_pk_bf16(o[4], o[5]); w.w = cvt_pk_bf16(o[6], o[7]);
                        *(u32x4*)(O + (size_t)(row0 + ai * 128 + m * 16) * D + bj * 128) = w;
                    }
        }
    }
};
struct EpiB {
    static constexpr bool PERM = true, AFTER_DRAIN = false;
    bf16_t* QKV;
    DI void operator()(const f32x4 (&acc)[2][2][4][2], const pg8::Unit& u, int wr, int wc, int fr, int fq) const {
        const int row0 = u.pm * 256 + wr * 64 + fr, pn = u.pn;
        bf16_t* O = QKV + (size_t)(pn >> 2) * (UNIT / 2) + (size_t)(256 * (pn & 3) + 32 * wc + 8 * fq);
#pragma unroll
        for (int ai = 0; ai < 2; ++ai)
#pragma unroll
            for (int m = 0; m < 4; ++m)
#pragma unroll
                for (int bj = 0; bj < 2; ++bj) {
                    const f32x4 v0 = acc[ai][bj][m][0], v1 = acc[ai][bj][m][1];
                    u32x4 w; w.x = cvt_pk_bf16(v0[0], v0[1]); w.y = cvt_pk_bf16(v0[2], v0[3]); w.z = cvt_pk_bf16(v1[0], v1[1]); w.w = cvt_pk_bf16(v1[2], v1[3]);
                    *(u32x4*)(O + (size_t)(row0 + ai * 128 + m * 16) * D + bj * 128) = w;
                }
    }
};
struct EpiYa {
    static constexpr bool PERM = true, AFTER_DRAIN = false;
    bf16_t* SGA;
    DI void operator()(const f32x4 (&acc)[2][2][4][2], const pg8::Unit& u, int wr, int wc, int fr, int fq) const {
        const int row0 = u.pm * 256 + wr * 64 + fr; bf16_t* O = SGA + (size_t)(256 * u.pn + 32 * wc + 8 * fq);
#pragma unroll
        for (int ai = 0; ai < 2; ++ai)
#pragma unroll
            for (int m = 0; m < 4; ++m)
#pragma unroll
                for (int bj = 0; bj < 2; ++bj) {
                    u32x4* p = (u32x4*)(O + (size_t)(row0 + ai * 128 + m * 16) * D + bj * 128);
                    const u32x4 s = *p; const f32x4 v0 = acc[ai][bj][m][0], v1 = acc[ai][bj][m][1];
                    u32x4 w; w.x = cvt_pk_bf16(bf_lo(s.x) * v0[0], bf_hi(s.x) * v0[1]); w.y = cvt_pk_bf16(bf_lo(s.y) * v0[2], bf_hi(s.y) * v0[3]);
                    w.z = cvt_pk_bf16(bf_lo(s.z) * v1[0], bf_hi(s.z) * v1[1]); w.w = cvt_pk_bf16(bf_lo(s.w) * v1[2], bf_hi(s.w) * v1[3]);
                    *p = w;
                }
    }
};
struct EpiYb {
    static constexpr bool PERM = true, AFTER_DRAIN = false;
    bf16_t* MA; const bf16_t* SGB;
    DI void operator()(const f32x4 (&acc)[2][2][4][2], const pg8::Unit& u, int wr, int wc, int fr, int fq) const {
        const int row0 = u.pm * 256 + wr * 64 + fr; const size_t c0 = (size_t)(256 * u.pn + 32 * wc + 8 * fq);
#pragma unroll
        for (int ai = 0; ai < 2; ++ai)
#pragma unroll
            for (int m = 0; m < 4; ++m)
#pragma unroll
                for (int bj = 0; bj < 2; ++bj) {
                    const size_t off = (size_t)(row0 + ai * 128 + m * 16) * D + bj * 128 + c0;
                    u32x4* p = (u32x4*)(MA + off); const u32x4 a = *p; const u32x4 s = *(const u32x4*)(SGB + off);
                    const f32x4 v0 = acc[ai][bj][m][0], v1 = acc[ai][bj][m][1];
                    u32x4 w; w.x = cvt_pk_bf16(bf_lo(a.x) + bf_lo(s.x) * v0[0], bf_hi(a.x) + bf_hi(s.x) * v0[1]); w.y = cvt_pk_bf16(bf_lo(a.y) + bf_lo(s.y) * v0[2], bf_hi(a.y) + bf_hi(s.y) * v0[3]);
                    w.z = cvt_pk_bf16(bf_lo(a.z) + bf_lo(s.z) * v1[0], bf_hi(a.z) + bf_hi(s.z) * v1[1]); w.w = cvt_pk_bf16(bf_lo(a.w) + bf_lo(s.w) * v1[2], bf_hi(a.w) + bf_hi(s.w) * v1[3]);
                    *p = w;
                }
    }
};
struct EpiOut {
    static constexpr bool PERM = true, AFTER_DRAIN = false;
    const float* X; const float* GATE; float* XN;
    DI void operator()(const f32x4 (&acc)[2][2][4][2], const pg8::Unit& u, int wr, int wc, int fr, int fq) const {
        const int row0 = u.pm * 256 + wr * 64 + fr; const int c0 = 256 * u.pn + 32 * wc + 8 * fq;
        const float* gp = GATE + (size_t)((u.pm * 256) / SEQ) * D + c0;
        f32x4 gt[2][2];
#pragma unroll
        for (int bj = 0; bj < 2; ++bj) { gt[bj][0] = *(const f32x4*)(gp + bj * 128); gt[bj][1] = *(const f32x4*)(gp + bj * 128 + 4); }
#pragma unroll
        for (int ai = 0; ai < 2; ++ai)
#pragma unroll
            for (int m = 0; m < 4; ++m)
#pragma unroll
                for (int bj = 0; bj < 2; ++bj) {
                    const size_t off = (size_t)(row0 + ai * 128 + m * 16) * D + bj * 128 + c0;
                    const f32x4 x0 = *(const f32x4*)(X + off), x1 = *(const f32x4*)(X + off + 4);
                    *(f32x4*)(XN + off) = x0 + gt[bj][0] * acc[ai][bj][m][0]; *(f32x4*)(XN + off + 4) = x1 + gt[bj][1] * acc[ai][bj][m][1];
                }
    }
};

constexpr size_t WS_PCNT = 255 * MiB + 336 * 1024;
constexpr size_t WS_PSS = 255 * MiB + 512 * 1024;
struct EpiOutFused {
    static constexpr bool PERM = true, AFTER_DRAIN = true;
    const float* X; const float* GATE; const float* FW; float* OUT; float* PSS; unsigned* PCNT;
    DI void operator()(const f32x4 (&)[2][2][4][2], const pg8::Unit&, int, int, int, int) const {}
    DI void fused(f32x4 (&acc)[2][2][4][2], const pg8::Unit& u, int wr, int wc, int fr, int fq, PG8_LAS unsigned char* lds, int wid, int lane) const {
        PG8_LAS float* P = (PG8_LAS float*)lds;
        PG8_LAS float* S = (PG8_LAS float*)(lds + 4096);
        const int row0 = u.pm * 256 + wr * 64 + fr; const int c0 = 256 * u.pn + 32 * wc + 8 * fq;
        const float* gp = GATE + (size_t)((u.pm * 256) / SEQ) * D + c0;
        f32x4 gt[2][2];
#pragma unroll
        for (int bj = 0; bj < 2; ++bj) { gt[bj][0] = *(const f32x4*)(gp + bj * 128); gt[bj][1] = *(const f32x4*)(gp + bj * 128 + 4); }
#pragma unroll
        for (int ai = 0; ai < 2; ++ai)
#pragma unroll
            for (int m = 0; m < 4; ++m) {
                float s = 0.f;
#pragma unroll
                for (int bj = 0; bj < 2; ++bj) {
                    const size_t off = (size_t)(row0 + ai * 128 + m * 16) * D + bj * 128 + c0;
                    const f32x4 v0 = *(const f32x4*)(X + off) + gt[bj][0] * acc[ai][bj][m][0], v1 = *(const f32x4*)(X + off + 4) + gt[bj][1] * acc[ai][bj][m][1];
                    acc[ai][bj][m][0] = v0; acc[ai][bj][m][1] = v1;
                    s += (v0[0] * v0[0] + v0[1] * v0[1]) + (v0[2] * v0[2] + v0[3] * v0[3]) + (v1[0] * v1[0] + v1[1] * v1[1]) + (v1[2] * v1[2] + v1[3] * v1[3]);
                }
                s += __shfl_xor(s, 16); s += __shfl_xor(s, 32);
                if (fq == 0) P[(ai * 128 + wr * 64 + m * 16 + fr) * 4 + wc] = s;
                if (m & 1) __builtin_amdgcn_sched_barrier(0);
            }
        asm volatile("s_waitcnt lgkmcnt(0)" ::: "memory"); __builtin_amdgcn_s_barrier(); asm volatile("" ::: "memory");
        const int row = wid * 32 + (lane & 31);
        if (lane < 32) {
            const float t = (P[row * 4 + 0] + P[row * 4 + 1]) + (P[row * 4 + 2] + P[row * 4 + 3]);
            __hip_atomic_store(PSS + (size_t)(u.pm * 256 + row) * 4 + u.pn, t, __ATOMIC_RELAXED, __HIP_MEMORY_SCOPE_AGENT);
        }
        asm volatile("s_waitcnt vmcnt(0)" ::: "memory");
        if (lane == 0) __hip_atomic_fetch_add(PCNT + 64 * u.pm, 1u, __ATOMIC_RELAXED, __HIP_MEMORY_SCOPE_AGENT);
        if (wid == 0) {
            unsigned sp = 0;
            while ((unsigned)__builtin_amdgcn_readfirstlane(__hip_atomic_load(PCNT + 64 * u.pm, __ATOMIC_RELAXED, __HIP_MEMORY_SCOPE_AGENT)) < 32u) { __builtin_amdgcn_s_sleep(2); if (++sp > (1u << 22)) break; }
            __builtin_amdgcn_fence(__ATOMIC_ACQUIRE, "agent");
        }
        asm volatile("s_waitcnt vmcnt(0) lgkmcnt(0)" ::: "memory"); __builtin_amdgcn_s_barrier(); asm volatile("" ::: "memory");
        if (lane < 32) {
            const float* ps = PSS + (size_t)(u.pm * 256 + row) * 4; float t = 0.f;
#pragma unroll
            for (int k = 0; k < 4; ++k) t += __hip_atomic_load(ps + k, __ATOMIC_RELAXED, __HIP_MEMORY_SCOPE_AGENT);
            S[row] = rsqrtf(t * (1.f / D) + NORM_EPS);
        }
        asm volatile("s_waitcnt vmcnt(0) lgkmcnt(0)" ::: "memory"); __builtin_amdgcn_s_barrier(); asm volatile("" ::: "memory");
        f32x4 fw[2][2];
#pragma unroll
        for (int bj = 0; bj < 2; ++bj) { fw[bj][0] = *(const f32x4*)(FW + c0 + bj * 128); fw[bj][1] = *(const f32x4*)(FW + c0 + bj * 128 + 4); }
#pragma unroll
        for (int ai = 0; ai < 2; ++ai)
#pragma unroll
            for (int m = 0; m < 4; ++m) {
                const float rs = S[ai * 128 + wr * 64 + m * 16 + fr];
#pragma unroll
                for (int bj = 0; bj < 2; ++bj) {
                    const size_t off = (size_t)(row0 + ai * 128 + m * 16) * D + bj * 128 + c0;
                    *(f32x4*)(OUT + off) = acc[ai][bj][m][0] * rs * fw[bj][0]; *(f32x4*)(OUT + off + 4) = acc[ai][bj][m][1] * rs * fw[bj][1];
                }
            }
    }
};

struct TwoGemmOrder {
    pg8::StaticOrder so;
    DI bool next(int i, pg8::Unit& u) const { if (i >= 2) return false; if (!so.next(0, u)) return false; if (i == 1) { u.pm += 256; u.pn += 4; } return true; }
    DI void a_ready(const pg8::Unit&) const {}
    DI void done(const pg8::Unit&) const {}
};
struct EpiYaYb {
    static constexpr bool PERM = true, AFTER_DRAIN = false;
    bf16_t* MA; const bf16_t* SGB;
    DI void operator()(const f32x4 (&acc)[2][2][4][2], const pg8::Unit& u, int wr, int wc, int fr, int fq) const {
        if (u.pn < 4) { EpiYa e{MA}; e(acc, u, wr, wc, fr, fq); }
        else { EpiYb e{MA, SGB}; pg8::Unit v; v.pm = u.pm - 256; v.pn = u.pn - 4; e(acc, v, wr, wc, fr, fq); }
    }
};

DI void p0_transpose_item(const float* W, int N, bf16_t* WT, int rg, int kg, int lane, bool is_win) {
    const int d = rg * 64 + lane; const int s = is_win ? win_src_col(d) : d; const int k0 = kg * 64;
    bf16_t* o = WT + (size_t)d * D + k0;
    if (s < 0) {
#pragma unroll
        for (int kk = 0; kk < 8; ++kk) *(u32x4*)(o + 8 * kk) = (u32x4){0u, 0u, 0u, 0u};
        return;
    }
    const float* w = W + (size_t)k0 * N + s;
    float v[64];
#pragma unroll
    for (int j = 0; j < 64; ++j) v[j] = w[(size_t)j * N];
#pragma unroll
    for (int kk = 0; kk < 8; ++kk) {
        u32x4 p; p.x = cvt_pk_bf16(v[8 * kk], v[8 * kk + 1]); p.y = cvt_pk_bf16(v[8 * kk + 2], v[8 * kk + 3]); p.z = cvt_pk_bf16(v[8 * kk + 4], v[8 * kk + 5]); p.w = cvt_pk_bf16(v[8 * kk + 6], v[8 * kk + 7]);
        *(u32x4*)(o + 8 * kk) = p;
    }
}
DI void phase0(const Params& p, int gw, int NGW, int lane) {
    unsigned char* ws = p.ws;
    constexpr int I_WIN = (NPAD / 64) * 16, I_SQ = 16 * 16, I_MOD = 48 * 8, NITEMS = I_WIN + 3 * I_SQ + I_MOD;
    for (int it = gw; it < NITEMS; it += NGW) {
        int r = it;
        if (r < I_WIN) { p0_transpose_item(p.in[5], NIN, (bf16_t*)(ws + WS_WIN), r >> 4, r & 15, lane, true); continue; } r -= I_WIN;
        if (r < I_SQ) { p0_transpose_item(p.in[11], D, (bf16_t*)(ws + WS_WPA), r >> 4, r & 15, lane, false); continue; } r -= I_SQ;
        if (r < I_SQ) { p0_transpose_item(p.in[12], D, (bf16_t*)(ws + WS_WPB), r >> 4, r & 15, lane, false); continue; } r -= I_SQ;
        if (r < I_SQ) { p0_transpose_item(p.in[13], D, (bf16_t*)(ws + WS_WO), r >> 4, r & 15, lane, false); continue; } r -= I_SQ;
        const int cgp = r >> 3, ks = r & 7; const float* c = p.in[1]; const float* wa = p.in[2] + (size_t)(ks * 128) * 3072 + cgp * 64 + lane;
        float a0 = 0.f, a1 = 0.f;
#pragma unroll
        for (int k0 = 0; k0 < 128; k0 += 32) {
            float wv[32];
#pragma unroll
            for (int k = 0; k < 32; ++k) wv[k] = wa[(size_t)(k0 + k) * 3072];
#pragma unroll
            for (int k = 0; k < 32; ++k) { a0 += siluf_(c[ks * 128 + k0 + k]) * wv[k]; a1 += siluf_(c[D + ks * 128 + k0 + k]) * wv[k]; }
        }
        float* mp = (float*)(ws + WS_MODP) + (size_t)ks * 2 * 3072 + cgp * 64 + lane;
        mp[0] = a0; mp[3072] = a1;
    }
}
DI void phase1(const Params& p, float* ldsf, int gw, int NGW, int lane, int tid) {
    const float* modp = (const float*)(p.ws + WS_MODP); const float* b_ada = p.in[3]; const float* nw = p.in[4];
    float* s_tab = ldsf;
    float* a_tab = ldsf + 2048;
    for (int idx = tid; idx < 2 * 2048; idx += NTHREADS) {
        const int b = idx >> 11, j = idx & 2047; float s = b_ada[j];
#pragma unroll
        for (int q = 0; q < 8; ++q) s += modp[(size_t)q * 2 * 3072 + b * 3072 + j];
        if (j < 1024) s_tab[b * 1024 + j] = s; else a_tab[b * 1024 + j - 1024] = nw[j - 1024] * (1.f + s);
    }
    if (blockIdx.x == 0) {
        float* modf = (float*)(p.ws + WS_MODF);
        for (int idx = tid; idx < 2 * 1024; idx += NTHREADS) {
            const int b = idx >> 10, j = idx & 1023; float s = b_ada[2048 + j];
#pragma unroll
            for (int q = 0; q < 8; ++q) s += modp[(size_t)q * 2 * 3072 + b * 3072 + 2048 + j];
            modf[b * 1024 + j] = s;
        }
    }
    __syncthreads();
    bf16_t* H = (bf16_t*)(p.ws + 0 * UNIT);
    for (int m0 = gw; m0 < M; m0 += 2 * NGW) {
        const int m1 = m0 + NGW < M ? m0 + NGW : m0;
        f32x4 v[2][4]; float s[2] = {0.f, 0.f};
#pragma unroll
        for (int u = 0; u < 2; ++u) { const f32x4* xr = (const f32x4*)(p.in[0] + (size_t)(u ? m1 : m0) * D) + lane;
#pragma unroll
            for (int j = 0; j < 4; ++j) v[u][j] = xr[64 * j]; }
#pragma unroll
        for (int u = 0; u < 2; ++u) {
#pragma unroll
            for (int j = 0; j < 4; ++j) s[u] += (v[u][j].x * v[u][j].x + v[u][j].y * v[u][j].y) + (v[u][j].z * v[u][j].z + v[u][j].w * v[u][j].w);
            const int m = u ? m1 : m0; const int b = m / SEQ;
            const float rstd = rsqrtf(wave_sum(s[u]) * (1.f / D) + NORM_EPS);
            u32x2* o = (u32x2*)(H + (size_t)m * D) + lane;
#pragma unroll
            for (int j = 0; j < 4; ++j) {
                const f32x4 a = *(const f32x4*)(a_tab + b * 1024 + 4 * lane + 256 * j), sh = *(const f32x4*)(s_tab + b * 1024 + 4 * lane + 256 * j);
                const f32x4 hh = v[u][j] * rstd * a + sh;
                u32x2 w; w.x = cvt_pk_bf16(hh.x, hh.y); w.y = cvt_pk_bf16(hh.z, hh.w); o[64 * j] = w;
            }
        }
    }
    __syncthreads();
}
DI void ab_item(const Params& p, int item, int lane) {
    unsigned char* ws = p.ws; const int il = lane & 15, q = lane >> 4;
    const bf16_t* Hr = (const bf16_t*)(ws + 0 * UNIT) + (size_t)(item * 16 + il) * D + 8 * q;
    const bf16_t* W0 = (const bf16_t*)(ws + WS_WIN) + (size_t)(10240 + il) * D + 8 * q; const bf16_t* W1 = W0 + (size_t)16 * D;
    f32x4 a0 = {0.f, 0.f, 0.f, 0.f}, a1 = {0.f, 0.f, 0.f, 0.f};
#pragma unroll 8
    for (int ks = 0; ks < 32; ++ks) { const bf16x8 hf = *(const bf16x8*)(Hr + 32 * ks);
        a0 = __builtin_amdgcn_mfma_f32_16x16x32_bf16(hf, *(const bf16x8*)(W0 + 32 * ks), a0, 0, 0, 0); a1 = __builtin_amdgcn_mfma_f32_16x16x32_bf16(hf, *(const bf16x8*)(W1 + 32 * ks), a1, 0, 0, 0); }
    float* AB = (float*)(ws + WS_AB) + (size_t)(item * 16 + 4 * q) * 32 + il;
#pragma unroll
    for (int r = 0; r < 4; ++r) { AB[r * 32] = a0[r]; AB[r * 32 + 16] = a1[r]; }
}
DI void phase3_item(const Params& p, int item, int lane) {
    unsigned char* ws = p.ws;
    const bf16_t* Qr = (const bf16_t*)(ws + 1 * UNIT); const bf16_t* Kr = (const bf16_t*)(ws + 2 * UNIT); const bf16_t* Vr = (const bf16_t*)(ws + 3 * UNIT);
    bf16_t* Qn = (bf16_t*)(ws + 4 * UNIT); bf16_t* Kn = (bf16_t*)(ws + 5 * UNIT); bf16_t* Vc = (bf16_t*)p.out;
    const int tg = item & 255, h = (item >> 8) & 7, b = item >> 11; const int t_base = tg * 32; const size_t rb = (size_t)b * SEQ;
    const int col = h * 128 + 2 * lane; const int pcol = h * 128 + permpos(2 * lane);
    const float* cw = p.in[7];
    f32x2 wq[5], wk[5], wv[5];
#pragma unroll
    for (int j = 0; j < 5; ++j) { wq[j] = *(const f32x2*)(cw + j * 3072 + col); wk[j] = *(const f32x2*)(cw + j * 3072 + 1024 + col); wv[j] = *(const f32x2*)(cw + j * 3072 + 2048 + col); }
#pragma unroll
    for (int hf = 0; hf < 2; ++hf) {
        unsigned rq[20], rk[20], rv[20];
#pragma unroll
        for (int j = 0; j < 20; ++j) {
            const int t = t_base + 16 * hf - 2 + j; const bool ok = (t >= 0) && (t < SEQ); const int tc = t < 0 ? 0 : (t >= SEQ ? SEQ - 1 : t);
            const size_t off = (rb + tc) * D + col;
            const unsigned a0 = *(const unsigned*)(Qr + off), a1 = *(const unsigned*)(Kr + off), a2 = *(const unsigned*)(Vr + off);
            rq[j] = ok ? a0 : 0u; rk[j] = ok ? a1 : 0u; rv[j] = ok ? a2 : 0u;
        }
#pragma unroll
        for (int t16 = 0; t16 < 16; ++t16) {
            const int tt = 16 * hf + t16, t = t_base + tt;
            float q0 = 0.f, q1 = 0.f, k0 = 0.f, k1 = 0.f, v0 = 0.f, v1 = 0.f;
#pragma unroll
            for (int j = 0; j < 5; ++j) { q0 += wq[j].x * bf_lo(rq[t16 + j]); q1 += wq[j].y * bf_hi(rq[t16 + j]); k0 += wk[j].x * bf_lo(rk[t16 + j]); k1 += wk[j].y * bf_hi(rk[t16 + j]); v0 += wv[j].x * bf_lo(rv[t16 + j]); v1 += wv[j].y * bf_hi(rv[t16 + j]); }
            q0 = siluf_(q0); q1 = siluf_(q1); k0 = siluf_(k0); k1 = siluf_(k1); v0 = siluf_(v0); v1 = siluf_(v1);
            const float rq_ = rsqrtf(wave_sum(q0 * q0 + q1 * q1) + L2_EPS) * 0.08838834764831845f, rk_ = rsqrtf(wave_sum(k0 * k0 + k1 * k1) + L2_EPS);
            q0 *= rq_; q1 *= rq_; k0 *= rk_; k1 *= rk_;
            const size_t ro = (rb + t) * D;
            *(unsigned*)(Qn + ro + pcol) = cvt_pk_bf16(q0, q1); *(unsigned*)(Kn + ro + pcol) = cvt_pk_bf16(k0, k1); *(unsigned*)(Vc + ro + col) = cvt_pk_bf16(v0, v1);
        }
    }
    { const int i = lane & 31, dir = lane >> 5; const size_t row = rb + t_base + i; const float* AB = (const float*)(ws + WS_AB);
      const float a_raw = AB[row * 32 + dir * 8 + h], b_raw = AB[row * 32 + 16 + dir * 8 + h];
      const float g = -__expf(p.in[8][dir * 8 + h]) * softplusf_(a_raw + p.in[9][dir * 8 + h]);
      ((float*)(ws + WS_G))[row * 16 + dir * 8 + h] = g; ((float*)(ws + WS_BETA))[row * 16 + dir * 8 + h] = sigmoidf_(b_raw); }
}
DI void naive_scan(const Params& p, float* ldsw, int task, int lane) {
    unsigned char* ws = p.ws;
    const bf16_t* Qn = (const bf16_t*)(ws + 4 * UNIT); const bf16_t* Kn = (const bf16_t*)(ws + 5 * UNIT); const bf16_t* Vc = (const bf16_t*)p.out;
    const float* G = (const float*)(ws + WS_G); const float* BE = (const float*)(ws + WS_BETA);
    const int chain = task >> 1, b = chain >> 4, dir = (chain >> 3) & 1, h = chain & 7, e = (task & 1) * 64 + lane;
    bf16_t* O = (dir ? (bf16_t*)(p.out) + (size_t)M * D : (bf16_t*)(ws + 3 * UNIT));
    float* kb = ldsw; float* qb = ldsw + 128;
    float P[128];
#pragma unroll
    for (int d = 0; d < 128; ++d) P[d] = 0.f;
    for (int n = 0; n < SEQ; ++n) {
        const int t = dir ? SEQ - 1 - n : n; const size_t row = (size_t)b * SEQ + t;
        const unsigned ku = *(const unsigned*)(Kn + row * D + h * 128 + 2 * lane), qu = *(const unsigned*)(Qn + row * D + h * 128 + 2 * lane);
        const float v = bf1(Vc[row * D + h * 128 + e]); const float al = __expf(G[row * 16 + dir * 8 + h]), be = BE[row * 16 + dir * 8 + h];
        kb[2 * lane] = bf_lo(ku); kb[2 * lane + 1] = bf_hi(ku); qb[2 * lane] = bf_lo(qu); qb[2 * lane + 1] = bf_hi(qu);
        asm volatile("s_waitcnt lgkmcnt(0)" ::: "memory");
        float sk = 0.f;
#pragma unroll
        for (int d4 = 0; d4 < 32; ++d4) { if ((d4 & 3) == 0) __builtin_amdgcn_sched_barrier(0); const f32x4 k4 = *(const f32x4*)(kb + 4 * d4); sk += P[4 * d4] * k4.x + P[4 * d4 + 1] * k4.y + P[4 * d4 + 2] * k4.z + P[4 * d4 + 3] * k4.w; }
        const float vn = be * (v - al * sk); float o = 0.f;
#pragma unroll
        for (int d4 = 0; d4 < 32; ++d4) { if ((d4 & 3) == 0) __builtin_amdgcn_sched_barrier(0); const f32x4 k4 = *(const f32x4*)(kb + 4 * d4), q4 = *(const f32x4*)(qb + 4 * d4);
            P[4 * d4] = al * P[4 * d4] + k4.x * vn; P[4 * d4 + 1] = al * P[4 * d4 + 1] + k4.y * vn; P[4 * d4 + 2] = al * P[4 * d4 + 2] + k4.z * vn; P[4 * d4 + 3] = al * P[4 * d4 + 3] + k4.w * vn;
            o += P[4 * d4] * q4.x + P[4 * d4 + 1] * q4.y + P[4 * d4 + 2] * q4.z + P[4 * d4 + 3] * q4.w; }
        O[row * D + h * 128 + e] = (bf16_t)(cvt_pk_bf16(o, 0.f) & 0xffffu);
        asm volatile("s_waitcnt lgkmcnt(0)" ::: "memory");
    }
}
DI void ya_acc(float (&acc)[8], const u32x4& pv, const f32x4& wa, const f32x4& wb) {
    acc[0] += wa.x * bf_lo(pv.x); acc[1] += wa.y * bf_hi(pv.x); acc[2] += wa.z * bf_lo(pv.y); acc[3] += wa.w * bf_hi(pv.y);
    acc[4] += wb.x * bf_lo(pv.z); acc[5] += wb.y * bf_hi(pv.z); acc[6] += wb.z * bf_lo(pv.w); acc[7] += wb.w * bf_hi(pv.w);
}
DI void phase7(const Params& p, int gw, int NGW, int lane, int gtid, int NGT) {
    unsigned char* ws = p.ws;
    const bf16_t* Pb = (const bf16_t*)(ws + 1 * UNIT); bf16_t* R = (bf16_t*)(ws + 2 * UNIT); const float* cw = p.in[6];
    for (int it = gtid; it < (M / 4) * 128; it += NGT) {
        const int row0 = (it >> 7) * 4, c8 = (it & 127) * 8, t0 = row0 & (SEQ - 1);
        const u32x4 z = (u32x4){0u, 0u, 0u, 0u};
        u32x4 pv[6], rv[4];
        { const u32x4 t_ = *(const u32x4*)(Pb + (size_t)(t0 > 0 ? row0 - 1 : row0) * D + c8); pv[0] = t0 > 0 ? t_ : z; }
#pragma unroll
        for (int j = 0; j < 4; ++j) { pv[j + 1] = *(const u32x4*)(Pb + (size_t)(row0 + j) * D + c8); rv[j] = *(const u32x4*)(R + (size_t)(row0 + j) * D + c8); }
        { const u32x4 t_ = *(const u32x4*)(Pb + (size_t)(t0 + 4 < SEQ ? row0 + 4 : row0) * D + c8); pv[5] = t0 + 4 < SEQ ? t_ : z; }
        f32x4 wa[3], wb[3];
#pragma unroll
        for (int j = 0; j < 3; ++j) { wa[j] = *(const f32x4*)(cw + j * D + c8); wb[j] = *(const f32x4*)(cw + j * D + c8 + 4); }
#pragma unroll
        for (int j = 0; j < 4; ++j) {
            float acc[8] = {0.f, 0.f, 0.f, 0.f, 0.f, 0.f, 0.f, 0.f};
            ya_acc(acc, pv[j], wa[0], wb[0]); ya_acc(acc, pv[j + 1], wa[1], wb[1]); ya_acc(acc, pv[j + 2], wa[2], wb[2]);
            u32x4 o; const u32x4 r = rv[j];
            o.x = cvt_pk_bf16(bf_lo(r.x) * acc[0], bf_hi(r.x) * acc[1]); o.y = cvt_pk_bf16(bf_lo(r.y) * acc[2], bf_hi(r.y) * acc[3]);
            o.z = cvt_pk_bf16(bf_lo(r.z) * acc[4], bf_hi(r.z) * acc[5]); o.w = cvt_pk_bf16(bf_lo(r.w) * acc[6], bf_hi(r.w) * acc[7]);
            *(u32x4*)(R + (size_t)(row0 + j) * D + c8) = o;
        }
    }
    const bf16_t* Of = (const bf16_t*)(ws + 3 * UNIT); const bf16_t* Ob = (const bf16_t*)p.out + (size_t)M * D; bf16_t* SZ = (bf16_t*)(ws + 6 * UNIT);
    const f32x4 g0 = *(const f32x4*)(p.in[10] + (lane & 15) * 8), g1 = *(const f32x4*)(p.in[10] + (lane & 15) * 8 + 4);
    for (int rp = gw; rp < M / 2; rp += NGW) {
        u32x4 a[4], bb[4], zz[4];
#pragma unroll
        for (int u = 0; u < 4; ++u) { const size_t off = (size_t)(rp * 2 + (u >> 1)) * D + (u & 1) * 512 + lane * 8;
            a[u] = *(const u32x4*)(Of + off); bb[u] = *(const u32x4*)(Ob + off); zz[u] = *(const u32x4*)(SZ + off); }
#pragma unroll
        for (int u = 0; u < 4; ++u) { const size_t off = (size_t)(rp * 2 + (u >> 1)) * D + (u & 1) * 512 + lane * 8;
            float o[8];
            o[0] = bf_lo(a[u].x) + bf_lo(bb[u].x); o[1] = bf_hi(a[u].x) + bf_hi(bb[u].x); o[2] = bf_lo(a[u].y) + bf_lo(bb[u].y); o[3] = bf_hi(a[u].y) + bf_hi(bb[u].y);
            o[4] = bf_lo(a[u].z) + bf_lo(bb[u].z); o[5] = bf_hi(a[u].z) + bf_hi(bb[u].z); o[6] = bf_lo(a[u].w) + bf_lo(bb[u].w); o[7] = bf_hi(a[u].w) + bf_hi(bb[u].w);
            float ss = 0.f;
#pragma unroll
            for (int j = 0; j < 8; ++j) ss += o[j] * o[j];
            ss = row16_sum(ss);
            const float rs = rsqrtf(ss * (1.f / 128.f) + NORM_EPS);
            u32x4 w;
            w.x = cvt_pk_bf16(o[0] * rs * g0.x * bf_lo(zz[u].x), o[1] * rs * g0.y * bf_hi(zz[u].x)); w.y = cvt_pk_bf16(o[2] * rs * g0.z * bf_lo(zz[u].y), o[3] * rs * g0.w * bf_hi(zz[u].y));
            w.z = cvt_pk_bf16(o[4] * rs * g1.x * bf_lo(zz[u].z), o[5] * rs * g1.y * bf_hi(zz[u].z)); w.w = cvt_pk_bf16(o[6] * rs * g1.z * bf_lo(zz[u].w), o[7] * rs * g1.w * bf_hi(zz[u].w));
            *(u32x4*)(SZ + off) = w;
        }
    }
}
DI void phase10(const Params& p, int gw, int NGW, int lane) {
    const float* XN = (const float*)(p.ws + 0 * UNIT); const float* fw = p.in[14];
    f32x4 w[4];
#pragma unroll
    for (int j = 0; j < 4; ++j) w[j] = *((const f32x4*)fw + lane + 64 * j);
    for (int m = gw; m < M; m += NGW) {
        const f32x4* xr = (const f32x4*)(XN + (size_t)m * D) + lane; f32x4 v[4]; float s = 0.f;
#pragma unroll
        for (int j = 0; j < 4; ++j) { v[j] = xr[64 * j]; s += (v[j].x * v[j].x + v[j].y * v[j].y) + (v[j].z * v[j].z + v[j].w * v[j].w); }
        const float rstd = rsqrtf(wave_sum(s) * (1.f / D) + NORM_EPS);
        f32x4* o = (f32x4*)(p.out + (size_t)m * D) + lane;
#pragma unroll
        for (int j = 0; j < 4; ++j) o[64 * j] = v[j] * rstd * w[j];
    }
}
#define MFMA16(a, b, c) __builtin_amdgcn_mfma_f32_16x16x32_bf16((a), (b), (c), 0, 0, 0)
DI void chunk_prep_item(const Params& p, float* Lm, int item, int lane) {
    unsigned char* ws = p.ws;
    const bf16_t* Qn = (const bf16_t*)(ws + 4 * UNIT); const bf16_t* Kn = (const bf16_t*)(ws + 5 * UNIT);
    bf16_t* TF = (bf16_t*)(ws + 1 * UNIT) + (size_t)item * 4096; bf16_t* AF = (bf16_t*)(ws + 2 * UNIT) + (size_t)item * 4096;
    float* csc = (float*)(ws + WS_CSC) + (size_t)item * 192;
    const int c = item & 127, h = (item >> 7) & 7, dir = (item >> 10) & 1, b = item >> 11;
    const size_t rb = (size_t)b * SEQ + c * 64; const int il = lane & 15, q = lane >> 4;
    const int tl = dir ? 63 - lane : lane;
    const float g = ((const float*)(ws + WS_G))[(rb + tl) * 16 + dir * 8 + h], be = ((const float*)(ws + WS_BETA))[(rb + tl) * 16 + dir * 8 + h];
    float gc = g;
#pragma unroll
    for (int o = 1; o < 64; o <<= 1) { const float v = __shfl_up(gc, o); if (lane >= o) gc += v; }
    const float gl = __shfl(gc, 63);
    csc[tl] = __expf(gc); csc[64 + tl] = be; csc[128 + tl] = __expf(gl - gc);
    float gcr[4][4], ber[4][4], gcc[4];
#pragma unroll
    for (int t = 0; t < 4; ++t) { gcc[t] = __shfl(gc, 16 * t + il);
#pragma unroll
        for (int r = 0; r < 4; ++r) { gcr[t][r] = __shfl(gc, 16 * t + 4 * q + r); ber[t][r] = __shfl(be, 16 * t + 4 * q + r); } }
    bf16x8 Kf[4][4];
#pragma unroll
    for (int rt = 0; rt < 4; ++rt) { const int ip = 16 * rt + il; const size_t ro = (rb + (dir ? 63 - ip : ip)) * D + h * 128 + 8 * q;
#pragma unroll
        for (int ks = 0; ks < 4; ++ks) Kf[rt][ks] = *(const bf16x8*)(Kn + ro + 32 * ks); }
#pragma unroll
    for (int it = 0; it < 4; ++it)
#pragma unroll
        for (int jt = 0; jt <= it; ++jt) {
            f32x4 acc = {0.f, 0.f, 0.f, 0.f};
#pragma unroll
            for (int ks = 0; ks < 4; ++ks) acc = MFMA16(Kf[it][ks], Kf[jt][ks], acc);
#pragma unroll
            for (int r = 0; r < 4; ++r) { const int ip = 16 * it + 4 * q + r, jp = 16 * jt + il;
                Lm[ip * 64 + jp] = ip > jp ? ber[it][r] * acc[r] * __expf(gcr[it][r] - gcc[jt]) : 0.f; }
        }
    __builtin_amdgcn_sched_barrier(0);
    bf16x8 Qnext[4];
    { const int ip = il; const size_t ro = (rb + (dir ? 63 - ip : ip)) * D + h * 128 + 8 * q;
#pragma unroll
      for (int ks = 0; ks < 4; ++ks) Qnext[ks] = *(const bf16x8*)(Qn + ro + 32 * ks); }
#pragma unroll
    for (int mt = 0; mt < 4; ++mt) {
        bf16x8 Qf[4];
#pragma unroll
        for (int ks = 0; ks < 4; ++ks) Qf[ks] = Qnext[ks];
        if (mt < 3) { const int ip = 16 * (mt + 1) + il; const size_t ro = (rb + (dir ? 63 - ip : ip)) * D + h * 128 + 8 * q;
#pragma unroll
          for (int ks = 0; ks < 4; ++ks) Qnext[ks] = *(const bf16x8*)(Qn + ro + 32 * ks); }
#pragma unroll
        for (int ks2 = 0; ks2 < 2; ++ks2) {
            float vals[8];
#pragma unroll
            for (int a = 0; a < 2; ++a) { const int jt = 2 * ks2 + a; f32x4 acc = {0.f, 0.f, 0.f, 0.f};
#pragma unroll
                for (int ks = 0; ks < 4; ++ks) acc = MFMA16(Kf[jt][ks], Qf[ks], acc);
#pragma unroll
                for (int r = 0; r < 4; ++r) { const int jp = 16 * jt + 4 * q + r, ip = 16 * mt + il; vals[4 * a + r] = ip >= jp ? acc[r] * __expf(gcc[mt] - gcr[jt][r]) : 0.f; } }
            u32x4 w;
            if (dir) { w.x = cvt_pk_bf16(vals[7], vals[6]); w.y = cvt_pk_bf16(vals[5], vals[4]); w.z = cvt_pk_bf16(vals[3], vals[2]); w.w = cvt_pk_bf16(vals[1], vals[0]); }
            else { w.x = cvt_pk_bf16(vals[0], vals[1]); w.y = cvt_pk_bf16(vals[2], vals[3]); w.z = cvt_pk_bf16(vals[4], vals[5]); w.w = cvt_pk_bf16(vals[6], vals[7]); }
            const int fi = dir ? ((3 - mt) * 2 + (1 - ks2)) : (mt * 2 + ks2), ln = dir ? ((3 - q) * 16 + (15 - il)) : lane;
            *(u32x4*)(AF + (size_t)(fi * 64 + ln) * 8) = w;
        }
        __builtin_amdgcn_sched_barrier(0);
    }
    asm volatile("s_waitcnt lgkmcnt(0)" ::: "memory");
    __builtin_amdgcn_sched_barrier(0);
    float T[64];
#pragma unroll
    for (int i = 0; i < 64; ++i) {
        float s0 = (lane == i) ? 1.f : 0.f, s1 = 0.f;
#pragma unroll
        for (int m4 = 0; m4 < (i + 3) / 4; ++m4) {
            const f32x4 l4 = *(const f32x4*)(Lm + i * 64 + 4 * m4);
            if (4 * m4 + 0 < i) s0 -= l4.x * T[4 * m4 + 0];
            if (4 * m4 + 1 < i) s1 -= l4.y * T[4 * m4 + 1];
            if (4 * m4 + 2 < i) s0 -= l4.z * T[4 * m4 + 2];
            if (4 * m4 + 3 < i) s1 -= l4.w * T[4 * m4 + 3];
        }
        T[i] = s0 + s1;
        if ((i & 3) == 3) __builtin_amdgcn_sched_barrier(0);
    }
    asm volatile("s_waitcnt lgkmcnt(0)" ::: "memory");
    bf16_t* TL = (bf16_t*)Lm;
#pragma unroll
    for (int i = 0; i < 64; ++i) TL[i * 72 + lane] = (bf16_t)(cvt_pk_bf16(T[i], 0.f) & 0xffffu);
    asm volatile("s_waitcnt lgkmcnt(0)" ::: "memory");
#pragma unroll
    for (int mt = 0; mt < 4; ++mt)
#pragma unroll
        for (int ks2 = 0; ks2 < 2; ++ks2) {
            u32x4 w;
            if (dir) {
                const int row = 63 - 16 * mt - il;
                const u32x2 lo = *(const u32x2*)(TL + row * 72 + (60 - 32 * ks2 - 4 * q)), hi = *(const u32x2*)(TL + row * 72 + (44 - 32 * ks2 - 4 * q));
                w.x = (lo.y >> 16) | (lo.y << 16); w.y = (lo.x >> 16) | (lo.x << 16); w.z = (hi.y >> 16) | (hi.y << 16); w.w = (hi.x >> 16) | (hi.x << 16);
            } else {
                const int row = 16 * mt + il;
                const u32x2 lo = *(const u32x2*)(TL + row * 72 + (32 * ks2 + 4 * q)), hi = *(const u32x2*)(TL + row * 72 + (32 * ks2 + 16 + 4 * q));
                w.x = lo.x; w.y = lo.y; w.z = hi.x; w.w = hi.y;
            }
            *(u32x4*)(TF + (size_t)((mt * 2 + ks2) * 64 + lane) * 8) = w;
        }
    asm volatile("s_waitcnt lgkmcnt(0)" ::: "memory");
}
DI bf16x8 pack8(const f32x4& a, const f32x4& b) {
    u32x4 w; w.x = cvt_pk_bf16(a[0], a[1]); w.y = cvt_pk_bf16(a[2], a[3]); w.z = cvt_pk_bf16(b[0], b[1]); w.w = cvt_pk_bf16(b[2], b[3]);
    return __builtin_bit_cast(bf16x8, w);
}
DI void mfma_scan(const Params& p, int chain, int slice, int lane) {
    unsigned char* ws = p.ws;
    const bf16_t* Qn = (const bf16_t*)(ws + 4 * UNIT); const bf16_t* Kn = (const bf16_t*)(ws + 5 * UNIT); const bf16_t* KT = (const bf16_t*)(ws + 6 * UNIT); const bf16_t* Vc = (const bf16_t*)p.out;
    const bf16_t* TFb = (const bf16_t*)(ws + 1 * UNIT); const bf16_t* AFb = (const bf16_t*)(ws + 2 * UNIT); const float* cscb = (const float*)(ws + WS_CSC);
    const int b = chain >> 4, dir = (chain >> 3) & 1, h = chain & 7, il = lane & 15, q = lane >> 4;
    bf16_t* O = (dir ? (bf16_t*)(p.out) + (size_t)M * D : (bf16_t*)(ws + 3 * UNIT));
    f32x4 S[8];
#pragma unroll
    for (int dt = 0; dt < 8; ++dt) S[dt] = (f32x4){0.f, 0.f, 0.f, 0.f};
    for (int n = 0; n < 128; ++n) {
        const int c = dir ? 127 - n : n; const int item = chain * 128 + c; const size_t rowbase = (size_t)b * SEQ + c * 64;
        const bf16_t* TF = TFb + (size_t)item * 4096 + lane * 8; const bf16_t* AF = AFb + (size_t)item * 4096 + lane * 8; const float* csc = cscb + (size_t)item * 192;
        const float gl = csc[dir ? 0 : 63];
        f32x4 EG[4], BE[4], EK[4], V[4];
#pragma unroll
        for (int mt = 0; mt < 4; ++mt) { EG[mt] = *(const f32x4*)(csc + 16 * mt + 4 * q); BE[mt] = *(const f32x4*)(csc + 64 + 16 * mt + 4 * q); EK[mt] = *(const f32x4*)(csc + 128 + 16 * mt + 4 * q);
#pragma unroll
            for (int r = 0; r < 4; ++r) V[mt][r] = bf1(Vc[(rowbase + 16 * mt + 4 * q + r) * D + h * 128 + 16 * slice + il]); }
        bf16x8 Sb[4];
#pragma unroll
        for (int ks = 0; ks < 4; ++ks) Sb[ks] = pack8(S[2 * ks], S[2 * ks + 1]);
        f32x4 KS[4], QS[4];
#pragma unroll
        for (int mt = 0; mt < 4; ++mt) { const size_t ro = (rowbase + 16 * mt + il) * D + h * 128 + 8 * q;
            KS[mt] = (f32x4){0.f, 0.f, 0.f, 0.f}; QS[mt] = (f32x4){0.f, 0.f, 0.f, 0.f};
#pragma unroll
            for (int ks = 0; ks < 4; ++ks) { KS[mt] = MFMA16(*(const bf16x8*)(Kn + ro + 32 * ks), Sb[ks], KS[mt]); QS[mt] = MFMA16(*(const bf16x8*)(Qn + ro + 32 * ks), Sb[ks], QS[mt]); } }
        f32x4 X[4];
#pragma unroll
        for (int mt = 0; mt < 4; ++mt) X[mt] = BE[mt] * (V[mt] - EG[mt] * KS[mt]);
        bf16x8 Xb[2] = {pack8(X[0], X[1]), pack8(X[2], X[3])};
        f32x4 VN[4];
#pragma unroll
        for (int mt = 0; mt < 4; ++mt) { VN[mt] = (f32x4){0.f, 0.f, 0.f, 0.f};
#pragma unroll
            for (int ks2 = 0; ks2 < 2; ++ks2) VN[mt] = MFMA16(*(const bf16x8*)(TF + (size_t)((mt * 2 + ks2) * 64) * 8), Xb[ks2], VN[mt]); }
        bf16x8 VNb[2] = {pack8(VN[0], VN[1]), pack8(VN[2], VN[3])};
        bf16x8 VNs[2] = {pack8(VN[0] * EK[0], VN[1] * EK[1]), pack8(VN[2] * EK[2], VN[3] * EK[3])};
#pragma unroll
        for (int mt = 0; mt < 4; ++mt) { f32x4 o = EG[mt] * QS[mt];
#pragma unroll
            for (int ks2 = 0; ks2 < 2; ++ks2) o = MFMA16(*(const bf16x8*)(AF + (size_t)((mt * 2 + ks2) * 64) * 8), VNb[ks2], o);
#pragma unroll
            for (int r = 0; r < 4; ++r) O[(rowbase + 16 * mt + 4 * q + r) * D + h * 128 + 16 * slice + il] = (bf16_t)(cvt_pk_bf16(o[r], 0.f) & 0xffffu); }
#pragma unroll
        for (int dt = 0; dt < 8; ++dt) { const bf16_t* kt = KT + ((size_t)((b * 8 + h) * 128 + 16 * dt + il)) * SEQ + c * 64 + 8 * q; f32x4 s = S[dt] * gl;
#pragma unroll
            for (int ks2 = 0; ks2 < 2; ++ks2) s = MFMA16(*(const bf16x8*)(kt + 32 * ks2), VNs[ks2], s);
            S[dt] = s; }
    }
}
constexpr int SC_K = 0, SC_Q = 16384, SC_T = 32768, SC_A = 40960, SC_V = 49152, SC_C = 51200, SC_BUF = 52224, SC_NPIECE = 3248, SC_NLD = 384, SC_PPL = 9;
constexpr int SC_SB = 2 * SC_BUF, SC_VB = SC_SB + 2 * 4096, SC_END = SC_VB + 2 * 2048;
static_assert(SC_END <= LDS_BYTES - 256, "scan LDS");
typedef short s16x4_t __attribute__((ext_vector_type(4)));
#define SC_BAR() do { asm volatile("s_waitcnt lgkmcnt(0)" ::: "memory"); __builtin_amdgcn_s_barrier(); asm volatile("" ::: "memory"); } while (0)
DI void scan_task(const Params& p, PG8_LAS unsigned char* lds, int chain, int slice, int tid, int wave, int lane) {
    unsigned char* ws = p.ws;
    const int b = chain >> 4, dir = (chain >> 3) & 1, h = chain & 7, il = lane & 15, q = lane >> 4;
    const int c0 = dir ? 127 : 0; const long sgn = dir ? -1 : 1;
    if (wave >= 2) {
        const int lt = tid - 128; const int wbase = 64 * (wave - 2);
        const unsigned char* gp[SC_PPL]; int gstride[SC_PPL];
        const size_t rowbase0 = (size_t)b * SEQ + c0 * 64; const size_t item0 = (size_t)chain * 128 + c0;
#pragma unroll
        for (int k = 0; k < SC_PPL; ++k) {
            int pid = lt + SC_NLD * k; if (pid >= SC_NPIECE) pid -= 64;
            const unsigned char* g = ws; int st = 0;
            if (pid < 2048) { const int pp = pid & 1023, row = pp >> 4, ch = (pp & 15) ^ (row & 15);
                g = ws + (pid < 1024 ? 5 : 4) * UNIT + ((rowbase0 + row) * D + h * 128) * 2 + ch * 16; st = 64 * D * 2; }
            else if (pid < 3072) { const int pp = pid & 511; const bool isT = pid < 2560;
                g = ws + (isT ? 1 : 2) * UNIT + item0 * 8192 + pp * 16; st = 8192; }
            else if (pid < 3200) { const int pp = pid - 3072, row = pp >> 1, hf = pp & 1;
                g = (const unsigned char*)p.out + ((rowbase0 + row) * D + h * 128 + slice * 16) * 2 + hf * 16; st = 64 * D * 2; }
            else { const int pp = pid - 3200; g = ws + WS_CSC + item0 * 768 + pp * 16; st = 768; }
            gp[k] = g; gstride[k] = st;
        }
#define SC_DMA(bo) do { _Pragma("unroll") for (int k = 0; k < SC_PPL; ++k) { if (wbase + SC_NLD * k < SC_NPIECE) \
            __builtin_amdgcn_global_load_lds((const unsigned*)gp[k], (PG8_LAS unsigned*)(lds + (bo) + (wbase + SC_NLD * k) * 16), 16, 0, 0); gp[k] += sgn * gstride[k]; } } while (0)
        SC_DMA(0u);
        asm volatile("s_waitcnt vmcnt(0)" ::: "memory");
        SC_BAR();
        for (int n = 0; n < 128; ++n) {
            if (n + 1 < 128) SC_DMA((unsigned)(((n + 1) & 1) * SC_BUF));
            asm volatile("s_waitcnt vmcnt(0)" ::: "memory");
            SC_BAR();
        }
#undef SC_DMA
    } else if (wave == 0) {
        f32x4 S[8];
#pragma unroll
        for (int dt = 0; dt < 8; ++dt) S[dt] = (f32x4){0.f, 0.f, 0.f, 0.f};
        bf16x8 Sb[4];
#pragma unroll
        for (int ks = 0; ks < 4; ++ks) { Sb[ks] = pack8(S[2 * ks], S[2 * ks + 1]); *(PG8_LAS bf16x8*)(lds + SC_SB + (ks * 64 + lane) * 16) = Sb[ks]; }
        SC_BAR();
        for (int n = 0; n < 128; ++n) {
            PG8_LAS unsigned char* L = lds + (n & 1) * SC_BUF;
            bf16x8 Kf[4][4];
#pragma unroll
            for (int mt = 0; mt < 4; ++mt)
#pragma unroll
                for (int ks = 0; ks < 4; ++ks) Kf[mt][ks] = *(PG8_LAS bf16x8*)(L + SC_K + (16 * mt + il) * 256 + (((4 * ks + q) ^ il) << 4));
            f32x4 EG[4], BE[4], V[4]; bf16x8 Tf[4][2];
#pragma unroll
            for (int mt = 0; mt < 4; ++mt) { EG[mt] = *(PG8_LAS f32x4*)(L + SC_C + (16 * mt + 4 * q) * 4); BE[mt] = *(PG8_LAS f32x4*)(L + SC_C + 256 + (16 * mt + 4 * q) * 4);
#pragma unroll
                for (int r = 0; r < 4; ++r) V[mt][r] = bf1(*(PG8_LAS bf16_t*)(L + SC_V + (16 * mt + 4 * q + r) * 32 + il * 2));
#pragma unroll
                for (int ks2 = 0; ks2 < 2; ++ks2) Tf[mt][ks2] = *(PG8_LAS bf16x8*)(L + SC_T + ((mt * 2 + ks2) * 64 + lane) * 16); }
            f32x4 KS[4];
#pragma unroll
            for (int mt = 0; mt < 4; ++mt) KS[mt] = (f32x4){0.f, 0.f, 0.f, 0.f};
#pragma unroll
            for (int ks = 0; ks < 4; ++ks)
#pragma unroll
                for (int mt = 0; mt < 4; ++mt) KS[mt] = MFMA16(Kf[mt][ks], Sb[ks], KS[mt]);
            __builtin_amdgcn_sched_barrier(0);
            bf16x8 KTf[8][2]; f32x4 EK[4];
            { const int rr = il >> 2, pc = il & 3;
              PG8_LAS unsigned char* kb = L + SC_K + (4 * q + rr) * 256;
#pragma unroll
              for (int dt = 0; dt < 8; ++dt) {
                const int cho = (((4 * (dt >> 1) + pc) ^ (4 * q + rr)) << 4) + 8 * (dt & 1);
#pragma unroll
                for (int ks2 = 0; ks2 < 2; ++ks2) {
                    const s16x4_t lo_ = __builtin_amdgcn_ds_read_tr16_b64_v4i16((PG8_LAS s16x4_t*)(kb + (32 * ks2) * 256 + cho));
                    const s16x4_t hi_ = __builtin_amdgcn_ds_read_tr16_b64_v4i16((PG8_LAS s16x4_t*)(kb + (32 * ks2 + 16) * 256 + cho));
                    KTf[dt][ks2] = __builtin_shufflevector(lo_, hi_, 0, 1, 2, 3, 4, 5, 6, 7);
                } } }
#pragma unroll
            for (int mt = 0; mt < 4; ++mt) EK[mt] = *(PG8_LAS f32x4*)(L + SC_C + 512 + (16 * mt + 4 * q) * 4);
            const float gl = *(PG8_LAS float*)(L + SC_C + (dir ? 0 : 63) * 4);
            f32x4 X[4];
#pragma unroll
            for (int mt = 0; mt < 4; ++mt) X[mt] = BE[mt] * (V[mt] - EG[mt] * KS[mt]);
            bf16x8 Xb[2] = {pack8(X[0], X[1]), pack8(X[2], X[3])};
            f32x4 VN[4];
#pragma unroll
            for (int mt = 0; mt < 4; ++mt) VN[mt] = (f32x4){0.f, 0.f, 0.f, 0.f};
#pragma unroll
            for (int ks2 = 0; ks2 < 2; ++ks2)
#pragma unroll
                for (int mt = 0; mt < 4; ++mt) VN[mt] = MFMA16(Tf[mt][ks2], Xb[ks2], VN[mt]);
            *(PG8_LAS bf16x8*)(lds + SC_VB + (n & 1) * 2048 + lane * 16) = pack8(VN[0], VN[1]); *(PG8_LAS bf16x8*)(lds + SC_VB + (n & 1) * 2048 + (64 + lane) * 16) = pack8(VN[2], VN[3]);
            bf16x8 VNs[2] = {pack8(VN[0] * EK[0], VN[1] * EK[1]), pack8(VN[2] * EK[2], VN[3] * EK[3])};
#pragma unroll
            for (int dt = 0; dt < 8; ++dt) S[dt] = S[dt] * gl;
#pragma unroll
            for (int ks2 = 0; ks2 < 2; ++ks2)
#pragma unroll
                for (int dt = 0; dt < 8; ++dt) S[dt] = MFMA16(KTf[dt][ks2], VNs[ks2], S[dt]);
#pragma unroll
            for (int ks = 0; ks < 4; ++ks) { Sb[ks] = pack8(S[2 * ks], S[2 * ks + 1]); *(PG8_LAS bf16x8*)(lds + SC_SB + ((n + 1) & 1) * 4096 + (ks * 64 + lane) * 16) = Sb[ks]; }
            SC_BAR();
        }
    } else {
        bf16_t* O = (dir ? (bf16_t*)(p.out) + (size_t)M * D : (bf16_t*)(ws + 3 * UNIT));
        f32x4 Oa[4]; bf16x8 Af[4][2];
#pragma unroll
        for (int mt = 0; mt < 4; ++mt) { Oa[mt] = (f32x4){0.f, 0.f, 0.f, 0.f}; Af[mt][0] = (bf16x8){0, 0, 0, 0, 0, 0, 0, 0}; Af[mt][1] = Af[mt][0]; }
        SC_BAR();
        for (int n = 0; n <= 128; ++n) {
            if (n > 0) {
                const int c = dir ? 128 - n : n - 1; const size_t rowbase = (size_t)b * SEQ + c * 64;
                PG8_LAS unsigned char* vb = lds + SC_VB + ((n - 1) & 1) * 2048;
                bf16x8 VNb[2] = {*(PG8_LAS bf16x8*)(vb + lane * 16), *(PG8_LAS bf16x8*)(vb + (64 + lane) * 16)};
#pragma unroll
                for (int ks2 = 0; ks2 < 2; ++ks2)
#pragma unroll
                    for (int mt = 0; mt < 4; ++mt) Oa[mt] = MFMA16(Af[mt][ks2], VNb[ks2], Oa[mt]);
#pragma unroll
                for (int mt = 0; mt < 4; ++mt)
#pragma unroll
                    for (int r = 0; r < 4; ++r) O[(rowbase + 16 * mt + 4 * q + r) * D + h * 128 + 16 * slice + il] = (bf16_t)(cvt_pk_bf16(Oa[mt][r], 0.f) & 0xffffu);
            }
            if (n < 128) {
                PG8_LAS unsigned char* L = lds + (n & 1) * SC_BUF;
                bf16x8 Qf[4][4], Sb[4]; f32x4 EG[4];
#pragma unroll
                for (int ks = 0; ks < 4; ++ks) Sb[ks] = *(PG8_LAS bf16x8*)(lds + SC_SB + (n & 1) * 4096 + (ks * 64 + lane) * 16);
#pragma unroll
                for (int mt = 0; mt < 4; ++mt) {
#pragma unroll
                    for (int ks = 0; ks < 4; ++ks) Qf[mt][ks] = *(PG8_LAS bf16x8*)(L + SC_Q + (16 * mt + il) * 256 + (((4 * ks + q) ^ il) << 4));
                    EG[mt] = *(PG8_LAS f32x4*)(L + SC_C + (16 * mt + 4 * q) * 4);
#pragma unroll
                    for (int ks2 = 0; ks2 < 2; ++ks2) Af[mt][ks2] = *(PG8_LAS bf16x8*)(L + SC_A + ((mt * 2 + ks2) * 64 + lane) * 16); }
                f32x4 QS[4];
#pragma unroll
                for (int mt = 0; mt < 4; ++mt) QS[mt] = (f32x4){0.f, 0.f, 0.f, 0.f};
#pragma unroll
                for (int ks = 0; ks < 4; ++ks)
#pragma unroll
                    for (int mt = 0; mt < 4; ++mt) QS[mt] = MFMA16(Qf[mt][ks], Sb[ks], QS[mt]);
#pragma unroll
                for (int mt = 0; mt < 4; ++mt) Oa[mt] = EG[mt] * QS[mt];
                SC_BAR();
            }
        }
    }
}


typedef const __attribute__((address_space(4))) Params* kparams_t;
#if defined(__HIP_DEVICE_COMPILE__)
DI Params load_params() { kparams_t pp = (kparams_t)__builtin_amdgcn_kernarg_segment_ptr(); asm volatile("" : "+s"(pp)); return *pp; }
#else
DI Params load_params() { return Params{}; }
#endif
#define PP() load_params()
#define XB_TMO      128
#define XB_XCNT(j)  (256  + 64 * (j))
#define XB_XSUB(j)  (1280 + 64 * (j))
#define XB_XGEN(j)  (2304 + 64 * (j))
#define XB_TOP      3328
#define XB_TOPGEN   3392
#define XCD_BAR_WORDS 3456
#define XB_SPIN_CAP (1u << 18)
#define LAS __attribute__((address_space(3)))

__device__ __forceinline__ unsigned xb_ld(unsigned* p)              { return __hip_atomic_load(p, __ATOMIC_RELAXED, __HIP_MEMORY_SCOPE_AGENT); }
__device__ __forceinline__ unsigned xb_add(unsigned* p, unsigned v) { return __hip_atomic_fetch_add(p, v, __ATOMIC_RELAXED, __HIP_MEMORY_SCOPE_AGENT); }
__device__ __forceinline__ unsigned xb_xcc_id() { return (unsigned)__builtin_amdgcn_s_getreg((3 << 11) | 20) & 0xFu; }
#define XB_SPIN(cond, bar) do { unsigned _sp = 0; while (cond) { __builtin_amdgcn_s_sleep(1); \
    if ((++_sp & 255u) == 0u) { if (xb_ld(&(bar)[XB_TMO])) break; if (_sp > XB_SPIN_CAP) { atomicAdd(&(bar)[XB_TMO], 1u); break; } } } } while (0)

struct XcdBarrier {
    unsigned* bar; unsigned x;
    volatile LAS unsigned* st;
};

__device__ __forceinline__ XcdBarrier xcd_barrier_post(unsigned* bar, volatile LAS unsigned* st) {
    XcdBarrier b; b.bar = bar; b.x = xb_xcc_id(); b.st = st;
    if (threadIdx.x == 0) (void)xb_add(&bar[XB_XCNT(b.x)], 1u);
    return b;
}
__device__ __forceinline__ void xcd_barrier_complete(unsigned* bar, unsigned x, unsigned& nloc, unsigned& nx) {
    const unsigned G = gridDim.x * gridDim.y * gridDim.z;
    unsigned sum, cnt, mine, sp = 0u;
    for (;;) {
        sum = 0u; cnt = 0u; mine = 0u;
#pragma unroll
        for (unsigned j = 0; j < 16; ++j) { const unsigned c = xb_ld(&bar[XB_XCNT(j)]); sum += c; cnt += (c > 0u) ? 1u : 0u; mine = (j == x) ? c : mine; }
        if (sum == G) break;
        __builtin_amdgcn_s_sleep(1);
        if ((++sp & 255u) == 0u) { if (xb_ld(&bar[XB_TMO])) break; if (sp > XB_SPIN_CAP) { atomicAdd(&bar[XB_TMO], 1u); break; } }
    }
    nloc = mine > 0u ? mine : 1u; nx = cnt > 0u ? cnt : 1u;
}

__device__ __forceinline__ void xcd_barrier(const XcdBarrier& b) {
    asm volatile("s_waitcnt vmcnt(0)" ::: "memory");
    __syncthreads();
    if (threadIdx.x == 0) {
        unsigned* bar = b.bar;
        __builtin_amdgcn_s_waitcnt(0);
        unsigned nloc = b.st[0], nx = b.st[1];
        if (nloc == 0u) { xcd_barrier_complete(bar, b.x, nloc, nx); b.st[0] = nloc; b.st[1] = nx; }
        const unsigned old = xb_add(&bar[XB_XSUB(b.x)], 1u);
        const unsigned gen = old / nloc;
        if (old + 1u == (gen + 1u) * nloc) {
            __builtin_amdgcn_fence(__ATOMIC_RELEASE, "agent");
            asm volatile("s_waitcnt vmcnt(0)" ::: "memory");
            const unsigned og = xb_add(&bar[XB_TOP], 1u);
            const unsigned tg = og / nx;
            if (og + 1u == (tg + 1u) * nx) xb_add(&bar[XB_TOPGEN], 1u);
            else XB_SPIN(xb_ld(&bar[XB_TOPGEN]) == tg, bar);
            __builtin_amdgcn_fence(__ATOMIC_ACQUIRE, "agent");
            xb_add(&bar[XB_XGEN(b.x)], 1u);
            asm volatile("s_waitcnt vmcnt(0)" ::: "memory");
        } else {
            XB_SPIN(xb_ld(&bar[XB_XGEN(b.x)]) == gen, bar);
            __builtin_amdgcn_fence(__ATOMIC_ACQUIRE, "agent");
            asm volatile("s_waitcnt vmcnt(0)" ::: "memory");
        }
    }
    __syncthreads();
}


constexpr size_t WS_BAR = 255 * MiB + 320 * 1024;
DI int fresh_tid() { int t = threadIdx.x; asm volatile("" : "+v"(t)); return t; }
#define IDS const int tid = fresh_tid(), lane = tid & 63, wave = __builtin_amdgcn_readfirstlane(tid >> 6); const int G = gridDim.x, bx = blockIdx.x; \
    const int gw = bx * NWAVES + wave, NGW = G * NWAVES, gtid = bx * NTHREADS + tid, NGT = G * NTHREADS; (void)lane; (void)gw; (void)NGW; (void)gtid; (void)NGT; (void)wave;
__global__ void __launch_bounds__(NTHREADS, 2) fwd_kernel(Params p) {
    extern __shared__ __attribute__((aligned(16))) unsigned char lds[];
    cg::grid_group grid = cg::this_grid();
    PG8_LAS unsigned char* ldsl = (PG8_LAS unsigned char*)lds;
    if (threadIdx.x < 4) ((PG8_LAS unsigned*)(ldsl + (LDS_BYTES - 256)))[threadIdx.x] = 0u;
    __syncthreads();
    const XcdBarrier bar = xcd_barrier_post((unsigned*)(PP().ws + WS_BAR), (volatile PG8_LAS unsigned*)(ldsl + (LDS_BYTES - 256)));

    { IDS phase0(PP(), gw, NGW, lane); }
    if (PP().ws == nullptr) grid.sync();
    xcd_barrier(bar);
    { IDS phase1(PP(), (float*)lds, gw, NGW, lane, tid); }
    xcd_barrier(bar);
    {
        const Params q = PP(); unsigned char* ws = q.ws; bf16_t* WIN = (bf16_t*)(ws + WS_WIN); const int G = gridDim.x, bx = blockIdx.x;
        pg8::Gemm g{(const bf16_t*)(ws + 0 * UNIT), WIN + (size_t)ROWS_A * D, M, NB_TILES * 256, D}; pg8::StaticOrder S; S.init(M, NB_TILES * 256, G, bx);
        EpiB E{(bf16_t*)(ws + 1 * UNIT)};
        pg8::gemm_phase<EpiB, pg8::StaticOrder, true, true>(ldsl, g, S, E);
    }
    { IDS for (int it = gw; it < M / 16; it += NGW) ab_item(PP(), it, lane); }
    xcd_barrier(bar);
    { IDS for (int it = gw; it < 4096; it += NGW) phase3_item(PP(), it, lane); }
    xcd_barrier(bar);
    { IDS for (int it = gw; it < 4096; it += NGW) chunk_prep_item(PP(), (float*)(lds + wave * 16384), it, lane); }
    xcd_barrier(bar);
    for (int tk = blockIdx.x; tk < 256; tk += gridDim.x) { const int t2 = fresh_tid(); scan_task(PP(), ldsl, (tk & 7) + 8 * (tk >> 6), (tk >> 3) & 7, t2, __builtin_amdgcn_readfirstlane(t2 >> 6), t2 & 63); __syncthreads(); }
    xcd_barrier(bar);
    {
        const Params q = PP(); unsigned char* ws = q.ws; bf16_t* WIN = (bf16_t*)(ws + WS_WIN); const int G = gridDim.x, bx = blockIdx.x;
        pg8::Gemm g{(const bf16_t*)(ws + 0 * UNIT), WIN, M, NA_TILES * 256, D}; pg8::StaticOrder S; S.init(M, NA_TILES * 256, G, bx);
        EpiA E{(bf16_t*)(ws + 1 * UNIT), (bf16_t*)(ws + 4 * UNIT)};
        pg8::gemm_phase<EpiA, pg8::StaticOrder, true, true>(ldsl, g, S, E);
    }
    xcd_barrier(bar);
    { IDS phase7(PP(), gw, NGW, lane, gtid, NGT); }
    xcd_barrier(bar);
    if (gridDim.x == 256) {
        const Params q = PP(); unsigned char* ws = q.ws; const int G = gridDim.x, bx = blockIdx.x;
        static_assert(6 * UNIT - 2 * UNIT == (size_t)256 * 256 * D * 2 && WS_WPB - WS_WPA == (size_t)4 * 256 * D * 2, "TwoGemmOrder address arithmetic");
        TwoGemmOrder S; S.so.init(M, D, G, bx);
        pg8::Gemm g{(const bf16_t*)(ws + 2 * UNIT), (const bf16_t*)(ws + WS_WPA), M, D, D}; EpiYaYb E{(bf16_t*)(ws + 4 * UNIT), (const bf16_t*)(ws + 5 * UNIT)};
        pg8::gemm_phase<EpiYaYb, TwoGemmOrder, true, true>(ldsl, g, S, E);
    } else {
        const Params q = PP(); unsigned char* ws = q.ws; const int G = gridDim.x, bx = blockIdx.x;
        pg8::StaticOrder S; S.init(M, D, G, bx);
        { pg8::Gemm g{(const bf16_t*)(ws + 2 * UNIT), (const bf16_t*)(ws + WS_WPA), M, D, D}; EpiYa E{(bf16_t*)(ws + 4 * UNIT)};
          pg8::gemm_phase<EpiYa, pg8::StaticOrder, true, true>(ldsl, g, S, E); }
        { pg8::Gemm g{(const bf16_t*)(ws + 6 * UNIT), (const bf16_t*)(ws + WS_WPB), M, D, D}; EpiYb E{(bf16_t*)(ws + 4 * UNIT), (const bf16_t*)(ws + 5 * UNIT)};
          pg8::gemm_phase<EpiYb, pg8::StaticOrder, true, true>(ldsl, g, S, E); }
    }
    xcd_barrier(bar);
    if (gridDim.x == 256) {
        const Params q = PP(); unsigned char* ws = q.ws; const int G = gridDim.x, bx = blockIdx.x;
        pg8::Gemm g{(const bf16_t*)(ws + 4 * UNIT), (const bf16_t*)(ws + WS_WO), M, D, D}; pg8::StaticOrder S; S.init(M, D, G, bx);
        EpiOutFused E{q.in[0], (const float*)(ws + WS_MODF), q.in[14], q.out, (float*)(ws + WS_PSS), (unsigned*)(ws + WS_PCNT)};
        pg8::gemm_phase<EpiOutFused, pg8::StaticOrder, true, true>(ldsl, g, S, E);
    } else {
        {
            const Params q = PP(); unsigned char* ws = q.ws; const int G = gridDim.x, bx = blockIdx.x;
            pg8::Gemm g{(const bf16_t*)(ws + 4 * UNIT), (const bf16_t*)(ws + WS_WO), M, D, D}; pg8::StaticOrder S; S.init(M, D, G, bx);
            EpiOut E{q.in[0], (const float*)(ws + WS_MODF), (float*)(ws + 0 * UNIT)};
            pg8::gemm_phase<EpiOut, pg8::StaticOrder, true, true>(ldsl, g, S, E);
        }
        xcd_barrier(bar);
        { IDS phase10(PP(), gw, NGW, lane); }
    }
}

extern "C" void kernel_launch(void* const* d_in, const int* in_sizes, int n_in, void* d_out, int out_size, void* d_ws, size_t ws_size, hipStream_t stream) {
    static int grid = 0;
    if (grid == 0) {
        int dev = 0, cus = 0, per_cu = 0;
        if (n_in != 15 || out_size != M * D || ws_size < 256 * MiB) { fprintf(stderr, "kernel_launch: unexpected shapes (n_in %d out %d ws %zu)\n", n_in, out_size, ws_size); grid = -1; return; }
        hipGetDevice(&dev); hipDeviceGetAttribute(&cus, hipDeviceAttributeMultiprocessorCount, dev);
        if (hipFuncSetAttribute((const void*)fwd_kernel, hipFuncAttributeMaxDynamicSharedMemorySize, LDS_BYTES) != hipSuccess) { fprintf(stderr, "kernel_launch: hipFuncSetAttribute failed\n"); grid = -1; return; }
        hipOccupancyMaxActiveBlocksPerMultiprocessor(&per_cu, (const void*)fwd_kernel, NTHREADS, LDS_BYTES);
        if (per_cu < 1) { fprintf(stderr, "kernel_launch: occupancy query says %d blocks/CU\n", per_cu); per_cu = 1; }
        (void)hipGetLastError();
        grid = cus;
    }
    if (grid < 0) return;
    if (hipMemsetAsync((char*)d_ws + WS_BAR, 0, 32768, stream) != hipSuccess) { fprintf(stderr, "kernel_launch: memset of barrier words failed\n"); return; }
    Params p{};
    for (int i = 0; i < 15; ++i) p.in[i] = (const float*)d_in[i];
    p.out = (float*)d_out; p.ws = (unsigned char*)d_ws;
    void* args[] = {&p};
    hipError_t e = hipLaunchCooperativeKernel((const void*)fwd_kernel, dim3(grid), dim3(NTHREADS), args, LDS_BYTES, stream);
    if (e != hipSuccess) fprintf(stderr, "cooperative launch failed: %s (grid %d)\n", hipGetErrorString(e), grid);
}
```

```cpp
#include <hip/hip_runtime.h>
#include <hip/hip_cooperative_groups.h>
#include <cstdio>
#include <cstdint>
namespace cg = cooperative_groups;

#define DI __device__ __forceinline__
#define PG8_LAS __attribute__((address_space(3)))
typedef unsigned short bf16_t;
typedef short bf16x8 __attribute__((ext_vector_type(8)));
typedef float f32x4 __attribute__((ext_vector_type(4)));
typedef float f32x2 __attribute__((ext_vector_type(2)));
typedef unsigned u32x4 __attribute__((ext_vector_type(4)));
typedef unsigned u32x2 __attribute__((ext_vector_type(2)));

namespace pg8 {
constexpr int BM = 256, BK = 64, HALF = 128, HTB = HALF * BK * 2, STAGE_BYTES = 8 * HTB, NXCD = 8, WGM = 8;
__host__ __device__ __forceinline__ int lds_byte(int r, int c) { const int st = (r >> 4) * 2 + (c >> 5), rr = r & 15, cc = c & 31, ob = rr * 64 + cc * 2; return st * 1024 + (ob ^ (((ob >> 9) & 1) << 5)); }
__host__ __device__ __forceinline__ void stage_rc(int b, int& R, int& C) { const int st = b / 1024, sb = b % 1024, swz = sb ^ (((sb >> 9) & 1) << 5); R = (st >> 1) * 16 + swz / 64; C = (st & 1) * 32 + (swz % 64) / 2; }
__host__ __device__ __forceinline__ int perm32(int rho) { const int n = rho >> 4, i = rho & 15; return 8 * (i >> 2) + 4 * n + (i & 3); }
struct Unit { int pm, pn; };
struct Gemm { const bf16_t* A; const bf16_t* Bt; int M, N, K; };
struct StaticOrder {
    int nM, nN, nwg, G, c;
    __host__ __device__ void init(int M, int N, int G_, int c_) { nM = M / BM; nN = N / BM; nwg = nM * nN; G = G_; c = c_; }
    __host__ __device__ bool next(int i, Unit& u) const {
        const long L = (long)i * G + c; if (L >= nwg) return false;
        int wgid = (int)L; { const int q = nwg / NXCD, r = nwg % NXCD, xcd = wgid % NXCD, off = wgid / NXCD; wgid = (xcd < r ? xcd * (q + 1) : r * (q + 1) + (xcd - r) * q) + off; }
        const int nig = WGM * nN, gid = wgid / nig, fm = gid * WGM, gsz = (nM - fm) < WGM ? (nM - fm) : WGM;
        u.pm = fm + ((wgid % nig) % gsz); u.pn = (wgid % nig) / gsz; return true;
    }
    __device__ __forceinline__ void a_ready(const Unit&) const {}
    __device__ __forceinline__ void done(const Unit&) const {}
};
template <class Epi, class Sched, bool ALIGN_EPI = false, bool SP2 = false>
__device__ __forceinline__ void gemm_phase(PG8_LAS unsigned char* lds, const Gemm g, const Sched& S, const Epi& E) {
    int tid = threadIdx.x; asm volatile("" : "+v"(tid)); const int wid = __builtin_amdgcn_readfirstlane(tid >> 6), lane = tid & 63, wr = wid >> 2, wc = wid & 3, fr = lane & 15, fq = lane >> 4;
    const int K = g.K, nt = K / BK;
    unsigned voffA[2], voffB[2];
#pragma unroll
    for (int i = 0; i < 2; ++i) { int R, C; stage_rc(tid * 16 + i * 8192, R, C); const int Rb = Epi::PERM ? ((R & ~31) + perm32(R & 31)) : R;
        voffA[i] = (unsigned)(R * K + C) * 2u; voffB[i] = (unsigned)(Rb * K + C) * 2u; }
    const size_t kstep = (size_t)(BK * 2);
    const size_t hstep = (size_t)HALF * K * 2;
    const size_t tstep = 2 * hstep;
    const unsigned ldsw = (unsigned)wid * 1024u;
    const int aoff = lds_byte(wr * 64 + fr, fq * 8), boff = lds_byte(wc * 32 + fr, fq * 8);
#define PG8_SA(b, h) (((b) * 2 + (h)) * HTB)
#define PG8_SB(b, h) ((4 + (b) * 2 + (h)) * HTB)
#define PG8_STAGE(bufoff, gbase, voff) do { _Pragma("unroll") for (int _i = 0; _i < 2; ++_i) \
        __builtin_amdgcn_global_load_lds((const unsigned*)((const char*)(gbase) + (voff)[_i]), (PG8_LAS unsigned*)(lds + (bufoff) + ldsw + _i * 8192), 16, 0, 0); } while (0)
#define PG8_LDA(dst, b, h) do { _Pragma("unroll") for (int m = 0; m < 4; ++m) _Pragma("unroll") for (int k = 0; k < 2; ++k) dst[m][k] = *(const PG8_LAS bf16x8*)(lds + PG8_SA(b, h) + aoff + m * 2048 + k * 1024); } while (0)
#define PG8_LDB(dst, b, h) do { _Pragma("unroll") for (int n = 0; n < 2; ++n) _Pragma("unroll") for (int k = 0; k < 2; ++k) dst[n][k] = *(const PG8_LAS bf16x8*)(lds + PG8_SB(b, h) + boff + n * 2048 + k * 1024); } while (0)
#define PG8_MMA(ai, bj, At, Bt) do { __builtin_amdgcn_s_setprio(1); _Pragma("unroll") for (int m = 0; m < 4; ++m) _Pragma("unroll") for (int n = 0; n < 2; ++n) _Pragma("unroll") for (int k = 0; k < 2; ++k) \
        acc[ai][bj][m][n] = __builtin_amdgcn_mfma_f32_16x16x32_bf16(Bt[n][k], At[m][k], acc[ai][bj][m][n], 0, 0, 0); __builtin_amdgcn_s_setprio(0); } while (0)
#define PG8_WAIT_V(n) asm volatile("s_waitcnt vmcnt(" #n ")" ::: "memory")
#define PG8_WAIT_L(n) asm volatile("s_waitcnt lgkmcnt(" #n ")" ::: "memory")
#define PG8_BAR __builtin_amdgcn_s_barrier()
#define PG8_SCHED __builtin_amdgcn_sched_barrier(0)
    Unit cur, nxt; int ui = 0;
    if (!S.next(0, cur)) return;
    f32x4 acc[2][2][4][2];
#pragma unroll
    for (int a = 0; a < 2; ++a)
#pragma unroll
        for (int b = 0; b < 2; ++b)
#pragma unroll
            for (int m = 0; m < 4; ++m)
#pragma unroll
                for (int n = 0; n < 2; ++n) acc[a][b][m][n] = (f32x4){0.f, 0.f, 0.f, 0.f};
    bf16x8 At[4][2], B0[2][2], B1[2][2];
    const char* cA = (const char*)g.A + (size_t)cur.pm * tstep; const char* cB = (const char*)g.Bt + (size_t)cur.pn * tstep;
    S.a_ready(cur);
    if constexpr (SP2) {
        PG8_STAGE(PG8_SB(0, 0), cB, voffB); PG8_STAGE(PG8_SB(0, 1), cB + hstep, voffB); PG8_STAGE(PG8_SA(0, 0), cA, voffA); PG8_STAGE(PG8_SA(0, 1), cA + hstep, voffA);
        if (wr == 1) PG8_BAR;
        PG8_WAIT_V(2); PG8_BAR;
        PG8_STAGE(PG8_SB(1, 0), cB + kstep, voffB); PG8_STAGE(PG8_SA(1, 0), cA + kstep, voffA); PG8_STAGE(PG8_SB(1, 1), cB + hstep + kstep, voffB);
        PG8_WAIT_V(6); PG8_BAR;
    } else {
        PG8_STAGE(PG8_SB(0, 0), cB, voffB); PG8_STAGE(PG8_SA(0, 0), cA, voffA); PG8_STAGE(PG8_SB(0, 1), cB + hstep, voffB); PG8_STAGE(PG8_SA(0, 1), cA + hstep, voffA);
        if (wr == 1) PG8_BAR;
        PG8_WAIT_V(4); PG8_BAR;
        PG8_STAGE(PG8_SB(1, 0), cB + kstep, voffB); PG8_STAGE(PG8_SA(1, 0), cA + kstep, voffA); PG8_STAGE(PG8_SB(1, 1), cB + hstep + kstep, voffB);
        PG8_WAIT_V(6); PG8_BAR;
    }
    for (;;) {
        const bool has_next = S.next(ui + 1, nxt);
        const char* nA = has_next ? (const char*)g.A + (size_t)nxt.pm * tstep : cA; const char* nB = has_next ? (const char*)g.Bt + (size_t)nxt.pn * tstep : cB;
        for (int t = 0; t < nt; t += 2) {
            const bool last = (t == nt - 2);
            const char* a1 = cA + (size_t)(t + 1) * kstep;
            const char* a2 = last ? nA : cA + (size_t)(t + 2) * kstep; const char* b2 = last ? nB : cB + (size_t)(t + 2) * kstep;
            const char* a3 = a2 + kstep; const char* b3 = b2 + kstep;
            if (last && has_next) S.a_ready(nxt);
            if constexpr (SP2) {
            PG8_LDB(B0, 0, 0); PG8_LDB(B1, 0, 1); PG8_SCHED; PG8_LDA(At, 0, 0); PG8_STAGE(PG8_SA(1, 1), a1 + hstep, voffA);
            PG8_WAIT_V(8); PG8_WAIT_L(0); PG8_BAR; PG8_MMA(0, 0, At, B0); PG8_MMA(0, 1, At, B1); PG8_BAR; PG8_SCHED;
            PG8_LDA(At, 0, 1); PG8_STAGE(PG8_SB(0, 0), b2, voffB); PG8_STAGE(PG8_SB(0, 1), b2 + hstep, voffB); PG8_STAGE(PG8_SA(0, 0), a2, voffA);
            PG8_WAIT_V(8); PG8_WAIT_L(0); PG8_BAR; PG8_MMA(1, 0, At, B0); PG8_MMA(1, 1, At, B1); PG8_BAR; PG8_SCHED;
            PG8_LDB(B0, 1, 0); PG8_LDB(B1, 1, 1); PG8_SCHED; PG8_LDA(At, 1, 0); PG8_STAGE(PG8_SA(0, 1), a2 + hstep, voffA);
            PG8_WAIT_V(8); PG8_WAIT_L(0); PG8_BAR; PG8_MMA(0, 0, At, B0); PG8_MMA(0, 1, At, B1); PG8_BAR; PG8_SCHED;
            PG8_LDA(At, 1, 1); PG8_STAGE(PG8_SB(1, 0), b3, voffB); PG8_STAGE(PG8_SB(1, 1), b3 + hstep, voffB); PG8_STAGE(PG8_SA(1, 0), a3, voffA);
            PG8_WAIT_V(8); PG8_WAIT_L(0); PG8_BAR; PG8_MMA(1, 0, At, B0); PG8_MMA(1, 1, At, B1); PG8_BAR; PG8_SCHED;
            } else {
            PG8_LDB(B0, 0, 0); PG8_SCHED; PG8_LDA(At, 0, 0); PG8_STAGE(PG8_SA(1, 1), a1 + hstep, voffA);
            PG8_WAIT_L(8); PG8_BAR; PG8_WAIT_L(0); PG8_MMA(0, 0, At, B0); PG8_BAR; PG8_SCHED;
            PG8_LDB(B1, 0, 1); PG8_STAGE(PG8_SB(0, 0), b2, voffB);
            PG8_BAR; PG8_WAIT_L(0); PG8_MMA(0, 1, At, B1); PG8_BAR;
            PG8_LDA(At, 0, 1); PG8_STAGE(PG8_SA(0, 0), a2, voffA);
            PG8_BAR; PG8_WAIT_L(0); PG8_MMA(1, 0, At, B0); PG8_BAR; PG8_SCHED;
            PG8_STAGE(PG8_SB(0, 1), b2 + hstep, voffB);
            PG8_WAIT_V(6); PG8_BAR; PG8_MMA(1, 1, At, B1); PG8_BAR;
            PG8_LDB(B0, 1, 0); PG8_SCHED; PG8_LDA(At, 1, 0); PG8_STAGE(PG8_SA(0, 1), a2 + hstep, voffA);
            PG8_WAIT_L(8); PG8_BAR; PG8_WAIT_L(0); PG8_MMA(0, 0, At, B0); PG8_BAR; PG8_SCHED;
            PG8_LDB(B1, 1, 1); PG8_STAGE(PG8_SB(1, 0), b3, voffB);
            PG8_BAR; PG8_WAIT_L(0); PG8_MMA(0, 1, At, B1); PG8_BAR;
            PG8_LDA(At, 1, 1); PG8_STAGE(PG8_SA(1, 0), a3, voffA);
            PG8_BAR; PG8_WAIT_L(0); PG8_MMA(1, 0, At, B0); PG8_BAR; PG8_SCHED;
            PG8_STAGE(PG8_SB(1, 1), b3 + hstep, voffB);
            PG8_WAIT_V(6); PG8_BAR; PG8_MMA(1, 1, At, B1); PG8_BAR;
            }
        }
        if constexpr (ALIGN_EPI) { if (wr == 0) PG8_BAR; }
        if constexpr (!Epi::AFTER_DRAIN) { E(acc, cur, wr, wc, fr, fq); S.done(cur); }
        if (!has_next) break;
#pragma unroll
        for (int a = 0; a < 2; ++a)
#pragma unroll
            for (int b = 0; b < 2; ++b)
#pragma unroll
                for (int m = 0; m < 4; ++m)
#pragma unroll
                    for (int n = 0; n < 2; ++n) acc[a][b][m][n] = (f32x4){0.f, 0.f, 0.f, 0.f};
        cur = nxt; cA = nA; cB = nB; ++ui;
        if constexpr (ALIGN_EPI) { if (wr == 1) PG8_BAR; }
    }
    PG8_WAIT_V(0);
    if constexpr (!ALIGN_EPI) { if (wr == 0) PG8_BAR; }
    PG8_BAR;
    if constexpr (Epi::AFTER_DRAIN) { E.fused(acc, cur, wr, wc, fr, fq, lds, wid, lane); S.done(cur); }
#undef PG8_SA
#undef PG8_SB
#undef PG8_STAGE
#undef PG8_LDA
#undef PG8_LDB
#undef PG8_MMA
#undef PG8_WAIT_V
#undef PG8_WAIT_L
#undef PG8_BAR
#undef PG8_SCHED
}}

constexpr int SEQ = 8192, NB = 2, M = NB * SEQ, D = 1024, NIN = 10272, NPAD = 10496;
constexpr int NA_TILES = 28, NB_TILES = 12, ROWS_A = NA_TILES * 256;
constexpr size_t MiB = 1u << 20;
constexpr size_t UNIT = 32 * MiB;
constexpr size_t WS_WIN = 224 * MiB, WS_WPA = 245 * MiB, WS_WPB = 247 * MiB, WS_WO = 249 * MiB, WS_AB = 251 * MiB, WS_G = 253 * MiB, WS_BETA = 254 * MiB;
constexpr size_t WS_MODP = 255 * MiB, WS_MODF = 255 * MiB + 256 * 1024;
constexpr size_t WS_CSC = 239 * MiB;
constexpr int LDS_BYTES = 155648;
constexpr int NWAVES = 8, NTHREADS = 512;
constexpr float NORM_EPS = 1e-6f, L2_EPS = 1e-6f;

struct Params { const float* in[15]; float* out; unsigned char* ws; };

typedef __bf16 bf16v2_t __attribute__((ext_vector_type(2)));
DI unsigned cvt_pk_bf16(float lo, float hi) { const f32x2 v = {lo, hi}; const bf16v2_t r = __builtin_convertvector(v, bf16v2_t); return __builtin_bit_cast(unsigned, r); }
DI float bf_lo(unsigned u) { return __uint_as_float(u << 16); }
DI float bf_hi(unsigned u) { return __uint_as_float(u & 0xffff0000u); }
DI float bf1(bf16_t u) { return __uint_as_float(((unsigned)u) << 16); }
DI float sigmoidf_(float x) { return __builtin_amdgcn_rcpf(1.0f + __expf(-x)); }
DI float siluf_(float x) { return x * __builtin_amdgcn_rcpf(1.0f + __expf(-x)); }
DI float softplusf_(float x) { return fmaxf(x, 0.f) + log1pf(__expf(-fabsf(x))); }
#define DPP_F(v, ctrl) __builtin_bit_cast(float, __builtin_amdgcn_mov_dpp(__builtin_bit_cast(int, (v)), (ctrl), 0xF, 0xF, true))
DI float row16_sum(float v) {
    v += DPP_F(v, 0xB1);
    v += DPP_F(v, 0x4E);
    v += DPP_F(v, 0x141);
    v += DPP_F(v, 0x140);
    return v;
}
DI float wave_sum(float v) {
    v = row16_sum(v);
    return __builtin_bit_cast(float, __builtin_amdgcn_readlane(__builtin_bit_cast(int, v), 0)) + __builtin_bit_cast(float, __builtin_amdgcn_readlane(__builtin_bit_cast(int, v), 16))
         + __builtin_bit_cast(float, __builtin_amdgcn_readlane(__builtin_bit_cast(int, v), 32)) + __builtin_bit_cast(float, __builtin_amdgcn_readlane(__builtin_bit_cast(int, v), 48));
}
DI int permpos(int dk) { const int loc = dk & 31; return (dk & ~31) + 8 * ((loc >> 2) & 3) + 4 * (loc >> 4) + (loc & 3); }
DI int win_src_col(int d) {
    if (d < 2048) { const int i = d >> 8, w = d & 255; return w < 128 ? (128 * i + w) : (2048 + 128 * i + (w - 128)); }
    if (d < 4096) { const int i = (d - 2048) >> 8, w = d & 255; return w < 128 ? (1024 + 128 * i + w) : (3072 + 128 * i + (w - 128)); }
    if (d < 5120) return 8224 + (d - 4096);
    if (d < 6144) return 9248 + (d - 5120);
    if (d < 7168) return 7168 + (d - 6144);
    if (d < 10240) return 4096 + (d - 7168);
    if (d < 10272) return 8192 + (d - 10240);
    return -1;
}

struct EpiA {
    static constexpr bool PERM = true, AFTER_DRAIN = false;
    bf16_t *PR, *SG;
    DI void operator()(const f32x4 (&acc)[2][2][4][2], const pg8::Unit& u, int wr, int wc, int fr, int fq) const {
        const int row0 = u.pm * 256 + wr * 64 + fr, pn = u.pn;
        if (pn < 16) {
            bf16_t* O = PR + (size_t)(pn >> 3) * (UNIT / 2) + (size_t)(128 * (pn & 7) + 32 * wc + 8 * fq);
#pragma unroll
            for (int ai = 0; ai < 2; ++ai)
#pragma unroll
                for (int m = 0; m < 4; ++m) {
                    float o[8];
#pragma unroll
                    for (int n = 0; n < 2; ++n)
#pragma unroll
                        for (int j = 0; j < 4; ++j) { const float a = acc[ai][0][m][n][j], b = acc[ai][1][m][n][j]; o[4 * n + j] = pn < 8 ? a * b : a * siluf_(b); }
                    u32x4 w; w.x = cvt_pk_bf16(o[0], o[1]); w.y = cvt_pk_bf16(o[2], o[3]); w.z = cvt_pk_bf16(o[4], o[5]); w.w = cvt_pk_bf16(o[6], o[7]);
                    *(u32x4*)(O + (size_t)(row0 + ai * 128 + m * 16) * D) = w;
                }
        } else {
            const int g = (pn - 16) >> 2;
            bf16_t* O = SG + (size_t)g * (UNIT / 2) + (size_t)(256 * ((pn - 16) & 3) + 32 * wc + 8 * fq);
#pragma unroll
            for (int ai = 0; ai < 2; ++ai)
#pragma unroll
                for (int m = 0; m < 4; ++m)
#pragma unroll
                    for (int bj = 0; bj < 2; ++bj) {
                        float o[8];
#pragma unroll
                        for (int n = 0; n < 2; ++n)
#pragma unroll
                            for (int j = 0; j < 4; ++j) { const float a = acc[ai][bj][m][n][j]; o[4 * n + j] = g == 2 ? siluf_(a) : sigmoidf_(a); }
                        u32x4 w; w.x = cvt_pk_bf16(o[0], o[1]); w.y = cvt_pk_bf16(o[2], o[3]); w.z = cvt_pk_bf16(o[4], o[5]); w.w = cvt_pk_bf16(o[6], o[7]);
                        *(u32x4*)(O + (size_t)(row0 + ai * 128 + m * 16) * D + bj * 128) = w;
                    }
        }
    }
};
struct EpiB {
    static constexpr bool PERM = true, AFTER_DRAIN = false;
    bf16_t* QKV;
    DI void operator()(const f32x4 (&acc)[2][2][4][2], const pg8::Unit& u, int wr, int wc, int fr, int fq) const {
        const int row0 = u.pm * 256 + wr * 64 + fr, pn = u.pn;
        bf16_t* O = QKV + (size_t)(pn >> 2) * (UNIT / 2) + (size_t)(256 * (pn & 3) + 32 * wc + 8 * fq);
#pragma unroll
        for (int ai = 0; ai < 2; ++ai)
#pragma unroll
            for (int m = 0; m < 4; ++m)
#pragma unroll
                for (int bj = 0; bj < 2; ++bj) {
                    const f32x4 v0 = acc[ai][bj][m][0], v1 = acc[ai][bj][m][1];
                    u32x4 w; w.x = cvt_pk_bf16(v0[0], v0[1]); w.y = cvt_pk_bf16(v0[2], v0[3]); w.z = cvt_pk_bf16(v1[0], v1[1]); w.w = cvt_pk_bf16(v1[2], v1[3]);
                    *(u32x4*)(O + (size_t)(row0 + ai * 128 + m * 16) * D + bj * 128) = w;
                }
    }
};
struct EpiYa {
    static constexpr bool PERM = true, AFTER_DRAIN = false;
    bf16_t* SGA;
    DI void operator()(const f32x4 (&acc)[2][2][4][2], const pg8::Unit& u, int wr, int wc, int fr, int fq) const {
        const int row0 = u.pm * 256 + wr * 64 + fr; bf16_t* O = SGA + (size_t)(256 * u.pn + 32 * wc + 8 * fq);
#pragma unroll
        for (int ai = 0; ai < 2; ++ai)
#pragma unroll
            for (int m = 0; m < 4; ++m)
#pragma unroll
                for (int bj = 0; bj < 2; ++bj) {
                    u32x4* p = (u32x4*)(O + (size_t)(row0 + ai * 128 + m * 16) * D + bj * 128);
                    const u32x4 s = *p; const f32x4 v0 = acc[ai][bj][m][0], v1 = acc[ai][bj][m][1];
                    u32x4 w; w.x = cvt_pk_bf16(bf_lo(s.x) * v0[0], bf_hi(s.x) * v0[1]); w.y = cvt_pk_bf16(bf_lo(s.y) * v0[2], bf_hi(s.y) * v0[3]);
                    w.z = cvt_pk_bf16(bf_lo(s.z) * v1[0], bf_hi(s.z) * v1[1]); w.w = cvt_pk_bf16(bf_lo(s.w) * v1[2], bf_hi(s.w) * v1[3]);
                    *p = w;
                }
    }
};
struct EpiYb {
    static constexpr bool PERM = true, AFTER_DRAIN = false;
    bf16_t* MA; const bf16_t* SGB;
    DI void operator()(const f32x4 (&acc)[2][2][4][2], const pg8::Unit& u, int wr, int wc, int fr, int fq) const {
        const int row0 = u.pm * 256 + wr * 64 + fr; const size_t c0 = (size_t)(256 * u.pn + 32 * wc + 8 * fq);
#pragma unroll
        for (int ai = 0; ai < 2; ++ai)
#pragma unroll
            for (int m = 0; m < 4; ++m)
#pragma unroll
                for (int bj = 0; bj < 2; ++bj) {
                    const size_t off = (size_t)(row0 + ai * 128 + m * 16) * D + bj * 128 + c0;
                    u32x4* p = (u32x4*)(MA + off); const u32x4 a = *p; const u32x4 s = *(const u32x4*)(SGB + off);
                    const f32x4 v0 = acc[ai][bj][m][0], v1 = acc[ai][bj][m][1];
                    u32x4 w; w.x = cvt_pk_bf16(bf_lo(a.x) + bf_lo(s.x) * v0[0], bf_hi(a.x) + bf_hi(s.x) * v0[1]); w.y = cvt_pk_bf16(bf_lo(a.y) + bf_lo(s.y) * v0[2], bf_hi(a.y) + bf_hi(s.y) * v0[3]);
                    w.z = cvt_pk_bf16(bf_lo(a.z) + bf_lo(s.z) * v1[0], bf_hi(a.z) + bf_hi(s.z) * v1[1]); w.w = cvt_pk_bf16(bf_lo(a.w) + bf_lo(s.w) * v1[2], bf_hi(a.w) + bf_hi(s.w) * v1[3]);
                    *p = w;
                }
    }
};
struct EpiOut {
    static constexpr bool PERM = true, AFTER_DRAIN = false;
    const float* X; const float* GATE; float* XN;
    DI void operator()(const f32x4 (&acc)[2][2][4][2], const pg8::Unit& u, int wr, int wc, int fr, int fq) const {
        const int row0 = u.pm * 256 + wr * 64 + fr; const int c0 = 256 * u.pn + 32 * wc + 8 * fq;
        const float* gp = GATE + (size_t)((u.pm * 256) / SEQ) * D + c0;
        f32x4 gt[2][2];
#pragma unroll
        for (int bj = 0; bj < 2; ++bj) { gt[bj][0] = *(const f32x4*)(gp + bj * 128); gt[bj][1] = *(const f32x4*)(gp + bj * 128 + 4); }
#pragma unroll
        for (int ai = 0; ai < 2; ++ai)
#pragma unroll
            for (int m = 0; m < 4; ++m)
#pragma unroll
                for (int bj = 0; bj < 2; ++bj) {
                    const size_t off = (size_t)(row0 + ai * 128 + m * 16) * D + bj * 128 + c0;
                    const f32x4 x0 = *(const f32x4*)(X + off), x1 = *(const f32x4*)(X + off + 4);
                    *(f32x4*)(XN + off) = x0 + gt[bj][0] * acc[ai][bj][m][0]; *(f32x4*)(XN + off + 4) = x1 + gt[bj][1] * acc[ai][bj][m][1];
                }
    }
};

constexpr size_t WS_PCNT = 255 * MiB + 336 * 1024;
constexpr size_t WS_PSS = 255 * MiB + 512 * 1024;
struct EpiOutFused {
    static constexpr bool PERM = true, AFTER_DRAIN = true;
    const float* X; const float* GATE; const float* FW; float* OUT; float* PSS; unsigned* PCNT;
    DI void operator()(const f32x4 (&)[2][2][4][2], const pg8::Unit&, int, int, int, int) const {}
    DI void fused(f32x4 (&acc)[2][2][4][2], const pg8::Unit& u, int wr, int wc, int fr, int fq, PG8_LAS unsigned char* lds, int wid, int lane) const {
        PG8_LAS float* P = (PG8_LAS float*)lds;
        PG8_LAS float* S = (PG8_LAS float*)(lds + 4096);
        const int row0 = u.pm * 256 + wr * 64 + fr; const int c0 = 256 * u.pn + 32 * wc + 8 * fq;
        const float* gp = GATE + (size_t)((u.pm * 256) / SEQ) * D + c0;
        f32x4 gt[2][2];
#pragma unroll
        for (int bj = 0; bj < 2; ++bj) { gt[bj][0] = *(const f32x4*)(gp + bj * 128); gt[bj][1] = *(const f32x4*)(gp + bj * 128 + 4); }
#pragma unroll
        for (int ai = 0; ai < 2; ++ai)
#pragma unroll
            for (int m = 0; m < 4; ++m) {
                float s = 0.f;
#pragma unroll
                for (int bj = 0; bj < 2; ++bj) {
                    const size_t off = (size_t)(row0 + ai * 128 + m * 16) * D + bj * 128 + c0;
                    const f32x4 v0 = __builtin_nontemporal_load((const f32x4*)(X + off)) + gt[bj][0] * acc[ai][bj][m][0], v1 = __builtin_nontemporal_load((const f32x4*)(X + off + 4)) + gt[bj][1] * acc[ai][bj][m][1];
                    acc[ai][bj][m][0] = v0; acc[ai][bj][m][1] = v1;
                    s += (v0[0] * v0[0] + v0[1] * v0[1]) + (v0[2] * v0[2] + v0[3] * v0[3]) + (v1[0] * v1[0] + v1[1] * v1[1]) + (v1[2] * v1[2] + v1[3] * v1[3]);
                }
                s += __shfl_xor(s, 16); s += __shfl_xor(s, 32);
                if (fq == 0) P[(ai * 128 + wr * 64 + m * 16 + fr) * 4 + wc] = s;
                if (m & 1) __builtin_amdgcn_sched_barrier(0);
            }
        asm volatile("s_waitcnt lgkmcnt(0)" ::: "memory"); __builtin_amdgcn_s_barrier(); asm volatile("" ::: "memory");
        const int row = wid * 32 + (lane & 31);
        if (lane < 32) {
            const float t = (P[row * 4 + 0] + P[row * 4 + 1]) + (P[row * 4 + 2] + P[row * 4 + 3]);
            __hip_atomic_store(PSS + (size_t)(u.pm * 256 + row) * 4 + u.pn, t, __ATOMIC_RELAXED, __HIP_MEMORY_SCOPE_AGENT);
        }
        asm volatile("s_waitcnt vmcnt(0)" ::: "memory");
        if (lane == 0) __hip_atomic_fetch_add(PCNT + 64 * u.pm, 1u, __ATOMIC_RELAXED, __HIP_MEMORY_SCOPE_AGENT);
        if (wid == 0) {
            unsigned sp = 0;
            while ((unsigned)__builtin_amdgcn_readfirstlane(__hip_atomic_load(PCNT + 64 * u.pm, __ATOMIC_RELAXED, __HIP_MEMORY_SCOPE_AGENT)) < 32u) { __builtin_amdgcn_s_sleep(2); if (++sp > (1u << 22)) break; }
            __builtin_amdgcn_fence(__ATOMIC_ACQUIRE, "agent");
        }
        asm volatile("s_waitcnt vmcnt(0) lgkmcnt(0)" ::: "memory"); __builtin_amdgcn_s_barrier(); asm volatile("" ::: "memory");
        if (lane < 32) {
            const float* ps = PSS + (size_t)(u.pm * 256 + row) * 4; float t = 0.f;
#pragma unroll
            for (int k = 0; k < 4; ++k) t += __hip_atomic_load(ps + k, __ATOMIC_RELAXED, __HIP_MEMORY_SCOPE_AGENT);
            S[row] = rsqrtf(t * (1.f / D) + NORM_EPS);
        }
        asm volatile("s_waitcnt vmcnt(0) lgkmcnt(0)" ::: "memory"); __builtin_amdgcn_s_barrier(); asm volatile("" ::: "memory");
        f32x4 fw[2][2];
#pragma unroll
        for (int bj = 0; bj < 2; ++bj) { fw[bj][0] = *(const f32x4*)(FW + c0 + bj * 128); fw[bj][1] = *(const f32x4*)(FW + c0 + bj * 128 + 4); }
#pragma unroll
        for (int ai = 0; ai < 2; ++ai)
#pragma unroll
            for (int m = 0; m < 4; ++m) {
                const float rs = S[ai * 128 + wr * 64 + m * 16 + fr];
#pragma unroll
                for (int bj = 0; bj < 2; ++bj) {
                    const size_t off = (size_t)(row0 + ai * 128 + m * 16) * D + bj * 128 + c0;
                    __builtin_nontemporal_store(acc[ai][bj][m][0] * rs * fw[bj][0], (f32x4*)(OUT + off)); __builtin_nontemporal_store(acc[ai][bj][m][1] * rs * fw[bj][1], (f32x4*)(OUT + off + 4));
                }
            }
    }
};

struct TwoGemmOrder {
    pg8::StaticOrder so;
    DI bool next(int i, pg8::Unit& u) const { if (i >= 2) return false; if (!so.next(0, u)) return false; if (i == 1) { u.pm += 256; u.pn += 4; } return true; }
    DI void a_ready(const pg8::Unit&) const {}
    DI void done(const pg8::Unit&) const {}
};
struct EpiYaYb {
    static constexpr bool PERM = true, AFTER_DRAIN = false;
    bf16_t* MA; const bf16_t* SGB;
    DI void operator()(const f32x4 (&acc)[2][2][4][2], const pg8::Unit& u, int wr, int wc, int fr, int fq) const {
        if (u.pn < 4) { EpiYa e{MA}; e(acc, u, wr, wc, fr, fq); }
        else { EpiYb e{MA, SGB}; pg8::Unit v; v.pm = u.pm - 256; v.pn = u.pn - 4; e(acc, v, wr, wc, fr, fq); }
    }
};

DI void p0_transpose_item(const float* W, int N, bf16_t* WT, int rg, int kg, int lane, bool is_win) {
    const int d = rg * 64 + lane; const int s = is_win ? win_src_col(d) : d; const int k0 = kg * 64;
    bf16_t* o = WT + (size_t)d * D + k0;
    if (s < 0) {
#pragma unroll
        for (int kk = 0; kk < 8; ++kk) *(u32x4*)(o + 8 * kk) = (u32x4){0u, 0u, 0u, 0u};
        return;
    }
    const float* w = W + (size_t)k0 * N + s;
    float v[64];
#pragma unroll
    for (int j = 0; j < 64; ++j) v[j] = __builtin_nontemporal_load(w + (size_t)j * N);
#pragma unroll
    for (int kk = 0; kk < 8; ++kk) {
        u32x4 p; p.x = cvt_pk_bf16(v[8 * kk], v[8 * kk + 1]); p.y = cvt_pk_bf16(v[8 * kk + 2], v[8 * kk + 3]); p.z = cvt_pk_bf16(v[8 * kk + 4], v[8 * kk + 5]); p.w = cvt_pk_bf16(v[8 * kk + 6], v[8 * kk + 7]);
        *(u32x4*)(o + 8 * kk) = p;
    }
}
DI void phase0(const Params& p, int gw, int NGW, int lane) {
    unsigned char* ws = p.ws;
    constexpr int I_WIN = (NPAD / 64) * 16, I_SQ = 16 * 16, I_MOD = 48 * 8, NITEMS = I_WIN + 3 * I_SQ + I_MOD;
    for (int it = gw; it < NITEMS; it += NGW) {
        int r = it;
        if (r < I_WIN) { p0_transpose_item(p.in[5], NIN, (bf16_t*)(ws + WS_WIN), r >> 4, r & 15, lane, true); continue; } r -= I_WIN;
        if (r < I_SQ) { p0_transpose_item(p.in[11], D, (bf16_t*)(ws + WS_WPA), r >> 4, r & 15, lane, false); continue; } r -= I_SQ;
        if (r < I_SQ) { p0_transpose_item(p.in[12], D, (bf16_t*)(ws + WS_WPB), r >> 4, r & 15, lane, false); continue; } r -= I_SQ;
        if (r < I_SQ) { p0_transpose_item(p.in[13], D, (bf16_t*)(ws + WS_WO), r >> 4, r & 15, lane, false); continue; } r -= I_SQ;
        const int cgp = r >> 3, ks = r & 7; const float* c = p.in[1]; const float* wa = p.in[2] + (size_t)(ks * 128) * 3072 + cgp * 64 + lane;
        float a0 = 0.f, a1 = 0.f;
#pragma unroll
        for (int k0 = 0; k0 < 128; k0 += 32) {
            float wv[32];
#pragma unroll
            for (int k = 0; k < 32; ++k) wv[k] = __builtin_nontemporal_load(wa + (size_t)(k0 + k) * 3072);
#pragma unroll
            for (int k = 0; k < 32; ++k) { a0 += siluf_(c[ks * 128 + k0 + k]) * wv[k]; a1 += siluf_(c[D + ks * 128 + k0 + k]) * wv[k]; }
        }
        float* mp = (float*)(ws + WS_MODP) + (size_t)ks * 2 * 3072 + cgp * 64 + lane;
        mp[0] = a0; mp[3072] = a1;
    }
}
DI void phase1(const Params& p, float* ldsf, int gw, int NGW, int lane, int tid) {
    const float* modp = (const float*)(p.ws + WS_MODP); const float* b_ada = p.in[3]; const float* nw = p.in[4];
    float* s_tab = ldsf;
    float* a_tab = ldsf + 2048;
    for (int idx = tid; idx < 2 * 2048; idx += NTHREADS) {
        const int b = idx >> 11, j = idx & 2047; float s = b_ada[j];
#pragma unroll
        for (int q = 0; q < 8; ++q) s += modp[(size_t)q * 2 * 3072 + b * 3072 + j];
        if (j < 1024) s_tab[b * 1024 + j] = s; else a_tab[b * 1024 + j - 1024] = nw[j - 1024] * (1.f + s);
    }
    if (blockIdx.x == 0) {
        float* modf = (float*)(p.ws + WS_MODF);
        for (int idx = tid; idx < 2 * 1024; idx += NTHREADS) {
            const int b = idx >> 10, j = idx & 1023; float s = b_ada[2048 + j];
#pragma unroll
            for (int q = 0; q < 8; ++q) s += modp[(size_t)q * 2 * 3072 + b * 3072 + 2048 + j];
            modf[b * 1024 + j] = s;
        }
    }
    __syncthreads();
    bf16_t* H = (bf16_t*)(p.ws + 0 * UNIT);
    for (int m0 = gw; m0 < M; m0 += 2 * NGW) {
        const int m1 = m0 + NGW < M ? m0 + NGW : m0;
        f32x4 v[2][4]; float s[2] = {0.f, 0.f};
#pragma unroll
        for (int u = 0; u < 2; ++u) { const f32x4* xr = (const f32x4*)(p.in[0] + (size_t)(u ? m1 : m0) * D) + lane;
#pragma unroll
            for (int j = 0; j < 4; ++j) v[u][j] = __builtin_nontemporal_load(xr + 64 * j); }
#pragma unroll
        for (int u = 0; u < 2; ++u) {
#pragma unroll
            for (int j = 0; j < 4; ++j) s[u] += (v[u][j].x * v[u][j].x + v[u][j].y * v[u][j].y) + (v[u][j].z * v[u][j].z + v[u][j].w * v[u][j].w);
            const int m = u ? m1 : m0; const int b = m / SEQ;
            const float rstd = rsqrtf(wave_sum(s[u]) * (1.f / D) + NORM_EPS);
            u32x2* o = (u32x2*)(H + (size_t)m * D) + lane;
#pragma unroll
            for (int j = 0; j < 4; ++j) {
                const f32x4 a = *(const f32x4*)(a_tab + b * 1024 + 4 * lane + 256 * j), sh = *(const f32x4*)(s_tab + b * 1024 + 4 * lane + 256 * j);
                const f32x4 hh = v[u][j] * rstd * a + sh;
                u32x2 w; w.x = cvt_pk_bf16(hh.x, hh.y); w.y = cvt_pk_bf16(hh.z, hh.w); o[64 * j] = w;
            }
        }
    }
    __syncthreads();
}
DI void ab_item(const Params& p, int item, int lane) {
    unsigned char* ws = p.ws; const int il = lane & 15, q = lane >> 4;
    const bf16_t* Hr = (const bf16_t*)(ws + 0 * UNIT) + (size_t)(item * 16 + il) * D + 8 * q;
    const bf16_t* W0 = (const bf16_t*)(ws + WS_WIN) + (size_t)(10240 + il) * D + 8 * q; const bf16_t* W1 = W0 + (size_t)16 * D;
    f32x4 a0 = {0.f, 0.f, 0.f, 0.f}, a1 = {0.f, 0.f, 0.f, 0.f};
#pragma unroll 8
    for (int ks = 0; ks < 32; ++ks) { const bf16x8 hf = *(const bf16x8*)(Hr + 32 * ks);
        a0 = __builtin_amdgcn_mfma_f32_16x16x32_bf16(hf, *(const bf16x8*)(W0 + 32 * ks), a0, 0, 0, 0); a1 = __builtin_amdgcn_mfma_f32_16x16x32_bf16(hf, *(const bf16x8*)(W1 + 32 * ks), a1, 0, 0, 0); }
    float* AB = (float*)(ws + WS_AB) + (size_t)(item * 16 + 4 * q) * 32 + il;
#pragma unroll
    for (int r = 0; r < 4; ++r) { AB[r * 32] = a0[r]; AB[r * 32 + 16] = a1[r]; }
}
DI void phase3_item(const Params& p, int item, int lane) {
    unsigned char* ws = p.ws;
    const bf16_t* Qr = (const bf16_t*)(ws + 1 * UNIT); const bf16_t* Kr = (const bf16_t*)(ws + 2 * UNIT); const bf16_t* Vr = (const bf16_t*)(ws + 3 * UNIT);
    bf16_t* Qn = (bf16_t*)(ws + 4 * UNIT); bf16_t* Kn = (bf16_t*)(ws + 5 * UNIT); bf16_t* Vc = (bf16_t*)p.out;
    const int tg = item & 255, h = (item >> 8) & 7, b = item >> 11; const int t_base = tg * 32; const size_t rb = (size_t)b * SEQ;
    const int col = h * 128 + 2 * lane; const int pcol = h * 128 + permpos(2 * lane);
    const float* cw = p.in[7];
    f32x2 wq[5], wk[5], wv[5];
#pragma unroll
    for (int j = 0; j < 5; ++j) { wq[j] = *(const f32x2*)(cw + j * 3072 + col); wk[j] = *(const f32x2*)(cw + j * 3072 + 1024 + col); wv[j] = *(const f32x2*)(cw + j * 3072 + 2048 + col); }
#pragma unroll
    for (int hf = 0; hf < 2; ++hf) {
        unsigned rq[20], rk[20], rv[20];
#pragma unroll
        for (int j = 0; j < 20; ++j) {
            const int t = t_base + 16 * hf - 2 + j; const bool ok = (t >= 0) && (t < SEQ); const int tc = t < 0 ? 0 : (t >= SEQ ? SEQ - 1 : t);
            const size_t off = (rb + tc) * D + col;
            const unsigned a0 = *(const unsigned*)(Qr + off), a1 = *(const unsigned*)(Kr + off), a2 = *(const unsigned*)(Vr + off);
            rq[j] = ok ? a0 : 0u; rk[j] = ok ? a1 : 0u; rv[j] = ok ? a2 : 0u;
        }
#pragma unroll
        for (int t16 = 0; t16 < 16; ++t16) {
            const int tt = 16 * hf + t16, t = t_base + tt;
            float q0 = 0.f, q1 = 0.f, k0 = 0.f, k1 = 0.f, v0 = 0.f, v1 = 0.f;
#pragma unroll
            for (int j = 0; j < 5; ++j) { q0 += wq[j].x * bf_lo(rq[t16 + j]); q1 += wq[j].y * bf_hi(rq[t16 + j]); k0 += wk[j].x * bf_lo(rk[t16 + j]); k1 += wk[j].y * bf_hi(rk[t16 + j]); v0 += wv[j].x * bf_lo(rv[t16 + j]); v1 += wv[j].y * bf_hi(rv[t16 + j]); }
            q0 = siluf_(q0); q1 = siluf_(q1); k0 = siluf_(k0); k1 = siluf_(k1); v0 = siluf_(v0); v1 = siluf_(v1);
            const float rq_ = rsqrtf(wave_sum(q0 * q0 + q1 * q1) + L2_EPS) * 0.08838834764831845f, rk_ = rsqrtf(wave_sum(k0 * k0 + k1 * k1) + L2_EPS);
            q0 *= rq_; q1 *= rq_; k0 *= rk_; k1 *= rk_;
            const size_t ro = (rb + t) * D;
            *(unsigned*)(Qn + ro + pcol) = cvt_pk_bf16(q0, q1); *(unsigned*)(Kn + ro + pcol) = cvt_pk_bf16(k0, k1); *(unsigned*)(Vc + ro + col) = cvt_pk_bf16(v0, v1);
        }
    }
    { const int i = lane & 31, dir = lane >> 5; const size_t row = rb + t_base + i; const float* AB = (const float*)(ws + WS_AB);
      const float a_raw = AB[row * 32 + dir * 8 + h], b_raw = AB[row * 32 + 16 + dir * 8 + h];
      const float g = -__expf(p.in[8][dir * 8 + h]) * softplusf_(a_raw + p.in[9][dir * 8 + h]);
      ((float*)(ws + WS_G))[row * 16 + dir * 8 + h] = g; ((float*)(ws + WS_BETA))[row * 16 + dir * 8 + h] = sigmoidf_(b_raw); }
}
DI void naive_scan(const Params& p, float* ldsw, int task, int lane) {
    unsigned char* ws = p.ws;
    const bf16_t* Qn = (const bf16_t*)(ws + 4 * UNIT); const bf16_t* Kn = (const bf16_t*)(ws + 5 * UNIT); const bf16_t* Vc = (const bf16_t*)p.out;
    const float* G = (const float*)(ws + WS_G); const float* BE = (const float*)(ws + WS_BETA);
    const int chain = task >> 1, b = chain >> 4, dir = (chain >> 3) & 1, h = chain & 7, e = (task & 1) * 64 + lane;
    bf16_t* O = (dir ? (bf16_t*)(p.out) + (size_t)M * D : (bf16_t*)(ws + 3 * UNIT));
    float* kb = ldsw; float* qb = ldsw + 128;
    float P[128];
#pragma unroll
    for (int d = 0; d < 128; ++d) P[d] = 0.f;
    for (int n = 0; n < SEQ; ++n) {
        const int t = dir ? SEQ - 1 - n : n; const size_t row = (size_t)b * SEQ + t;
        const unsigned ku = *(const unsigned*)(Kn + row * D + h * 128 + 2 * lane), qu = *(const unsigned*)(Qn + row * D + h * 128 + 2 * lane);
        const float v = bf1(Vc[row * D + h * 128 + e]); const float al = __expf(G[row * 16 + dir * 8 + h]), be = BE[row * 16 + dir * 8 + h];
        kb[2 * lane] = bf_lo(ku); kb[2 * lane + 1] = bf_hi(ku); qb[2 * lane] = bf_lo(qu); qb[2 * lane + 1] = bf_hi(qu);
        asm volatile("s_waitcnt lgkmcnt(0)" ::: "memory");
        float sk = 0.f;
#pragma unroll
        for (int d4 = 0; d4 < 32; ++d4) { if ((d4 & 3) == 0) __builtin_amdgcn_sched_barrier(0); const f32x4 k4 = *(const f32x4*)(kb + 4 * d4); sk += P[4 * d4] * k4.x + P[4 * d4 + 1] * k4.y + P[4 * d4 + 2] * k4.z + P[4 * d4 + 3] * k4.w; }
        const float vn = be * (v - al * sk); float o = 0.f;
#pragma unroll
        for (int d4 = 0; d4 < 32; ++d4) { if ((d4 & 3) == 0) __builtin_amdgcn_sched_barrier(0); const f32x4 k4 = *(const f32x4*)(kb + 4 * d4), q4 = *(const f32x4*)(qb + 4 * d4);
            P[4 * d4] = al * P[4 * d4] + k4.x * vn; P[4 * d4 + 1] = al * P[4 * d4 + 1] + k4.y * vn; P[4 * d4 + 2] = al * P[4 * d4 + 2] + k4.z * vn; P[4 * d4 + 3] = al * P[4 * d4 + 3] + k4.w * vn;
            o += P[4 * d4] * q4.x + P[4 * d4 + 1] * q4.y + P[4 * d4 + 2] * q4.z + P[4 * d4 + 3] * q4.w; }
        O[row * D + h * 128 + e] = (bf16_t)(cvt_pk_bf16(o, 0.f) & 0xffffu);
        asm volatile("s_waitcnt lgkmcnt(0)" ::: "memory");
    }
}
DI void ya_acc(float (&acc)[8], const u32x4& pv, const f32x4& wa, const f32x4& wb) {
    acc[0] += wa.x * bf_lo(pv.x); acc[1] += wa.y * bf_hi(pv.x); acc[2] += wa.z * bf_lo(pv.y); acc[3] += wa.w * bf_hi(pv.y);
    acc[4] += wb.x * bf_lo(pv.z); acc[5] += wb.y * bf_hi(pv.z); acc[6] += wb.z * bf_lo(pv.w); acc[7] += wb.w * bf_hi(pv.w);
}
DI void phase7(const Params& p, int gw, int NGW, int lane, int gtid, int NGT) {
    unsigned char* ws = p.ws;
    const bf16_t* Pb = (const bf16_t*)(ws + 1 * UNIT); bf16_t* R = (bf16_t*)(ws + 2 * UNIT); const float* cw = p.in[6];
    for (int it = gtid; it < (M / 4) * 128; it += NGT) {
        const int row0 = (it >> 7) * 4, c8 = (it & 127) * 8, t0 = row0 & (SEQ - 1);
        const u32x4 z = (u32x4){0u, 0u, 0u, 0u};
        u32x4 pv[6], rv[4];
        { const u32x4 t_ = *(const u32x4*)(Pb + (size_t)(t0 > 0 ? row0 - 1 : row0) * D + c8); pv[0] = t0 > 0 ? t_ : z; }
#pragma unroll
        for (int j = 0; j < 4; ++j) { pv[j + 1] = *(const u32x4*)(Pb + (size_t)(row0 + j) * D + c8); rv[j] = *(const u32x4*)(R + (size_t)(row0 + j) * D + c8); }
        { const u32x4 t_ = *(const u32x4*)(Pb + (size_t)(t0 + 4 < SEQ ? row0 + 4 : row0) * D + c8); pv[5] = t0 + 4 < SEQ ? t_ : z; }
        f32x4 wa[3], wb[3];
#pragma unroll
        for (int j = 0; j < 3; ++j) { wa[j] = *(const f32x4*)(cw + j * D + c8); wb[j] = *(const f32x4*)(cw + j * D + c8 + 4); }
#pragma unroll
        for (int j = 0; j < 4; ++j) {
            float acc[8] = {0.f, 0.f, 0.f, 0.f, 0.f, 0.f, 0.f, 0.f};
            ya_acc(acc, pv[j], wa[0], wb[0]); ya_acc(acc, pv[j + 1], wa[1], wb[1]); ya_acc(acc, pv[j + 2], wa[2], wb[2]);
            u32x4 o; const u32x4 r = rv[j];
            o.x = cvt_pk_bf16(bf_lo(r.x) * acc[0], bf_hi(r.x) * acc[1]); o.y = cvt_pk_bf16(bf_lo(r.y) * acc[2], bf_hi(r.y) * acc[3]);
            o.z = cvt_pk_bf16(bf_lo(r.z) * acc[4], bf_hi(r.z) * acc[5]); o.w = cvt_pk_bf16(bf_lo(r.w) * acc[6], bf_hi(r.w) * acc[7]);
            *(u32x4*)(R + (size_t)(row0 + j) * D + c8) = o;
        }
    }
    const bf16_t* Of = (const bf16_t*)(ws + 3 * UNIT); const bf16_t* Ob = (const bf16_t*)p.out + (size_t)M * D; bf16_t* SZ = (bf16_t*)(ws + 6 * UNIT);
    const f32x4 g0 = *(const f32x4*)(p.in[10] + (lane & 15) * 8), g1 = *(const f32x4*)(p.in[10] + (lane & 15) * 8 + 4);
    for (int rp = gw; rp < M / 2; rp += NGW) {
        u32x4 a[4], bb[4], zz[4];
#pragma unroll
        for (int u = 0; u < 4; ++u) { const size_t off = (size_t)(rp * 2 + (u >> 1)) * D + (u & 1) * 512 + lane * 8;
            a[u] = __builtin_nontemporal_load((const u32x4*)(Of + off)); bb[u] = __builtin_nontemporal_load((const u32x4*)(Ob + off)); zz[u] = __builtin_nontemporal_load((const u32x4*)(SZ + off)); }
#pragma unroll
        for (int u = 0; u < 4; ++u) { const size_t off = (size_t)(rp * 2 + (u >> 1)) * D + (u & 1) * 512 + lane * 8;
            float o[8];
            o[0] = bf_lo(a[u].x) + bf_lo(bb[u].x); o[1] = bf_hi(a[u].x) + bf_hi(bb[u].x); o[2] = bf_lo(a[u].y) + bf_lo(bb[u].y); o[3] = bf_hi(a[u].y) + bf_hi(bb[u].y);
            o[4] = bf_lo(a[u].z) + bf_lo(bb[u].z); o[5] = bf_hi(a[u].z) + bf_hi(bb[u].z); o[6] = bf_lo(a[u].w) + bf_lo(bb[u].w); o[7] = bf_hi(a[u].w) + bf_hi(bb[u].w);
            float ss = 0.f;
#pragma unroll
            for (int j = 0; j < 8; ++j) ss += o[j] * o[j];
            ss = row16_sum(ss);
            const float rs = rsqrtf(ss * (1.f / 128.f) + NORM_EPS);
            u32x4 w;
            w.x = cvt_pk_bf16(o[0] * rs * g0.x * bf_lo(zz[u].x), o[1] * rs * g0.y * bf_hi(zz[u].x)); w.y = cvt_pk_bf16(o[2] * rs * g0.z * bf_lo(zz[u].y), o[3] * rs * g0.w * bf_hi(zz[u].y));
            w.z = cvt_pk_bf16(o[4] * rs * g1.x * bf_lo(zz[u].z), o[5] * rs * g1.y * bf_hi(zz[u].z)); w.w = cvt_pk_bf16(o[6] * rs * g1.z * bf_lo(zz[u].w), o[7] * rs * g1.w * bf_hi(zz[u].w));
            *(u32x4*)(SZ + off) = w;
        }
    }
}
DI void phase10(const Params& p, int gw, int NGW, int lane) {
    const float* XN = (const float*)(p.ws + 0 * UNIT); const float* fw = p.in[14];
    f32x4 w[4];
#pragma unroll
    for (int j = 0; j < 4; ++j) w[j] = *((const f32x4*)fw + lane + 64 * j);
    for (int m = gw; m < M; m += NGW) {
        const f32x4* xr = (const f32x4*)(XN + (size_t)m * D) + lane; f32x4 v[4]; float s = 0.f;
#pragma unroll
        for (int j = 0; j < 4; ++j) { v[j] = xr[64 * j]; s += (v[j].x * v[j].x + v[j].y * v[j].y) + (v[j].z * v[j].z + v[j].w * v[j].w); }
        const float rstd = rsqrtf(wave_sum(s) * (1.f / D) + NORM_EPS);
        f32x4* o = (f32x4*)(p.out + (size_t)m * D) + lane;
#pragma unroll
        for (int j = 0; j < 4; ++j) o[64 * j] = v[j] * rstd * w[j];
    }
}
#define MFMA16(a, b, c) __builtin_amdgcn_mfma_f32_16x16x32_bf16((a), (b), (c), 0, 0, 0)
DI void chunk_prep_item(const Params& p, float* Lm, int item, int lane) {
    unsigned char* ws = p.ws;
    const bf16_t* Qn = (const bf16_t*)(ws + 4 * UNIT); const bf16_t* Kn = (const bf16_t*)(ws + 5 * UNIT);
    bf16_t* TF = (bf16_t*)(ws + 1 * UNIT) + (size_t)item * 4096; bf16_t* AF = (bf16_t*)(ws + 2 * UNIT) + (size_t)item * 4096;
    float* csc = (float*)(ws + WS_CSC) + (size_t)item * 192;
    const int c = item & 127, h = (item >> 7) & 7, dir = (item >> 10) & 1, b = item >> 11;
    const size_t rb = (size_t)b * SEQ + c * 64; const int il = lane & 15, q = lane >> 4;
    const int tl = dir ? 63 - lane : lane;
    const float g = ((const float*)(ws + WS_G))[(rb + tl) * 16 + dir * 8 + h], be = ((const float*)(ws + WS_BETA))[(rb + tl) * 16 + dir * 8 + h];
    float gc = g;
#pragma unroll
    for (int o = 1; o < 64; o <<= 1) { const float v = __shfl_up(gc, o); if (lane >= o) gc += v; }
    const float gl = __shfl(gc, 63);
    csc[tl] = __expf(gc); csc[64 + tl] = be; csc[128 + tl] = __expf(gl - gc);
    float gcr[4][4], ber[4][4], gcc[4];
#pragma unroll
    for (int t = 0; t < 4; ++t) { gcc[t] = __shfl(gc, 16 * t + il);
#pragma unroll
        for (int r = 0; r < 4; ++r) { gcr[t][r] = __shfl(gc, 16 * t + 4 * q + r); ber[t][r] = __shfl(be, 16 * t + 4 * q + r); } }
    bf16x8 Kf[4][4];
#pragma unroll
    for (int rt = 0; rt < 4; ++rt) { const int ip = 16 * rt + il; const size_t ro = (rb + (dir ? 63 - ip : ip)) * D + h * 128 + 8 * q;
#pragma unroll
        for (int ks = 0; ks < 4; ++ks) Kf[rt][ks] = *(const bf16x8*)(Kn + ro + 32 * ks); }
#pragma unroll
    for (int it = 0; it < 4; ++it)
#pragma unroll
        for (int jt = 0; jt <= it; ++jt) {
            f32x4 acc = {0.f, 0.f, 0.f, 0.f};
#pragma unroll
            for (int ks = 0; ks < 4; ++ks) acc = MFMA16(Kf[it][ks], Kf[jt][ks], acc);
#pragma unroll
            for (int r = 0; r < 4; ++r) { const int ip = 16 * it + 4 * q + r, jp = 16 * jt + il;
                Lm[ip * 64 + jp] = ip > jp ? ber[it][r] * acc[r] * __expf(gcr[it][r] - gcc[jt]) : 0.f; }
        }
    __builtin_amdgcn_sched_barrier(0);
    bf16x8 Qnext[4];
    { const int ip = il; const size_t ro = (rb + (dir ? 63 - ip : ip)) * D + h * 128 + 8 * q;
#pragma unroll
      for (int ks = 0; ks < 4; ++ks) Qnext[ks] = *(const bf16x8*)(Qn + ro + 32 * ks); }
#pragma unroll
    for (int mt = 0; mt < 4; ++mt) {
        bf16x8 Qf[4];
#pragma unroll
        for (int ks = 0; ks < 4; ++ks) Qf[ks] = Qnext[ks];
        if (mt < 3) { const int ip = 16 * (mt + 1) + il; const size_t ro = (rb + (dir ? 63 - ip : ip)) * D + h * 128 + 8 * q;
#pragma unroll
          for (int ks = 0; ks < 4; ++ks) Qnext[ks] = *(const bf16x8*)(Qn + ro + 32 * ks); }
#pragma unroll
        for (int ks2 = 0; ks2 < 2; ++ks2) {
            float vals[8];
#pragma unroll
            for (int a = 0; a < 2; ++a) { const int jt = 2 * ks2 + a; f32x4 acc = {0.f, 0.f, 0.f, 0.f};
#pragma unroll
                for (int ks = 0; ks < 4; ++ks) acc = MFMA16(Kf[jt][ks], Qf[ks], acc);
#pragma unroll
                for (int r = 0; r < 4; ++r) { const int jp = 16 * jt + 4 * q + r, ip = 16 * mt + il; vals[4 * a + r] = ip >= jp ? acc[r] * __expf(gcc[mt] - gcr[jt][r]) : 0.f; } }
            u32x4 w;
            if (dir) { w.x = cvt_pk_bf16(vals[7], vals[6]); w.y = cvt_pk_bf16(vals[5], vals[4]); w.z = cvt_pk_bf16(vals[3], vals[2]); w.w = cvt_pk_bf16(vals[1], vals[0]); }
            else { w.x = cvt_pk_bf16(vals[0], vals[1]); w.y = cvt_pk_bf16(vals[2], vals[3]); w.z = cvt_pk_bf16(vals[4], vals[5]); w.w = cvt_pk_bf16(vals[6], vals[7]); }
            const int fi = dir ? ((3 - mt) * 2 + (1 - ks2)) : (mt * 2 + ks2), ln = dir ? ((3 - q) * 16 + (15 - il)) : lane;
            *(u32x4*)(AF + (size_t)(fi * 64 + ln) * 8) = w;
        }
        __builtin_amdgcn_sched_barrier(0);
    }
    asm volatile("s_waitcnt lgkmcnt(0)" ::: "memory");
    __builtin_amdgcn_sched_barrier(0);
    float T[64];
#pragma unroll
    for (int i = 0; i < 64; ++i) {
        float s0 = (lane == i) ? 1.f : 0.f, s1 = 0.f;
#pragma unroll
        for (int m4 = 0; m4 < (i + 3) / 4; ++m4) {
            const f32x4 l4 = *(const f32x4*)(Lm + i * 64 + 4 * m4);
            if (4 * m4 + 0 < i) s0 -= l4.x * T[4 * m4 + 0];
            if (4 * m4 + 1 < i) s1 -= l4.y * T[4 * m4 + 1];
            if (4 * m4 + 2 < i) s0 -= l4.z * T[4 * m4 + 2];
            if (4 * m4 + 3 < i) s1 -= l4.w * T[4 * m4 + 3];
        }
        T[i] = s0 + s1;
        if ((i & 3) == 3) __builtin_amdgcn_sched_barrier(0);
    }
    asm volatile("s_waitcnt lgkmcnt(0)" ::: "memory");
    bf16_t* TL = (bf16_t*)Lm;
#pragma unroll
    for (int i = 0; i < 64; ++i) TL[i * 72 + lane] = (bf16_t)(cvt_pk_bf16(T[i], 0.f) & 0xffffu);
    asm volatile("s_waitcnt lgkmcnt(0)" ::: "memory");
#pragma unroll
    for (int mt = 0; mt < 4; ++mt)
#pragma unroll
        for (int ks2 = 0; ks2 < 2; ++ks2) {
            u32x4 w;
            if (dir) {
                const int row = 63 - 16 * mt - il;
                const u32x2 lo = *(const u32x2*)(TL + row * 72 + (60 - 32 * ks2 - 4 * q)), hi = *(const u32x2*)(TL + row * 72 + (44 - 32 * ks2 - 4 * q));
                w.x = (lo.y >> 16) | (lo.y << 16); w.y = (lo.x >> 16) | (lo.x << 16); w.z = (hi.y >> 16) | (hi.y << 16); w.w = (hi.x >> 16) | (hi.x << 16);
            } else {
                const int row = 16 * mt + il;
                const u32x2 lo = *(const u32x2*)(TL + row * 72 + (32 * ks2 + 4 * q)), hi = *(const u32x2*)(TL + row * 72 + (32 * ks2 + 16 + 4 * q));
                w.x = lo.x; w.y = lo.y; w.z = hi.x; w.w = hi.y;
            }
            *(u32x4*)(TF + (size_t)((mt * 2 + ks2) * 64 + lane) * 8) = w;
        }
    asm volatile("s_waitcnt lgkmcnt(0)" ::: "memory");
}
DI bf16x8 pack8(const f32x4& a, const f32x4& b) {
    u32x4 w; w.x = cvt_pk_bf16(a[0], a[1]); w.y = cvt_pk_bf16(a[2], a[3]); w.z = cvt_pk_bf16(b[0], b[1]); w.w = cvt_pk_bf16(b[2], b[3]);
    return __builtin_bit_cast(bf16x8, w);
}
DI void mfma_scan(const Params& p, int chain, int slice, int lane) {
    unsigned char* ws = p.ws;
    const bf16_t* Qn = (const bf16_t*)(ws + 4 * UNIT); const bf16_t* Kn = (const bf16_t*)(ws + 5 * UNIT); const bf16_t* KT = (const bf16_t*)(ws + 6 * UNIT); const bf16_t* Vc = (const bf16_t*)p.out;
    const bf16_t* TFb = (const bf16_t*)(ws + 1 * UNIT); const bf16_t* AFb = (const bf16_t*)(ws + 2 * UNIT); const float* cscb = (const float*)(ws + WS_CSC);
    const int b = chain >> 4, dir = (chain >> 3) & 1, h = chain & 7, il = lane & 15, q = lane >> 4;
    bf16_t* O = (dir ? (bf16_t*)(p.out) + (size_t)M * D : (bf16_t*)(ws + 3 * UNIT));
    f32x4 S[8];
#pragma unroll
    for (int dt = 0; dt < 8; ++dt) S[dt] = (f32x4){0.f, 0.f, 0.f, 0.f};
    for (int n = 0; n < 128; ++n) {
        const int c = dir ? 127 - n : n; const int item = chain * 128 + c; const size_t rowbase = (size_t)b * SEQ + c * 64;
        const bf16_t* TF = TFb + (size_t)item * 4096 + lane * 8; const bf16_t* AF = AFb + (size_t)item * 4096 + lane * 8; const float* csc = cscb + (size_t)item * 192;
        const float gl = csc[dir ? 0 : 63];
        f32x4 EG[4], BE[4], EK[4], V[4];
#pragma unroll
        for (int mt = 0; mt < 4; ++mt) { EG[mt] = *(const f32x4*)(csc + 16 * mt + 4 * q); BE[mt] = *(const f32x4*)(csc + 64 + 16 * mt + 4 * q); EK[mt] = *(const f32x4*)(csc + 128 + 16 * mt + 4 * q);
#pragma unroll
            for (int r = 0; r < 4; ++r) V[mt][r] = bf1(Vc[(rowbase + 16 * mt + 4 * q + r) * D + h * 128 + 16 * slice + il]); }
        bf16x8 Sb[4];
#pragma unroll
        for (int ks = 0; ks < 4; ++ks) Sb[ks] = pack8(S[2 * ks], S[2 * ks + 1]);
        f32x4 KS[4], QS[4];
#pragma unroll
        for (int mt = 0; mt < 4; ++mt) { const size_t ro = (rowbase + 16 * mt + il) * D + h * 128 + 8 * q;
            KS[mt] = (f32x4){0.f, 0.f, 0.f, 0.f}; QS[mt] = (f32x4){0.f, 0.f, 0.f, 0.f};
#pragma unroll
            for (int ks = 0; ks < 4; ++ks) { KS[mt] = MFMA16(*(const bf16x8*)(Kn + ro + 32 * ks), Sb[ks], KS[mt]); QS[mt] = MFMA16(*(const bf16x8*)(Qn + ro + 32 * ks), Sb[ks], QS[mt]); } }
        f32x4 X[4];
#pragma unroll
        for (int mt = 0; mt < 4; ++mt) X[mt] = BE[mt] * (V[mt] - EG[mt] * KS[mt]);
        bf16x8 Xb[2] = {pack8(X[0], X[1]), pack8(X[2], X[3])};
        f32x4 VN[4];
#pragma unroll
        for (int mt = 0; mt < 4; ++mt) { VN[mt] = (f32x4){0.f, 0.f, 0.f, 0.f};
#pragma unroll
            for (int ks2 = 0; ks2 < 2; ++ks2) VN[mt] = MFMA16(*(const bf16x8*)(TF + (size_t)((mt * 2 + ks2) * 64) * 8), Xb[ks2], VN[mt]); }
        bf16x8 VNb[2] = {pack8(VN[0], VN[1]), pack8(VN[2], VN[3])};
        bf16x8 VNs[2] = {pack8(VN[0] * EK[0], VN[1] * EK[1]), pack8(VN[2] * EK[2], VN[3] * EK[3])};
#pragma unroll
        for (int mt = 0; mt < 4; ++mt) { f32x4 o = EG[mt] * QS[mt];
#pragma unroll
            for (int ks2 = 0; ks2 < 2; ++ks2) o = MFMA16(*(const bf16x8*)(AF + (size_t)((mt * 2 + ks2) * 64) * 8), VNb[ks2], o);
#pragma unroll
            for (int r = 0; r < 4; ++r) O[(rowbase + 16 * mt + 4 * q + r) * D + h * 128 + 16 * slice + il] = (bf16_t)(cvt_pk_bf16(o[r], 0.f) & 0xffffu); }
#pragma unroll
        for (int dt = 0; dt < 8; ++dt) { const bf16_t* kt = KT + ((size_t)((b * 8 + h) * 128 + 16 * dt + il)) * SEQ + c * 64 + 8 * q; f32x4 s = S[dt] * gl;
#pragma unroll
            for (int ks2 = 0; ks2 < 2; ++ks2) s = MFMA16(*(const bf16x8*)(kt + 32 * ks2), VNs[ks2], s);
            S[dt] = s; }
    }
}
constexpr int SC_K = 0, SC_Q = 16384, SC_T = 32768, SC_A = 40960, SC_V = 49152, SC_C = 51200, SC_BUF = 52224, SC_NPIECE = 3248, SC_NLD = 384, SC_PPL = 9;
constexpr int SC_SB = 2 * SC_BUF, SC_VB = SC_SB + 2 * 4096, SC_END = SC_VB + 2 * 2048;
static_assert(SC_END <= LDS_BYTES - 256, "scan LDS");
typedef short s16x4_t __attribute__((ext_vector_type(4)));
#define SC_BAR() do { asm volatile("s_waitcnt lgkmcnt(0)" ::: "memory"); __builtin_amdgcn_s_barrier(); asm volatile("" ::: "memory"); } while (0)
DI void scan_task(const Params& p, PG8_LAS unsigned char* lds, int chain, int slice, int tid, int wave, int lane) {
    unsigned char* ws = p.ws;
    const int b = chain >> 4, dir = (chain >> 3) & 1, h = chain & 7, il = lane & 15, q = lane >> 4;
    const int c0 = dir ? 127 : 0; const long sgn = dir ? -1 : 1;
    if (wave >= 2) {
        const int lt = tid - 128; const int wbase = 64 * (wave - 2);
        const unsigned char* gp[SC_PPL]; int gstride[SC_PPL];
        const size_t rowbase0 = (size_t)b * SEQ + c0 * 64; const size_t item0 = (size_t)chain * 128 + c0;
#pragma unroll
        for (int k = 0; k < SC_PPL; ++k) {
            int pid = lt + SC_NLD * k; if (pid >= SC_NPIECE) pid -= 64;
            const unsigned char* g = ws; int st = 0;
            if (pid < 2048) { const int pp = pid & 1023, row = pp >> 4, ch = (pp & 15) ^ (row & 15);
                g = ws + (pid < 1024 ? 5 : 4) * UNIT + ((rowbase0 + row) * D + h * 128) * 2 + ch * 16; st = 64 * D * 2; }
            else if (pid < 3072) { const int pp = pid & 511; const bool isT = pid < 2560;
                g = ws + (isT ? 1 : 2) * UNIT + item0 * 8192 + pp * 16; st = 8192; }
            else if (pid < 3200) { const int pp = pid - 3072, row = pp >> 1, hf = pp & 1;
                g = (const unsigned char*)p.out + ((rowbase0 + row) * D + h * 128 + slice * 16) * 2 + hf * 16; st = 64 * D * 2; }
            else { const int pp = pid - 3200; g = ws + WS_CSC + item0 * 768 + pp * 16; st = 768; }
            gp[k] = g; gstride[k] = st;
        }
#define SC_DMA(bo) do { _Pragma("unroll") for (int k = 0; k < SC_PPL; ++k) { if (wbase + SC_NLD * k < SC_NPIECE) \
            __builtin_amdgcn_global_load_lds((const unsigned*)gp[k], (PG8_LAS unsigned*)(lds + (bo) + (wbase + SC_NLD * k) * 16), 16, 0, 0); gp[k] += sgn * gstride[k]; } } while (0)
        SC_DMA(0u);
        asm volatile("s_waitcnt vmcnt(0)" ::: "memory");
        SC_BAR();
        for (int n = 0; n < 128; ++n) {
            if (n + 1 < 128) SC_DMA((unsigned)(((n + 1) & 1) * SC_BUF));
            asm volatile("s_waitcnt vmcnt(0)" ::: "memory");
            SC_BAR();
        }
#undef SC_DMA
    } else if (wave == 0) {
        f32x4 S[8];
#pragma unroll
        for (int dt = 0; dt < 8; ++dt) S[dt] = (f32x4){0.f, 0.f, 0.f, 0.f};
        bf16x8 Sb[4];
#pragma unroll
        for (int ks = 0; ks < 4; ++ks) { Sb[ks] = pack8(S[2 * ks], S[2 * ks + 1]); *(PG8_LAS bf16x8*)(lds + SC_SB + (ks * 64 + lane) * 16) = Sb[ks]; }
        SC_BAR();
        for (int n = 0; n < 128; ++n) {
            PG8_LAS unsigned char* L = lds + (n & 1) * SC_BUF;
            bf16x8 Kf[4][4];
#pragma unroll
            for (int mt = 0; mt < 4; ++mt)
#pragma unroll
                for (int ks = 0; ks < 4; ++ks) Kf[mt][ks] = *(PG8_LAS bf16x8*)(L + SC_K + (16 * mt + il) * 256 + (((4 * ks + q) ^ il) << 4));
            f32x4 EG[4], BE[4], V[4]; bf16x8 Tf[4][2];
#pragma unroll
            for (int mt = 0; mt < 4; ++mt) { EG[mt] = *(PG8_LAS f32x4*)(L + SC_C + (16 * mt + 4 * q) * 4); BE[mt] = *(PG8_LAS f32x4*)(L + SC_C + 256 + (16 * mt + 4 * q) * 4);
#pragma unroll
                for (int r = 0; r < 4; ++r) V[mt][r] = bf1(*(PG8_LAS bf16_t*)(L + SC_V + (16 * mt + 4 * q + r) * 32 + il * 2));
#pragma unroll
                for (int ks2 = 0; ks2 < 2; ++ks2) Tf[mt][ks2] = *(PG8_LAS bf16x8*)(L + SC_T + ((mt * 2 + ks2) * 64 + lane) * 16); }
            f32x4 KS[4];
#pragma unroll
            for (int mt = 0; mt < 4; ++mt) KS[mt] = (f32x4){0.f, 0.f, 0.f, 0.f};
#pragma unroll
            for (int ks = 0; ks < 4; ++ks)
#pragma unroll
                for (int mt = 0; mt < 4; ++mt) KS[mt] = MFMA16(Kf[mt][ks], Sb[ks], KS[mt]);
            __builtin_amdgcn_sched_barrier(0);
            bf16x8 KTf[8][2]; f32x4 EK[4];
            { const int rr = il >> 2, pc = il & 3;
              PG8_LAS unsigned char* kb = L + SC_K + (4 * q + rr) * 256;
#pragma unroll
              for (int dt = 0; dt < 8; ++dt) {
                const int cho = (((4 * (dt >> 1) + pc) ^ (4 * q + rr)) << 4) + 8 * (dt & 1);
#pragma unroll
                for (int ks2 = 0; ks2 < 2; ++ks2) {
                    const s16x4_t lo_ = __builtin_amdgcn_ds_read_tr16_b64_v4i16((PG8_LAS s16x4_t*)(kb + (32 * ks2) * 256 + cho));
                    const s16x4_t hi_ = __builtin_amdgcn_ds_read_tr16_b64_v4i16((PG8_LAS s16x4_t*)(kb + (32 * ks2 + 16) * 256 + cho));
                    KTf[dt][ks2] = __builtin_shufflevector(lo_, hi_, 0, 1, 2, 3, 4, 5, 6, 7);
                } } }
#pragma unroll
            for (int mt = 0; mt < 4; ++mt) EK[mt] = *(PG8_LAS f32x4*)(L + SC_C + 512 + (16 * mt + 4 * q) * 4);
            const float gl = *(PG8_LAS float*)(L + SC_C + (dir ? 0 : 63) * 4);
            f32x4 X[4];
#pragma unroll
            for (int mt = 0; mt < 4; ++mt) X[mt] = BE[mt] * (V[mt] - EG[mt] * KS[mt]);
            bf16x8 Xb[2] = {pack8(X[0], X[1]), pack8(X[2], X[3])};
            f32x4 VN[4];
#pragma unroll
            for (int mt = 0; mt < 4; ++mt) VN[mt] = (f32x4){0.f, 0.f, 0.f, 0.f};
#pragma unroll
            for (int ks2 = 0; ks2 < 2; ++ks2)
#pragma unroll
                for (int mt = 0; mt < 4; ++mt) VN[mt] = MFMA16(Tf[mt][ks2], Xb[ks2], VN[mt]);
            *(PG8_LAS bf16x8*)(lds + SC_VB + (n & 1) * 2048 + lane * 16) = pack8(VN[0], VN[1]); *(PG8_LAS bf16x8*)(lds + SC_VB + (n & 1) * 2048 + (64 + lane) * 16) = pack8(VN[2], VN[3]);
            bf16x8 VNs[2] = {pack8(VN[0] * EK[0], VN[1] * EK[1]), pack8(VN[2] * EK[2], VN[3] * EK[3])};
#pragma unroll
            for (int dt = 0; dt < 8; ++dt) S[dt] = S[dt] * gl;
#pragma unroll
            for (int ks2 = 0; ks2 < 2; ++ks2)
#pragma unroll
                for (int dt = 0; dt < 8; ++dt) S[dt] = MFMA16(KTf[dt][ks2], VNs[ks2], S[dt]);
#pragma unroll
            for (int ks = 0; ks < 4; ++ks) { Sb[ks] = pack8(S[2 * ks], S[2 * ks + 1]); *(PG8_LAS bf16x8*)(lds + SC_SB + ((n + 1) & 1) * 4096 + (ks * 64 + lane) * 16) = Sb[ks]; }
            SC_BAR();
        }
    } else {
        bf16_t* O = (dir ? (bf16_t*)(p.out) + (size_t)M * D : (bf16_t*)(ws + 3 * UNIT));
        f32x4 Oa[4]; bf16x8 Af[4][2];
#pragma unroll
        for (int mt = 0; mt < 4; ++mt) { Oa[mt] = (f32x4){0.f, 0.f, 0.f, 0.f}; Af[mt][0] = (bf16x8){0, 0, 0, 0, 0, 0, 0, 0}; Af[mt][1] = Af[mt][0]; }
        SC_BAR();
        for (int n = 0; n <= 128; ++n) {
            if (n > 0) {
                const int c = dir ? 128 - n : n - 1; const size_t rowbase = (size_t)b * SEQ + c * 64;
                PG8_LAS unsigned char* vb = lds + SC_VB + ((n - 1) & 1) * 2048;
                bf16x8 VNb[2] = {*(PG8_LAS bf16x8*)(vb + lane * 16), *(PG8_LAS bf16x8*)(vb + (64 + lane) * 16)};
#pragma unroll
                for (int ks2 = 0; ks2 < 2; ++ks2)
#pragma unroll
                    for (int mt = 0; mt < 4; ++mt) Oa[mt] = MFMA16(Af[mt][ks2], VNb[ks2], Oa[mt]);
#pragma unroll
                for (int mt = 0; mt < 4; ++mt)
#pragma unroll
                    for (int r = 0; r < 4; ++r) O[(rowbase + 16 * mt + 4 * q + r) * D + h * 128 + 16 * slice + il] = (bf16_t)(cvt_pk_bf16(Oa[mt][r], 0.f) & 0xffffu);
            }
            if (n < 128) {
                PG8_LAS unsigned char* L = lds + (n & 1) * SC_BUF;
                bf16x8 Qf[4][4], Sb[4]; f32x4 EG[4];
#pragma unroll
                for (int ks = 0; ks < 4; ++ks) Sb[ks] = *(PG8_LAS bf16x8*)(lds + SC_SB + (n & 1) * 4096 + (ks * 64 + lane) * 16);
#pragma unroll
                for (int mt = 0; mt < 4; ++mt) {
#pragma unroll
                    for (int ks = 0; ks < 4; ++ks) Qf[mt][ks] = *(PG8_LAS bf16x8*)(L + SC_Q + (16 * mt + il) * 256 + (((4 * ks + q) ^ il) << 4));
                    EG[mt] = *(PG8_LAS f32x4*)(L + SC_C + (16 * mt + 4 * q) * 4);
#pragma unroll
                    for (int ks2 = 0; ks2 < 2; ++ks2) Af[mt][ks2] = *(PG8_LAS bf16x8*)(L + SC_A + ((mt * 2 + ks2) * 64 + lane) * 16); }
                f32x4 QS[4];
#pragma unroll
                for (int mt = 0; mt < 4; ++mt) QS[mt] = (f32x4){0.f, 0.f, 0.f, 0.f};
#pragma unroll
                for (int ks = 0; ks < 4; ++ks)
#pragma unroll
                    for (int mt = 0; mt < 4; ++mt) QS[mt] = MFMA16(Qf[mt][ks], Sb[ks], QS[mt]);
#pragma unroll
                for (int mt = 0; mt < 4; ++mt) Oa[mt] = EG[mt] * QS[mt];
                SC_BAR();
            }
        }
    }
}


typedef const __attribute__((address_space(4))) Params* kparams_t;
#if defined(__HIP_DEVICE_COMPILE__)
DI Params load_params() { kparams_t pp = (kparams_t)__builtin_amdgcn_kernarg_segment_ptr(); asm volatile("" : "+s"(pp)); return *pp; }
#else
DI Params load_params() { return Params{}; }
#endif
#define PP() load_params()
#define XB_TMO      128
#define XB_XCNT(j)  (256  + 64 * (j))
#define XB_XSUB(j)  (1280 + 64 * (j))
#define XB_XGEN(j)  (2304 + 64 * (j))
#define XB_TOP      3328
#define XB_TOPGEN   3392
#define XCD_BAR_WORDS 3456
#define XB_SPIN_CAP (1u << 18)
#define LAS __attribute__((address_space(3)))

__device__ __forceinline__ unsigned xb_ld(unsigned* p)              { return __hip_atomic_load(p, __ATOMIC_RELAXED, __HIP_MEMORY_SCOPE_AGENT); }
__device__ __forceinline__ unsigned xb_add(unsigned* p, unsigned v) { return __hip_atomic_fetch_add(p, v, __ATOMIC_RELAXED, __HIP_MEMORY_SCOPE_AGENT); }
__device__ __forceinline__ unsigned xb_xcc_id() { return (unsigned)__builtin_amdgcn_s_getreg((3 << 11) | 20) & 0xFu; }
#define XB_SPIN(cond, bar) do { unsigned _sp = 0; while (cond) { __builtin_amdgcn_s_sleep(1); \
    if ((++_sp & 255u) == 0u) { if (xb_ld(&(bar)[XB_TMO])) break; if (_sp > XB_SPIN_CAP) { atomicAdd(&(bar)[XB_TMO], 1u); break; } } } } while (0)

struct XcdBarrier {
    unsigned* bar; unsigned x;
    volatile LAS unsigned* st;
};

__device__ __forceinline__ XcdBarrier xcd_barrier_post(unsigned* bar, volatile LAS unsigned* st) {
    XcdBarrier b; b.bar = bar; b.x = xb_xcc_id(); b.st = st;
    if (threadIdx.x == 0) (void)xb_add(&bar[XB_XCNT(b.x)], 1u);
    return b;
}
__device__ __forceinline__ void xcd_barrier_complete(unsigned* bar, unsigned x, unsigned& nloc, unsigned& nx) {
    const unsigned G = gridDim.x * gridDim.y * gridDim.z;
    unsigned sum, cnt, mine, sp = 0u;
    for (;;) {
        sum = 0u; cnt = 0u; mine = 0u;
#pragma unroll
        for (unsigned j = 0; j < 16; ++j) { const unsigned c = xb_ld(&bar[XB_XCNT(j)]); sum += c; cnt += (c > 0u) ? 1u : 0u; mine = (j == x) ? c : mine; }
        if (sum == G) break;
        __builtin_amdgcn_s_sleep(1);
        if ((++sp & 255u) == 0u) { if (xb_ld(&bar[XB_TMO])) break; if (sp > XB_SPIN_CAP) { atomicAdd(&bar[XB_TMO], 1u); break; } }
    }
    nloc = mine > 0u ? mine : 1u; nx = cnt > 0u ? cnt : 1u;
}

__device__ __forceinline__ void xcd_barrier(const XcdBarrier& b) {
    asm volatile("s_waitcnt vmcnt(0)" ::: "memory");
    __syncthreads();
    if (threadIdx.x == 0) {
        unsigned* bar = b.bar;
        __builtin_amdgcn_s_waitcnt(0);
        unsigned nloc = b.st[0], nx = b.st[1];
        if (nloc == 0u) { xcd_barrier_complete(bar, b.x, nloc, nx); b.st[0] = nloc; b.st[1] = nx; }
        const unsigned old = xb_add(&bar[XB_XSUB(b.x)], 1u);
        const unsigned gen = old / nloc;
        if (old + 1u == (gen + 1u) * nloc) {
            __builtin_amdgcn_fence(__ATOMIC_RELEASE, "agent");
            asm volatile("s_waitcnt vmcnt(0)" ::: "memory");
            const unsigned og = xb_add(&bar[XB_TOP], 1u);
            const unsigned tg = og / nx;
            if (og + 1u == (tg + 1u) * nx) xb_add(&bar[XB_TOPGEN], 1u);
            else XB_SPIN(xb_ld(&bar[XB_TOPGEN]) == tg, bar);
            __builtin_amdgcn_fence(__ATOMIC_ACQUIRE, "agent");
            xb_add(&bar[XB_XGEN(b.x)], 1u);
            asm volatile("s_waitcnt vmcnt(0)" ::: "memory");
        } else {
            XB_SPIN(xb_ld(&bar[XB_XGEN(b.x)]) == gen, bar);
            __builtin_amdgcn_fence(__ATOMIC_ACQUIRE, "agent");
            asm volatile("s_waitcnt vmcnt(0)" ::: "memory");
        }
    }
    __syncthreads();
}


constexpr size_t WS_BAR = 255 * MiB + 320 * 1024;
DI int fresh_tid() { int t = threadIdx.x; asm volatile("" : "+v"(t)); return t; }
#define IDS const int tid = fresh_tid(), lane = tid & 63, wave = __builtin_amdgcn_readfirstlane(tid >> 6); const int G = gridDim.x, bx = blockIdx.x; \
    const int gw = bx * NWAVES + wave, NGW = G * NWAVES, gtid = bx * NTHREADS + tid, NGT = G * NTHREADS; (void)lane; (void)gw; (void)NGW; (void)gtid; (void)NGT; (void)wave;
__global__ void __launch_bounds__(NTHREADS, 2) fwd_kernel(Params p) {
    extern __shared__ __attribute__((aligned(16))) unsigned char lds[];
    cg::grid_group grid = cg::this_grid();
    PG8_LAS unsigned char* ldsl = (PG8_LAS unsigned char*)lds;
    if (threadIdx.x < 4) ((PG8_LAS unsigned*)(ldsl + (LDS_BYTES - 256)))[threadIdx.x] = 0u;
    __syncthreads();
    const XcdBarrier bar = xcd_barrier_post((unsigned*)(PP().ws + WS_BAR), (volatile PG8_LAS unsigned*)(ldsl + (LDS_BYTES - 256)));

    { IDS phase0(PP(), gw, NGW, lane); }
    if (PP().ws == nullptr) grid.sync();
    xcd_barrier(bar);
    { IDS phase1(PP(), (float*)lds, gw, NGW, lane, tid); }
    xcd_barrier(bar);
    {
        const Params q = PP(); unsigned char* ws = q.ws; bf16_t* WIN = (bf16_t*)(ws + WS_WIN); const int G = gridDim.x, bx = blockIdx.x;
        pg8::Gemm g{(const bf16_t*)(ws + 0 * UNIT), WIN + (size_t)ROWS_A * D, M, NB_TILES * 256, D}; pg8::StaticOrder S; S.init(M, NB_TILES * 256, G, bx);
        EpiB E{(bf16_t*)(ws + 1 * UNIT)};
        pg8::gemm_phase<EpiB, pg8::StaticOrder, true, true>(ldsl, g, S, E);
    }
    { IDS for (int it = gw; it < M / 16; it += NGW) ab_item(PP(), it, lane); }
    xcd_barrier(bar);
    { IDS for (int it = gw; it < 4096; it += NGW) phase3_item(PP(), it, lane); }
    xcd_barrier(bar);
    { IDS for (int it = gw; it < 4096; it += NGW) chunk_prep_item(PP(), (float*)(lds + wave * 16384), it, lane); }
    xcd_barrier(bar);
    for (int tk = blockIdx.x; tk < 256; tk += gridDim.x) { const int t2 = fresh_tid(); scan_task(PP(), ldsl, (tk & 7) + 8 * (tk >> 6), (tk >> 3) & 7, t2, __builtin_amdgcn_readfirstlane(t2 >> 6), t2 & 63); __syncthreads(); }
    xcd_barrier(bar);
    {
        const Params q = PP(); unsigned char* ws = q.ws; bf16_t* WIN = (bf16_t*)(ws + WS_WIN); const int G = gridDim.x, bx = blockIdx.x;
        pg8::Gemm g{(const bf16_t*)(ws + 0 * UNIT), WIN, M, NA_TILES * 256, D}; pg8::StaticOrder S; S.init(M, NA_TILES * 256, G, bx);
        EpiA E{(bf16_t*)(ws + 1 * UNIT), (bf16_t*)(ws + 4 * UNIT)};
        pg8::gemm_phase<EpiA, pg8::StaticOrder, true, true>(ldsl, g, S, E);
    }
    xcd_barrier(bar);
    { IDS phase7(PP(), gw, NGW, lane, gtid, NGT); }
    xcd_barrier(bar);
    if (gridDim.x == 256) {
        const Params q = PP(); unsigned char* ws = q.ws; const int G = gridDim.x, bx = blockIdx.x;
        static_assert(6 * UNIT - 2 * UNIT == (size_t)256 * 256 * D * 2 && WS_WPB - WS_WPA == (size_t)4 * 256 * D * 2, "TwoGemmOrder address arithmetic");
        TwoGemmOrder S; S.so.init(M, D, G, bx);
        pg8::Gemm g{(const bf16_t*)(ws + 2 * UNIT), (const bf16_t*)(ws + WS_WPA), M, D, D}; EpiYaYb E{(bf16_t*)(ws + 4 * UNIT), (const bf16_t*)(ws + 5 * UNIT)};
        pg8::gemm_phase<EpiYaYb, TwoGemmOrder, true, true>(ldsl, g, S, E);
    } else {
        const Params q = PP(); unsigned char* ws = q.ws; const int G = gridDim.x, bx = blockIdx.x;
        pg8::StaticOrder S; S.init(M, D, G, bx);
        { pg8::Gemm g{(const bf16_t*)(ws + 2 * UNIT), (const bf16_t*)(ws + WS_WPA), M, D, D}; EpiYa E{(bf16_t*)(ws + 4 * UNIT)};
          pg8::gemm_phase<EpiYa, pg8::StaticOrder, true, true>(ldsl, g, S, E); }
        { pg8::Gemm g{(const bf16_t*)(ws + 6 * UNIT), (const bf16_t*)(ws + WS_WPB), M, D, D}; EpiYb E{(bf16_t*)(ws + 4 * UNIT), (const bf16_t*)(ws + 5 * UNIT)};
          pg8::gemm_phase<EpiYb, pg8::StaticOrder, true, true>(ldsl, g, S, E); }
    }
    xcd_barrier(bar);
    if (gridDim.x == 256) {
        const Params q = PP(); unsigned char* ws = q.ws; const int G = gridDim.x, bx = blockIdx.x;
        pg8::Gemm g{(const bf16_t*)(ws + 4 * UNIT), (const bf16_t*)(ws + WS_WO), M, D, D}; pg8::StaticOrder S; S.init(M, D, G, bx);
        EpiOutFused E{q.in[0], (const float*)(ws + WS_MODF), q.in[14], q.out, (float*)(ws + WS_PSS), (unsigned*)(ws + WS_PCNT)};
        pg8::gemm_phase<EpiOutFused, pg8::StaticOrder, true, true>(ldsl, g, S, E);
    } else {
        {
            const Params q = PP(); unsigned char* ws = q.ws; const int G = gridDim.x, bx = blockIdx.x;
            pg8::Gemm g{(const bf16_t*)(ws + 4 * UNIT), (const bf16_t*)(ws + WS_WO), M, D, D}; pg8::StaticOrder S; S.init(M, D, G, bx);
            EpiOut E{q.in[0], (const float*)(ws + WS_MODF), (float*)(ws + 0 * UNIT)};
            pg8::gemm_phase<EpiOut, pg8::StaticOrder, true, true>(ldsl, g, S, E);
        }
        xcd_barrier(bar);
        { IDS phase10(PP(), gw, NGW, lane); }
    }
}

extern "C" void kernel_launch(void* const* d_in, const int* in_sizes, int n_in, void* d_out, int out_size, void* d_ws, size_t ws_size, hipStream_t stream) {
    static int grid = 0;
    if (grid == 0) {
        int dev = 0, cus = 0, per_cu = 0;
        if (n_in != 15 || out_size != M * D || ws_size < 256 * MiB) { fprintf(stderr, "kernel_launch: unexpected shapes (n_in %d out %d ws %zu)\n", n_in, out_size, ws_size); grid = -1; return; }
        hipGetDevice(&dev); hipDeviceGetAttribute(&cus, hipDeviceAttributeMultiprocessorCount, dev);
        if (hipFuncSetAttribute((const void*)fwd_kernel, hipFuncAttributeMaxDynamicSharedMemorySize, LDS_BYTES) != hipSuccess) { fprintf(stderr, "kernel_launch: hipFuncSetAttribute failed\n"); grid = -1; return; }
        hipOccupancyMaxActiveBlocksPerMultiprocessor(&per_cu, (const void*)fwd_kernel, NTHREADS, LDS_BYTES);
        if (per_cu < 1) { fprintf(stderr, "kernel_launch: occupancy query says %d blocks/CU\n", per_cu); per_cu = 1; }
        (void)hipGetLastError();
        grid = cus;
    }
    if (grid < 0) return;
    if (hipMemsetAsync((char*)d_ws + WS_BAR, 0, 32768, stream) != hipSuccess) { fprintf(stderr, "kernel_launch: memset of barrier words failed\n"); return; }
    Params p{};
    for (int i = 0; i < 15; ++i) p.in[i] = (const float*)d_in[i];
    p.out = (float*)d_out; p.ws = (unsigned char*)d_ws;
    void* args[] = {&p};
    hipError_t e = hipLaunchCooperativeKernel((const void*)fwd_kernel, dim3(grid), dim3(NTHREADS), args, LDS_BYTES, stream);
    if (e != hipSuccess) fprintf(stderr, "cooperative launch failed: %s (grid %d)\n", hipGetErrorString(e), grid);
}
```

```cpp
#include <hip/hip_runtime.h>
#include <hip/hip_cooperative_groups.h>
#include <cstdio>
#include <cstdint>
namespace cg = cooperative_groups;

#define DI __device__ __forceinline__
#define PG8_LAS __attribute__((address_space(3)))
typedef unsigned short bf16_t;
typedef short bf16x8 __attribute__((ext_vector_type(8)));
typedef float f32x4 __attribute__((ext_vector_type(4)));
typedef float f32x2 __attribute__((ext_vector_type(2)));
typedef unsigned u32x4 __attribute__((ext_vector_type(4)));
typedef unsigned u32x2 __attribute__((ext_vector_type(2)));

namespace pg8 {
constexpr int BM = 256, BK = 64, HALF = 128, HTB = HALF * BK * 2, STAGE_BYTES = 8 * HTB, NXCD = 8, WGM = 8;
__host__ __device__ __forceinline__ int lds_byte(int r, int c) { const int st = (r >> 4) * 2 + (c >> 5), rr = r & 15, cc = c & 31, ob = rr * 64 + cc * 2; return st * 1024 + (ob ^ (((ob >> 9) & 1) << 5)); }
__host__ __device__ __forceinline__ void stage_rc(int b, int& R, int& C) { const int st = b / 1024, sb = b % 1024, swz = sb ^ (((sb >> 9) & 1) << 5); R = (st >> 1) * 16 + swz / 64; C = (st & 1) * 32 + (swz % 64) / 2; }
__host__ __device__ __forceinline__ int perm32(int rho) { const int n = rho >> 4, i = rho & 15; return 8 * (i >> 2) + 4 * n + (i & 3); }
struct Unit { int pm, pn; };
struct Gemm { const bf16_t* A; const bf16_t* Bt; int M, N, K; };
struct StaticOrder {
    int nM, nN, nwg, G, c;
    __host__ __device__ void init(int M, int N, int G_, int c_) { nM = M / BM; nN = N / BM; nwg = nM * nN; G = G_; c = c_; }
    __host__ __device__ bool next(int i, Unit& u) const {
        const long L = (long)i * G + c; if (L >= nwg) return false;
        int wgid = (int)L; { const int q = nwg / NXCD, r = nwg % NXCD, xcd = wgid % NXCD, off = wgid / NXCD; wgid = (xcd < r ? xcd * (q + 1) : r * (q + 1) + (xcd - r) * q) + off; }
        const int nig = WGM * nN, gid = wgid / nig, fm = gid * WGM, gsz = (nM - fm) < WGM ? (nM - fm) : WGM;
        u.pm = fm + ((wgid % nig) % gsz); u.pn = (wgid % nig) / gsz; return true;
    }
    __device__ __forceinline__ void a_ready(const Unit&) const {}
    __device__ __forceinline__ void done(const Unit&) const {}
};
template <class Epi, class Sched, bool ALIGN_EPI = false, bool SP2 = false>
__device__ __forceinline__ void gemm_phase(PG8_LAS unsigned char* lds, const Gemm g, const Sched& S, const Epi& E) {
    int tid = threadIdx.x; asm volatile("" : "+v"(tid)); const int wid = __builtin_amdgcn_readfirstlane(tid >> 6), lane = tid & 63, wr = wid >> 2, wc = wid & 3, fr = lane & 15, fq = lane >> 4;
    const int K = g.K, nt = K / BK;
    unsigned voffA[2], voffB[2];
#pragma unroll
    for (int i = 0; i < 2; ++i) { int R, C; stage_rc(tid * 16 + i * 8192, R, C); const int Rb = Epi::PERM ? ((R & ~31) + perm32(R & 31)) : R;
        voffA[i] = (unsigned)(R * K + C) * 2u; voffB[i] = (unsigned)(Rb * K + C) * 2u; }
    const size_t kstep = (size_t)(BK * 2);
    const size_t hstep = (size_t)HALF * K * 2;
    const size_t tstep = 2 * hstep;
    const unsigned ldsw = (unsigned)wid * 1024u;
    const int aoff = lds_byte(wr * 64 + fr, fq * 8), boff = lds_byte(wc * 32 + fr, fq * 8);
#define PG8_SA(b, h) (((b) * 2 + (h)) * HTB)
#define PG8_SB(b, h) ((4 + (b) * 2 + (h)) * HTB)
#define PG8_STAGE(bufoff, gbase, voff) do { _Pragma("unroll") for (int _i = 0; _i < 2; ++_i) \
        __builtin_amdgcn_global_load_lds((const unsigned*)((const char*)(gbase) + (voff)[_i]), (PG8_LAS unsigned*)(lds + (bufoff) + ldsw + _i * 8192), 16, 0, 0); } while (0)
#define PG8_LDA(dst, b, h) do { _Pragma("unroll") for (int m = 0; m < 4; ++m) _Pragma("unroll") for (int k = 0; k < 2; ++k) dst[m][k] = *(const PG8_LAS bf16x8*)(lds + PG8_SA(b, h) + aoff + m * 2048 + k * 1024); } while (0)
#define PG8_LDB(dst, b, h) do { _Pragma("unroll") for (int n = 0; n < 2; ++n) _Pragma("unroll") for (int k = 0; k < 2; ++k) dst[n][k] = *(const PG8_LAS bf16x8*)(lds + PG8_SB(b, h) + boff + n * 2048 + k * 1024); } while (0)
#define PG8_MMA(ai, bj, At, Bt) do { __builtin_amdgcn_s_setprio(1); _Pragma("unroll") for (int m = 0; m < 4; ++m) _Pragma("unroll") for (int n = 0; n < 2; ++n) _Pragma("unroll") for (int k = 0; k < 2; ++k) \
        acc[ai][bj][m][n] = __builtin_amdgcn_mfma_f32_16x16x32_bf16(Bt[n][k], At[m][k], acc[ai][bj][m][n], 0, 0, 0); __builtin_amdgcn_s_setprio(0); } while (0)
#define PG8_WAIT_V(n) asm volatile("s_waitcnt vmcnt(" #n ")" ::: "memory")
#define PG8_WAIT_L(n) asm volatile("s_waitcnt lgkmcnt(" #n ")" ::: "memory")
#define PG8_BAR __builtin_amdgcn_s_barrier()
#define PG8_SCHED __builtin_amdgcn_sched_barrier(0)
    Unit cur, nxt; int ui = 0;
    if (!S.next(0, cur)) return;
    f32x4 acc[2][2][4][2];
#pragma unroll
    for (int a = 0; a < 2; ++a)
#pragma unroll
        for (int b = 0; b < 2; ++b)
#pragma unroll
            for (int m = 0; m < 4; ++m)
#pragma unroll
                for (int n = 0; n < 2; ++n) acc[a][b][m][n] = (f32x4){0.f, 0.f, 0.f, 0.f};
    bf16x8 At[4][2], B0[2][2], B1[2][2];
    const char* cA = (const char*)g.A + (size_t)cur.pm * tstep; const char* cB = (const char*)g.Bt + (size_t)cur.pn * tstep;
    S.a_ready(cur);
    if constexpr (SP2) {
        PG8_STAGE(PG8_SB(0, 0), cB, voffB); PG8_STAGE(PG8_SB(0, 1), cB + hstep, voffB); PG8_STAGE(PG8_SA(0, 0), cA, voffA); PG8_STAGE(PG8_SA(0, 1), cA + hstep, voffA);
        if (wr == 1) PG8_BAR;
        PG8_WAIT_V(2); PG8_BAR;
        PG8_STAGE(PG8_SB(1, 0), cB + kstep, voffB); PG8_STAGE(PG8_SA(1, 0), cA + kstep, voffA); PG8_STAGE(PG8_SB(1, 1), cB + hstep + kstep, voffB);
        PG8_WAIT_V(6); PG8_BAR;
    } else {
        PG8_STAGE(PG8_SB(0, 0), cB, voffB); PG8_STAGE(PG8_SA(0, 0), cA, voffA); PG8_STAGE(PG8_SB(0, 1), cB + hstep, voffB); PG8_STAGE(PG8_SA(0, 1), cA + hstep, voffA);
        if (wr == 1) PG8_BAR;
        PG8_WAIT_V(4); PG8_BAR;
        PG8_STAGE(PG8_SB(1, 0), cB + kstep, voffB); PG8_STAGE(PG8_SA(1, 0), cA + kstep, voffA); PG8_STAGE(PG8_SB(1, 1), cB + hstep + kstep, voffB);
        PG8_WAIT_V(6); PG8_BAR;
    }
    for (;;) {
        const bool has_next = S.next(ui + 1, nxt);
        const char* nA = has_next ? (const char*)g.A + (size_t)nxt.pm * tstep : cA; const char* nB = has_next ? (const char*)g.Bt + (size_t)nxt.pn * tstep : cB;
        for (int t = 0; t < nt; t += 2) {
            const bool last = (t == nt - 2);
            const char* a1 = cA + (size_t)(t + 1) * kstep;
            const char* a2 = last ? nA : cA + (size_t)(t + 2) * kstep; const char* b2 = last ? nB : cB + (size_t)(t + 2) * kstep;
            const char* a3 = a2 + kstep; const char* b3 = b2 + kstep;
            if (last && has_next) S.a_ready(nxt);
            if constexpr (SP2) {
            PG8_LDB(B0, 0, 0); PG8_LDB(B1, 0, 1); PG8_SCHED; PG8_LDA(At, 0, 0); PG8_STAGE(PG8_SA(1, 1), a1 + hstep, voffA);
            PG8_WAIT_V(8); PG8_WAIT_L(0); PG8_BAR; PG8_MMA(0, 0, At, B0); PG8_MMA(0, 1, At, B1); PG8_BAR; PG8_SCHED;
            PG8_LDA(At, 0, 1); PG8_STAGE(PG8_SB(0, 0), b2, voffB); PG8_STAGE(PG8_SB(0, 1), b2 + hstep, voffB); PG8_STAGE(PG8_SA(0, 0), a2, voffA);
            PG8_WAIT_V(8); PG8_WAIT_L(0); PG8_BAR; PG8_MMA(1, 0, At, B0); PG8_MMA(1, 1, At, B1); PG8_BAR; PG8_SCHED;
            PG8_LDB(B0, 1, 0); PG8_LDB(B1, 1, 1); PG8_SCHED; PG8_LDA(At, 1, 0); PG8_STAGE(PG8_SA(0, 1), a2 + hstep, voffA);
            PG8_WAIT_V(8); PG8_WAIT_L(0); PG8_BAR; PG8_MMA(0, 0, At, B0); PG8_MMA(0, 1, At, B1); PG8_BAR; PG8_SCHED;
            PG8_LDA(At, 1, 1); PG8_STAGE(PG8_SB(1, 0), b3, voffB); PG8_STAGE(PG8_SB(1, 1), b3 + hstep, voffB); PG8_STAGE(PG8_SA(1, 0), a3, voffA);
            PG8_WAIT_V(8); PG8_WAIT_L(0); PG8_BAR; PG8_MMA(1, 0, At, B0); PG8_MMA(1, 1, At, B1); PG8_BAR; PG8_SCHED;
            } else {
            PG8_LDB(B0, 0, 0); PG8_SCHED; PG8_LDA(At, 0, 0); PG8_STAGE(PG8_SA(1, 1), a1 + hstep, voffA);
            PG8_WAIT_L(8); PG8_BAR; PG8_WAIT_L(0); PG8_MMA(0, 0, At, B0); PG8_BAR; PG8_SCHED;
            PG8_LDB(B1, 0, 1); PG8_STAGE(PG8_SB(0, 0), b2, voffB);
            PG8_BAR; PG8_WAIT_L(0); PG8_MMA(0, 1, At, B1); PG8_BAR;
            PG8_LDA(At, 0, 1); PG8_STAGE(PG8_SA(0, 0), a2, voffA);
            PG8_BAR; PG8_WAIT_L(0); PG8_MMA(1, 0, At, B0); PG8_BAR; PG8_SCHED;
            PG8_STAGE(PG8_SB(0, 1), b2 + hstep, voffB);
            PG8_WAIT_V(6); PG8_BAR; PG8_MMA(1, 1, At, B1); PG8_BAR;
            PG8_LDB(B0, 1, 0); PG8_SCHED; PG8_LDA(At, 1, 0); PG8_STAGE(PG8_SA(0, 1), a2 + hstep, voffA);
            PG8_WAIT_L(8); PG8_BAR; PG8_WAIT_L(0); PG8_MMA(0, 0, At, B0); PG8_BAR; PG8_SCHED;
            PG8_LDB(B1, 1, 1); PG8_STAGE(PG8_SB(1, 0), b3, voffB);
            PG8_BAR; PG8_WAIT_L(0); PG8_MMA(0, 1, At, B1); PG8_BAR;
            PG8_LDA(At, 1, 1); PG8_STAGE(PG8_SA(1, 0), a3, voffA);
            PG8_BAR; PG8_WAIT_L(0); PG8_MMA(1, 0, At, B0); PG8_BAR; PG8_SCHED;
            PG8_STAGE(PG8_SB(1, 1), b3 + hstep, voffB);
            PG8_WAIT_V(6); PG8_BAR; PG8_MMA(1, 1, At, B1); PG8_BAR;
            }
        }
        if constexpr (ALIGN_EPI) { if (wr == 0) PG8_BAR; }
        if constexpr (!Epi::AFTER_DRAIN) { E(acc, cur, wr, wc, fr, fq); S.done(cur); }
        if (!has_next) break;
#pragma unroll
        for (int a = 0; a < 2; ++a)
#pragma unroll
            for (int b = 0; b < 2; ++b)
#pragma unroll
                for (int m = 0; m < 4; ++m)
#pragma unroll
                    for (int n = 0; n < 2; ++n) acc[a][b][m][n] = (f32x4){0.f, 0.f, 0.f, 0.f};
        cur = nxt; cA = nA; cB = nB; ++ui;
        if constexpr (ALIGN_EPI) { if (wr == 1) PG8_BAR; }
    }
    PG8_WAIT_V(0);
    if constexpr (!ALIGN_EPI) { if (wr == 0) PG8_BAR; }
    PG8_BAR;
    if constexpr (Epi::AFTER_DRAIN) { E.fused(acc, cur, wr, wc, fr, fq, lds, wid, lane); S.done(cur); }
#undef PG8_SA
#undef PG8_SB
#undef PG8_STAGE
#undef PG8_LDA
#undef PG8_LDB
#undef PG8_MMA
#undef PG8_WAIT_V
#undef PG8_WAIT_L
#undef PG8_BAR
#undef PG8_SCHED
}}

constexpr int SEQ = 8192, NB = 2, M = NB * SEQ, D = 1024, NIN = 10272, NPAD = 10496;
constexpr int NA_TILES = 28, NB_TILES = 12, ROWS_A = NA_TILES * 256;
constexpr size_t MiB = 1u << 20;
constexpr size_t UNIT = 32 * MiB;
constexpr size_t WS_WIN = 224 * MiB, WS_WPA = 245 * MiB, WS_WPB = 247 * MiB, WS_WO = 249 * MiB, WS_AB = 251 * MiB, WS_G = 253 * MiB, WS_BETA = 254 * MiB;
constexpr size_t WS_MODP = 255 * MiB, WS_MODF = 255 * MiB + 256 * 1024;
constexpr size_t WS_CSC = 239 * MiB;
constexpr int LDS_BYTES = 155648;
constexpr int NWAVES = 8, NTHREADS = 512;
constexpr float NORM_EPS = 1e-6f, L2_EPS = 1e-6f;

struct Params { const float* in[15]; float* out; unsigned char* ws; };

typedef __bf16 bf16v2_t __attribute__((ext_vector_type(2)));
DI unsigned cvt_pk_bf16(float lo, float hi) { const f32x2 v = {lo, hi}; const bf16v2_t r = __builtin_convertvector(v, bf16v2_t); return __builtin_bit_cast(unsigned, r); }
DI float bf_lo(unsigned u) { return __uint_as_float(u << 16); }
DI float bf_hi(unsigned u) { return __uint_as_float(u & 0xffff0000u); }
DI float bf1(bf16_t u) { return __uint_as_float(((unsigned)u) << 16); }
DI float sigmoidf_(float x) { return __builtin_amdgcn_rcpf(1.0f + __expf(-x)); }
DI float siluf_(float x) { return x * __builtin_amdgcn_rcpf(1.0f + __expf(-x)); }
DI float softplusf_(float x) { return fmaxf(x, 0.f) + log1pf(__expf(-fabsf(x))); }
#define DPP_F(v, ctrl) __builtin_bit_cast(float, __builtin_amdgcn_mov_dpp(__builtin_bit_cast(int, (v)), (ctrl), 0xF, 0xF, true))
DI float row16_sum(float v) {
    v += DPP_F(v, 0xB1);
    v += DPP_F(v, 0x4E);
    v += DPP_F(v, 0x141);
    v += DPP_F(v, 0x140);
    return v;
}
DI float wave_sum(float v) {
    v = row16_sum(v);
    return __builtin_bit_cast(float, __builtin_amdgcn_readlane(__builtin_bit_cast(int, v), 0)) + __builtin_bit_cast(float, __builtin_amdgcn_readlane(__builtin_bit_cast(int, v), 16))
         + __builtin_bit_cast(float, __builtin_amdgcn_readlane(__builtin_bit_cast(int, v), 32)) + __builtin_bit_cast(float, __builtin_amdgcn_readlane(__builtin_bit_cast(int, v), 48));
}
DI int permpos(int dk) { const int loc = dk & 31; return (dk & ~31) + 8 * ((loc >> 2) & 3) + 4 * (loc >> 4) + (loc & 3); }
DI int win_src_col(int d) {
    if (d < 2048) { const int i = d >> 8, w = d & 255; return w < 128 ? (128 * i + w) : (2048 + 128 * i + (w - 128)); }
    if (d < 4096) { const int i = (d - 2048) >> 8, w = d & 255; return w < 128 ? (1024 + 128 * i + w) : (3072 + 128 * i + (w - 128)); }
    if (d < 5120) return 8224 + (d - 4096);
    if (d < 6144) return 9248 + (d - 5120);
    if (d < 7168) return 7168 + (d - 6144);
    if (d < 10240) return 4096 + (d - 7168);
    if (d < 10272) return 8192 + (d - 10240);
    return -1;
}

struct EpiA {
    static constexpr bool PERM = true, AFTER_DRAIN = false;
    bf16_t *PR, *SG;
    DI void operator()(const f32x4 (&acc)[2][2][4][2], const pg8::Unit& u, int wr, int wc, int fr, int fq) const {
        const int row0 = u.pm * 256 + wr * 64 + fr, pn = u.pn;
        if (pn < 16) {
            bf16_t* O = PR + (size_t)(pn >> 3) * (UNIT / 2) + (size_t)(128 * (pn & 7) + 32 * wc + 8 * fq);
#pragma unroll
            for (int ai = 0; ai < 2; ++ai)
#pragma unroll
                for (int m = 0; m < 4; ++m) {
                    float o[8];
#pragma unroll
                    for (int n = 0; n < 2; ++n)
#pragma unroll
                        for (int j = 0; j < 4; ++j) { const float a = acc[ai][0][m][n][j], b = acc[ai][1][m][n][j]; o[4 * n + j] = pn < 8 ? a * b : a * siluf_(b); }
                    u32x4 w; w.x = cvt_pk_bf16(o[0], o[1]); w.y = cvt_pk_bf16(o[2], o[3]); w.z = cvt_pk_bf16(o[4], o[5]); w.w = cvt_pk_bf16(o[6], o[7]);
                    *(u32x4*)(O + (size_t)(row0 + ai * 128 + m * 16) * D) = w;
                }
        } else {
            const int g = (pn - 16) >> 2;
            bf16_t* O = SG + (size_t)g * (UNIT / 2) + (size_t)(256 * ((pn - 16) & 3) + 32 * wc + 8 * fq);
#pragma unroll
            for (int ai = 0; ai < 2; ++ai)
#pragma unroll
                for (int m = 0; m < 4; ++m)
#pragma unroll
                    for (int bj = 0; bj < 2; ++bj) {
                        float o[8];
#pragma unroll
                        for (int n = 0; n < 2; ++n)
#pragma unroll
                            for (int j = 0; j < 4; ++j) { const float a = acc[ai][bj][m][n][j]; o[4 * n + j] = g == 2 ? siluf_(a) : sigmoidf_(a); }
                        u32x4 w; w.x = cvt_pk_bf16(o[0], o[1]); w.y = cvt_pk_bf16(o[2], o[3]); w.z = cvt_pk_bf16(o[4], o[5]); w.w = cvt_pk_bf16(o[6], o[7]);
                        *(u32x4*)(O + (size_t)(row0 + ai * 128 + m * 16) * D + bj * 128) = w;
                    }
        }
    }
};
struct EpiB {
    static constexpr bool PERM = true, AFTER_DRAIN = false;
    bf16_t* QKV;
    DI void operator()(const f32x4 (&acc)[2][2][4][2], const pg8::Unit& u, int wr, int wc, int fr, int fq) const {
        const int row0 = u.pm * 256 + wr * 64 + fr, pn = u.pn;
        bf16_t* O = QKV + (size_t)(pn >> 2) * (UNIT / 2) + (size_t)(256 * (pn & 3) + 32 * wc + 8 * fq);
#pragma unroll
        for (int ai = 0; ai < 2; ++ai)
#pragma unroll
            for (int m = 0; m < 4; ++m)
#pragma unroll
                for (int bj = 0; bj < 2; ++bj) {
                    const f32x4 v0 = acc[ai][bj][m][0], v1 = acc[ai][bj][m][1];
                    u32x4 w; w.x = cvt_pk_bf16(v0[0], v0[1]); w.y = cvt_pk_bf16(v0[2], v0[3]); w.z = cvt_pk_bf16(v1[0], v1[1]); w.w = cvt_pk_bf16(v1[2], v1[3]);
                    *(u32x4*)(O + (size_t)(row0 + ai * 128 + m * 16) * D + bj * 128) = w;
                }
    }
};
struct EpiYa {
    static constexpr bool PERM = true, AFTER_DRAIN = false;
    bf16_t* SGA;
    DI void operator()(const f32x4 (&acc)[2][2][4][2], const pg8::Unit& u, int wr, int wc, int fr, int fq) const {
        const int row0 = u.pm * 256 + wr * 64 + fr; bf16_t* O = SGA + (size_t)(256 * u.pn + 32 * wc + 8 * fq);
#pragma unroll
        for (int ai = 0; ai < 2; ++ai)
#pragma unroll
            for (int m = 0; m < 4; ++m)
#pragma unroll
                for (int bj = 0; bj < 2; ++bj) {
                    u32x4* p = (u32x4*)(O + (size_t)(row0 + ai * 128 + m * 16) * D + bj * 128);
                    const u32x4 s = *p; const f32x4 v0 = acc[ai][bj][m][0], v1 = acc[ai][bj][m][1];
                    u32x4 w; w.x = cvt_pk_bf16(bf_lo(s.x) * v0[0], bf_hi(s.x) * v0[1]); w.y = cvt_pk_bf16(bf_lo(s.y) * v0[2], bf_hi(s.y) * v0[3]);
                    w.z = cvt_pk_bf16(bf_lo(s.z) * v1[0], bf_hi(s.z) * v1[1]); w.w = cvt_pk_bf16(bf_lo(s.w) * v1[2], bf_hi(s.w) * v1[3]);
                    *p = w;
                }
    }
};
struct EpiYb {
    static constexpr bool PERM = true, AFTER_DRAIN = false;
    bf16_t* MA; const bf16_t* SGB;
    DI void operator()(const f32x4 (&acc)[2][2][4][2], const pg8::Unit& u, int wr, int wc, int fr, int fq) const {
        const int row0 = u.pm * 256 + wr * 64 + fr; const size_t c0 = (size_t)(256 * u.pn + 32 * wc + 8 * fq);
#pragma unroll
        for (int ai = 0; ai < 2; ++ai)
#pragma unroll
            for (int m = 0; m < 4; ++m)
#pragma unroll
                for (int bj = 0; bj < 2; ++bj) {
                    const size_t off = (size_t)(row0 + ai * 128 + m * 16) * D + bj * 128 + c0;
                    u32x4* p = (u32x4*)(MA + off); const u32x4 a = *p; const u32x4 s = *(const u32x4*)(SGB + off);
                    const f32x4 v0 = acc[ai][bj][m][0], v1 = acc[ai][bj][m][1];
                    u32x4 w; w.x = cvt_pk_bf16(bf_lo(a.x) + bf_lo(s.x) * v0[0], bf_hi(a.x) + bf_hi(s.x) * v0[1]); w.y = cvt_pk_bf16(bf_lo(a.y) + bf_lo(s.y) * v0[2], bf_hi(a.y) + bf_hi(s.y) * v0[3]);
                    w.z = cvt_pk_bf16(bf_lo(a.z) + bf_lo(s.z) * v1[0], bf_hi(a.z) + bf_hi(s.z) * v1[1]); w.w = cvt_pk_bf16(bf_lo(a.w) + bf_lo(s.w) * v1[2], bf_hi(a.w) + bf_hi(s.w) * v1[3]);
                    *p = w;
                }
    }
};
struct EpiOut {
    static constexpr bool PERM = true, AFTER_DRAIN = false;
    const float* X; const float* GATE; float* XN;
    DI void operator()(const f32x4 (&acc)[2][2][4][2], const pg8::Unit& u, int wr, int wc, int fr, int fq) const {
        const int row0 = u.pm * 256 + wr * 64 + fr; const int c0 = 256 * u.pn + 32 * wc + 8 * fq;
        const float* gp = GATE + (size_t)((u.pm * 256) / SEQ) * D + c0;
        f32x4 gt[2][2];
#pragma unroll
        for (int bj = 0; bj < 2; ++bj) { gt[bj][0] = *(const f32x4*)(gp + bj * 128); gt[bj][1] = *(const f32x4*)(gp + bj * 128 + 4); }
#pragma unroll
        for (int ai = 0; ai < 2; ++ai)
#pragma unroll
            for (int m = 0; m < 4; ++m)
#pragma unroll
                for (int bj = 0; bj < 2; ++bj) {
                    const size_t off = (size_t)(row0 + ai * 128 + m * 16) * D + bj * 128 + c0;
                    const f32x4 x0 = *(const f32x4*)(X + off), x1 = *(const f32x4*)(X + off + 4);
                    *(f32x4*)(XN + off) = x0 + gt[bj][0] * acc[ai][bj][m][0]; *(f32x4*)(XN + off + 4) = x1 + gt[bj][1] * acc[ai][bj][m][1];
                }
    }
};

constexpr size_t WS_PCNT = 255 * MiB + 336 * 1024;
constexpr size_t WS_PSS = 255 * MiB + 512 * 1024;
struct EpiOutFused {
    static constexpr bool PERM = true, AFTER_DRAIN = true;
    const float* X; const float* GATE; const float* FW; float* OUT; float* PSS; unsigned* PCNT;
    DI void operator()(const f32x4 (&)[2][2][4][2], const pg8::Unit&, int, int, int, int) const {}
    DI void fused(f32x4 (&acc)[2][2][4][2], const pg8::Unit& u, int wr, int wc, int fr, int fq, PG8_LAS unsigned char* lds, int wid, int lane) const {
        PG8_LAS float* P = (PG8_LAS float*)lds;
        PG8_LAS float* S = (PG8_LAS float*)(lds + 4096);
        const int row0 = u.pm * 256 + wr * 64 + fr; const int c0 = 256 * u.pn + 32 * wc + 8 * fq;
        const float* gp = GATE + (size_t)((u.pm * 256) / SEQ) * D + c0;
        f32x4 gt[2][2];
#pragma unroll
        for (int bj = 0; bj < 2; ++bj) { gt[bj][0] = *(const f32x4*)(gp + bj * 128); gt[bj][1] = *(const f32x4*)(gp + bj * 128 + 4); }
#pragma unroll
        for (int ai = 0; ai < 2; ++ai)
#pragma unroll
            for (int m = 0; m < 4; ++m) {
                float s = 0.f;
#pragma unroll
                for (int bj = 0; bj < 2; ++bj) {
                    const size_t off = (size_t)(row0 + ai * 128 + m * 16) * D + bj * 128 + c0;
                    const f32x4 v0 = __builtin_nontemporal_load((const f32x4*)(X + off)) + gt[bj][0] * acc[ai][bj][m][0], v1 = __builtin_nontemporal_load((const f32x4*)(X + off + 4)) + gt[bj][1] * acc[ai][bj][m][1];
                    acc[ai][bj][m][0] = v0; acc[ai][bj][m][1] = v1;
                    s += (v0[0] * v0[0] + v0[1] * v0[1]) + (v0[2] * v0[2] + v0[3] * v0[3]) + (v1[0] * v1[0] + v1[1] * v1[1]) + (v1[2] * v1[2] + v1[3] * v1[3]);
                }
                s += __shfl_xor(s, 16); s += __shfl_xor(s, 32);
                if (fq == 0) P[(ai * 128 + wr * 64 + m * 16 + fr) * 4 + wc] = s;
                if (m & 1) __builtin_amdgcn_sched_barrier(0);
            }
        asm volatile("s_waitcnt lgkmcnt(0)" ::: "memory"); __builtin_amdgcn_s_barrier(); asm volatile("" ::: "memory");
        const int row = wid * 32 + (lane & 31);
        if (lane < 32) {
            const float t = (P[row * 4 + 0] + P[row * 4 + 1]) + (P[row * 4 + 2] + P[row * 4 + 3]);
            __hip_atomic_store(PSS + (size_t)(u.pm * 256 + row) * 4 + u.pn, t, __ATOMIC_RELAXED, __HIP_MEMORY_SCOPE_AGENT);
        }
        asm volatile("s_waitcnt vmcnt(0)" ::: "memory");
        if (lane == 0) __hip_atomic_fetch_add(PCNT + 64 * u.pm, 1u, __ATOMIC_RELAXED, __HIP_MEMORY_SCOPE_AGENT);
        if (wid == 0) {
            unsigned sp = 0;
            while ((unsigned)__builtin_amdgcn_readfirstlane(__hip_atomic_load(PCNT + 64 * u.pm, __ATOMIC_RELAXED, __HIP_MEMORY_SCOPE_AGENT)) < 32u) { __builtin_amdgcn_s_sleep(2); if (++sp > (1u << 22)) break; }
            __builtin_amdgcn_fence(__ATOMIC_ACQUIRE, "agent");
        }
        asm volatile("s_waitcnt vmcnt(0) lgkmcnt(0)" ::: "memory"); __builtin_amdgcn_s_barrier(); asm volatile("" ::: "memory");
        if (lane < 32) {
            const float* ps = PSS + (size_t)(u.pm * 256 + row) * 4; float t = 0.f;
#pragma unroll
            for (int k = 0; k < 4; ++k) t += __hip_atomic_load(ps + k, __ATOMIC_RELAXED, __HIP_MEMORY_SCOPE_AGENT);
            S[row] = rsqrtf(t * (1.f / D) + NORM_EPS);
        }
        asm volatile("s_waitcnt vmcnt(0) lgkmcnt(0)" ::: "memory"); __builtin_amdgcn_s_barrier(); asm volatile("" ::: "memory");
        f32x4 fw[2][2];
#pragma unroll
        for (int bj = 0; bj < 2; ++bj) { fw[bj][0] = *(const f32x4*)(FW + c0 + bj * 128); fw[bj][1] = *(const f32x4*)(FW + c0 + bj * 128 + 4); }
#pragma unroll
        for (int ai = 0; ai < 2; ++ai)
#pragma unroll
            for (int m = 0; m < 4; ++m) {
                const float rs = S[ai * 128 + wr * 64 + m * 16 + fr];
#pragma unroll
                for (int bj = 0; bj < 2; ++bj) {
                    const size_t off = (size_t)(row0 + ai * 128 + m * 16) * D + bj * 128 + c0;
                    __builtin_nontemporal_store(acc[ai][bj][m][0] * rs * fw[bj][0], (f32x4*)(OUT + off)); __builtin_nontemporal_store(acc[ai][bj][m][1] * rs * fw[bj][1], (f32x4*)(OUT + off + 4));
                }
            }
    }
};

struct TwoGemmOrder {
    pg8::StaticOrder so;
    DI bool next(int i, pg8::Unit& u) const { if (i >= 2) return false; if (!so.next(0, u)) return false; if (i == 1) { u.pm += 256; u.pn += 4; } return true; }
    DI void a_ready(const pg8::Unit&) const {}
    DI void done(const pg8::Unit&) const {}
};
struct EpiYaYb {
    static constexpr bool PERM = true, AFTER_DRAIN = false;
    bf16_t* MA; const bf16_t* SGB;
    DI void operator()(const f32x4 (&acc)[2][2][4][2], const pg8::Unit& u, int wr, int wc, int fr, int fq) const {
        if (u.pn < 4) { EpiYa e{MA}; e(acc, u, wr, wc, fr, fq); }
        else { EpiYb e{MA, SGB}; pg8::Unit v; v.pm = u.pm - 256; v.pn = u.pn - 4; e(acc, v, wr, wc, fr, fq); }
    }
};

DI void p0_transpose_item(const float* W, int N, bf16_t* WT, int rg, int kg, int lane, bool is_win) {
    const int d = rg * 64 + lane; const int s = is_win ? win_src_col(d) : d; const int k0 = kg * 64;
    bf16_t* o = WT + (size_t)d * D + k0;
    if (s < 0) {
#pragma unroll
        for (int kk = 0; kk < 8; ++kk) *(u32x4*)(o + 8 * kk) = (u32x4){0u, 0u, 0u, 0u};
        return;
    }
    const float* w = W + (size_t)k0 * N + s;
    float v[64];
#pragma unroll
    for (int j = 0; j < 64; ++j) v[j] = __builtin_nontemporal_load(w + (size_t)j * N);
#pragma unroll
    for (int kk = 0; kk < 8; ++kk) {
        u32x4 p; p.x = cvt_pk_bf16(v[8 * kk], v[8 * kk + 1]); p.y = cvt_pk_bf16(v[8 * kk + 2], v[8 * kk + 3]); p.z = cvt_pk_bf16(v[8 * kk + 4], v[8 * kk + 5]); p.w = cvt_pk_bf16(v[8 * kk + 6], v[8 * kk + 7]);
        *(u32x4*)(o + 8 * kk) = p;
    }
}
DI void phase0(const Params& p, int gw, int NGW, int lane) {
    unsigned char* ws = p.ws;
    constexpr int I_WIN = (NPAD / 64) * 16, I_SQ = 16 * 16, I_MOD = 48 * 8, NITEMS = I_WIN + 3 * I_SQ + I_MOD;
    for (int it = gw; it < NITEMS; it += NGW) {
        int r = it;
        if (r < I_WIN) { p0_transpose_item(p.in[5], NIN, (bf16_t*)(ws + WS_WIN), r >> 4, r & 15, lane, true); continue; } r -= I_WIN;
        if (r < I_SQ) { p0_transpose_item(p.in[11], D, (bf16_t*)(ws + WS_WPA), r >> 4, r & 15, lane, false); continue; } r -= I_SQ;
        if (r < I_SQ) { p0_transpose_item(p.in[12], D, (bf16_t*)(ws + WS_WPB), r >> 4, r & 15, lane, false); continue; } r -= I_SQ;
        if (r < I_SQ) { p0_transpose_item(p.in[13], D, (bf16_t*)(ws + WS_WO), r >> 4, r & 15, lane, false); continue; } r -= I_SQ;
        const int cgp = r >> 3, ks = r & 7; const float* c = p.in[1]; const float* wa = p.in[2] + (size_t)(ks * 128) * 3072 + cgp * 64 + lane;
        float a0 = 0.f, a1 = 0.f;
#pragma unroll
        for (int k0 = 0; k0 < 128; k0 += 32) {
            float wv[32];
#pragma unroll
            for (int k = 0; k < 32; ++k) wv[k] = __builtin_nontemporal_load(wa + (size_t)(k0 + k) * 3072);
#pragma unroll
            for (int k = 0; k < 32; ++k) { a0 += siluf_(c[ks * 128 + k0 + k]) * wv[k]; a1 += siluf_(c[D + ks * 128 + k0 + k]) * wv[k]; }
        }
        float* mp = (float*)(ws + WS_MODP) + (size_t)ks * 2 * 3072 + cgp * 64 + lane;
        mp[0] = a0; mp[3072] = a1;
    }
}
DI void phase1(const Params& p, float* ldsf, int gw, int NGW, int lane, int tid) {
    const float* modp = (const float*)(p.ws + WS_MODP); const float* b_ada = p.in[3]; const float* nw = p.in[4];
    float* s_tab = ldsf;
    float* a_tab = ldsf + 2048;
    for (int idx = tid; idx < 2 * 2048; idx += NTHREADS) {
        const int b = idx >> 11, j = idx & 2047; float s = b_ada[j];
#pragma unroll
        for (int q = 0; q < 8; ++q) s += modp[(size_t)q * 2 * 3072 + b * 3072 + j];
        if (j < 1024) s_tab[b * 1024 + j] = s; else a_tab[b * 1024 + j - 1024] = nw[j - 1024] * (1.f + s);
    }
    if (blockIdx.x == 0) {
        float* modf = (float*)(p.ws + WS_MODF);
        for (int idx = tid; idx < 2 * 1024; idx += NTHREADS) {
            const int b = idx >> 10, j = idx & 1023; float s = b_ada[2048 + j];
#pragma unroll
            for (int q = 0; q < 8; ++q) s += modp[(size_t)q * 2 * 3072 + b * 3072 + 2048 + j];
            modf[b * 1024 + j] = s;
        }
    }
    __syncthreads();
    bf16_t* H = (bf16_t*)(p.ws + 0 * UNIT);
    for (int m0 = gw; m0 < M; m0 += 2 * NGW) {
        const int m1 = m0 + NGW < M ? m0 + NGW : m0;
        f32x4 v[2][4]; float s[2] = {0.f, 0.f};
#pragma unroll
        for (int u = 0; u < 2; ++u) { const f32x4* xr = (const f32x4*)(p.in[0] + (size_t)(u ? m1 : m0) * D) + lane;
#pragma unroll
            for (int j = 0; j < 4; ++j) v[u][j] = __builtin_nontemporal_load(xr + 64 * j); }
#pragma unroll
        for (int u = 0; u < 2; ++u) {
#pragma unroll
            for (int j = 0; j < 4; ++j) s[u] += (v[u][j].x * v[u][j].x + v[u][j].y * v[u][j].y) + (v[u][j].z * v[u][j].z + v[u][j].w * v[u][j].w);
            const int m = u ? m1 : m0; const int b = m / SEQ;
            const float rstd = rsqrtf(wave_sum(s[u]) * (1.f / D) + NORM_EPS);
            u32x2* o = (u32x2*)(H + (size_t)m * D) + lane;
#pragma unroll
            for (int j = 0; j < 4; ++j) {
                const f32x4 a = *(const f32x4*)(a_tab + b * 1024 + 4 * lane + 256 * j), sh = *(const f32x4*)(s_tab + b * 1024 + 4 * lane + 256 * j);
                const f32x4 hh = v[u][j] * rstd * a + sh;
                u32x2 w; w.x = cvt_pk_bf16(hh.x, hh.y); w.y = cvt_pk_bf16(hh.z, hh.w); o[64 * j] = w;
            }
        }
    }
    __syncthreads();
}
DI void ab_item(const Params& p, int item, int lane) {
    unsigned char* ws = p.ws; const int il = lane & 15, q = lane >> 4;
    const bf16_t* Hr = (const bf16_t*)(ws + 0 * UNIT) + (size_t)(item * 16 + il) * D + 8 * q;
    const bf16_t* W0 = (const bf16_t*)(ws + WS_WIN) + (size_t)(10240 + il) * D + 8 * q; const bf16_t* W1 = W0 + (size_t)16 * D;
    f32x4 a0 = {0.f, 0.f, 0.f, 0.f}, a1 = {0.f, 0.f, 0.f, 0.f};
#pragma unroll 8
    for (int ks = 0; ks < 32; ++ks) { const bf16x8 hf = *(const bf16x8*)(Hr + 32 * ks);
        a0 = __builtin_amdgcn_mfma_f32_16x16x32_bf16(hf, *(const bf16x8*)(W0 + 32 * ks), a0, 0, 0, 0); a1 = __builtin_amdgcn_mfma_f32_16x16x32_bf16(hf, *(const bf16x8*)(W1 + 32 * ks), a1, 0, 0, 0); }
    float* AB = (float*)(ws + WS_AB) + (size_t)(item * 16 + 4 * q) * 32 + il;
#pragma unroll
    for (int r = 0; r < 4; ++r) { AB[r * 32] = a0[r]; AB[r * 32 + 16] = a1[r]; }
}
DI void phase3_item(const Params& p, int item, int lane) {
    unsigned char* ws = p.ws;
    const bf16_t* Qr = (const bf16_t*)(ws + 1 * UNIT); const bf16_t* Kr = (const bf16_t*)(ws + 2 * UNIT); const bf16_t* Vr = (const bf16_t*)(ws + 3 * UNIT);
    bf16_t* Qn = (bf16_t*)(ws + 4 * UNIT); bf16_t* Kn = (bf16_t*)(ws + 5 * UNIT); bf16_t* Vc = (bf16_t*)p.out;
    const int tg = item & 255, h = (item >> 8) & 7, b = item >> 11; const int t_base = tg * 32; const size_t rb = (size_t)b * SEQ;
    const int col = h * 128 + 2 * lane; const int pcol = h * 128 + permpos(2 * lane);
    const float* cw = p.in[7];
    f32x2 wq[5], wk[5], wv[5];
#pragma unroll
    for (int j = 0; j < 5; ++j) { wq[j] = *(const f32x2*)(cw + j * 3072 + col); wk[j] = *(const f32x2*)(cw + j * 3072 + 1024 + col); wv[j] = *(const f32x2*)(cw + j * 3072 + 2048 + col); }
#pragma unroll
    for (int hf = 0; hf < 2; ++hf) {
        unsigned rq[20], rk[20], rv[20];
#pragma unroll
        for (int j = 0; j < 20; ++j) {
            const int t = t_base + 16 * hf - 2 + j; const bool ok = (t >= 0) && (t < SEQ); const int tc = t < 0 ? 0 : (t >= SEQ ? SEQ - 1 : t);
            const size_t off = (rb + tc) * D + col;
            const unsigned a0 = *(const unsigned*)(Qr + off), a1 = *(const unsigned*)(Kr + off), a2 = *(const unsigned*)(Vr + off);
            rq[j] = ok ? a0 : 0u; rk[j] = ok ? a1 : 0u; rv[j] = ok ? a2 : 0u;
        }
#pragma unroll
        for (int t16 = 0; t16 < 16; ++t16) {
            const int tt = 16 * hf + t16, t = t_base + tt;
            float q0 = 0.f, q1 = 0.f, k0 = 0.f, k1 = 0.f, v0 = 0.f, v1 = 0.f;
#pragma unroll
            for (int j = 0; j < 5; ++j) { q0 += wq[j].x * bf_lo(rq[t16 + j]); q1 += wq[j].y * bf_hi(rq[t16 + j]); k0 += wk[j].x * bf_lo(rk[t16 + j]); k1 += wk[j].y * bf_hi(rk[t16 + j]); v0 += wv[j].x * bf_lo(rv[t16 + j]); v1 += wv[j].y * bf_hi(rv[t16 + j]); }
            q0 = siluf_(q0); q1 = siluf_(q1); k0 = siluf_(k0); k1 = siluf_(k1); v0 = siluf_(v0); v1 = siluf_(v1);
            const float rq_ = rsqrtf(wave_sum(q0 * q0 + q1 * q1) + L2_EPS) * 0.08838834764831845f, rk_ = rsqrtf(wave_sum(k0 * k0 + k1 * k1) + L2_EPS);
            q0 *= rq_; q1 *= rq_; k0 *= rk_; k1 *= rk_;
            const size_t ro = (rb + t) * D;
            *(unsigned*)(Qn + ro + pcol) = cvt_pk_bf16(q0, q1); *(unsigned*)(Kn + ro + pcol) = cvt_pk_bf16(k0, k1); *(unsigned*)(Vc + ro + col) = cvt_pk_bf16(v0, v1);
        }
    }
    { const int i = lane & 31, dir = lane >> 5; const size_t row = rb + t_base + i; const float* AB = (const float*)(ws + WS_AB);
      const float a_raw = AB[row * 32 + dir * 8 + h], b_raw = AB[row * 32 + 16 + dir * 8 + h];
      const float g = -__expf(p.in[8][dir * 8 + h]) * softplusf_(a_raw + p.in[9][dir * 8 + h]);
      ((float*)(ws + WS_G))[row * 16 + dir * 8 + h] = g; ((float*)(ws + WS_BETA))[row * 16 + dir * 8 + h] = sigmoidf_(b_raw); }
}
DI void naive_scan(const Params& p, float* ldsw, int task, int lane) {
    unsigned char* ws = p.ws;
    const bf16_t* Qn = (const bf16_t*)(ws + 4 * UNIT); const bf16_t* Kn = (const bf16_t*)(ws + 5 * UNIT); const bf16_t* Vc = (const bf16_t*)p.out;
    const float* G = (const float*)(ws + WS_G); const float* BE = (const float*)(ws + WS_BETA);
    const int chain = task >> 1, b = chain >> 4, dir = (chain >> 3) & 1, h = chain & 7, e = (task & 1) * 64 + lane;
    bf16_t* O = (dir ? (bf16_t*)(p.out) + (size_t)M * D : (bf16_t*)(ws + 3 * UNIT));
    float* kb = ldsw; float* qb = ldsw + 128;
    float P[128];
#pragma unroll
    for (int d = 0; d < 128; ++d) P[d] = 0.f;
    for (int n = 0; n < SEQ; ++n) {
        const int t = dir ? SEQ - 1 - n : n; const size_t row = (size_t)b * SEQ + t;
        const unsigned ku = *(const unsigned*)(Kn + row * D + h * 128 + 2 * lane), qu = *(const unsigned*)(Qn + row * D + h * 128 + 2 * lane);
        const float v = bf1(Vc[row * D + h * 128 + e]); const float al = __expf(G[row * 16 + dir * 8 + h]), be = BE[row * 16 + dir * 8 + h];
        kb[2 * lane] = bf_lo(ku); kb[2 * lane + 1] = bf_hi(ku); qb[2 * lane] = bf_lo(qu); qb[2 * lane + 1] = bf_hi(qu);
        asm volatile("s_waitcnt lgkmcnt(0)" ::: "memory");
        float sk = 0.f;
#pragma unroll
        for (int d4 = 0; d4 < 32; ++d4) { if ((d4 & 3) == 0) __builtin_amdgcn_sched_barrier(0); const f32x4 k4 = *(const f32x4*)(kb + 4 * d4); sk += P[4 * d4] * k4.x + P[4 * d4 + 1] * k4.y + P[4 * d4 + 2] * k4.z + P[4 * d4 + 3] * k4.w; }
        const float vn = be * (v - al * sk); float o = 0.f;
#pragma unroll
        for (int d4 = 0; d4 < 32; ++d4) { if ((d4 & 3) == 0) __builtin_amdgcn_sched_barrier(0); const f32x4 k4 = *(const f32x4*)(kb + 4 * d4), q4 = *(const f32x4*)(qb + 4 * d4);
            P[4 * d4] = al * P[4 * d4] + k4.x * vn; P[4 * d4 + 1] = al * P[4 * d4 + 1] + k4.y * vn; P[4 * d4 + 2] = al * P[4 * d4 + 2] + k4.z * vn; P[4 * d4 + 3] = al * P[4 * d4 + 3] + k4.w * vn;
            o += P[4 * d4] * q4.x + P[4 * d4 + 1] * q4.y + P[4 * d4 + 2] * q4.z + P[4 * d4 + 3] * q4.w; }
        O[row * D + h * 128 + e] = (bf16_t)(cvt_pk_bf16(o, 0.f) & 0xffffu);
        asm volatile("s_waitcnt lgkmcnt(0)" ::: "memory");
    }
}
DI void ya_acc(float (&acc)[8], const u32x4& pv, const f32x4& wa, const f32x4& wb) {
    acc[0] += wa.x * bf_lo(pv.x); acc[1] += wa.y * bf_hi(pv.x); acc[2] += wa.z * bf_lo(pv.y); acc[3] += wa.w * bf_hi(pv.y);
    acc[4] += wb.x * bf_lo(pv.z); acc[5] += wb.y * bf_hi(pv.z); acc[6] += wb.z * bf_lo(pv.w); acc[7] += wb.w * bf_hi(pv.w);
}
DI void phase7(const Params& p, int gw, int NGW, int lane, int gtid, int NGT) {
    unsigned char* ws = p.ws;
    const bf16_t* Pb = (const bf16_t*)(ws + 1 * UNIT); bf16_t* R = (bf16_t*)(ws + 2 * UNIT); const float* cw = p.in[6];
    for (int it = gtid; it < (M / 4) * 128; it += NGT) {
        const int row0 = (it >> 7) * 4, c8 = (it & 127) * 8, t0 = row0 & (SEQ - 1);
        const u32x4 z = (u32x4){0u, 0u, 0u, 0u};
        u32x4 pv[6], rv[4];
        { const u32x4 t_ = *(const u32x4*)(Pb + (size_t)(t0 > 0 ? row0 - 1 : row0) * D + c8); pv[0] = t0 > 0 ? t_ : z; }
#pragma unroll
        for (int j = 0; j < 4; ++j) { pv[j + 1] = *(const u32x4*)(Pb + (size_t)(row0 + j) * D + c8); rv[j] = *(const u32x4*)(R + (size_t)(row0 + j) * D + c8); }
        { const u32x4 t_ = *(const u32x4*)(Pb + (size_t)(t0 + 4 < SEQ ? row0 + 4 : row0) * D + c8); pv[5] = t0 + 4 < SEQ ? t_ : z; }
        f32x4 wa[3], wb[3];
#pragma unroll
        for (int j = 0; j < 3; ++j) { wa[j] = *(const f32x4*)(cw + j * D + c8); wb[j] = *(const f32x4*)(cw + j * D + c8 + 4); }
#pragma unroll
        for (int j = 0; j < 4; ++j) {
            float acc[8] = {0.f, 0.f, 0.f, 0.f, 0.f, 0.f, 0.f, 0.f};
            ya_acc(acc, pv[j], wa[0], wb[0]); ya_acc(acc, pv[j + 1], wa[1], wb[1]); ya_acc(acc, pv[j + 2], wa[2], wb[2]);
            u32x4 o; const u32x4 r = rv[j];
            o.x = cvt_pk_bf16(bf_lo(r.x) * acc[0], bf_hi(r.x) * acc[1]); o.y = cvt_pk_bf16(bf_lo(r.y) * acc[2], bf_hi(r.y) * acc[3]);
            o.z = cvt_pk_bf16(bf_lo(r.z) * acc[4], bf_hi(r.z) * acc[5]); o.w = cvt_pk_bf16(bf_lo(r.w) * acc[6], bf_hi(r.w) * acc[7]);
            *(u32x4*)(R + (size_t)(row0 + j) * D + c8) = o;
        }
    }
    const bf16_t* Of = (const bf16_t*)(ws + 3 * UNIT); const bf16_t* Ob = (const bf16_t*)p.out + (size_t)M * D; bf16_t* SZ = (bf16_t*)(ws + 6 * UNIT);
    const f32x4 g0 = *(const f32x4*)(p.in[10] + (lane & 15) * 8), g1 = *(const f32x4*)(p.in[10] + (lane & 15) * 8 + 4);
    for (int rp = gw; rp < M / 2; rp += NGW) {
        u32x4 a[4], bb[4], zz[4];
#pragma unroll
        for (int u = 0; u < 4; ++u) { const size_t off = (size_t)(rp * 2 + (u >> 1)) * D + (u & 1) * 512 + lane * 8;
            a[u] = __builtin_nontemporal_load((const u32x4*)(Of + off)); bb[u] = __builtin_nontemporal_load((const u32x4*)(Ob + off)); zz[u] = __builtin_nontemporal_load((const u32x4*)(SZ + off)); }
#pragma unroll
        for (int u = 0; u < 4; ++u) { const size_t off = (size_t)(rp * 2 + (u >> 1)) * D + (u & 1) * 512 + lane * 8;
            float o[8];
            o[0] = bf_lo(a[u].x) + bf_lo(bb[u].x); o[1] = bf_hi(a[u].x) + bf_hi(bb[u].x); o[2] = bf_lo(a[u].y) + bf_lo(bb[u].y); o[3] = bf_hi(a[u].y) + bf_hi(bb[u].y);
            o[4] = bf_lo(a[u].z) + bf_lo(bb[u].z); o[5] = bf_hi(a[u].z) + bf_hi(bb[u].z); o[6] = bf_lo(a[u].w) + bf_lo(bb[u].w); o[7] = bf_hi(a[u].w) + bf_hi(bb[u].w);
            float ss = 0.f;
#pragma unroll
            for (int j = 0; j < 8; ++j) ss += o[j] * o[j];
            ss = row16_sum(ss);
            const float rs = rsqrtf(ss * (1.f / 128.f) + NORM_EPS);
            u32x4 w;
            w.x = cvt_pk_bf16(o[0] * rs * g0.x * bf_lo(zz[u].x), o[1] * rs * g0.y * bf_hi(zz[u].x)); w.y = cvt_pk_bf16(o[2] * rs * g0.z * bf_lo(zz[u].y), o[3] * rs * g0.w * bf_hi(zz[u].y));
            w.z = cvt_pk_bf16(o[4] * rs * g1.x * bf_lo(zz[u].z), o[5] * rs * g1.y * bf_hi(zz[u].z)); w.w = cvt_pk_bf16(o[6] * rs * g1.z * bf_lo(zz[u].w), o[7] * rs * g1.w * bf_hi(zz[u].w));
            *(u32x4*)(SZ + off) = w;
        }
    }
}
DI void phase10(const Params& p, int gw, int NGW, int lane) {
    const float* XN = (const float*)(p.ws + 0 * UNIT); const float* fw = p.in[14];
    f32x4 w[4];
#pragma unroll
    for (int j = 0; j < 4; ++j) w[j] = *((const f32x4*)fw + lane + 64 * j);
    for (int m = gw; m < M; m += NGW) {
        const f32x4* xr = (const f32x4*)(XN + (size_t)m * D) + lane; f32x4 v[4]; float s = 0.f;
#pragma unroll
        for (int j = 0; j < 4; ++j) { v[j] = xr[64 * j]; s += (v[j].x * v[j].x + v[j].y * v[j].y) + (v[j].z * v[j].z + v[j].w * v[j].w); }
        const float rstd = rsqrtf(wave_sum(s) * (1.f / D) + NORM_EPS);
        f32x4* o = (f32x4*)(p.out + (size_t)m * D) + lane;
#pragma unroll
        for (int j = 0; j < 4; ++j) o[64 * j] = v[j] * rstd * w[j];
    }
}
#define MFMA16(a, b, c) __builtin_amdgcn_mfma_f32_16x16x32_bf16((a), (b), (c), 0, 0, 0)
DI void chunk_prep_item(const Params& p, float* Lm, int item, int lane) {
    unsigned char* ws = p.ws;
    const bf16_t* Qn = (const bf16_t*)(ws + 4 * UNIT); const bf16_t* Kn = (const bf16_t*)(ws + 5 * UNIT);
    bf16_t* TF = (bf16_t*)(ws + 1 * UNIT) + (size_t)item * 4096; bf16_t* AF = (bf16_t*)(ws + 2 * UNIT) + (size_t)item * 4096;
    float* csc = (float*)(ws + WS_CSC) + (size_t)item * 192;
    const int c = item & 127, h = (item >> 7) & 7, dir = (item >> 10) & 1, b = item >> 11;
    const size_t rb = (size_t)b * SEQ + c * 64; const int il = lane & 15, q = lane >> 4;
    const int tl = dir ? 63 - lane : lane;
    const float g = ((const float*)(ws + WS_G))[(rb + tl) * 16 + dir * 8 + h], be = ((const float*)(ws + WS_BETA))[(rb + tl) * 16 + dir * 8 + h];
    float gc = g;
#pragma unroll
    for (int o = 1; o < 64; o <<= 1) { const float v = __shfl_up(gc, o); if (lane >= o) gc += v; }
    const float gl = __shfl(gc, 63);
    csc[tl] = __expf(gc); csc[64 + tl] = be; csc[128 + tl] = __expf(gl - gc);
    float gcr[4][4], ber[4][4], gcc[4];
#pragma unroll
    for (int t = 0; t < 4; ++t) { gcc[t] = __shfl(gc, 16 * t + il);
#pragma unroll
        for (int r = 0; r < 4; ++r) { gcr[t][r] = __shfl(gc, 16 * t + 4 * q + r); ber[t][r] = __shfl(be, 16 * t + 4 * q + r); } }
    bf16x8 Kf[4][4];
#pragma unroll
    for (int rt = 0; rt < 4; ++rt) { const int ip = 16 * rt + il; const size_t ro = (rb + (dir ? 63 - ip : ip)) * D + h * 128 + 8 * q;
#pragma unroll
        for (int ks = 0; ks < 4; ++ks) Kf[rt][ks] = *(const bf16x8*)(Kn + ro + 32 * ks); }
#pragma unroll
    for (int it = 0; it < 4; ++it)
#pragma unroll
        for (int jt = 0; jt <= it; ++jt) {
            f32x4 acc = {0.f, 0.f, 0.f, 0.f};
#pragma unroll
            for (int ks = 0; ks < 4; ++ks) acc = MFMA16(Kf[it][ks], Kf[jt][ks], acc);
#pragma unroll
            for (int r = 0; r < 4; ++r) { const int ip = 16 * it + 4 * q + r, jp = 16 * jt + il;
                Lm[ip * 64 + jp] = ip > jp ? ber[it][r] * acc[r] * __expf(gcr[it][r] - gcc[jt]) : 0.f; }
        }
    __builtin_amdgcn_sched_barrier(0);
    bf16x8 Qnext[4];
    { const int ip = il; const size_t ro = (rb + (dir ? 63 - ip : ip)) * D + h * 128 + 8 * q;
#pragma unroll
      for (int ks = 0; ks < 4; ++ks) Qnext[ks] = *(const bf16x8*)(Qn + ro + 32 * ks); }
#pragma unroll
    for (int mt = 0; mt < 4; ++mt) {
        bf16x8 Qf[4];
#pragma unroll
        for (int ks = 0; ks < 4; ++ks) Qf[ks] = Qnext[ks];
        if (mt < 3) { const int ip = 16 * (mt + 1) + il; const size_t ro = (rb + (dir ? 63 - ip : ip)) * D + h * 128 + 8 * q;
#pragma unroll
          for (int ks = 0; ks < 4; ++ks) Qnext[ks] = *(const bf16x8*)(Qn + ro + 32 * ks); }
#pragma unroll
        for (int ks2 = 0; ks2 < 2; ++ks2) {
            float vals[8];
#pragma unroll
            for (int a = 0; a < 2; ++a) { const int jt = 2 * ks2 + a; f32x4 acc = {0.f, 0.f, 0.f, 0.f};
#pragma unroll
                for (int ks = 0; ks < 4; ++ks) acc = MFMA16(Kf[jt][ks], Qf[ks], acc);
#pragma unroll
                for (int r = 0; r < 4; ++r) { const int jp = 16 * jt + 4 * q + r, ip = 16 * mt + il; vals[4 * a + r] = ip >= jp ? acc[r] * __expf(gcc[mt] - gcr[jt][r]) : 0.f; } }
            u32x4 w;
            if (dir) { w.x = cvt_pk_bf16(vals[7], vals[6]); w.y = cvt_pk_bf16(vals[5], vals[4]); w.z = cvt_pk_bf16(vals[3], vals[2]); w.w = cvt_pk_bf16(vals[1], vals[0]); }
            else { w.x = cvt_pk_bf16(vals[0], vals[1]); w.y = cvt_pk_bf16(vals[2], vals[3]); w.z = cvt_pk_bf16(vals[4], vals[5]); w.w = cvt_pk_bf16(vals[6], vals[7]); }
            const int fi = dir ? ((3 - mt) * 2 + (1 - ks2)) : (mt * 2 + ks2), ln = dir ? ((3 - q) * 16 + (15 - il)) : lane;
            *(u32x4*)(AF + (size_t)(fi * 64 + ln) * 8) = w;
        }
        __builtin_amdgcn_sched_barrier(0);
    }
    asm volatile("s_waitcnt lgkmcnt(0)" ::: "memory");
    __builtin_amdgcn_sched_barrier(0);
    float T[64];
#pragma unroll
    for (int i = 0; i < 64; ++i) {
        float s0 = (lane == i) ? 1.f : 0.f, s1 = 0.f;
#pragma unroll
        for (int m4 = 0; m4 < (i + 3) / 4; ++m4) {
            const f32x4 l4 = *(const f32x4*)(Lm + i * 64 + 4 * m4);
            if (4 * m4 + 0 < i) s0 -= l4.x * T[4 * m4 + 0];
            if (4 * m4 + 1 < i) s1 -= l4.y * T[4 * m4 + 1];
            if (4 * m4 + 2 < i) s0 -= l4.z * T[4 * m4 + 2];
            if (4 * m4 + 3 < i) s1 -= l4.w * T[4 * m4 + 3];
        }
        T[i] = s0 + s1;
        if ((i & 3) == 3) __builtin_amdgcn_sched_barrier(0);
    }
    asm volatile("s_waitcnt lgkmcnt(0)" ::: "memory");
    bf16_t* TL = (bf16_t*)Lm;
#pragma unroll
    for (int i = 0; i < 64; ++i) TL[i * 72 + lane] = (bf16_t)(cvt_pk_bf16(T[i], 0.f) & 0xffffu);
    asm volatile("s_waitcnt lgkmcnt(0)" ::: "memory");
#pragma unroll
    for (int mt = 0; mt < 4; ++mt)
#pragma unroll
        for (int ks2 = 0; ks2 < 2; ++ks2) {
            u32x4 w;
            if (dir) {
                const int row = 63 - 16 * mt - il;
                const u32x2 lo = *(const u32x2*)(TL + row * 72 + (60 - 32 * ks2 - 4 * q)), hi = *(const u32x2*)(TL + row * 72 + (44 - 32 * ks2 - 4 * q));
                w.x = (lo.y >> 16) | (lo.y << 16); w.y = (lo.x >> 16) | (lo.x << 16); w.z = (hi.y >> 16) | (hi.y << 16); w.w = (hi.x >> 16) | (hi.x << 16);
            } else {
                const int row = 16 * mt + il;
                const u32x2 lo = *(const u32x2*)(TL + row * 72 + (32 * ks2 + 4 * q)), hi = *(const u32x2*)(TL + row * 72 + (32 * ks2 + 16 + 4 * q));
                w.x = lo.x; w.y = lo.y; w.z = hi.x; w.w = hi.y;
            }
            *(u32x4*)(TF + (size_t)((mt * 2 + ks2) * 64 + lane) * 8) = w;
        }
    asm volatile("s_waitcnt lgkmcnt(0)" ::: "memory");
}
DI bf16x8 pack8(const f32x4& a, const f32x4& b) {
    u32x4 w; w.x = cvt_pk_bf16(a[0], a[1]); w.y = cvt_pk_bf16(a[2], a[3]); w.z = cvt_pk_bf16(b[0], b[1]); w.w = cvt_pk_bf16(b[2], b[3]);
    return __builtin_bit_cast(bf16x8, w);
}
DI void mfma_scan(const Params& p, int chain, int slice, int lane) {
    unsigned char* ws = p.ws;
    const bf16_t* Qn = (const bf16_t*)(ws + 4 * UNIT); const bf16_t* Kn = (const bf16_t*)(ws + 5 * UNIT); const bf16_t* KT = (const bf16_t*)(ws + 6 * UNIT); const bf16_t* Vc = (const bf16_t*)p.out;
    const bf16_t* TFb = (const bf16_t*)(ws + 1 * UNIT); const bf16_t* AFb = (const bf16_t*)(ws + 2 * UNIT); const float* cscb = (const float*)(ws + WS_CSC);
    const int b = chain >> 4, dir = (chain >> 3) & 1, h = chain & 7, il = lane & 15, q = lane >> 4;
    bf16_t* O = (dir ? (bf16_t*)(p.out) + (size_t)M * D : (bf16_t*)(ws + 3 * UNIT));
    f32x4 S[8];
#pragma unroll
    for (int dt = 0; dt < 8; ++dt) S[dt] = (f32x4){0.f, 0.f, 0.f, 0.f};
    for (int n = 0; n < 128; ++n) {
        const int c = dir ? 127 - n : n; const int item = chain * 128 + c; const size_t rowbase = (size_t)b * SEQ + c * 64;
        const bf16_t* TF = TFb + (size_t)item * 4096 + lane * 8; const bf16_t* AF = AFb + (size_t)item * 4096 + lane * 8; const float* csc = cscb + (size_t)item * 192;
        const float gl = csc[dir ? 0 : 63];
        f32x4 EG[4], BE[4], EK[4], V[4];
#pragma unroll
        for (int mt = 0; mt < 4; ++mt) { EG[mt] = *(const f32x4*)(csc + 16 * mt + 4 * q); BE[mt] = *(const f32x4*)(csc + 64 + 16 * mt + 4 * q); EK[mt] = *(const f32x4*)(csc + 128 + 16 * mt + 4 * q);
#pragma unroll
            for (int r = 0; r < 4; ++r) V[mt][r] = bf1(Vc[(rowbase + 16 * mt + 4 * q + r) * D + h * 128 + 16 * slice + il]); }
        bf16x8 Sb[4];
#pragma unroll
        for (int ks = 0; ks < 4; ++ks) Sb[ks] = pack8(S[2 * ks], S[2 * ks + 1]);
        f32x4 KS[4], QS[4];
#pragma unroll
        for (int mt = 0; mt < 4; ++mt) { const size_t ro = (rowbase + 16 * mt + il) * D + h * 128 + 8 * q;
            KS[mt] = (f32x4){0.f, 0.f, 0.f, 0.f}; QS[mt] = (f32x4){0.f, 0.f, 0.f, 0.f};
#pragma unroll
            for (int ks = 0; ks < 4; ++ks) { KS[mt] = MFMA16(*(const bf16x8*)(Kn + ro + 32 * ks), Sb[ks], KS[mt]); QS[mt] = MFMA16(*(const bf16x8*)(Qn + ro + 32 * ks), Sb[ks], QS[mt]); } }
        f32x4 X[4];
#pragma unroll
        for (int mt = 0; mt < 4; ++mt) X[mt] = BE[mt] * (V[mt] - EG[mt] * KS[mt]);
        bf16x8 Xb[2] = {pack8(X[0], X[1]), pack8(X[2], X[3])};
        f32x4 VN[4];
#pragma unroll
        for (int mt = 0; mt < 4; ++mt) { VN[mt] = (f32x4){0.f, 0.f, 0.f, 0.f};
#pragma unroll
            for (int ks2 = 0; ks2 < 2; ++ks2) VN[mt] = MFMA16(*(const bf16x8*)(TF + (size_t)((mt * 2 + ks2) * 64) * 8), Xb[ks2], VN[mt]); }
        bf16x8 VNb[2] = {pack8(VN[0], VN[1]), pack8(VN[2], VN[3])};
        bf16x8 VNs[2] = {pack8(VN[0] * EK[0], VN[1] * EK[1]), pack8(VN[2] * EK[2], VN[3] * EK[3])};
#pragma unroll
        for (int mt = 0; mt < 4; ++mt) { f32x4 o = EG[mt] * QS[mt];
#pragma unroll
            for (int ks2 = 0; ks2 < 2; ++ks2) o = MFMA16(*(const bf16x8*)(AF + (size_t)((mt * 2 + ks2) * 64) * 8), VNb[ks2], o);
#pragma unroll
            for (int r = 0; r < 4; ++r) O[(rowbase + 16 * mt + 4 * q + r) * D + h * 128 + 16 * slice + il] = (bf16_t)(cvt_pk_bf16(o[r], 0.f) & 0xffffu); }
#pragma unroll
        for (int dt = 0; dt < 8; ++dt) { const bf16_t* kt = KT + ((size_t)((b * 8 + h) * 128 + 16 * dt + il)) * SEQ + c * 64 + 8 * q; f32x4 s = S[dt] * gl;
#pragma unroll
            for (int ks2 = 0; ks2 < 2; ++ks2) s = MFMA16(*(const bf16x8*)(kt + 32 * ks2), VNs[ks2], s);
            S[dt] = s; }
    }
}
constexpr int SC_K = 0, SC_Q = 16384, SC_T = 32768, SC_A = 40960, SC_V = 49152, SC_C = 51200, SC_BUF = 52224, SC_NPIECE = 3248, SC_NLD = 384, SC_PPL = 9;
constexpr int SC_SB = 2 * SC_BUF, SC_VB = SC_SB + 2 * 4096, SC_END = SC_VB + 2 * 2048;
static_assert(SC_END <= LDS_BYTES - 256, "scan LDS");
typedef short s16x4_t __attribute__((ext_vector_type(4)));
#define SC_BAR() do { asm volatile("s_waitcnt lgkmcnt(0)" ::: "memory"); __builtin_amdgcn_s_barrier(); asm volatile("" ::: "memory"); } while (0)
DI void scan_task(const Params& p, PG8_LAS unsigned char* lds, int chain, int slice, int tid, int wave, int lane) {
    unsigned char* ws = p.ws;
    const int b = chain >> 4, dir = (chain >> 3) & 1, h = chain & 7, il = lane & 15, q = lane >> 4;
    const int c0 = dir ? 127 : 0; const long sgn = dir ? -1 : 1;
    if (wave >= 2) {
        const int lt = tid - 128; const int wbase = 64 * (wave - 2);
        const unsigned char* gp[SC_PPL]; int gstride[SC_PPL];
        const size_t rowbase0 = (size_t)b * SEQ + c0 * 64; const size_t item0 = (size_t)chain * 128 + c0;
#pragma unroll
        for (int k = 0; k < SC_PPL; ++k) {
            int pid = lt + SC_NLD * k; if (pid >= SC_NPIECE) pid -= 64;
            const unsigned char* g = ws; int st = 0;
            if (pid < 2048) { const int pp = pid & 1023, row = pp >> 4, ch = (pp & 15) ^ (row & 15);
                g = ws + (pid < 1024 ? 5 : 4) * UNIT + ((rowbase0 + row) * D + h * 128) * 2 + ch * 16; st = 64 * D * 2; }
            else if (pid < 3072) { const int pp = pid & 511; const bool isT = pid < 2560;
                g = ws + (isT ? 1 : 2) * UNIT + item0 * 8192 + pp * 16; st = 8192; }
            else if (pid < 3200) { const int pp = pid - 3072, row = pp >> 1, hf = pp & 1;
                g = (const unsigned char*)p.out + ((rowbase0 + row) * D + h * 128 + slice * 16) * 2 + hf * 16; st = 64 * D * 2; }
            else { const int pp = pid - 3200; g = ws + WS_CSC + item0 * 768 + pp * 16; st = 768; }
            gp[k] = g; gstride[k] = st;
        }
#define SC_DMA(bo) do { _Pragma("unroll") for (int k = 0; k < SC_PPL; ++k) { if (wbase + SC_NLD * k < SC_NPIECE) \
            __builtin_amdgcn_global_load_lds((const unsigned*)gp[k], (PG8_LAS unsigned*)(lds + (bo) + (wbase + SC_NLD * k) * 16), 16, 0, 0); gp[k] += sgn * gstride[k]; } } while (0)
        SC_DMA(0u);
        asm volatile("s_waitcnt vmcnt(0)" ::: "memory");
        SC_BAR();
        for (int n = 0; n < 128; ++n) {
            if (n + 1 < 128) SC_DMA((unsigned)(((n + 1) & 1) * SC_BUF));
            asm volatile("s_waitcnt vmcnt(0)" ::: "memory");
            SC_BAR();
        }
#undef SC_DMA
    } else if (wave == 0) {
        f32x4 S[8];
#pragma unroll
        for (int dt = 0; dt < 8; ++dt) S[dt] = (f32x4){0.f, 0.f, 0.f, 0.f};
        bf16x8 Sb[4];
#pragma unroll
        for (int ks = 0; ks < 4; ++ks) { Sb[ks] = pack8(S[2 * ks], S[2 * ks + 1]); *(PG8_LAS bf16x8*)(lds + SC_SB + (ks * 64 + lane) * 16) = Sb[ks]; }
        SC_BAR();
        for (int n = 0; n < 128; ++n) {
            PG8_LAS unsigned char* L = lds + (n & 1) * SC_BUF;
            bf16x8 Kf[4][4];
#pragma unroll
            for (int mt = 0; mt < 4; ++mt)
#pragma unroll
                for (int ks = 0; ks < 4; ++ks) Kf[mt][ks] = *(PG8_LAS bf16x8*)(L + SC_K + (16 * mt + il) * 256 + (((4 * ks + q) ^ il) << 4));
            f32x4 EG[4], BE[4], V[4]; bf16x8 Tf[4][2];
#pragma unroll
            for (int mt = 0; mt < 4; ++mt) { EG[mt] = *(PG8_LAS f32x4*)(L + SC_C + (16 * mt + 4 * q) * 4); BE[mt] = *(PG8_LAS f32x4*)(L + SC_C + 256 + (16 * mt + 4 * q) * 4);
#pragma unroll
                for (int r = 0; r < 4; ++r) V[mt][r] = bf1(*(PG8_LAS bf16_t*)(L + SC_V + (16 * mt + 4 * q + r) * 32 + il * 2));
#pragma unroll
                for (int ks2 = 0; ks2 < 2; ++ks2) Tf[mt][ks2] = *(PG8_LAS bf16x8*)(L + SC_T + ((mt * 2 + ks2) * 64 + lane) * 16); }
            f32x4 KS[4];
#pragma unroll
            for (int mt = 0; mt < 4; ++mt) KS[mt] = (f32x4){0.f, 0.f, 0.f, 0.f};
#pragma unroll
            for (int ks = 0; ks < 4; ++ks)
#pragma unroll
                for (int mt = 0; mt < 4; ++mt) KS[mt] = MFMA16(Kf[mt][ks], Sb[ks], KS[mt]);
            __builtin_amdgcn_sched_barrier(0);
            bf16x8 KTf[8][2]; f32x4 EK[4];
            { const int rr = il >> 2, pc = il & 3;
              PG8_LAS unsigned char* kb = L + SC_K + (4 * q + rr) * 256;
#pragma unroll
              for (int dt = 0; dt < 8; ++dt) {
                const int cho = (((4 * (dt >> 1) + pc) ^ (4 * q + rr)) << 4) + 8 * (dt & 1);
#pragma unroll
                for (int ks2 = 0; ks2 < 2; ++ks2) {
                    const s16x4_t lo_ = __builtin_amdgcn_ds_read_tr16_b64_v4i16((PG8_LAS s16x4_t*)(kb + (32 * ks2) * 256 + cho));
                    const s16x4_t hi_ = __builtin_amdgcn_ds_read_tr16_b64_v4i16((PG8_LAS s16x4_t*)(kb + (32 * ks2 + 16) * 256 + cho));
                    KTf[dt][ks2] = __builtin_shufflevector(lo_, hi_, 0, 1, 2, 3, 4, 5, 6, 7);
                } } }
#pragma unroll
            for (int mt = 0; mt < 4; ++mt) EK[mt] = *(PG8_LAS f32x4*)(L + SC_C + 512 + (16 * mt + 4 * q) * 4);
            const float gl = *(PG8_LAS float*)(L + SC_C + (dir ? 0 : 63) * 4);
            f32x4 X[4];
#pragma unroll
            for (int mt = 0; mt < 4; ++mt) X[mt] = BE[mt] * (V[mt] - EG[mt] * KS[mt]);
            bf16x8 Xb[2] = {pack8(X[0], X[1]), pack8(X[2], X[3])};
            f32x4 VN[4];
#pragma unroll
            for (int mt = 0; mt < 4; ++mt) VN[mt] = (f32x4){0.f, 0.f, 0.f, 0.f};
#pragma unroll
            for (int ks2 = 0; ks2 < 2; ++ks2)
#pragma unroll
                for (int mt = 0; mt < 4; ++mt) VN[mt] = MFMA16(Tf[mt][ks2], Xb[ks2], VN[mt]);
            *(PG8_LAS bf16x8*)(lds + SC_VB + (n & 1) * 2048 + lane * 16) = pack8(VN[0], VN[1]); *(PG8_LAS bf16x8*)(lds + SC_VB + (n & 1) * 2048 + (64 + lane) * 16) = pack8(VN[2], VN[3]);
            bf16x8 VNs[2] = {pack8(VN[0] * EK[0], VN[1] * EK[1]), pack8(VN[2] * EK[2], VN[3] * EK[3])};
#pragma unroll
            for (int dt = 0; dt < 8; ++dt) S[dt] = S[dt] * gl;
#pragma unroll
            for (int ks2 = 0; ks2 < 2; ++ks2)
#pragma unroll
                for (int dt = 0; dt < 8; ++dt) S[dt] = MFMA16(KTf[dt][ks2], VNs[ks2], S[dt]);
#pragma unroll
            for (int ks = 0; ks < 4; ++ks) { Sb[ks] = pack8(S[2 * ks], S[2 * ks + 1]); *(PG8_LAS bf16x8*)(lds + SC_SB + ((n + 1) & 1) * 4096 + (ks * 64 + lane) * 16) = Sb[ks]; }
            SC_BAR();
        }
    } else {
        bf16_t* O = (dir ? (bf16_t*)(p.out) + (size_t)M * D : (bf16_t*)(ws + 3 * UNIT));
        f32x4 Oa[4]; bf16x8 Af[4][2];
#pragma unroll
        for (int mt = 0; mt < 4; ++mt) { Oa[mt] = (f32x4){0.f, 0.f, 0.f, 0.f}; Af[mt][0] = (bf16x8){0, 0, 0, 0, 0, 0, 0, 0}; Af[mt][1] = Af[mt][0]; }
        SC_BAR();
        for (int n = 0; n <= 128; ++n) {
            if (n > 0) {
                const int c = dir ? 128 - n : n - 1; const size_t rowbase = (size_t)b * SEQ + c * 64;
                PG8_LAS unsigned char* vb = lds + SC_VB + ((n - 1) & 1) * 2048;
                bf16x8 VNb[2] = {*(PG8_LAS bf16x8*)(vb + lane * 16), *(PG8_LAS bf16x8*)(vb + (64 + lane) * 16)};
#pragma unroll
                for (int ks2 = 0; ks2 < 2; ++ks2)
#pragma unroll
                    for (int mt = 0; mt < 4; ++mt) Oa[mt] = MFMA16(Af[mt][ks2], VNb[ks2], Oa[mt]);
#pragma unroll
                for (int mt = 0; mt < 4; ++mt)
#pragma unroll
                    for (int r = 0; r < 4; ++r) __builtin_nontemporal_store((bf16_t)(cvt_pk_bf16(Oa[mt][r], 0.f) & 0xffffu), O + (rowbase + 16 * mt + 4 * q + r) * D + h * 128 + 16 * slice + il);
            }
            if (n < 128) {
                PG8_LAS unsigned char* L = lds + (n & 1) * SC_BUF;
                bf16x8 Qf[4][4], Sb[4]; f32x4 EG[4];
#pragma unroll
                for (int ks = 0; ks < 4; ++ks) Sb[ks] = *(PG8_LAS bf16x8*)(lds + SC_SB + (n & 1) * 4096 + (ks * 64 + lane) * 16);
#pragma unroll
                for (int mt = 0; mt < 4; ++mt) {
#pragma unroll
                    for (int ks = 0; ks < 4; ++ks) Qf[mt][ks] = *(PG8_LAS bf16x8*)(L + SC_Q + (16 * mt + il) * 256 + (((4 * ks + q) ^ il) << 4));
                    EG[mt] = *(PG8_LAS f32x4*)(L + SC_C + (16 * mt + 4 * q) * 4);
#pragma unroll
                    for (int ks2 = 0; ks2 < 2; ++ks2) Af[mt][ks2] = *(PG8_LAS bf16x8*)(L + SC_A + ((mt * 2 + ks2) * 64 + lane) * 16); }
                f32x4 QS[4];
#pragma unroll
                for (int mt = 0; mt < 4; ++mt) QS[mt] = (f32x4){0.f, 0.f, 0.f, 0.f};
#pragma unroll
                for (int ks = 0; ks < 4; ++ks)
#pragma unroll
                    for (int mt = 0; mt < 4; ++mt) QS[mt] = MFMA16(Qf[mt][ks], Sb[ks], QS[mt]);
#pragma unroll
                for (int mt = 0; mt < 4; ++mt) Oa[mt] = EG[mt] * QS[mt];
                SC_BAR();
            }
        }
    }
}


typedef const __attribute__((address_space(4))) Params* kparams_t;
#if defined(__HIP_DEVICE_COMPILE__)
DI Params load_params() { kparams_t pp = (kparams_t)__builtin_amdgcn_kernarg_segment_ptr(); asm volatile("" : "+s"(pp)); return *pp; }
#else
DI Params load_params() { return Params{}; }
#endif
#define PP() load_params()
#define XB_TMO      128
#define XB_XCNT(j)  (256  + 64 * (j))
#define XB_XSUB(j)  (1280 + 64 * (j))
#define XB_XGEN(j)  (2304 + 64 * (j))
#define XB_TOP      3328
#define XB_TOPGEN   3392
#define XCD_BAR_WORDS 3456
#define XB_SPIN_CAP (1u << 18)
#define LAS __attribute__((address_space(3)))

__device__ __forceinline__ unsigned xb_ld(unsigned* p)              { return __hip_atomic_load(p, __ATOMIC_RELAXED, __HIP_MEMORY_SCOPE_AGENT); }
__device__ __forceinline__ unsigned xb_add(unsigned* p, unsigned v) { return __hip_atomic_fetch_add(p, v, __ATOMIC_RELAXED, __HIP_MEMORY_SCOPE_AGENT); }
__device__ __forceinline__ unsigned xb_xcc_id() { return (unsigned)__builtin_amdgcn_s_getreg((3 << 11) | 20) & 0xFu; }
#define XB_SPIN(cond, bar) do { unsigned _sp = 0; while (cond) { __builtin_amdgcn_s_sleep(1); \
    if ((++_sp & 255u) == 0u) { if (xb_ld(&(bar)[XB_TMO])) break; if (_sp > XB_SPIN_CAP) { atomicAdd(&(bar)[XB_TMO], 1u); break; } } } } while (0)

struct XcdBarrier {
    unsigned* bar; unsigned x;
    volatile LAS unsigned* st;
};

__device__ __forceinline__ XcdBarrier xcd_barrier_post(unsigned* bar, volatile LAS unsigned* st) {
    XcdBarrier b; b.bar = bar; b.x = xb_xcc_id(); b.st = st;
    if (threadIdx.x == 0) (void)xb_add(&bar[XB_XCNT(b.x)], 1u);
    return b;
}
__device__ __forceinline__ void xcd_barrier_complete(unsigned* bar, unsigned x, unsigned& nloc, unsigned& nx) {
    const unsigned G = gridDim.x * gridDim.y * gridDim.z;
    unsigned sum, cnt, mine, sp = 0u;
    for (;;) {
        sum = 0u; cnt = 0u; mine = 0u;
#pragma unroll
        for (unsigned j = 0; j < 16; ++j) { const unsigned c = xb_ld(&bar[XB_XCNT(j)]); sum += c; cnt += (c > 0u) ? 1u : 0u; mine = (j == x) ? c : mine; }
        if (sum == G) break;
        __builtin_amdgcn_s_sleep(1);
        if ((++sp & 255u) == 0u) { if (xb_ld(&bar[XB_TMO])) break; if (sp > XB_SPIN_CAP) { atomicAdd(&bar[XB_TMO], 1u); break; } }
    }
    nloc = mine > 0u ? mine : 1u; nx = cnt > 0u ? cnt : 1u;
}

__device__ __forceinline__ void xcd_barrier(const XcdBarrier& b) {
    asm volatile("s_waitcnt vmcnt(0)" ::: "memory");
    __syncthreads();
    if (threadIdx.x == 0) {
        unsigned* bar = b.bar;
        __builtin_amdgcn_s_waitcnt(0);
        unsigned nloc = b.st[0], nx = b.st[1];
        if (nloc == 0u) { xcd_barrier_complete(bar, b.x, nloc, nx); b.st[0] = nloc; b.st[1] = nx; }
        const unsigned old = xb_add(&bar[XB_XSUB(b.x)], 1u);
        const unsigned gen = old / nloc;
        if (old + 1u == (gen + 1u) * nloc) {
            __builtin_amdgcn_fence(__ATOMIC_RELEASE, "agent");
            asm volatile("s_waitcnt vmcnt(0)" ::: "memory");
            const unsigned og = xb_add(&bar[XB_TOP], 1u);
            const unsigned tg = og / nx;
            if (og + 1u == (tg + 1u) * nx) xb_add(&bar[XB_TOPGEN], 1u);
            else XB_SPIN(xb_ld(&bar[XB_TOPGEN]) == tg, bar);
            __builtin_amdgcn_fence(__ATOMIC_ACQUIRE, "agent");
            xb_add(&bar[XB_XGEN(b.x)], 1u);
            asm volatile("s_waitcnt vmcnt(0)" ::: "memory");
        } else {
            XB_SPIN(xb_ld(&bar[XB_XGEN(b.x)]) == gen, bar);
            __builtin_amdgcn_fence(__ATOMIC_ACQUIRE, "agent");
            asm volatile("s_waitcnt vmcnt(0)" ::: "memory");
        }
    }
    __syncthreads();
}


constexpr size_t WS_BAR = 255 * MiB + 320 * 1024;
DI int fresh_tid() { int t = threadIdx.x; asm volatile("" : "+v"(t)); return t; }
#define IDS const int tid = fresh_tid(), lane = tid & 63, wave = __builtin_amdgcn_readfirstlane(tid >> 6); const int G = gridDim.x, bx = blockIdx.x; \
    const int gw = bx * NWAVES + wave, NGW = G * NWAVES, gtid = bx * NTHREADS + tid, NGT = G * NTHREADS; (void)lane; (void)gw; (void)NGW; (void)gtid; (void)NGT; (void)wave;
__global__ void __launch_bounds__(NTHREADS, 2) fwd_kernel(Params p) {
    extern __shared__ __attribute__((aligned(16))) unsigned char lds[];
    cg::grid_group grid = cg::this_grid();
    PG8_LAS unsigned char* ldsl = (PG8_LAS unsigned char*)lds;
    if (threadIdx.x < 4) ((PG8_LAS unsigned*)(ldsl + (LDS_BYTES - 256)))[threadIdx.x] = 0u;
    __syncthreads();
    const XcdBarrier bar = xcd_barrier_post((unsigned*)(PP().ws + WS_BAR), (volatile PG8_LAS unsigned*)(ldsl + (LDS_BYTES - 256)));

    { IDS phase0(PP(), gw, NGW, lane); }
    if (PP().ws == nullptr) grid.sync();
    xcd_barrier(bar);
    { IDS phase1(PP(), (float*)lds, gw, NGW, lane, tid); }
    xcd_barrier(bar);
    {
        const Params q = PP(); unsigned char* ws = q.ws; bf16_t* WIN = (bf16_t*)(ws + WS_WIN); const int G = gridDim.x, bx = blockIdx.x;
        pg8::Gemm g{(const bf16_t*)(ws + 0 * UNIT), WIN + (size_t)ROWS_A * D, M, NB_TILES * 256, D}; pg8::StaticOrder S; S.init(M, NB_TILES * 256, G, bx);
        EpiB E{(bf16_t*)(ws + 1 * UNIT)};
        pg8::gemm_phase<EpiB, pg8::StaticOrder, true, true>(ldsl, g, S, E);
    }
    { IDS for (int it = gw; it < M / 16; it += NGW) ab_item(PP(), it, lane); }
    xcd_barrier(bar);
    { IDS for (int it = gw; it < 4096; it += NGW) phase3_item(PP(), it, lane); }
    xcd_barrier(bar);
    { IDS for (int it = gw; it < 4096; it += NGW) chunk_prep_item(PP(), (float*)(lds + wave * 16384), it, lane); }
    xcd_barrier(bar);
    for (int tk = blockIdx.x; tk < 256; tk += gridDim.x) { const int t2 = fresh_tid(); scan_task(PP(), ldsl, (tk & 7) + 8 * (tk >> 6), (tk >> 3) & 7, t2, __builtin_amdgcn_readfirstlane(t2 >> 6), t2 & 63); __syncthreads(); }
    xcd_barrier(bar);
    {
        const Params q = PP(); unsigned char* ws = q.ws; bf16_t* WIN = (bf16_t*)(ws + WS_WIN); const int G = gridDim.x, bx = blockIdx.x;
        pg8::Gemm g{(const bf16_t*)(ws + 0 * UNIT), WIN, M, NA_TILES * 256, D}; pg8::StaticOrder S; S.init(M, NA_TILES * 256, G, bx);
        EpiA E{(bf16_t*)(ws + 1 * UNIT), (bf16_t*)(ws + 4 * UNIT)};
        pg8::gemm_phase<EpiA, pg8::StaticOrder, true, true>(ldsl, g, S, E);
    }
    xcd_barrier(bar);
    { IDS phase7(PP(), gw, NGW, lane, gtid, NGT); }
    xcd_barrier(bar);
    if (gridDim.x == 256) {
        const Params q = PP(); unsigned char* ws = q.ws; const int G = gridDim.x, bx = blockIdx.x;
        static_assert(6 * UNIT - 2 * UNIT == (size_t)256 * 256 * D * 2 && WS_WPB - WS_WPA == (size_t)4 * 256 * D * 2, "TwoGemmOrder address arithmetic");
        TwoGemmOrder S; S.so.init(M, D, G, bx);
        pg8::Gemm g{(const bf16_t*)(ws + 2 * UNIT), (const bf16_t*)(ws + WS_WPA), M, D, D}; EpiYaYb E{(bf16_t*)(ws + 4 * UNIT), (const bf16_t*)(ws + 5 * UNIT)};
        pg8::gemm_phase<EpiYaYb, TwoGemmOrder, true, true>(ldsl, g, S, E);
    } else {
        const Params q = PP(); unsigned char* ws = q.ws; const int G = gridDim.x, bx = blockIdx.x;
        pg8::StaticOrder S; S.init(M, D, G, bx);
        { pg8::Gemm g{(const bf16_t*)(ws + 2 * UNIT), (const bf16_t*)(ws + WS_WPA), M, D, D}; EpiYa E{(bf16_t*)(ws + 4 * UNIT)};
          pg8::gemm_phase<EpiYa, pg8::StaticOrder, true, true>(ldsl, g, S, E); }
        { pg8::Gemm g{(const bf16_t*)(ws + 6 * UNIT), (const bf16_t*)(ws + WS_WPB), M, D, D}; EpiYb E{(bf16_t*)(ws + 4 * UNIT), (const bf16_t*)(ws + 5 * UNIT)};
          pg8::gemm_phase<EpiYb, pg8::StaticOrder, true, true>(ldsl, g, S, E); }
    }
    xcd_barrier(bar);
    if (gridDim.x == 256) {
        const Params q = PP(); unsigned char* ws = q.ws; const int G = gridDim.x, bx = blockIdx.x;
        pg8::Gemm g{(const bf16_t*)(ws + 4 * UNIT), (const bf16_t*)(ws + WS_WO), M, D, D}; pg8::StaticOrder S; S.init(M, D, G, bx);
        EpiOutFused E{q.in[0], (const float*)(ws + WS_MODF), q.in[14], q.out, (float*)(ws + WS_PSS), (unsigned*)(ws + WS_PCNT)};
        pg8::gemm_phase<EpiOutFused, pg8::StaticOrder, true, true>(ldsl, g, S, E);
    } else {
        {
            const Params q = PP(); unsigned char* ws = q.ws; const int G = gridDim.x, bx = blockIdx.x;
            pg8::Gemm g{(const bf16_t*)(ws + 4 * UNIT), (const bf16_t*)(ws + WS_WO), M, D, D}; pg8::StaticOrder S; S.init(M, D, G, bx);
            EpiOut E{q.in[0], (const float*)(ws + WS_MODF), (float*)(ws + 0 * UNIT)};
            pg8::gemm_phase<EpiOut, pg8::StaticOrder, true, true>(ldsl, g, S, E);
        }
        xcd_barrier(bar);
        { IDS phase10(PP(), gw, NGW, lane); }
    }
}

extern "C" void kernel_launch(void* const* d_in, const int* in_sizes, int n_in, void* d_out, int out_size, void* d_ws, size_t ws_size, hipStream_t stream) {
    static int grid = 0;
    if (grid == 0) {
        int dev = 0, cus = 0, per_cu = 0;
        if (n_in != 15 || out_size != M * D || ws_size < 256 * MiB) { fprintf(stderr, "kernel_launch: unexpected shapes (n_in %d out %d ws %zu)\n", n_in, out_size, ws_size); grid = -1; return; }
        hipGetDevice(&dev); hipDeviceGetAttribute(&cus, hipDeviceAttributeMultiprocessorCount, dev);
        if (hipFuncSetAttribute((const void*)fwd_kernel, hipFuncAttributeMaxDynamicSharedMemorySize, LDS_BYTES) != hipSuccess) { fprintf(stderr, "kernel_launch: hipFuncSetAttribute failed\n"); grid = -1; return; }
        hipOccupancyMaxActiveBlocksPerMultiprocessor(&per_cu, (const void*)fwd_kernel, NTHREADS, LDS_BYTES);
        if (per_cu < 1) { fprintf(stderr, "kernel_launch: occupancy query says %d blocks/CU\n", per_cu); per_cu = 1; }
        (void)hipGetLastError();
        grid = cus;
    }
    if (grid < 0) return;
    if (hipMemsetAsync((char*)d_ws + WS_BAR, 0, 32768, stream) != hipSuccess) { fprintf(stderr, "kernel_launch: memset of barrier words failed\n"); return; }
    Params p{};
    for (int i = 0; i < 15; ++i) p.in[i] = (const float*)d_in[i];
    p.out = (float*)d_out; p.ws = (unsigned char*)d_ws;
    void* args[] = {&p};
    hipError_t e = hipLaunchCooperativeKernel((const void*)fwd_kernel, dim3(grid), dim3(NTHREADS), args, LDS_BYTES, stream);
    if (e != hipSuccess) fprintf(stderr, "cooperative launch failed: %s (grid %d)\n", hipGetErrorString(e), grid);
}
```

```cpp
#include <hip/hip_runtime.h>
#include <hip/hip_cooperative_groups.h>
#include <cstdio>
#include <cstdint>
namespace cg = cooperative_groups;

#define DI __device__ __forceinline__
#define PG8_LAS __attribute__((address_space(3)))
typedef unsigned short bf16_t;
typedef short bf16x8 __attribute__((ext_vector_type(8)));
typedef float f32x4 __attribute__((ext_vector_type(4)));
typedef float f32x2 __attribute__((ext_vector_type(2)));
typedef unsigned u32x4 __attribute__((ext_vector_type(4)));
typedef unsigned u32x2 __attribute__((ext_vector_type(2)));

namespace pg8 {
constexpr int BM = 256, BK = 64, HALF = 128, HTB = HALF * BK * 2, STAGE_BYTES = 8 * HTB, NXCD = 8, WGM = 8;
__host__ __device__ __forceinline__ int lds_byte(int r, int c) { const int st = (r >> 4) * 2 + (c >> 5), rr = r & 15, cc = c & 31, ob = rr * 64 + cc * 2; return st * 1024 + (ob ^ (((ob >> 9) & 1) << 5)); }
__host__ __device__ __forceinline__ void stage_rc(int b, int& R, int& C) { const int st = b / 1024, sb = b % 1024, swz = sb ^ (((sb >> 9) & 1) << 5); R = (st >> 1) * 16 + swz / 64; C = (st & 1) * 32 + (swz % 64) / 2; }
__host__ __device__ __forceinline__ int perm32(int rho) { const int n = rho >> 4, i = rho & 15; return 8 * (i >> 2) + 4 * n + (i & 3); }
struct Unit { int pm, pn; };
struct Gemm { const bf16_t* A; const bf16_t* Bt; int M, N, K; };
struct StaticOrder {
    int nM, nN, nwg, G, c;
    __host__ __device__ void init(int M, int N, int G_, int c_) { nM = M / BM; nN = N / BM; nwg = nM * nN; G = G_; c = c_; }
    __host__ __device__ bool next(int i, Unit& u) const {
        const long L = (long)i * G + c; if (L >= nwg) return false;
        int wgid = (int)L; { const int q = nwg / NXCD, r = nwg % NXCD, xcd = wgid % NXCD, off = wgid / NXCD; wgid = (xcd < r ? xcd * (q + 1) : r * (q + 1) + (xcd - r) * q) + off; }
        const int nig = WGM * nN, gid = wgid / nig, fm = gid * WGM, gsz = (nM - fm) < WGM ? (nM - fm) : WGM;
        u.pm = fm + ((wgid % nig) % gsz); u.pn = (wgid % nig) / gsz; return true;
    }
    __device__ __forceinline__ void a_ready(const Unit&) const {}
    __device__ __forceinline__ void done(const Unit&) const {}
};
template <class Epi, class Sched, bool ALIGN_EPI = false, bool SP2 = false>
__device__ __forceinline__ void gemm_phase(PG8_LAS unsigned char* lds, const Gemm g, const Sched& S, const Epi& E) {
    int tid = threadIdx.x; asm volatile("" : "+v"(tid)); const int wid = __builtin_amdgcn_readfirstlane(tid >> 6), lane = tid & 63, wr = wid >> 2, wc = wid & 3, fr = lane & 15, fq = lane >> 4;
    const int K = g.K, nt = K / BK;
    unsigned voffA[2], voffB[2];
#pragma unroll
    for (int i = 0; i < 2; ++i) { int R, C; stage_rc(tid * 16 + i * 8192, R, C); const int Rb = Epi::PERM ? ((R & ~31) + perm32(R & 31)) : R;
        voffA[i] = (unsigned)(R * K + C) * 2u; voffB[i] = (unsigned)(Rb * K + C) * 2u; }
    const size_t kstep = (size_t)(BK * 2);
    const size_t hstep = (size_t)HALF * K * 2;
    const size_t tstep = 2 * hstep;
    const unsigned ldsw = (unsigned)wid * 1024u;
    const int aoff = lds_byte(wr * 64 + fr, fq * 8), boff = lds_byte(wc * 32 + fr, fq * 8);
#define PG8_SA(b, h) (((b) * 2 + (h)) * HTB)
#define PG8_SB(b, h) ((4 + (b) * 2 + (h)) * HTB)
#define PG8_STAGE(bufoff, gbase, voff) do { _Pragma("unroll") for (int _i = 0; _i < 2; ++_i) \
        __builtin_amdgcn_global_load_lds((const unsigned*)((const char*)(gbase) + (voff)[_i]), (PG8_LAS unsigned*)(lds + (bufoff) + ldsw + _i * 8192), 16, 0, 0); } while (0)
#define PG8_LDA(dst, b, h) do { _Pragma("unroll") for (int m = 0; m < 4; ++m) _Pragma("unroll") for (int k = 0; k < 2; ++k) dst[m][k] = *(const PG8_LAS bf16x8*)(lds + PG8_SA(b, h) + aoff + m * 2048 + k * 1024); } while (0)
#define PG8_LDB(dst, b, h) do { _Pragma("unroll") for (int n = 0; n < 2; ++n) _Pragma("unroll") for (int k = 0; k < 2; ++k) dst[n][k] = *(const PG8_LAS bf16x8*)(lds + PG8_SB(b, h) + boff + n * 2048 + k * 1024); } while (0)
#define PG8_MMA(ai, bj, At, Bt) do { __builtin_amdgcn_s_setprio(1); _Pragma("unroll") for (int m = 0; m < 4; ++m) _Pragma("unroll") for (int n = 0; n < 2; ++n) _Pragma("unroll") for (int k = 0; k < 2; ++k) \
        acc[ai][bj][m][n] = __builtin_amdgcn_mfma_f32_16x16x32_bf16(Bt[n][k], At[m][k], acc[ai][bj][m][n], 0, 0, 0); __builtin_amdgcn_s_setprio(0); } while (0)
#define PG8_WAIT_V(n) asm volatile("s_waitcnt vmcnt(" #n ")" ::: "memory")
#define PG8_WAIT_L(n) asm volatile("s_waitcnt lgkmcnt(" #n ")" ::: "memory")
#define PG8_BAR __builtin_amdgcn_s_barrier()
#define PG8_SCHED __builtin_amdgcn_sched_barrier(0)
    Unit cur, nxt; int ui = 0;
    if (!S.next(0, cur)) return;
    f32x4 acc[2][2][4][2];
#pragma unroll
    for (int a = 0; a < 2; ++a)
#pragma unroll
        for (int b = 0; b < 2; ++b)
#pragma unroll
            for (int m = 0; m < 4; ++m)
#pragma unroll
                for (int n = 0; n < 2; ++n) acc[a][b][m][n] = (f32x4){0.f, 0.f, 0.f, 0.f};
    bf16x8 At[4][2], B0[2][2], B1[2][2];
    const char* cA = (const char*)g.A + (size_t)cur.pm * tstep; const char* cB = (const char*)g.Bt + (size_t)cur.pn * tstep;
    S.a_ready(cur);
    if constexpr (SP2) {
        PG8_STAGE(PG8_SB(0, 0), cB, voffB); PG8_STAGE(PG8_SB(0, 1), cB + hstep, voffB); PG8_STAGE(PG8_SA(0, 0), cA, voffA); PG8_STAGE(PG8_SA(0, 1), cA + hstep, voffA);
        if (wr == 1) PG8_BAR;
        PG8_WAIT_V(2); PG8_BAR;
        PG8_STAGE(PG8_SB(1, 0), cB + kstep, voffB); PG8_STAGE(PG8_SA(1, 0), cA + kstep, voffA); PG8_STAGE(PG8_SB(1, 1), cB + hstep + kstep, voffB);
        PG8_WAIT_V(6); PG8_BAR;
    } else {
        PG8_STAGE(PG8_SB(0, 0), cB, voffB); PG8_STAGE(PG8_SA(0, 0), cA, voffA); PG8_STAGE(PG8_SB(0, 1), cB + hstep, voffB); PG8_STAGE(PG8_SA(0, 1), cA + hstep, voffA);
        if (wr == 1) PG8_BAR;
        PG8_WAIT_V(4); PG8_BAR;
        PG8_STAGE(PG8_SB(1, 0), cB + kstep, voffB); PG8_STAGE(PG8_SA(1, 0), cA + kstep, voffA); PG8_STAGE(PG8_SB(1, 1), cB + hstep + kstep, voffB);
        PG8_WAIT_V(6); PG8_BAR;
    }
    for (;;) {
        const bool has_next = S.next(ui + 1, nxt);
        const char* nA = has_next ? (const char*)g.A + (size_t)nxt.pm * tstep : cA; const char* nB = has_next ? (const char*)g.Bt + (size_t)nxt.pn * tstep : cB;
        for (int t = 0; t < nt; t += 2) {
            const bool last = (t == nt - 2);
            const char* a1 = cA + (size_t)(t + 1) * kstep;
            const char* a2 = last ? nA : cA + (size_t)(t + 2) * kstep; const char* b2 = last ? nB : cB + (size_t)(t + 2) * kstep;
            const char* a3 = a2 + kstep; const char* b3 = b2 + kstep;
            if (last && has_next) S.a_ready(nxt);
            if constexpr (SP2) {
            PG8_LDB(B0, 0, 0); PG8_LDB(B1, 0, 1); PG8_SCHED; PG8_LDA(At, 0, 0); PG8_STAGE(PG8_SA(1, 1), a1 + hstep, voffA);
            PG8_WAIT_V(8); PG8_WAIT_L(0); PG8_BAR; PG8_MMA(0, 0, At, B0); PG8_MMA(0, 1, At, B1); PG8_BAR; PG8_SCHED;
            PG8_LDA(At, 0, 1); PG8_STAGE(PG8_SB(0, 0), b2, voffB); PG8_STAGE(PG8_SB(0, 1), b2 + hstep, voffB); PG8_STAGE(PG8_SA(0, 0), a2, voffA);
            PG8_WAIT_V(8); PG8_WAIT_L(0); PG8_BAR; PG8_MMA(1, 0, At, B0); PG8_MMA(1, 1, At, B1); PG8_BAR; PG8_SCHED;
            PG8_LDB(B0, 1, 0); PG8_LDB(B1, 1, 1); PG8_SCHED; PG8_LDA(At, 1, 0); PG8_STAGE(PG8_SA(0, 1), a2 + hstep, voffA);
            PG8_WAIT_V(8); PG8_WAIT_L(0); PG8_BAR; PG8_MMA(0, 0, At, B0); PG8_MMA(0, 1, At, B1); PG8_BAR; PG8_SCHED;
            PG8_LDA(At, 1, 1); PG8_STAGE(PG8_SB(1, 0), b3, voffB); PG8_STAGE(PG8_SB(1, 1), b3 + hstep, voffB); PG8_STAGE(PG8_SA(1, 0), a3, voffA);
            PG8_WAIT_V(8); PG8_WAIT_L(0); PG8_BAR; PG8_MMA(1, 0, At, B0); PG8_MMA(1, 1, At, B1); PG8_BAR; PG8_SCHED;
            } else {
            PG8_LDB(B0, 0, 0); PG8_SCHED; PG8_LDA(At, 0, 0); PG8_STAGE(PG8_SA(1, 1), a1 + hstep, voffA);
            PG8_WAIT_L(8); PG8_BAR; PG8_WAIT_L(0); PG8_MMA(0, 0, At, B0); PG8_BAR; PG8_SCHED;
            PG8_LDB(B1, 0, 1); PG8_STAGE(PG8_SB(0, 0), b2, voffB);
            PG8_BAR; PG8_WAIT_L(0); PG8_MMA(0, 1, At, B1); PG8_BAR;
            PG8_LDA(At, 0, 1); PG8_STAGE(PG8_SA(0, 0), a2, voffA);
            PG8_BAR; PG8_WAIT_L(0); PG8_MMA(1, 0, At, B0); PG8_BAR; PG8_SCHED;
            PG8_STAGE(PG8_SB(0, 1), b2 + hstep, voffB);
            PG8_WAIT_V(6); PG8_BAR; PG8_MMA(1, 1, At, B1); PG8_BAR;
            PG8_LDB(B0, 1, 0); PG8_SCHED; PG8_LDA(At, 1, 0); PG8_STAGE(PG8_SA(0, 1), a2 + hstep, voffA);
            PG8_WAIT_L(8); PG8_BAR; PG8_WAIT_L(0); PG8_MMA(0, 0, At, B0); PG8_BAR; PG8_SCHED;
            PG8_LDB(B1, 1, 1); PG8_STAGE(PG8_SB(1, 0), b3, voffB);
            PG8_BAR; PG8_WAIT_L(0); PG8_MMA(0, 1, At, B1); PG8_BAR;
            PG8_LDA(At, 1, 1); PG8_STAGE(PG8_SA(1, 0), a3, voffA);
            PG8_BAR; PG8_WAIT_L(0); PG8_MMA(1, 0, At, B0); PG8_BAR; PG8_SCHED;
            PG8_STAGE(PG8_SB(1, 1), b3 + hstep, voffB);
            PG8_WAIT_V(6); PG8_BAR; PG8_MMA(1, 1, At, B1); PG8_BAR;
            }
        }
        if constexpr (ALIGN_EPI) { if (wr == 0) PG8_BAR; }
        if constexpr (!Epi::AFTER_DRAIN) { E(acc, cur, wr, wc, fr, fq); S.done(cur); }
        if (!has_next) break;
#pragma unroll
        for (int a = 0; a < 2; ++a)
#pragma unroll
            for (int b = 0; b < 2; ++b)
#pragma unroll
                for (int m = 0; m < 4; ++m)
#pragma unroll
                    for (int n = 0; n < 2; ++n) acc[a][b][m][n] = (f32x4){0.f, 0.f, 0.f, 0.f};
        cur = nxt; cA = nA; cB = nB; ++ui;
        if constexpr (ALIGN_EPI) { if (wr == 1) PG8_BAR; }
    }
    PG8_WAIT_V(0);
    if constexpr (!ALIGN_EPI) { if (wr == 0) PG8_BAR; }
    PG8_BAR;
    if constexpr (Epi::AFTER_DRAIN) { E.fused(acc, cur, wr, wc, fr, fq, lds, wid, lane); S.done(cur); }
#undef PG8_SA
#undef PG8_SB
#undef PG8_STAGE
#undef PG8_LDA
#undef PG8_LDB
#undef PG8_MMA
#undef PG8_WAIT_V
#undef PG8_WAIT_L
#undef PG8_BAR
#undef PG8_SCHED
}}

constexpr int SEQ = 8192, NB = 2, M = NB * SEQ, D = 1024, NIN = 10272, NPAD = 10496;
constexpr int NA_TILES = 28, NB_TILES = 12, ROWS_A = NA_TILES * 256;
constexpr size_t MiB = 1u << 20;
constexpr size_t UNIT = 32 * MiB;
constexpr size_t WS_WIN = 224 * MiB, WS_WPA = 245 * MiB, WS_WPB = 247 * MiB, WS_WO = 249 * MiB, WS_AB = 251 * MiB, WS_G = 253 * MiB, WS_BETA = 254 * MiB;
constexpr size_t WS_MODP = 255 * MiB, WS_MODF = 255 * MiB + 256 * 1024;
constexpr size_t WS_CSC = 239 * MiB;
constexpr int LDS_BYTES = 155648;
constexpr int NWAVES = 8, NTHREADS = 512;
constexpr float NORM_EPS = 1e-6f, L2_EPS = 1e-6f;

struct Params { const float* in[15]; float* out; unsigned char* ws; };

typedef __bf16 bf16v2_t __attribute__((ext_vector_type(2)));
DI unsigned cvt_pk_bf16(float lo, float hi) { const f32x2 v = {lo, hi}; const bf16v2_t r = __builtin_convertvector(v, bf16v2_t); return __builtin_bit_cast(unsigned, r); }
DI void store_wt16(void* p, const u32x4& v) { asm volatile("global_store_dwordx4 %0, %1, off sc1\n\ts_nop 1" :: "v"(p), "v"(v) : "memory"); }
DI float bf_lo(unsigned u) { return __uint_as_float(u << 16); }
DI float bf_hi(unsigned u) { return __uint_as_float(u & 0xffff0000u); }
DI float bf1(bf16_t u) { return __uint_as_float(((unsigned)u) << 16); }
DI float sigmoidf_(float x) { return __builtin_amdgcn_rcpf(1.0f + __expf(-x)); }
DI float siluf_(float x) { return x * __builtin_amdgcn_rcpf(1.0f + __expf(-x)); }
DI float softplusf_(float x) { return fmaxf(x, 0.f) + log1pf(__expf(-fabsf(x))); }
#define DPP_F(v, ctrl) __builtin_bit_cast(float, __builtin_amdgcn_mov_dpp(__builtin_bit_cast(int, (v)), (ctrl), 0xF, 0xF, true))
DI float row16_sum(float v) {
    v += DPP_F(v, 0xB1);
    v += DPP_F(v, 0x4E);
    v += DPP_F(v, 0x141);
    v += DPP_F(v, 0x140);
    return v;
}
DI float wave_sum(float v) {
    v = row16_sum(v);
    return __builtin_bit_cast(float, __builtin_amdgcn_readlane(__builtin_bit_cast(int, v), 0)) + __builtin_bit_cast(float, __builtin_amdgcn_readlane(__builtin_bit_cast(int, v), 16))
         + __builtin_bit_cast(float, __builtin_amdgcn_readlane(__builtin_bit_cast(int, v), 32)) + __builtin_bit_cast(float, __builtin_amdgcn_readlane(__builtin_bit_cast(int, v), 48));
}
DI int permpos(int dk) { const int loc = dk & 31; return (dk & ~31) + 8 * ((loc >> 2) & 3) + 4 * (loc >> 4) + (loc & 3); }
DI int win_src_col(int d) {
    if (d < 2048) { const int i = d >> 8, w = d & 255; return w < 128 ? (128 * i + w) : (2048 + 128 * i + (w - 128)); }
    if (d < 4096) { const int i = (d - 2048) >> 8, w = d & 255; return w < 128 ? (1024 + 128 * i + w) : (3072 + 128 * i + (w - 128)); }
    if (d < 5120) return 8224 + (d - 4096);
    if (d < 6144) return 9248 + (d - 5120);
    if (d < 7168) return 7168 + (d - 6144);
    if (d < 10240) return 4096 + (d - 7168);
    if (d < 10272) return 8192 + (d - 10240);
    return -1;
}

struct EpiA {
    static constexpr bool PERM = true, AFTER_DRAIN = false;
    bf16_t *PR, *SG;
    DI void operator()(const f32x4 (&acc)[2][2][4][2], const pg8::Unit& u, int wr, int wc, int fr, int fq) const {
        const int row0 = u.pm * 256 + wr * 64 + fr, pn = u.pn;
        if (pn < 16) {
            bf16_t* O = PR + (size_t)(pn >> 3) * (UNIT / 2) + (size_t)(128 * (pn & 7) + 32 * wc + 8 * fq);
#pragma unroll
            for (int ai = 0; ai < 2; ++ai)
#pragma unroll
                for (int m = 0; m < 4; ++m) {
                    float o[8];
#pragma unroll
                    for (int n = 0; n < 2; ++n)
#pragma unroll
                        for (int j = 0; j < 4; ++j) { const float a = acc[ai][0][m][n][j], b = acc[ai][1][m][n][j]; o[4 * n + j] = pn < 8 ? a * b : a * siluf_(b); }
                    u32x4 w; w.x = cvt_pk_bf16(o[0], o[1]); w.y = cvt_pk_bf16(o[2], o[3]); w.z = cvt_pk_bf16(o[4], o[5]); w.w = cvt_pk_bf16(o[6], o[7]);
                    store_wt16(O + (size_t)(row0 + ai * 128 + m * 16) * D, w);
                }
        } else {
            const int g = (pn - 16) >> 2;
            bf16_t* O = SG + (size_t)g * (UNIT / 2) + (size_t)(256 * ((pn - 16) & 3) + 32 * wc + 8 * fq);
#pragma unroll
            for (int ai = 0; ai < 2; ++ai)
#pragma unroll
                for (int m = 0; m < 4; ++m)
#pragma unroll
                    for (int bj = 0; bj < 2; ++bj) {
                        float o[8];
#pragma unroll
                        for (int n = 0; n < 2; ++n)
#pragma unroll
                            for (int j = 0; j < 4; ++j) { const float a = acc[ai][bj][m][n][j]; o[4 * n + j] = g == 2 ? siluf_(a) : sigmoidf_(a); }
                        u32x4 w; w.x = cvt_pk_bf16(o[0], o[1]); w.y = cvt_pk_bf16(o[2], o[3]); w.z = cvt_pk_bf16(o[4], o[5]); w.w = cvt_pk_bf16(o[6], o[7]);
                        store_wt16(O + (size_t)(row0 + ai * 128 + m * 16) * D + bj * 128, w);
                    }
        }
    }
};
struct EpiB {
    static constexpr bool PERM = true, AFTER_DRAIN = false;
    bf16_t* QKV;
    DI void operator()(const f32x4 (&acc)[2][2][4][2], const pg8::Unit& u, int wr, int wc, int fr, int fq) const {
        const int row0 = u.pm * 256 + wr * 64 + fr, pn = u.pn;
        bf16_t* O = QKV + (size_t)(pn >> 2) * (UNIT / 2) + (size_t)(256 * (pn & 3) + 32 * wc + 8 * fq);
#pragma unroll
        for (int ai = 0; ai < 2; ++ai)
#pragma unroll
            for (int m = 0; m < 4; ++m)
#pragma unroll
                for (int bj = 0; bj < 2; ++bj) {
                    const f32x4 v0 = acc[ai][bj][m][0], v1 = acc[ai][bj][m][1];
                    u32x4 w; w.x = cvt_pk_bf16(v0[0], v0[1]); w.y = cvt_pk_bf16(v0[2], v0[3]); w.z = cvt_pk_bf16(v1[0], v1[1]); w.w = cvt_pk_bf16(v1[2], v1[3]);
                    store_wt16(O + (size_t)(row0 + ai * 128 + m * 16) * D + bj * 128, w);
                }
    }
};
struct EpiYa {
    static constexpr bool PERM = true, AFTER_DRAIN = false;
    bf16_t* SGA;
    DI void operator()(const f32x4 (&acc)[2][2][4][2], const pg8::Unit& u, int wr, int wc, int fr, int fq) const {
        const int row0 = u.pm * 256 + wr * 64 + fr; bf16_t* O = SGA + (size_t)(256 * u.pn + 32 * wc + 8 * fq);
#pragma unroll
        for (int ai = 0; ai < 2; ++ai)
#pragma unroll
            for (int m = 0; m < 4; ++m)
#pragma unroll
                for (int bj = 0; bj < 2; ++bj) {
                    u32x4* p = (u32x4*)(O + (size_t)(row0 + ai * 128 + m * 16) * D + bj * 128);
                    const u32x4 s = *p; const f32x4 v0 = acc[ai][bj][m][0], v1 = acc[ai][bj][m][1];
                    u32x4 w; w.x = cvt_pk_bf16(bf_lo(s.x) * v0[0], bf_hi(s.x) * v0[1]); w.y = cvt_pk_bf16(bf_lo(s.y) * v0[2], bf_hi(s.y) * v0[3]);
                    w.z = cvt_pk_bf16(bf_lo(s.z) * v1[0], bf_hi(s.z) * v1[1]); w.w = cvt_pk_bf16(bf_lo(s.w) * v1[2], bf_hi(s.w) * v1[3]);
                    *p = w;
                }
    }
};
struct EpiYb {
    static constexpr bool PERM = true, AFTER_DRAIN = false;
    bf16_t* MA; const bf16_t* SGB;
    DI void operator()(const f32x4 (&acc)[2][2][4][2], const pg8::Unit& u, int wr, int wc, int fr, int fq) const {
        const int row0 = u.pm * 256 + wr * 64 + fr; const size_t c0 = (size_t)(256 * u.pn + 32 * wc + 8 * fq);
#pragma unroll
        for (int ai = 0; ai < 2; ++ai)
#pragma unroll
            for (int m = 0; m < 4; ++m)
#pragma unroll
                for (int bj = 0; bj < 2; ++bj) {
                    const size_t off = (size_t)(row0 + ai * 128 + m * 16) * D + bj * 128 + c0;
                    u32x4* p = (u32x4*)(MA + off); const u32x4 a = *p; const u32x4 s = *(const u32x4*)(SGB + off);
                    const f32x4 v0 = acc[ai][bj][m][0], v1 = acc[ai][bj][m][1];
                    u32x4 w; w.x = cvt_pk_bf16(bf_lo(a.x) + bf_lo(s.x) * v0[0], bf_hi(a.x) + bf_hi(s.x) * v0[1]); w.y = cvt_pk_bf16(bf_lo(a.y) + bf_lo(s.y) * v0[2], bf_hi(a.y) + bf_hi(s.y) * v0[3]);
                    w.z = cvt_pk_bf16(bf_lo(a.z) + bf_lo(s.z) * v1[0], bf_hi(a.z) + bf_hi(s.z) * v1[1]); w.w = cvt_pk_bf16(bf_lo(a.w) + bf_lo(s.w) * v1[2], bf_hi(a.w) + bf_hi(s.w) * v1[3]);
                    *p = w;
                }
    }
};
struct EpiOut {
    static constexpr bool PERM = true, AFTER_DRAIN = false;
    const float* X; const float* GATE; float* XN;
    DI void operator()(const f32x4 (&acc)[2][2][4][2], const pg8::Unit& u, int wr, int wc, int fr, int fq) const {
        const int row0 = u.pm * 256 + wr * 64 + fr; const int c0 = 256 * u.pn + 32 * wc + 8 * fq;
        const float* gp = GATE + (size_t)((u.pm * 256) / SEQ) * D + c0;
        f32x4 gt[2][2];
#pragma unroll
        for (int bj = 0; bj < 2; ++bj) { gt[bj][0] = *(const f32x4*)(gp + bj * 128); gt[bj][1] = *(const f32x4*)(gp + bj * 128 + 4); }
#pragma unroll
        for (int ai = 0; ai < 2; ++ai)
#pragma unroll
            for (int m = 0; m < 4; ++m)
#pragma unroll
                for (int bj = 0; bj < 2; ++bj) {
                    const size_t off = (size_t)(row0 + ai * 128 + m * 16) * D + bj * 128 + c0;
                    const f32x4 x0 = *(const f32x4*)(X + off), x1 = *(const f32x4*)(X + off + 4);
                    *(f32x4*)(XN + off) = x0 + gt[bj][0] * acc[ai][bj][m][0]; *(f32x4*)(XN + off + 4) = x1 + gt[bj][1] * acc[ai][bj][m][1];
                }
    }
};

constexpr size_t WS_PCNT = 255 * MiB + 336 * 1024;
constexpr size_t WS_PSS = 255 * MiB + 512 * 1024;
struct EpiOutFused {
    static constexpr bool PERM = true, AFTER_DRAIN = true;
    const float* X; const float* GATE; const float* FW; float* OUT; float* PSS; unsigned* PCNT;
    DI void operator()(const f32x4 (&)[2][2][4][2], const pg8::Unit&, int, int, int, int) const {}
    DI void fused(f32x4 (&acc)[2][2][4][2], const pg8::Unit& u, int wr, int wc, int fr, int fq, PG8_LAS unsigned char* lds, int wid, int lane) const {
        PG8_LAS float* P = (PG8_LAS float*)lds;
        PG8_LAS float* S = (PG8_LAS float*)(lds + 4096);
        const int row0 = u.pm * 256 + wr * 64 + fr; const int c0 = 256 * u.pn + 32 * wc + 8 * fq;
        const float* gp = GATE + (size_t)((u.pm * 256) / SEQ) * D + c0;
        f32x4 gt[2][2];
#pragma unroll
        for (int bj = 0; bj < 2; ++bj) { gt[bj][0] = *(const f32x4*)(gp + bj * 128); gt[bj][1] = *(const f32x4*)(gp + bj * 128 + 4); }
#pragma unroll
        for (int ai = 0; ai < 2; ++ai)
#pragma unroll
            for (int m = 0; m < 4; ++m) {
                float s = 0.f;
#pragma unroll
                for (int bj = 0; bj < 2; ++bj) {
                    const size_t off = (size_t)(row0 + ai * 128 + m * 16) * D + bj * 128 + c0;
                    const f32x4 v0 = __builtin_nontemporal_load((const f32x4*)(X + off)) + gt[bj][0] * acc[ai][bj][m][0], v1 = __builtin_nontemporal_load((const f32x4*)(X + off + 4)) + gt[bj][1] * acc[ai][bj][m][1];
                    acc[ai][bj][m][0] = v0; acc[ai][bj][m][1] = v1;
                    s += (v0[0] * v0[0] + v0[1] * v0[1]) + (v0[2] * v0[2] + v0[3] * v0[3]) + (v1[0] * v1[0] + v1[1] * v1[1]) + (v1[2] * v1[2] + v1[3] * v1[3]);
                }
                s += __shfl_xor(s, 16); s += __shfl_xor(s, 32);
                if (fq == 0) P[(ai * 128 + wr * 64 + m * 16 + fr) * 4 + wc] = s;
                if (m & 1) __builtin_amdgcn_sched_barrier(0);
            }
        asm volatile("s_waitcnt lgkmcnt(0)" ::: "memory"); __builtin_amdgcn_s_barrier(); asm volatile("" ::: "memory");
        const int row = wid * 32 + (lane & 31);
        if (lane < 32) {
            const float t = (P[row * 4 + 0] + P[row * 4 + 1]) + (P[row * 4 + 2] + P[row * 4 + 3]);
            __hip_atomic_store(PSS + (size_t)(u.pm * 256 + row) * 4 + u.pn, t, __ATOMIC_RELAXED, __HIP_MEMORY_SCOPE_AGENT);
        }
        asm volatile("s_waitcnt vmcnt(0)" ::: "memory");
        if (lane == 0) __hip_atomic_fetch_add(PCNT + 64 * u.pm, 1u, __ATOMIC_RELAXED, __HIP_MEMORY_SCOPE_AGENT);
        if (wid == 0) {
            unsigned sp = 0;
            while ((unsigned)__builtin_amdgcn_readfirstlane(__hip_atomic_load(PCNT + 64 * u.pm, __ATOMIC_RELAXED, __HIP_MEMORY_SCOPE_AGENT)) < 32u) { __builtin_amdgcn_s_sleep(2); if (++sp > (1u << 22)) break; }
            __builtin_amdgcn_fence(__ATOMIC_ACQUIRE, "agent");
        }
        asm volatile("s_waitcnt vmcnt(0) lgkmcnt(0)" ::: "memory"); __builtin_amdgcn_s_barrier(); asm volatile("" ::: "memory");
        if (lane < 32) {
            const float* ps = PSS + (size_t)(u.pm * 256 + row) * 4; float t = 0.f;
#pragma unroll
            for (int k = 0; k < 4; ++k) t += __hip_atomic_load(ps + k, __ATOMIC_RELAXED, __HIP_MEMORY_SCOPE_AGENT);
            S[row] = rsqrtf(t * (1.f / D) + NORM_EPS);
        }
        asm volatile("s_waitcnt vmcnt(0) lgkmcnt(0)" ::: "memory"); __builtin_amdgcn_s_barrier(); asm volatile("" ::: "memory");
        f32x4 fw[2][2];
#pragma unroll
        for (int bj = 0; bj < 2; ++bj) { fw[bj][0] = *(const f32x4*)(FW + c0 + bj * 128); fw[bj][1] = *(const f32x4*)(FW + c0 + bj * 128 + 4); }
#pragma unroll
        for (int ai = 0; ai < 2; ++ai)
#pragma unroll
            for (int m = 0; m < 4; ++m) {
                const float rs = S[ai * 128 + wr * 64 + m * 16 + fr];
#pragma unroll
                for (int bj = 0; bj < 2; ++bj) {
                    const size_t off = (size_t)(row0 + ai * 128 + m * 16) * D + bj * 128 + c0;
                    __builtin_nontemporal_store(acc[ai][bj][m][0] * rs * fw[bj][0], (f32x4*)(OUT + off)); __builtin_nontemporal_store(acc[ai][bj][m][1] * rs * fw[bj][1], (f32x4*)(OUT + off + 4));
                }
            }
    }
};

struct TwoGemmOrder {
    pg8::StaticOrder so;
    DI bool next(int i, pg8::Unit& u) const { if (i >= 2) return false; if (!so.next(0, u)) return false; if (i == 1) { u.pm += 256; u.pn += 4; } return true; }
    DI void a_ready(const pg8::Unit&) const {}
    DI void done(const pg8::Unit&) const {}
};
struct EpiYaYb {
    static constexpr bool PERM = true, AFTER_DRAIN = false;
    bf16_t* MA; const bf16_t* SGB;
    DI void operator()(const f32x4 (&acc)[2][2][4][2], const pg8::Unit& u, int wr, int wc, int fr, int fq) const {
        if (u.pn < 4) { EpiYa e{MA}; e(acc, u, wr, wc, fr, fq); }
        else { EpiYb e{MA, SGB}; pg8::Unit v; v.pm = u.pm - 256; v.pn = u.pn - 4; e(acc, v, wr, wc, fr, fq); }
    }
};

DI void p0_transpose_item(const float* W, int N, bf16_t* WT, int rg, int kg, int lane, bool is_win) {
    const int d = rg * 64 + lane; const int s = is_win ? win_src_col(d) : d; const int k0 = kg * 64;
    bf16_t* o = WT + (size_t)d * D + k0;
    if (s < 0) {
#pragma unroll
        for (int kk = 0; kk < 8; ++kk) *(u32x4*)(o + 8 * kk) = (u32x4){0u, 0u, 0u, 0u};
        return;
    }
    const float* w = W + (size_t)k0 * N + s;
    float v[64];
#pragma unroll
    for (int j = 0; j < 64; ++j) v[j] = __builtin_nontemporal_load(w + (size_t)j * N);
#pragma unroll
    for (int kk = 0; kk < 8; ++kk) {
        u32x4 p; p.x = cvt_pk_bf16(v[8 * kk], v[8 * kk + 1]); p.y = cvt_pk_bf16(v[8 * kk + 2], v[8 * kk + 3]); p.z = cvt_pk_bf16(v[8 * kk + 4], v[8 * kk + 5]); p.w = cvt_pk_bf16(v[8 * kk + 6], v[8 * kk + 7]);
        *(u32x4*)(o + 8 * kk) = p;
    }
}
DI void phase0(const Params& p, int gw, int NGW, int lane) {
    unsigned char* ws = p.ws;
    constexpr int I_WIN = (NPAD / 64) * 16, I_SQ = 16 * 16, I_MOD = 48 * 8, NITEMS = I_WIN + 3 * I_SQ + I_MOD;
    for (int it = gw; it < NITEMS; it += NGW) {
        int r = it;
        if (r < I_WIN) { p0_transpose_item(p.in[5], NIN, (bf16_t*)(ws + WS_WIN), r >> 4, r & 15, lane, true); continue; } r -= I_WIN;
        if (r < I_SQ) { p0_transpose_item(p.in[11], D, (bf16_t*)(ws + WS_WPA), r >> 4, r & 15, lane, false); continue; } r -= I_SQ;
        if (r < I_SQ) { p0_transpose_item(p.in[12], D, (bf16_t*)(ws + WS_WPB), r >> 4, r & 15, lane, false); continue; } r -= I_SQ;
        if (r < I_SQ) { p0_transpose_item(p.in[13], D, (bf16_t*)(ws + WS_WO), r >> 4, r & 15, lane, false); continue; } r -= I_SQ;
        const int cgp = r >> 3, ks = r & 7; const float* c = p.in[1]; const float* wa = p.in[2] + (size_t)(ks * 128) * 3072 + cgp * 64 + lane;
        float a0 = 0.f, a1 = 0.f;
#pragma unroll
        for (int k0 = 0; k0 < 128; k0 += 32) {
            float wv[32];
#pragma unroll
            for (int k = 0; k < 32; ++k) wv[k] = __builtin_nontemporal_load(wa + (size_t)(k0 + k) * 3072);
#pragma unroll
            for (int k = 0; k < 32; ++k) { a0 += siluf_(c[ks * 128 + k0 + k]) * wv[k]; a1 += siluf_(c[D + ks * 128 + k0 + k]) * wv[k]; }
        }
        float* mp = (float*)(ws + WS_MODP) + (size_t)ks * 2 * 3072 + cgp * 64 + lane;
        mp[0] = a0; mp[3072] = a1;
    }
}
DI void phase1(const Params& p, float* ldsf, int gw, int NGW, int lane, int tid) {
    const float* modp = (const float*)(p.ws + WS_MODP); const float* b_ada = p.in[3]; const float* nw = p.in[4];
    float* s_tab = ldsf;
    float* a_tab = ldsf + 2048;
    for (int idx = tid; idx < 2 * 2048; idx += NTHREADS) {
        const int b = idx >> 11, j = idx & 2047; float s = b_ada[j];
#pragma unroll
        for (int q = 0; q < 8; ++q) s += modp[(size_t)q * 2 * 3072 + b * 3072 + j];
        if (j < 1024) s_tab[b * 1024 + j] = s; else a_tab[b * 1024 + j - 1024] = nw[j - 1024] * (1.f + s);
    }
    if (blockIdx.x == 0) {
        float* modf = (float*)(p.ws + WS_MODF);
        for (int idx = tid; idx < 2 * 1024; idx += NTHREADS) {
            const int b = idx >> 10, j = idx & 1023; float s = b_ada[2048 + j];
#pragma unroll
            for (int q = 0; q < 8; ++q) s += modp[(size_t)q * 2 * 3072 + b * 3072 + 2048 + j];
            modf[b * 1024 + j] = s;
        }
    }
    __syncthreads();
    bf16_t* H = (bf16_t*)(p.ws + 0 * UNIT);
    for (int m0 = gw; m0 < M; m0 += 2 * NGW) {
        const int m1 = m0 + NGW < M ? m0 + NGW : m0;
        f32x4 v[2][4]; float s[2] = {0.f, 0.f};
#pragma unroll
        for (int u = 0; u < 2; ++u) { const f32x4* xr = (const f32x4*)(p.in[0] + (size_t)(u ? m1 : m0) * D) + lane;
#pragma unroll
            for (int j = 0; j < 4; ++j) v[u][j] = __builtin_nontemporal_load(xr + 64 * j); }
#pragma unroll
        for (int u = 0; u < 2; ++u) {
#pragma unroll
            for (int j = 0; j < 4; ++j) s[u] += (v[u][j].x * v[u][j].x + v[u][j].y * v[u][j].y) + (v[u][j].z * v[u][j].z + v[u][j].w * v[u][j].w);
            const int m = u ? m1 : m0; const int b = m / SEQ;
            const float rstd = rsqrtf(wave_sum(s[u]) * (1.f / D) + NORM_EPS);
            u32x2* o = (u32x2*)(H + (size_t)m * D) + lane;
#pragma unroll
            for (int j = 0; j < 4; ++j) {
                const f32x4 a = *(const f32x4*)(a_tab + b * 1024 + 4 * lane + 256 * j), sh = *(const f32x4*)(s_tab + b * 1024 + 4 * lane + 256 * j);
                const f32x4 hh = v[u][j] * rstd * a + sh;
                u32x2 w; w.x = cvt_pk_bf16(hh.x, hh.y); w.y = cvt_pk_bf16(hh.z, hh.w); o[64 * j] = w;
            }
        }
    }
    __syncthreads();
}
DI void ab_item(const Params& p, int item, int lane) {
    unsigned char* ws = p.ws; const int il = lane & 15, q = lane >> 4;
    const bf16_t* Hr = (const bf16_t*)(ws + 0 * UNIT) + (size_t)(item * 16 + il) * D + 8 * q;
    const bf16_t* W0 = (const bf16_t*)(ws + WS_WIN) + (size_t)(10240 + il) * D + 8 * q; const bf16_t* W1 = W0 + (size_t)16 * D;
    f32x4 a0 = {0.f, 0.f, 0.f, 0.f}, a1 = {0.f, 0.f, 0.f, 0.f};
#pragma unroll 8
    for (int ks = 0; ks < 32; ++ks) { const bf16x8 hf = *(const bf16x8*)(Hr + 32 * ks);
        a0 = __builtin_amdgcn_mfma_f32_16x16x32_bf16(hf, *(const bf16x8*)(W0 + 32 * ks), a0, 0, 0, 0); a1 = __builtin_amdgcn_mfma_f32_16x16x32_bf16(hf, *(const bf16x8*)(W1 + 32 * ks), a1, 0, 0, 0); }
    float* AB = (float*)(ws + WS_AB) + (size_t)(item * 16 + 4 * q) * 32 + il;
#pragma unroll
    for (int r = 0; r < 4; ++r) { AB[r * 32] = a0[r]; AB[r * 32 + 16] = a1[r]; }
}
DI void phase3_item(const Params& p, int item, int lane) {
    unsigned char* ws = p.ws;
    const bf16_t* Qr = (const bf16_t*)(ws + 1 * UNIT); const bf16_t* Kr = (const bf16_t*)(ws + 2 * UNIT); const bf16_t* Vr = (const bf16_t*)(ws + 3 * UNIT);
    bf16_t* Qn = (bf16_t*)(ws + 4 * UNIT); bf16_t* Kn = (bf16_t*)(ws + 5 * UNIT); bf16_t* Vc = (bf16_t*)p.out;
    const int tg = item & 255, h = (item >> 8) & 7, b = item >> 11; const int t_base = tg * 32; const size_t rb = (size_t)b * SEQ;
    const int col = h * 128 + 2 * lane; const int pcol = h * 128 + permpos(2 * lane);
    const float* cw = p.in[7];
    f32x2 wq[5], wk[5], wv[5];
#pragma unroll
    for (int j = 0; j < 5; ++j) { wq[j] = *(const f32x2*)(cw + j * 3072 + col); wk[j] = *(const f32x2*)(cw + j * 3072 + 1024 + col); wv[j] = *(const f32x2*)(cw + j * 3072 + 2048 + col); }
#pragma unroll
    for (int hf = 0; hf < 2; ++hf) {
        unsigned rq[20], rk[20], rv[20];
#pragma unroll
        for (int j = 0; j < 20; ++j) {
            const int t = t_base + 16 * hf - 2 + j; const bool ok = (t >= 0) && (t < SEQ); const int tc = t < 0 ? 0 : (t >= SEQ ? SEQ - 1 : t);
            const size_t off = (rb + tc) * D + col;
            const unsigned a0 = *(const unsigned*)(Qr + off), a1 = *(const unsigned*)(Kr + off), a2 = *(const unsigned*)(Vr + off);
            rq[j] = ok ? a0 : 0u; rk[j] = ok ? a1 : 0u; rv[j] = ok ? a2 : 0u;
        }
#pragma unroll
        for (int t16 = 0; t16 < 16; ++t16) {
            const int tt = 16 * hf + t16, t = t_base + tt;
            float q0 = 0.f, q1 = 0.f, k0 = 0.f, k1 = 0.f, v0 = 0.f, v1 = 0.f;
#pragma unroll
            for (int j = 0; j < 5; ++j) { q0 += wq[j].x * bf_lo(rq[t16 + j]); q1 += wq[j].y * bf_hi(rq[t16 + j]); k0 += wk[j].x * bf_lo(rk[t16 + j]); k1 += wk[j].y * bf_hi(rk[t16 + j]); v0 += wv[j].x * bf_lo(rv[t16 + j]); v1 += wv[j].y * bf_hi(rv[t16 + j]); }
            q0 = siluf_(q0); q1 = siluf_(q1); k0 = siluf_(k0); k1 = siluf_(k1); v0 = siluf_(v0); v1 = siluf_(v1);
            const float rq_ = rsqrtf(wave_sum(q0 * q0 + q1 * q1) + L2_EPS) * 0.08838834764831845f, rk_ = rsqrtf(wave_sum(k0 * k0 + k1 * k1) + L2_EPS);
            q0 *= rq_; q1 *= rq_; k0 *= rk_; k1 *= rk_;
            const size_t ro = (rb + t) * D;
            *(unsigned*)(Qn + ro + pcol) = cvt_pk_bf16(q0, q1); *(unsigned*)(Kn + ro + pcol) = cvt_pk_bf16(k0, k1); *(unsigned*)(Vc + ro + col) = cvt_pk_bf16(v0, v1);
        }
    }
    { const int i = lane & 31, dir = lane >> 5; const size_t row = rb + t_base + i; const float* AB = (const float*)(ws + WS_AB);
      const float a_raw = AB[row * 32 + dir * 8 + h], b_raw = AB[row * 32 + 16 + dir * 8 + h];
      const float g = -__expf(p.in[8][dir * 8 + h]) * softplusf_(a_raw + p.in[9][dir * 8 + h]);
      ((float*)(ws + WS_G))[row * 16 + dir * 8 + h] = g; ((float*)(ws + WS_BETA))[row * 16 + dir * 8 + h] = sigmoidf_(b_raw); }
}
DI void naive_scan(const Params& p, float* ldsw, int task, int lane) {
    unsigned char* ws = p.ws;
    const bf16_t* Qn = (const bf16_t*)(ws + 4 * UNIT); const bf16_t* Kn = (const bf16_t*)(ws + 5 * UNIT); const bf16_t* Vc = (const bf16_t*)p.out;
    const float* G = (const float*)(ws + WS_G); const float* BE = (const float*)(ws + WS_BETA);
    const int chain = task >> 1, b = chain >> 4, dir = (chain >> 3) & 1, h = chain & 7, e = (task & 1) * 64 + lane;
    bf16_t* O = (dir ? (bf16_t*)(p.out) + (size_t)M * D : (bf16_t*)(ws + 3 * UNIT));
    float* kb = ldsw; float* qb = ldsw + 128;
    float P[128];
#pragma unroll
    for (int d = 0; d < 128; ++d) P[d] = 0.f;
    for (int n = 0; n < SEQ; ++n) {
        const int t = dir ? SEQ - 1 - n : n; const size_t row = (size_t)b * SEQ + t;
        const unsigned ku = *(const unsigned*)(Kn + row * D + h * 128 + 2 * lane), qu = *(const unsigned*)(Qn + row * D + h * 128 + 2 * lane);
        const float v = bf1(Vc[row * D + h * 128 + e]); const float al = __expf(G[row * 16 + dir * 8 + h]), be = BE[row * 16 + dir * 8 + h];
        kb[2 * lane] = bf_lo(ku); kb[2 * lane + 1] = bf_hi(ku); qb[2 * lane] = bf_lo(qu); qb[2 * lane + 1] = bf_hi(qu);
        asm volatile("s_waitcnt lgkmcnt(0)" ::: "memory");
        float sk = 0.f;
#pragma unroll
        for (int d4 = 0; d4 < 32; ++d4) { if ((d4 & 3) == 0) __builtin_amdgcn_sched_barrier(0); const f32x4 k4 = *(const f32x4*)(kb + 4 * d4); sk += P[4 * d4] * k4.x + P[4 * d4 + 1] * k4.y + P[4 * d4 + 2] * k4.z + P[4 * d4 + 3] * k4.w; }
        const float vn = be * (v - al * sk); float o = 0.f;
#pragma unroll
        for (int d4 = 0; d4 < 32; ++d4) { if ((d4 & 3) == 0) __builtin_amdgcn_sched_barrier(0); const f32x4 k4 = *(const f32x4*)(kb + 4 * d4), q4 = *(const f32x4*)(qb + 4 * d4);
            P[4 * d4] = al * P[4 * d4] + k4.x * vn; P[4 * d4 + 1] = al * P[4 * d4 + 1] + k4.y * vn; P[4 * d4 + 2] = al * P[4 * d4 + 2] + k4.z * vn; P[4 * d4 + 3] = al * P[4 * d4 + 3] + k4.w * vn;
            o += P[4 * d4] * q4.x + P[4 * d4 + 1] * q4.y + P[4 * d4 + 2] * q4.z + P[4 * d4 + 3] * q4.w; }
        O[row * D + h * 128 + e] = (bf16_t)(cvt_pk_bf16(o, 0.f) & 0xffffu);
        asm volatile("s_waitcnt lgkmcnt(0)" ::: "memory");
    }
}
DI void ya_acc(float (&acc)[8], const u32x4& pv, const f32x4& wa, const f32x4& wb) {
    acc[0] += wa.x * bf_lo(pv.x); acc[1] += wa.y * bf_hi(pv.x); acc[2] += wa.z * bf_lo(pv.y); acc[3] += wa.w * bf_hi(pv.y);
    acc[4] += wb.x * bf_lo(pv.z); acc[5] += wb.y * bf_hi(pv.z); acc[6] += wb.z * bf_lo(pv.w); acc[7] += wb.w * bf_hi(pv.w);
}
DI void phase7(const Params& p, int gw, int NGW, int lane, int gtid, int NGT) {
    unsigned char* ws = p.ws;
    const bf16_t* Pb = (const bf16_t*)(ws + 1 * UNIT); bf16_t* R = (bf16_t*)(ws + 2 * UNIT); const float* cw = p.in[6];
    for (int it = gtid; it < (M / 4) * 128; it += NGT) {
        const int row0 = (it >> 7) * 4, c8 = (it & 127) * 8, t0 = row0 & (SEQ - 1);
        const u32x4 z = (u32x4){0u, 0u, 0u, 0u};
        u32x4 pv[6], rv[4];
        { const u32x4 t_ = *(const u32x4*)(Pb + (size_t)(t0 > 0 ? row0 - 1 : row0) * D + c8); pv[0] = t0 > 0 ? t_ : z; }
#pragma unroll
        for (int j = 0; j < 4; ++j) { pv[j + 1] = *(const u32x4*)(Pb + (size_t)(row0 + j) * D + c8); rv[j] = *(const u32x4*)(R + (size_t)(row0 + j) * D + c8); }
        { const u32x4 t_ = *(const u32x4*)(Pb + (size_t)(t0 + 4 < SEQ ? row0 + 4 : row0) * D + c8); pv[5] = t0 + 4 < SEQ ? t_ : z; }
        f32x4 wa[3], wb[3];
#pragma unroll
        for (int j = 0; j < 3; ++j) { wa[j] = *(const f32x4*)(cw + j * D + c8); wb[j] = *(const f32x4*)(cw + j * D + c8 + 4); }
#pragma unroll
        for (int j = 0; j < 4; ++j) {
            float acc[8] = {0.f, 0.f, 0.f, 0.f, 0.f, 0.f, 0.f, 0.f};
            ya_acc(acc, pv[j], wa[0], wb[0]); ya_acc(acc, pv[j + 1], wa[1], wb[1]); ya_acc(acc, pv[j + 2], wa[2], wb[2]);
            u32x4 o; const u32x4 r = rv[j];
            o.x = cvt_pk_bf16(bf_lo(r.x) * acc[0], bf_hi(r.x) * acc[1]); o.y = cvt_pk_bf16(bf_lo(r.y) * acc[2], bf_hi(r.y) * acc[3]);
            o.z = cvt_pk_bf16(bf_lo(r.z) * acc[4], bf_hi(r.z) * acc[5]); o.w = cvt_pk_bf16(bf_lo(r.w) * acc[6], bf_hi(r.w) * acc[7]);
            *(u32x4*)(R + (size_t)(row0 + j) * D + c8) = o;
        }
    }
    const bf16_t* Of = (const bf16_t*)(ws + 3 * UNIT); const bf16_t* Ob = (const bf16_t*)p.out + (size_t)M * D; bf16_t* SZ = (bf16_t*)(ws + 6 * UNIT);
    const f32x4 g0 = *(const f32x4*)(p.in[10] + (lane & 15) * 8), g1 = *(const f32x4*)(p.in[10] + (lane & 15) * 8 + 4);
    for (int rp = gw; rp < M / 2; rp += NGW) {
        u32x4 a[4], bb[4], zz[4];
#pragma unroll
        for (int u = 0; u < 4; ++u) { const size_t off = (size_t)(rp * 2 + (u >> 1)) * D + (u & 1) * 512 + lane * 8;
            a[u] = __builtin_nontemporal_load((const u32x4*)(Of + off)); bb[u] = __builtin_nontemporal_load((const u32x4*)(Ob + off)); zz[u] = __builtin_nontemporal_load((const u32x4*)(SZ + off)); }
#pragma unroll
        for (int u = 0; u < 4; ++u) { const size_t off = (size_t)(rp * 2 + (u >> 1)) * D + (u & 1) * 512 + lane * 8;
            float o[8];
            o[0] = bf_lo(a[u].x) + bf_lo(bb[u].x); o[1] = bf_hi(a[u].x) + bf_hi(bb[u].x); o[2] = bf_lo(a[u].y) + bf_lo(bb[u].y); o[3] = bf_hi(a[u].y) + bf_hi(bb[u].y);
            o[4] = bf_lo(a[u].z) + bf_lo(bb[u].z); o[5] = bf_hi(a[u].z) + bf_hi(bb[u].z); o[6] = bf_lo(a[u].w) + bf_lo(bb[u].w); o[7] = bf_hi(a[u].w) + bf_hi(bb[u].w);
            float ss = 0.f;
#pragma unroll
            for (int j = 0; j < 8; ++j) ss += o[j] * o[j];
            ss = row16_sum(ss);
            const float rs = rsqrtf(ss * (1.f / 128.f) + NORM_EPS);
            u32x4 w;
            w.x = cvt_pk_bf16(o[0] * rs * g0.x * bf_lo(zz[u].x), o[1] * rs * g0.y * bf_hi(zz[u].x)); w.y = cvt_pk_bf16(o[2] * rs * g0.z * bf_lo(zz[u].y), o[3] * rs * g0.w * bf_hi(zz[u].y));
            w.z = cvt_pk_bf16(o[4] * rs * g1.x * bf_lo(zz[u].z), o[5] * rs * g1.y * bf_hi(zz[u].z)); w.w = cvt_pk_bf16(o[6] * rs * g1.z * bf_lo(zz[u].w), o[7] * rs * g1.w * bf_hi(zz[u].w));
            *(u32x4*)(SZ + off) = w;
        }
    }
}
DI void phase10(const Params& p, int gw, int NGW, int lane) {
    const float* XN = (const float*)(p.ws + 0 * UNIT); const float* fw = p.in[14];
    f32x4 w[4];
#pragma unroll
    for (int j = 0; j < 4; ++j) w[j] = *((const f32x4*)fw + lane + 64 * j);
    for (int m = gw; m < M; m += NGW) {
        const f32x4* xr = (const f32x4*)(XN + (size_t)m * D) + lane; f32x4 v[4]; float s = 0.f;
#pragma unroll
        for (int j = 0; j < 4; ++j) { v[j] = xr[64 * j]; s += (v[j].x * v[j].x + v[j].y * v[j].y) + (v[j].z * v[j].z + v[j].w * v[j].w); }
        const float rstd = rsqrtf(wave_sum(s) * (1.f / D) + NORM_EPS);
        f32x4* o = (f32x4*)(p.out + (size_t)m * D) + lane;
#pragma unroll
        for (int j = 0; j < 4; ++j) o[64 * j] = v[j] * rstd * w[j];
    }
}
#define MFMA16(a, b, c) __builtin_amdgcn_mfma_f32_16x16x32_bf16((a), (b), (c), 0, 0, 0)
DI void chunk_prep_item(const Params& p, float* Lm, int item, int lane) {
    unsigned char* ws = p.ws;
    const bf16_t* Qn = (const bf16_t*)(ws + 4 * UNIT); const bf16_t* Kn = (const bf16_t*)(ws + 5 * UNIT);
    bf16_t* TF = (bf16_t*)(ws + 1 * UNIT) + (size_t)item * 4096; bf16_t* AF = (bf16_t*)(ws + 2 * UNIT) + (size_t)item * 4096;
    float* csc = (float*)(ws + WS_CSC) + (size_t)item * 192;
    const int c = item & 127, h = (item >> 7) & 7, dir = (item >> 10) & 1, b = item >> 11;
    const size_t rb = (size_t)b * SEQ + c * 64; const int il = lane & 15, q = lane >> 4;
    const int tl = dir ? 63 - lane : lane;
    const float g = ((const float*)(ws + WS_G))[(rb + tl) * 16 + dir * 8 + h], be = ((const float*)(ws + WS_BETA))[(rb + tl) * 16 + dir * 8 + h];
    float gc = g;
#pragma unroll
    for (int o = 1; o < 64; o <<= 1) { const float v = __shfl_up(gc, o); if (lane >= o) gc += v; }
    const float gl = __shfl(gc, 63);
    csc[tl] = __expf(gc); csc[64 + tl] = be; csc[128 + tl] = __expf(gl - gc);
    float gcr[4][4], ber[4][4], gcc[4];
#pragma unroll
    for (int t = 0; t < 4; ++t) { gcc[t] = __shfl(gc, 16 * t + il);
#pragma unroll
        for (int r = 0; r < 4; ++r) { gcr[t][r] = __shfl(gc, 16 * t + 4 * q + r); ber[t][r] = __shfl(be, 16 * t + 4 * q + r); } }
    bf16x8 Kf[4][4];
#pragma unroll
    for (int rt = 0; rt < 4; ++rt) { const int ip = 16 * rt + il; const size_t ro = (rb + (dir ? 63 - ip : ip)) * D + h * 128 + 8 * q;
#pragma unroll
        for (int ks = 0; ks < 4; ++ks) Kf[rt][ks] = *(const bf16x8*)(Kn + ro + 32 * ks); }
#pragma unroll
    for (int it = 0; it < 4; ++it)
#pragma unroll
        for (int jt = 0; jt <= it; ++jt) {
            f32x4 acc = {0.f, 0.f, 0.f, 0.f};
#pragma unroll
            for (int ks = 0; ks < 4; ++ks) acc = MFMA16(Kf[it][ks], Kf[jt][ks], acc);
#pragma unroll
            for (int r = 0; r < 4; ++r) { const int ip = 16 * it + 4 * q + r, jp = 16 * jt + il;
                Lm[ip * 64 + jp] = ip > jp ? ber[it][r] * acc[r] * __expf(gcr[it][r] - gcc[jt]) : 0.f; }
        }
    __builtin_amdgcn_sched_barrier(0);
    bf16x8 Qnext[4];
    { const int ip = il; const size_t ro = (rb + (dir ? 63 - ip : ip)) * D + h * 128 + 8 * q;
#pragma unroll
      for (int ks = 0; ks < 4; ++ks) Qnext[ks] = *(const bf16x8*)(Qn + ro + 32 * ks); }
#pragma unroll
    for (int mt = 0; mt < 4; ++mt) {
        bf16x8 Qf[4];
#pragma unroll
        for (int ks = 0; ks < 4; ++ks) Qf[ks] = Qnext[ks];
        if (mt < 3) { const int ip = 16 * (mt + 1) + il; const size_t ro = (rb + (dir ? 63 - ip : ip)) * D + h * 128 + 8 * q;
#pragma unroll
          for (int ks = 0; ks < 4; ++ks) Qnext[ks] = *(const bf16x8*)(Qn + ro + 32 * ks); }
#pragma unroll
        for (int ks2 = 0; ks2 < 2; ++ks2) {
            float vals[8];
#pragma unroll
            for (int a = 0; a < 2; ++a) { const int jt = 2 * ks2 + a; f32x4 acc = {0.f, 0.f, 0.f, 0.f};
#pragma unroll
                for (int ks = 0; ks < 4; ++ks) acc = MFMA16(Kf[jt][ks], Qf[ks], acc);
#pragma unroll
                for (int r = 0; r < 4; ++r) { const int jp = 16 * jt + 4 * q + r, ip = 16 * mt + il; vals[4 * a + r] = ip >= jp ? acc[r] * __expf(gcc[mt] - gcr[jt][r]) : 0.f; } }
            u32x4 w;
            if (dir) { w.x = cvt_pk_bf16(vals[7], vals[6]); w.y = cvt_pk_bf16(vals[5], vals[4]); w.z = cvt_pk_bf16(vals[3], vals[2]); w.w = cvt_pk_bf16(vals[1], vals[0]); }
            else { w.x = cvt_pk_bf16(vals[0], vals[1]); w.y = cvt_pk_bf16(vals[2], vals[3]); w.z = cvt_pk_bf16(vals[4], vals[5]); w.w = cvt_pk_bf16(vals[6], vals[7]); }
            const int fi = dir ? ((3 - mt) * 2 + (1 - ks2)) : (mt * 2 + ks2), ln = dir ? ((3 - q) * 16 + (15 - il)) : lane;
            *(u32x4*)(AF + (size_t)(fi * 64 + ln) * 8) = w;
        }
        __builtin_amdgcn_sched_barrier(0);
    }
    asm volatile("s_waitcnt lgkmcnt(0)" ::: "memory");
    __builtin_amdgcn_sched_barrier(0);
    float T[64];
#pragma unroll
    for (int i = 0; i < 64; ++i) {
        float s0 = (lane == i) ? 1.f : 0.f, s1 = 0.f;
#pragma unroll
        for (int m4 = 0; m4 < (i + 3) / 4; ++m4) {
            const f32x4 l4 = *(const f32x4*)(Lm + i * 64 + 4 * m4);
            if (4 * m4 + 0 < i) s0 -= l4.x * T[4 * m4 + 0];
            if (4 * m4 + 1 < i) s1 -= l4.y * T[4 * m4 + 1];
            if (4 * m4 + 2 < i) s0 -= l4.z * T[4 * m4 + 2];
            if (4 * m4 + 3 < i) s1 -= l4.w * T[4 * m4 + 3];
        }
        T[i] = s0 + s1;
        if ((i & 3) == 3) __builtin_amdgcn_sched_barrier(0);
    }
    asm volatile("s_waitcnt lgkmcnt(0)" ::: "memory");
    bf16_t* TL = (bf16_t*)Lm;
#pragma unroll
    for (int i = 0; i < 64; ++i) TL[i * 72 + lane] = (bf16_t)(cvt_pk_bf16(T[i], 0.f) & 0xffffu);
    asm volatile("s_waitcnt lgkmcnt(0)" ::: "memory");
#pragma unroll
    for (int mt = 0; mt < 4; ++mt)
#pragma unroll
        for (int ks2 = 0; ks2 < 2; ++ks2) {
            u32x4 w;
            if (dir) {
                const int row = 63 - 16 * mt - il;
                const u32x2 lo = *(const u32x2*)(TL + row * 72 + (60 - 32 * ks2 - 4 * q)), hi = *(const u32x2*)(TL + row * 72 + (44 - 32 * ks2 - 4 * q));
                w.x = (lo.y >> 16) | (lo.y << 16); w.y = (lo.x >> 16) | (lo.x << 16); w.z = (hi.y >> 16) | (hi.y << 16); w.w = (hi.x >> 16) | (hi.x << 16);
            } else {
                const int row = 16 * mt + il;
                const u32x2 lo = *(const u32x2*)(TL + row * 72 + (32 * ks2 + 4 * q)), hi = *(const u32x2*)(TL + row * 72 + (32 * ks2 + 16 + 4 * q));
                w.x = lo.x; w.y = lo.y; w.z = hi.x; w.w = hi.y;
            }
            *(u32x4*)(TF + (size_t)((mt * 2 + ks2) * 64 + lane) * 8) = w;
        }
    asm volatile("s_waitcnt lgkmcnt(0)" ::: "memory");
}
DI bf16x8 pack8(const f32x4& a, const f32x4& b) {
    u32x4 w; w.x = cvt_pk_bf16(a[0], a[1]); w.y = cvt_pk_bf16(a[2], a[3]); w.z = cvt_pk_bf16(b[0], b[1]); w.w = cvt_pk_bf16(b[2], b[3]);
    return __builtin_bit_cast(bf16x8, w);
}
DI void mfma_scan(const Params& p, int chain, int slice, int lane) {
    unsigned char* ws = p.ws;
    const bf16_t* Qn = (const bf16_t*)(ws + 4 * UNIT); const bf16_t* Kn = (const bf16_t*)(ws + 5 * UNIT); const bf16_t* KT = (const bf16_t*)(ws + 6 * UNIT); const bf16_t* Vc = (const bf16_t*)p.out;
    const bf16_t* TFb = (const bf16_t*)(ws + 1 * UNIT); const bf16_t* AFb = (const bf16_t*)(ws + 2 * UNIT); const float* cscb = (const float*)(ws + WS_CSC);
    const int b = chain >> 4, dir = (chain >> 3) & 1, h = chain & 7, il = lane & 15, q = lane >> 4;
    bf16_t* O = (dir ? (bf16_t*)(p.out) + (size_t)M * D : (bf16_t*)(ws + 3 * UNIT));
    f32x4 S[8];
#pragma unroll
    for (int dt = 0; dt < 8; ++dt) S[dt] = (f32x4){0.f, 0.f, 0.f, 0.f};
    for (int n = 0; n < 128; ++n) {
        const int c = dir ? 127 - n : n; const int item = chain * 128 + c; const size_t rowbase = (size_t)b * SEQ + c * 64;
        const bf16_t* TF = TFb + (size_t)item * 4096 + lane * 8; const bf16_t* AF = AFb + (size_t)item * 4096 + lane * 8; const float* csc = cscb + (size_t)item * 192;
        const float gl = csc[dir ? 0 : 63];
        f32x4 EG[4], BE[4], EK[4], V[4];
#pragma unroll
        for (int mt = 0; mt < 4; ++mt) { EG[mt] = *(const f32x4*)(csc + 16 * mt + 4 * q); BE[mt] = *(const f32x4*)(csc + 64 + 16 * mt + 4 * q); EK[mt] = *(const f32x4*)(csc + 128 + 16 * mt + 4 * q);
#pragma unroll
            for (int r = 0; r < 4; ++r) V[mt][r] = bf1(Vc[(rowbase + 16 * mt + 4 * q + r) * D + h * 128 + 16 * slice + il]); }
        bf16x8 Sb[4];
#pragma unroll
        for (int ks = 0; ks < 4; ++ks) Sb[ks] = pack8(S[2 * ks], S[2 * ks + 1]);
        f32x4 KS[4], QS[4];
#pragma unroll
        for (int mt = 0; mt < 4; ++mt) { const size_t ro = (rowbase + 16 * mt + il) * D + h * 128 + 8 * q;
            KS[mt] = (f32x4){0.f, 0.f, 0.f, 0.f}; QS[mt] = (f32x4){0.f, 0.f, 0.f, 0.f};
#pragma unroll
            for (int ks = 0; ks < 4; ++ks) { KS[mt] = MFMA16(*(const bf16x8*)(Kn + ro + 32 * ks), Sb[ks], KS[mt]); QS[mt] = MFMA16(*(const bf16x8*)(Qn + ro + 32 * ks), Sb[ks], QS[mt]); } }
        f32x4 X[4];
#pragma unroll
        for (int mt = 0; mt < 4; ++mt) X[mt] = BE[mt] * (V[mt] - EG[mt] * KS[mt]);
        bf16x8 Xb[2] = {pack8(X[0], X[1]), pack8(X[2], X[3])};
        f32x4 VN[4];
#pragma unroll
        for (int mt = 0; mt < 4; ++mt) { VN[mt] = (f32x4){0.f, 0.f, 0.f, 0.f};
#pragma unroll
            for (int ks2 = 0; ks2 < 2; ++ks2) VN[mt] = MFMA16(*(const bf16x8*)(TF + (size_t)((mt * 2 + ks2) * 64) * 8), Xb[ks2], VN[mt]); }
        bf16x8 VNb[2] = {pack8(VN[0], VN[1]), pack8(VN[2], VN[3])};
        bf16x8 VNs[2] = {pack8(VN[0] * EK[0], VN[1] * EK[1]), pack8(VN[2] * EK[2], VN[3] * EK[3])};
#pragma unroll
        for (int mt = 0; mt < 4; ++mt) { f32x4 o = EG[mt] * QS[mt];
#pragma unroll
            for (int ks2 = 0; ks2 < 2; ++ks2) o = MFMA16(*(const bf16x8*)(AF + (size_t)((mt * 2 + ks2) * 64) * 8), VNb[ks2], o);
#pragma unroll
            for (int r = 0; r < 4; ++r) O[(rowbase + 16 * mt + 4 * q + r) * D + h * 128 + 16 * slice + il] = (bf16_t)(cvt_pk_bf16(o[r], 0.f) & 0xffffu); }
#pragma unroll
        for (int dt = 0; dt < 8; ++dt) { const bf16_t* kt = KT + ((size_t)((b * 8 + h) * 128 + 16 * dt + il)) * SEQ + c * 64 + 8 * q; f32x4 s = S[dt] * gl;
#pragma unroll
            for (int ks2 = 0; ks2 < 2; ++ks2) s = MFMA16(*(const bf16x8*)(kt + 32 * ks2), VNs[ks2], s);
            S[dt] = s; }
    }
}
constexpr int SC_K = 0, SC_Q = 16384, SC_T = 32768, SC_A = 40960, SC_V = 49152, SC_C = 51200, SC_BUF = 52224, SC_NPIECE = 3248, SC_NLD = 384, SC_PPL = 9;
constexpr int SC_SB = 2 * SC_BUF, SC_VB = SC_SB + 2 * 4096, SC_END = SC_VB + 2 * 2048;
static_assert(SC_END <= LDS_BYTES - 256, "scan LDS");
typedef short s16x4_t __attribute__((ext_vector_type(4)));
#define SC_BAR() do { asm volatile("s_waitcnt lgkmcnt(0)" ::: "memory"); __builtin_amdgcn_s_barrier(); asm volatile("" ::: "memory"); } while (0)
DI void scan_task(const Params& p, PG8_LAS unsigned char* lds, int chain, int slice, int tid, int wave, int lane) {
    unsigned char* ws = p.ws;
    const int b = chain >> 4, dir = (chain >> 3) & 1, h = chain & 7, il = lane & 15, q = lane >> 4;
    const int c0 = dir ? 127 : 0; const long sgn = dir ? -1 : 1;
    if (wave >= 2) {
        const int lt = tid - 128; const int wbase = 64 * (wave - 2);
        const unsigned char* gp[SC_PPL]; int gstride[SC_PPL];
        const size_t rowbase0 = (size_t)b * SEQ + c0 * 64; const size_t item0 = (size_t)chain * 128 + c0;
#pragma unroll
        for (int k = 0; k < SC_PPL; ++k) {
            int pid = lt + SC_NLD * k; if (pid >= SC_NPIECE) pid -= 64;
            const unsigned char* g = ws; int st = 0;
            if (pid < 2048) { const int pp = pid & 1023, row = pp >> 4, ch = (pp & 15) ^ (row & 15);
                g = ws + (pid < 1024 ? 5 : 4) * UNIT + ((rowbase0 + row) * D + h * 128) * 2 + ch * 16; st = 64 * D * 2; }
            else if (pid < 3072) { const int pp = pid & 511; const bool isT = pid < 2560;
                g = ws + (isT ? 1 : 2) * UNIT + item0 * 8192 + pp * 16; st = 8192; }
            else if (pid < 3200) { const int pp = pid - 3072, row = pp >> 1, hf = pp & 1;
                g = (const unsigned char*)p.out + ((rowbase0 + row) * D + h * 128 + slice * 16) * 2 + hf * 16; st = 64 * D * 2; }
            else { const int pp = pid - 3200; g = ws + WS_CSC + item0 * 768 + pp * 16; st = 768; }
            gp[k] = g; gstride[k] = st;
        }
#define SC_DMA(bo) do { _Pragma("unroll") for (int k = 0; k < SC_PPL; ++k) { if (wbase + SC_NLD * k < SC_NPIECE) \
            __builtin_amdgcn_global_load_lds((const unsigned*)gp[k], (PG8_LAS unsigned*)(lds + (bo) + (wbase + SC_NLD * k) * 16), 16, 0, 0); gp[k] += sgn * gstride[k]; } } while (0)
        SC_DMA(0u);
        asm volatile("s_waitcnt vmcnt(0)" ::: "memory");
        SC_BAR();
        for (int n = 0; n < 128; ++n) {
            if (n + 1 < 128) SC_DMA((unsigned)(((n + 1) & 1) * SC_BUF));
            asm volatile("s_waitcnt vmcnt(0)" ::: "memory");
            SC_BAR();
        }
#undef SC_DMA
    } else if (wave == 0) {
        f32x4 S[8];
#pragma unroll
        for (int dt = 0; dt < 8; ++dt) S[dt] = (f32x4){0.f, 0.f, 0.f, 0.f};
        bf16x8 Sb[4];
#pragma unroll
        for (int ks = 0; ks < 4; ++ks) { Sb[ks] = pack8(S[2 * ks], S[2 * ks + 1]); *(PG8_LAS bf16x8*)(lds + SC_SB + (ks * 64 + lane) * 16) = Sb[ks]; }
        SC_BAR();
        for (int n = 0; n < 128; ++n) {
            PG8_LAS unsigned char* L = lds + (n & 1) * SC_BUF;
            bf16x8 Kf[4][4];
#pragma unroll
            for (int mt = 0; mt < 4; ++mt)
#pragma unroll
                for (int ks = 0; ks < 4; ++ks) Kf[mt][ks] = *(PG8_LAS bf16x8*)(L + SC_K + (16 * mt + il) * 256 + (((4 * ks + q) ^ il) << 4));
            f32x4 EG[4], BE[4], V[4]; bf16x8 Tf[4][2];
#pragma unroll
            for (int mt = 0; mt < 4; ++mt) { EG[mt] = *(PG8_LAS f32x4*)(L + SC_C + (16 * mt + 4 * q) * 4); BE[mt] = *(PG8_LAS f32x4*)(L + SC_C + 256 + (16 * mt + 4 * q) * 4);
#pragma unroll
                for (int r = 0; r < 4; ++r) V[mt][r] = bf1(*(PG8_LAS bf16_t*)(L + SC_V + (16 * mt + 4 * q + r) * 32 + il * 2));
#pragma unroll
                for (int ks2 = 0; ks2 < 2; ++ks2) Tf[mt][ks2] = *(PG8_LAS bf16x8*)(L + SC_T + ((mt * 2 + ks2) * 64 + lane) * 16); }
            f32x4 KS[4];
#pragma unroll
            for (int mt = 0; mt < 4; ++mt) KS[mt] = (f32x4){0.f, 0.f, 0.f, 0.f};
#pragma unroll
            for (int ks = 0; ks < 4; ++ks)
#pragma unroll
                for (int mt = 0; mt < 4; ++mt) KS[mt] = MFMA16(Kf[mt][ks], Sb[ks], KS[mt]);
            __builtin_amdgcn_sched_barrier(0);
            bf16x8 KTf[8][2]; f32x4 EK[4];
            { const int rr = il >> 2, pc = il & 3;
              PG8_LAS unsigned char* kb = L + SC_K + (4 * q + rr) * 256;
#pragma unroll
              for (int dt = 0; dt < 8; ++dt) {
                const int cho = (((4 * (dt >> 1) + pc) ^ (4 * q + rr)) << 4) + 8 * (dt & 1);
#pragma unroll
                for (int ks2 = 0; ks2 < 2; ++ks2) {
                    const s16x4_t lo_ = __builtin_amdgcn_ds_read_tr16_b64_v4i16((PG8_LAS s16x4_t*)(kb + (32 * ks2) * 256 + cho));
                    const s16x4_t hi_ = __builtin_amdgcn_ds_read_tr16_b64_v4i16((PG8_LAS s16x4_t*)(kb + (32 * ks2 + 16) * 256 + cho));
                    KTf[dt][ks2] = __builtin_shufflevector(lo_, hi_, 0, 1, 2, 3, 4, 5, 6, 7);
                } } }
#pragma unroll
            for (int mt = 0; mt < 4; ++mt) EK[mt] = *(PG8_LAS f32x4*)(L + SC_C + 512 + (16 * mt + 4 * q) * 4);
            const float gl = *(PG8_LAS float*)(L + SC_C + (dir ? 0 : 63) * 4);
            f32x4 X[4];
#pragma unroll
            for (int mt = 0; mt < 4; ++mt) X[mt] = BE[mt] * (V[mt] - EG[mt] * KS[mt]);
            bf16x8 Xb[2] = {pack8(X[0], X[1]), pack8(X[2], X[3])};
            f32x4 VN[4];
#pragma unroll
            for (int mt = 0; mt < 4; ++mt) VN[mt] = (f32x4){0.f, 0.f, 0.f, 0.f};
#pragma unroll
            for (int ks2 = 0; ks2 < 2; ++ks2)
#pragma unroll
                for (int mt = 0; mt < 4; ++mt) VN[mt] = MFMA16(Tf[mt][ks2], Xb[ks2], VN[mt]);
            *(PG8_LAS bf16x8*)(lds + SC_VB + (n & 1) * 2048 + lane * 16) = pack8(VN[0], VN[1]); *(PG8_LAS bf16x8*)(lds + SC_VB + (n & 1) * 2048 + (64 + lane) * 16) = pack8(VN[2], VN[3]);
            bf16x8 VNs[2] = {pack8(VN[0] * EK[0], VN[1] * EK[1]), pack8(VN[2] * EK[2], VN[3] * EK[3])};
#pragma unroll
            for (int dt = 0; dt < 8; ++dt) S[dt] = S[dt] * gl;
#pragma unroll
            for (int ks2 = 0; ks2 < 2; ++ks2)
#pragma unroll
                for (int dt = 0; dt < 8; ++dt) S[dt] = MFMA16(KTf[dt][ks2], VNs[ks2], S[dt]);
#pragma unroll
            for (int ks = 0; ks < 4; ++ks) { Sb[ks] = pack8(S[2 * ks], S[2 * ks + 1]); *(PG8_LAS bf16x8*)(lds + SC_SB + ((n + 1) & 1) * 4096 + (ks * 64 + lane) * 16) = Sb[ks]; }
            SC_BAR();
        }
    } else {
        bf16_t* O = (dir ? (bf16_t*)(p.out) + (size_t)M * D : (bf16_t*)(ws + 3 * UNIT));
        f32x4 Oa[4]; bf16x8 Af[4][2];
#pragma unroll
        for (int mt = 0; mt < 4; ++mt) { Oa[mt] = (f32x4){0.f, 0.f, 0.f, 0.f}; Af[mt][0] = (bf16x8){0, 0, 0, 0, 0, 0, 0, 0}; Af[mt][1] = Af[mt][0]; }
        SC_BAR();
        for (int n = 0; n <= 128; ++n) {
            if (n > 0) {
                const int c = dir ? 128 - n : n - 1; const size_t rowbase = (size_t)b * SEQ + c * 64;
                PG8_LAS unsigned char* vb = lds + SC_VB + ((n - 1) & 1) * 2048;
                bf16x8 VNb[2] = {*(PG8_LAS bf16x8*)(vb + lane * 16), *(PG8_LAS bf16x8*)(vb + (64 + lane) * 16)};
#pragma unroll
                for (int ks2 = 0; ks2 < 2; ++ks2)
#pragma unroll
                    for (int mt = 0; mt < 4; ++mt) Oa[mt] = MFMA16(Af[mt][ks2], VNb[ks2], Oa[mt]);
#pragma unroll
                for (int mt = 0; mt < 4; ++mt)
#pragma unroll
                    for (int r = 0; r < 4; ++r) __builtin_nontemporal_store((bf16_t)(cvt_pk_bf16(Oa[mt][r], 0.f) & 0xffffu), O + (rowbase + 16 * mt + 4 * q + r) * D + h * 128 + 16 * slice + il);
            }
            if (n < 128) {
                PG8_LAS unsigned char* L = lds + (n & 1) * SC_BUF;
                bf16x8 Qf[4][4], Sb[4]; f32x4 EG[4];
#pragma unroll
                for (int ks = 0; ks < 4; ++ks) Sb[ks] = *(PG8_LAS bf16x8*)(lds + SC_SB + (n & 1) * 4096 + (ks * 64 + lane) * 16);
#pragma unroll
                for (int mt = 0; mt < 4; ++mt) {
#pragma unroll
                    for (int ks = 0; ks < 4; ++ks) Qf[mt][ks] = *(PG8_LAS bf16x8*)(L + SC_Q + (16 * mt + il) * 256 + (((4 * ks + q) ^ il) << 4));
                    EG[mt] = *(PG8_LAS f32x4*)(L + SC_C + (16 * mt + 4 * q) * 4);
#pragma unroll
                    for (int ks2 = 0; ks2 < 2; ++ks2) Af[mt][ks2] = *(PG8_LAS bf16x8*)(L + SC_A + ((mt * 2 + ks2) * 64 + lane) * 16); }
                f32x4 QS[4];
#pragma unroll
                for (int mt = 0; mt < 4; ++mt) QS[mt] = (f32x4){0.f, 0.f, 0.f, 0.f};
#pragma unroll
                for (int ks = 0; ks < 4; ++ks)
#pragma unroll
                    for (int mt = 0; mt < 4; ++mt) QS[mt] = MFMA16(Qf[mt][ks], Sb[ks], QS[mt]);
#pragma unroll
                for (int mt = 0; mt < 4; ++mt) Oa[mt] = EG[mt] * QS[mt];
                SC_BAR();
            }
        }
    }
}


typedef const __attribute__((address_space(4))) Params* kparams_t;
#if defined(__HIP_DEVICE_COMPILE__)
DI Params load_params() { kparams_t pp = (kparams_t)__builtin_amdgcn_kernarg_segment_ptr(); asm volatile("" : "+s"(pp)); return *pp; }
#else
DI Params load_params() { return Params{}; }
#endif
#define PP() load_params()
#define XB_TMO      128
#define XB_XCNT(j)  (256  + 64 * (j))
#define XB_XSUB(j)  (1280 + 64 * (j))
#define XB_XGEN(j)  (2304 + 64 * (j))
#define XB_TOP      3328
#define XB_TOPGEN   3392
#define XCD_BAR_WORDS 3456
#define XB_SPIN_CAP (1u << 18)
#define LAS __attribute__((address_space(3)))

__device__ __forceinline__ unsigned xb_ld(unsigned* p)              { return __hip_atomic_load(p, __ATOMIC_RELAXED, __HIP_MEMORY_SCOPE_AGENT); }
__device__ __forceinline__ unsigned xb_add(unsigned* p, unsigned v) { return __hip_atomic_fetch_add(p, v, __ATOMIC_RELAXED, __HIP_MEMORY_SCOPE_AGENT); }
__device__ __forceinline__ unsigned xb_xcc_id() { return (unsigned)__builtin_amdgcn_s_getreg((3 << 11) | 20) & 0xFu; }
#define XB_SPIN(cond, bar) do { unsigned _sp = 0; while (cond) { __builtin_amdgcn_s_sleep(1); \
    if ((++_sp & 255u) == 0u) { if (xb_ld(&(bar)[XB_TMO])) break; if (_sp > XB_SPIN_CAP) { atomicAdd(&(bar)[XB_TMO], 1u); break; } } } } while (0)

struct XcdBarrier {
    unsigned* bar; unsigned x;
    volatile LAS unsigned* st;
};

__device__ __forceinline__ XcdBarrier xcd_barrier_post(unsigned* bar, volatile LAS unsigned* st) {
    XcdBarrier b; b.bar = bar; b.x = xb_xcc_id(); b.st = st;
    if (threadIdx.x == 0) (void)xb_add(&bar[XB_XCNT(b.x)], 1u);
    return b;
}
__device__ __forceinline__ void xcd_barrier_complete(unsigned* bar, unsigned x, unsigned& nloc, unsigned& nx) {
    const unsigned G = gridDim.x * gridDim.y * gridDim.z;
    unsigned sum, cnt, mine, sp = 0u;
    for (;;) {
        sum = 0u; cnt = 0u; mine = 0u;
#pragma unroll
        for (unsigned j = 0; j < 16; ++j) { const unsigned c = xb_ld(&bar[XB_XCNT(j)]); sum += c; cnt += (c > 0u) ? 1u : 0u; mine = (j == x) ? c : mine; }
        if (sum == G) break;
        __builtin_amdgcn_s_sleep(1);
        if ((++sp & 255u) == 0u) { if (xb_ld(&bar[XB_TMO])) break; if (sp > XB_SPIN_CAP) { atomicAdd(&bar[XB_TMO], 1u); break; } }
    }
    nloc = mine > 0u ? mine : 1u; nx = cnt > 0u ? cnt : 1u;
}

__device__ __forceinline__ void xcd_barrier(const XcdBarrier& b) {
    asm volatile("s_waitcnt vmcnt(0)" ::: "memory");
    __syncthreads();
    if (threadIdx.x == 0) {
        unsigned* bar = b.bar;
        __builtin_amdgcn_s_waitcnt(0);
        unsigned nloc = b.st[0], nx = b.st[1];
        if (nloc == 0u) { xcd_barrier_complete(bar, b.x, nloc, nx); b.st[0] = nloc; b.st[1] = nx; }
        const unsigned old = xb_add(&bar[XB_XSUB(b.x)], 1u);
        const unsigned gen = old / nloc;
        if (old + 1u == (gen + 1u) * nloc) {
            __builtin_amdgcn_fence(__ATOMIC_RELEASE, "agent");
            asm volatile("s_waitcnt vmcnt(0)" ::: "memory");
            const unsigned og = xb_add(&bar[XB_TOP], 1u);
            const unsigned tg = og / nx;
            if (og + 1u == (tg + 1u) * nx) xb_add(&bar[XB_TOPGEN], 1u);
            else XB_SPIN(xb_ld(&bar[XB_TOPGEN]) == tg, bar);
            __builtin_amdgcn_fence(__ATOMIC_ACQUIRE, "agent");
            xb_add(&bar[XB_XGEN(b.x)], 1u);
            asm volatile("s_waitcnt vmcnt(0)" ::: "memory");
        } else {
            XB_SPIN(xb_ld(&bar[XB_XGEN(b.x)]) == gen, bar);
            __builtin_amdgcn_fence(__ATOMIC_ACQUIRE, "agent");
            asm volatile("s_waitcnt vmcnt(0)" ::: "memory");
        }
    }
    __syncthreads();
}


constexpr size_t WS_BAR = 255 * MiB + 320 * 1024;
DI int fresh_tid() { int t = threadIdx.x; asm volatile("" : "+v"(t)); return t; }
#define IDS const int tid = fresh_tid(), lane = tid & 63, wave = __builtin_amdgcn_readfirstlane(tid >> 6); const int G = gridDim.x, bx = blockIdx.x; \
    const int gw = bx * NWAVES + wave, NGW = G * NWAVES, gtid = bx * NTHREADS + tid, NGT = G * NTHREADS; (void)lane; (void)gw; (void)NGW; (void)gtid; (void)NGT; (void)wave;
__global__ void __launch_bounds__(NTHREADS, 2) fwd_kernel(Params p) {
    extern __shared__ __attribute__((aligned(16))) unsigned char lds[];
    cg::grid_group grid = cg::this_grid();
    PG8_LAS unsigned char* ldsl = (PG8_LAS unsigned char*)lds;
    if (threadIdx.x < 4) ((PG8_LAS unsigned*)(ldsl + (LDS_BYTES - 256)))[threadIdx.x] = 0u;
    __syncthreads();
    const XcdBarrier bar = xcd_barrier_post((unsigned*)(PP().ws + WS_BAR), (volatile PG8_LAS unsigned*)(ldsl + (LDS_BYTES - 256)));

    { IDS phase0(PP(), gw, NGW, lane); }
    if (PP().ws == nullptr) grid.sync();
    xcd_barrier(bar);
    { IDS phase1(PP(), (float*)lds, gw, NGW, lane, tid); }
    xcd_barrier(bar);
    {
        const Params q = PP(); unsigned char* ws = q.ws; bf16_t* WIN = (bf16_t*)(ws + WS_WIN); const int G = gridDim.x, bx = blockIdx.x;
        pg8::Gemm g{(const bf16_t*)(ws + 0 * UNIT), WIN + (size_t)ROWS_A * D, M, NB_TILES * 256, D}; pg8::StaticOrder S; S.init(M, NB_TILES * 256, G, bx);
        EpiB E{(bf16_t*)(ws + 1 * UNIT)};
        pg8::gemm_phase<EpiB, pg8::StaticOrder, true, true>(ldsl, g, S, E);
    }
    { IDS for (int it = gw; it < M / 16; it += NGW) ab_item(PP(), it, lane); }
    xcd_barrier(bar);
    { IDS for (int it = gw; it < 4096; it += NGW) phase3_item(PP(), it, lane); }
    xcd_barrier(bar);
    { IDS for (int it = gw; it < 4096; it += NGW) chunk_prep_item(PP(), (float*)(lds + wave * 16384), it, lane); }
    xcd_barrier(bar);
    for (int tk = blockIdx.x; tk < 256; tk += gridDim.x) { const int t2 = fresh_tid(); scan_task(PP(), ldsl, (tk & 7) + 8 * (tk >> 6), (tk >> 3) & 7, t2, __builtin_amdgcn_readfirstlane(t2 >> 6), t2 & 63); __syncthreads(); }
    xcd_barrier(bar);
    {
        const Params q = PP(); unsigned char* ws = q.ws; bf16_t* WIN = (bf16_t*)(ws + WS_WIN); const int G = gridDim.x, bx = blockIdx.x;
        pg8::Gemm g{(const bf16_t*)(ws + 0 * UNIT), WIN, M, NA_TILES * 256, D}; pg8::StaticOrder S; S.init(M, NA_TILES * 256, G, bx);
        EpiA E{(bf16_t*)(ws + 1 * UNIT), (bf16_t*)(ws + 4 * UNIT)};
        pg8::gemm_phase<EpiA, pg8::StaticOrder, true, true>(ldsl, g, S, E);
    }
    xcd_barrier(bar);
    { IDS phase7(PP(), gw, NGW, lane, gtid, NGT); }
    xcd_barrier(bar);
    if (gridDim.x == 256) {
        const Params q = PP(); unsigned char* ws = q.ws; const int G = gridDim.x, bx = blockIdx.x;
        static_assert(6 * UNIT - 2 * UNIT == (size_t)256 * 256 * D * 2 && WS_WPB - WS_WPA == (size_t)4 * 256 * D * 2, "TwoGemmOrder address arithmetic");
        TwoGemmOrder S; S.so.init(M, D, G, bx);
        pg8::Gemm g{(const bf16_t*)(ws + 2 * UNIT), (const bf16_t*)(ws + WS_WPA), M, D, D}; EpiYaYb E{(bf16_t*)(ws + 4 * UNIT), (const bf16_t*)(ws + 5 * UNIT)};
        pg8::gemm_phase<EpiYaYb, TwoGemmOrder, true, true>(ldsl, g, S, E);
    } else {
        const Params q = PP(); unsigned char* ws = q.ws; const int G = gridDim.x, bx = blockIdx.x;
        pg8::StaticOrder S; S.init(M, D, G, bx);
        { pg8::Gemm g{(const bf16_t*)(ws + 2 * UNIT), (const bf16_t*)(ws + WS_WPA), M, D, D}; EpiYa E{(bf16_t*)(ws + 4 * UNIT)};
          pg8::gemm_phase<EpiYa, pg8::StaticOrder, true, true>(ldsl, g, S, E); }
        { pg8::Gemm g{(const bf16_t*)(ws + 6 * UNIT), (const bf16_t*)(ws + WS_WPB), M, D, D}; EpiYb E{(bf16_t*)(ws + 4 * UNIT), (const bf16_t*)(ws + 5 * UNIT)};
          pg8::gemm_phase<EpiYb, pg8::StaticOrder, true, true>(ldsl, g, S, E); }
    }
    xcd_barrier(bar);
    if (gridDim.x == 256) {
        const Params q = PP(); unsigned char* ws = q.ws; const int G = gridDim.x, bx = blockIdx.x;
        pg8::Gemm g{(const bf16_t*)(ws + 4 * UNIT), (const bf16_t*)(ws + WS_WO), M, D, D}; pg8::StaticOrder S; S.init(M, D, G, bx);
        EpiOutFused E{q.in[0], (const float*)(ws + WS_MODF), q.in[14], q.out, (float*)(ws + WS_PSS), (unsigned*)(ws + WS_PCNT)};
        pg8::gemm_phase<EpiOutFused, pg8::StaticOrder, true, true>(ldsl, g, S, E);
    } else {
        {
            const Params q = PP(); unsigned char* ws = q.ws; const int G = gridDim.x, bx = blockIdx.x;
            pg8::Gemm g{(const bf16_t*)(ws + 4 * UNIT), (const bf16_t*)(ws + WS_WO), M, D, D}; pg8::StaticOrder S; S.init(M, D, G, bx);
            EpiOut E{q.in[0], (const float*)(ws + WS_MODF), (float*)(ws + 0 * UNIT)};
            pg8::gemm_phase<EpiOut, pg8::StaticOrder, true, true>(ldsl, g, S, E);
        }
        xcd_barrier(bar);
        { IDS phase10(PP(), gw, NGW, lane); }
    }
}

extern "C" void kernel_launch(void* const* d_in, const int* in_sizes, int n_in, void* d_out, int out_size, void* d_ws, size_t ws_size, hipStream_t stream) {
    static int grid = 0;
    if (grid == 0) {
        int dev = 0, cus = 0, per_cu = 0;
        if (n_in != 15 || out_size != M * D || ws_size < 256 * MiB) { fprintf(stderr, "kernel_launch: unexpected shapes (n_in %d out %d ws %zu)\n", n_in, out_size, ws_size); grid = -1; return; }
        hipGetDevice(&dev); hipDeviceGetAttribute(&cus, hipDeviceAttributeMultiprocessorCount, dev);
        if (hipFuncSetAttribute((const void*)fwd_kernel, hipFuncAttributeMaxDynamicSharedMemorySize, LDS_BYTES) != hipSuccess) { fprintf(stderr, "kernel_launch: hipFuncSetAttribute failed\n"); grid = -1; return; }
        hipOccupancyMaxActiveBlocksPerMultiprocessor(&per_cu, (const void*)fwd_kernel, NTHREADS, LDS_BYTES);
        if (per_cu < 1) { fprintf(stderr, "kernel_launch: occupancy query says %d blocks/CU\n", per_cu); per_cu = 1; }
        (void)hipGetLastError();
        grid = cus;
    }
    if (grid < 0) return;
    if (hipMemsetAsync((char*)d_ws + WS_BAR, 0, 32768, stream) != hipSuccess) { fprintf(stderr, "kernel_launch: memset of barrier words failed\n"); return; }
    Params p{};
    for (int i = 0; i < 15; ++i) p.in[i] = (const float*)d_in[i];
    p.out = (float*)d_out; p.ws = (unsigned char*)d_ws;
    void* args[] = {&p};
    hipError_t e = hipLaunchCooperativeKernel((const void*)fwd_kernel, dim3(grid), dim3(NTHREADS), args, LDS_BYTES, stream);
    if (e != hipSuccess) fprintf(stderr, "cooperative launch failed: %s (grid %d)\n", hipGetErrorString(e), grid);
}
```

```cpp
#include <hip/hip_runtime.h>
#include <hip/hip_cooperative_groups.h>
#include <cstdio>
#include <cstdint>
namespace cg = cooperative_groups;

#define DI __device__ __forceinline__
#define PG8_LAS __attribute__((address_space(3)))
typedef unsigned short bf16_t;
typedef short bf16x8 __attribute__((ext_vector_type(8)));
typedef float f32x4 __attribute__((ext_vector_type(4)));
typedef float f32x2 __attribute__((ext_vector_type(2)));
typedef unsigned u32x4 __attribute__((ext_vector_type(4)));
typedef unsigned u32x2 __attribute__((ext_vector_type(2)));

namespace pg8 {
constexpr int BM = 256, BK = 64, HALF = 128, HTB = HALF * BK * 2, STAGE_BYTES = 8 * HTB, NXCD = 8, WGM = 8;
__host__ __device__ __forceinline__ int lds_byte(int r, int c) { const int st = (r >> 4) * 2 + (c >> 5), rr = r & 15, cc = c & 31, ob = rr * 64 + cc * 2; return st * 1024 + (ob ^ (((ob >> 9) & 1) << 5)); }
__host__ __device__ __forceinline__ void stage_rc(int b, int& R, int& C) { const int st = b / 1024, sb = b % 1024, swz = sb ^ (((sb >> 9) & 1) << 5); R = (st >> 1) * 16 + swz / 64; C = (st & 1) * 32 + (swz % 64) / 2; }
__host__ __device__ __forceinline__ int perm32(int rho) { const int n = rho >> 4, i = rho & 15; return 8 * (i >> 2) + 4 * n + (i & 3); }
struct Unit { int pm, pn; };
struct Gemm { const bf16_t* A; const bf16_t* Bt; int M, N, K; };
struct StaticOrder {
    int nM, nN, nwg, G, c;
    __host__ __device__ void init(int M, int N, int G_, int c_) { nM = M / BM; nN = N / BM; nwg = nM * nN; G = G_; c = c_; }
    __host__ __device__ bool next(int i, Unit& u) const {
        const long L = (long)i * G + c; if (L >= nwg) return false;
        int wgid = (int)L; { const int q = nwg / NXCD, r = nwg % NXCD, xcd = wgid % NXCD, off = wgid / NXCD; wgid = (xcd < r ? xcd * (q + 1) : r * (q + 1) + (xcd - r) * q) + off; }
        const int nig = WGM * nN, gid = wgid / nig, fm = gid * WGM, gsz = (nM - fm) < WGM ? (nM - fm) : WGM;
        u.pm = fm + ((wgid % nig) % gsz); u.pn = (wgid % nig) / gsz; return true;
    }
    __device__ __forceinline__ void a_ready(const Unit&) const {}
    __device__ __forceinline__ void done(const Unit&) const {}
};
template <class Epi, class Sched, bool ALIGN_EPI = false, bool SP2 = false>
__device__ __forceinline__ void gemm_phase(PG8_LAS unsigned char* lds, const Gemm g, const Sched& S, const Epi& E) {
    int tid = threadIdx.x; asm volatile("" : "+v"(tid)); const int wid = __builtin_amdgcn_readfirstlane(tid >> 6), lane = tid & 63, wr = wid >> 2, wc = wid & 3, fr = lane & 15, fq = lane >> 4;
    const int K = g.K, nt = K / BK;
    unsigned voffA[2], voffB[2];
#pragma unroll
    for (int i = 0; i < 2; ++i) { int R, C; stage_rc(tid * 16 + i * 8192, R, C); const int Rb = Epi::PERM ? ((R & ~31) + perm32(R & 31)) : R;
        voffA[i] = (unsigned)(R * K + C) * 2u; voffB[i] = (unsigned)(Rb * K + C) * 2u; }
    const size_t kstep = (size_t)(BK * 2);
    const size_t hstep = (size_t)HALF * K * 2;
    const size_t tstep = 2 * hstep;
    const unsigned ldsw = (unsigned)wid * 1024u;
    const int aoff = lds_byte(wr * 64 + fr, fq * 8), boff = lds_byte(wc * 32 + fr, fq * 8);
#define PG8_SA(b, h) (((b) * 2 + (h)) * HTB)
#define PG8_SB(b, h) ((4 + (b) * 2 + (h)) * HTB)
#define PG8_STAGE(bufoff, gbase, voff) do { _Pragma("unroll") for (int _i = 0; _i < 2; ++_i) \
        __builtin_amdgcn_global_load_lds((const unsigned*)((const char*)(gbase) + (voff)[_i]), (PG8_LAS unsigned*)(lds + (bufoff) + ldsw + _i * 8192), 16, 0, 0); } while (0)
#define PG8_LDA(dst, b, h) do { _Pragma("unroll") for (int m = 0; m < 4; ++m) _Pragma("unroll") for (int k = 0; k < 2; ++k) dst[m][k] = *(const PG8_LAS bf16x8*)(lds + PG8_SA(b, h) + aoff + m * 2048 + k * 1024); } while (0)
#define PG8_LDB(dst, b, h) do { _Pragma("unroll") for (int n = 0; n < 2; ++n) _Pragma("unroll") for (int k = 0; k < 2; ++k) dst[n][k] = *(const PG8_LAS bf16x8*)(lds + PG8_SB(b, h) + boff + n * 2048 + k * 1024); } while (0)
#define PG8_MMA(ai, bj, At, Bt) do { __builtin_amdgcn_s_setprio(1); _Pragma("unroll") for (int m = 0; m < 4; ++m) _Pragma("unroll") for (int n = 0; n < 2; ++n) _Pragma("unroll") for (int k = 0; k < 2; ++k) \
        acc[ai][bj][m][n] = __builtin_amdgcn_mfma_f32_16x16x32_bf16(Bt[n][k], At[m][k], acc[ai][bj][m][n], 0, 0, 0); __builtin_amdgcn_s_setprio(0); } while (0)
#define PG8_WAIT_V(n) asm volatile("s_waitcnt vmcnt(" #n ")" ::: "memory")
#define PG8_WAIT_L(n) asm volatile("s_waitcnt lgkmcnt(" #n ")" ::: "memory")
#define PG8_BAR __builtin_amdgcn_s_barrier()
#define PG8_SCHED __builtin_amdgcn_sched_barrier(0)
    Unit cur, nxt; int ui = 0;
    if (!S.next(0, cur)) return;
    f32x4 acc[2][2][4][2];
#pragma unroll
    for (int a = 0; a < 2; ++a)
#pragma unroll
        for (int b = 0; b < 2; ++b)
#pragma unroll
            for (int m = 0; m < 4; ++m)
#pragma unroll
                for (int n = 0; n < 2; ++n) acc[a][b][m][n] = (f32x4){0.f, 0.f, 0.f, 0.f};
    bf16x8 At[4][2], B0[2][2], B1[2][2];
    const char* cA = (const char*)g.A + (size_t)cur.pm * tstep; const char* cB = (const char*)g.Bt + (size_t)cur.pn * tstep;
    S.a_ready(cur);
    if constexpr (SP2) {
        PG8_STAGE(PG8_SB(0, 0), cB, voffB); PG8_STAGE(PG8_SB(0, 1), cB + hstep, voffB); PG8_STAGE(PG8_SA(0, 0), cA, voffA); PG8_STAGE(PG8_SA(0, 1), cA + hstep, voffA);
        if (wr == 1) PG8_BAR;
        PG8_WAIT_V(2); PG8_BAR;
        PG8_STAGE(PG8_SB(1, 0), cB + kstep, voffB); PG8_STAGE(PG8_SA(1, 0), cA + kstep, voffA); PG8_STAGE(PG8_SB(1, 1), cB + hstep + kstep, voffB);
        PG8_WAIT_V(6); PG8_BAR;
    } else {
        PG8_STAGE(PG8_SB(0, 0), cB, voffB); PG8_STAGE(PG8_SA(0, 0), cA, voffA); PG8_STAGE(PG8_SB(0, 1), cB + hstep, voffB); PG8_STAGE(PG8_SA(0, 1), cA + hstep, voffA);
        if (wr == 1) PG8_BAR;
        PG8_WAIT_V(4); PG8_BAR;
        PG8_STAGE(PG8_SB(1, 0), cB + kstep, voffB); PG8_STAGE(PG8_SA(1, 0), cA + kstep, voffA); PG8_STAGE(PG8_SB(1, 1), cB + hstep + kstep, voffB);
        PG8_WAIT_V(6); PG8_BAR;
    }
    for (;;) {
        const bool has_next = S.next(ui + 1, nxt);
        const char* nA = has_next ? (const char*)g.A + (size_t)nxt.pm * tstep : cA; const char* nB = has_next ? (const char*)g.Bt + (size_t)nxt.pn * tstep : cB;
        for (int t = 0; t < nt; t += 2) {
            const bool last = (t == nt - 2);
            const char* a1 = cA + (size_t)(t + 1) * kstep;
            const char* a2 = last ? nA : cA + (size_t)(t + 2) * kstep; const char* b2 = last ? nB : cB + (size_t)(t + 2) * kstep;
            const char* a3 = a2 + kstep; const char* b3 = b2 + kstep;
            if (last && has_next) S.a_ready(nxt);
            if constexpr (SP2) {
            PG8_LDB(B0, 0, 0); PG8_LDB(B1, 0, 1); PG8_SCHED; PG8_LDA(At, 0, 0); PG8_STAGE(PG8_SA(1, 1), a1 + hstep, voffA);
            PG8_WAIT_V(8); PG8_WAIT_L(0); PG8_BAR; PG8_MMA(0, 0, At, B0); PG8_MMA(0, 1, At, B1); PG8_BAR; PG8_SCHED;
            PG8_LDA(At, 0, 1); PG8_STAGE(PG8_SB(0, 0), b2, voffB); PG8_STAGE(PG8_SB(0, 1), b2 + hstep, voffB); PG8_STAGE(PG8_SA(0, 0), a2, voffA);
            PG8_WAIT_V(8); PG8_WAIT_L(0); PG8_BAR; PG8_MMA(1, 0, At, B0); PG8_MMA(1, 1, At, B1); PG8_BAR; PG8_SCHED;
            PG8_LDB(B0, 1, 0); PG8_LDB(B1, 1, 1); PG8_SCHED; PG8_LDA(At, 1, 0); PG8_STAGE(PG8_SA(0, 1), a2 + hstep, voffA);
            PG8_WAIT_V(8); PG8_WAIT_L(0); PG8_BAR; PG8_MMA(0, 0, At, B0); PG8_MMA(0, 1, At, B1); PG8_BAR; PG8_SCHED;
            PG8_LDA(At, 1, 1); PG8_STAGE(PG8_SB(1, 0), b3, voffB); PG8_STAGE(PG8_SB(1, 1), b3 + hstep, voffB); PG8_STAGE(PG8_SA(1, 0), a3, voffA);
            PG8_WAIT_V(8); PG8_WAIT_L(0); PG8_BAR; PG8_MMA(1, 0, At, B0); PG8_MMA(1, 1, At, B1); PG8_BAR; PG8_SCHED;
            } else {
            PG8_LDB(B0, 0, 0); PG8_SCHED; PG8_LDA(At, 0, 0); PG8_STAGE(PG8_SA(1, 1), a1 + hstep, voffA);
            PG8_WAIT_L(8); PG8_BAR; PG8_WAIT_L(0); PG8_MMA(0, 0, At, B0); PG8_BAR; PG8_SCHED;
            PG8_LDB(B1, 0, 1); PG8_STAGE(PG8_SB(0, 0), b2, voffB);
            PG8_BAR; PG8_WAIT_L(0); PG8_MMA(0, 1, At, B1); PG8_BAR;
            PG8_LDA(At, 0, 1); PG8_STAGE(PG8_SA(0, 0), a2, voffA);
            PG8_BAR; PG8_WAIT_L(0); PG8_MMA(1, 0, At, B0); PG8_BAR; PG8_SCHED;
            PG8_STAGE(PG8_SB(0, 1), b2 + hstep, voffB);
            PG8_WAIT_V(6); PG8_BAR; PG8_MMA(1, 1, At, B1); PG8_BAR;
            PG8_LDB(B0, 1, 0); PG8_SCHED; PG8_LDA(At, 1, 0); PG8_STAGE(PG8_SA(0, 1), a2 + hstep, voffA);
            PG8_WAIT_L(8); PG8_BAR; PG8_WAIT_L(0); PG8_MMA(0, 0, At, B0); PG8_BAR; PG8_SCHED;
            PG8_LDB(B1, 1, 1); PG8_STAGE(PG8_SB(1, 0), b3, voffB);
            PG8_BAR; PG8_WAIT_L(0); PG8_MMA(0, 1, At, B1); PG8_BAR;
            PG8_LDA(At, 1, 1); PG8_STAGE(PG8_SA(1, 0), a3, voffA);
            PG8_BAR; PG8_WAIT_L(0); PG8_MMA(1, 0, At, B0); PG8_BAR; PG8_SCHED;
            PG8_STAGE(PG8_SB(1, 1), b3 + hstep, voffB);
            PG8_WAIT_V(6); PG8_BAR; PG8_MMA(1, 1, At, B1); PG8_BAR;
            }
        }
        if constexpr (ALIGN_EPI) { if (wr == 0) PG8_BAR; }
        if constexpr (!Epi::AFTER_DRAIN) { E(acc, cur, wr, wc, fr, fq); S.done(cur); }
        if (!has_next) break;
#pragma unroll
        for (int a = 0; a < 2; ++a)
#pragma unroll
            for (int b = 0; b < 2; ++b)
#pragma unroll
                for (int m = 0; m < 4; ++m)
#pragma unroll
                    for (int n = 0; n < 2; ++n) acc[a][b][m][n] = (f32x4){0.f, 0.f, 0.f, 0.f};
        cur = nxt; cA = nA; cB = nB; ++ui;
        if constexpr (ALIGN_EPI) { if (wr == 1) PG8_BAR; }
    }
    PG8_WAIT_V(0);
    if constexpr (!ALIGN_EPI) { if (wr == 0) PG8_BAR; }
    PG8_BAR;
    if constexpr (Epi::AFTER_DRAIN) { E.fused(acc, cur, wr, wc, fr, fq, lds, wid, lane); S.done(cur); }
#undef PG8_SA
#undef PG8_SB
#undef PG8_STAGE
#undef PG8_LDA
#undef PG8_LDB
#undef PG8_MMA
#undef PG8_WAIT_V
#undef PG8_WAIT_L
#undef PG8_BAR
#undef PG8_SCHED
}}

constexpr int SEQ = 8192, NB = 2, M = NB * SEQ, D = 1024, NIN = 10272, NPAD = 10496;
constexpr int NA_TILES = 28, NB_TILES = 12, ROWS_A = NA_TILES * 256;
constexpr size_t MiB = 1u << 20;
constexpr size_t UNIT = 32 * MiB;
constexpr size_t WS_WIN = 224 * MiB, WS_WPA = 245 * MiB, WS_WPB = 247 * MiB, WS_WO = 249 * MiB, WS_AB = 251 * MiB, WS_G = 253 * MiB, WS_BETA = 254 * MiB;
constexpr size_t WS_MODP = 255 * MiB, WS_MODF = 255 * MiB + 256 * 1024;
constexpr size_t WS_CSC = 239 * MiB;
constexpr int LDS_BYTES = 155648;
constexpr int NWAVES = 8, NTHREADS = 512;
constexpr float NORM_EPS = 1e-6f, L2_EPS = 1e-6f;

struct Params { const float* in[15]; float* out; unsigned char* ws; };

typedef __bf16 bf16v2_t __attribute__((ext_vector_type(2)));
DI unsigned cvt_pk_bf16(float lo, float hi) { const f32x2 v = {lo, hi}; const bf16v2_t r = __builtin_convertvector(v, bf16v2_t); return __builtin_bit_cast(unsigned, r); }
DI void store_wt16(void* p, const u32x4& v) { asm volatile("global_store_dwordx4 %0, %1, off sc1\n\ts_nop 1" :: "v"(p), "v"(v) : "memory"); }
DI float bf_lo(unsigned u) { return __uint_as_float(u << 16); }
DI float bf_hi(unsigned u) { return __uint_as_float(u & 0xffff0000u); }
DI float bf1(bf16_t u) { return __uint_as_float(((unsigned)u) << 16); }
DI float sigmoidf_(float x) { return __builtin_amdgcn_rcpf(1.0f + __expf(-x)); }
DI float siluf_(float x) { return x * __builtin_amdgcn_rcpf(1.0f + __expf(-x)); }
DI float softplusf_(float x) { return fmaxf(x, 0.f) + log1pf(__expf(-fabsf(x))); }
#define DPP_F(v, ctrl) __builtin_bit_cast(float, __builtin_amdgcn_mov_dpp(__builtin_bit_cast(int, (v)), (ctrl), 0xF, 0xF, true))
DI float row16_sum(float v) {
    v += DPP_F(v, 0xB1);
    v += DPP_F(v, 0x4E);
    v += DPP_F(v, 0x141);
    v += DPP_F(v, 0x140);
    return v;
}
DI float wave_sum(float v) {
    v = row16_sum(v);
    return __builtin_bit_cast(float, __builtin_amdgcn_readlane(__builtin_bit_cast(int, v), 0)) + __builtin_bit_cast(float, __builtin_amdgcn_readlane(__builtin_bit_cast(int, v), 16))
         + __builtin_bit_cast(float, __builtin_amdgcn_readlane(__builtin_bit_cast(int, v), 32)) + __builtin_bit_cast(float, __builtin_amdgcn_readlane(__builtin_bit_cast(int, v), 48));
}
DI int permpos(int dk) { const int loc = dk & 31; return (dk & ~31) + 8 * ((loc >> 2) & 3) + 4 * (loc >> 4) + (loc & 3); }
DI int win_src_col(int d) {
    if (d < 2048) { const int i = d >> 8, w = d & 255; return w < 128 ? (128 * i + w) : (2048 + 128 * i + (w - 128)); }
    if (d < 4096) { const int i = (d - 2048) >> 8, w = d & 255; return w < 128 ? (1024 + 128 * i + w) : (3072 + 128 * i + (w - 128)); }
    if (d < 5120) return 8224 + (d - 4096);
    if (d < 6144) return 9248 + (d - 5120);
    if (d < 7168) return 7168 + (d - 6144);
    if (d < 10240) return 4096 + (d - 7168);
    if (d < 10272) return 8192 + (d - 10240);
    return -1;
}

struct EpiA {
    static constexpr bool PERM = true, AFTER_DRAIN = false;
    bf16_t *PR, *SG;
    DI void operator()(const f32x4 (&acc)[2][2][4][2], const pg8::Unit& u, int wr, int wc, int fr, int fq) const {
        const int row0 = u.pm * 256 + wr * 64 + fr, pn = u.pn;
        if (pn < 16) {
            bf16_t* O = PR + (size_t)(pn >> 3) * (UNIT / 2) + (size_t)(128 * (pn & 7) + 32 * wc + 8 * fq);
#pragma unroll
            for (int ai = 0; ai < 2; ++ai)
#pragma unroll
                for (int m = 0; m < 4; ++m) {
                    float o[8];
#pragma unroll
                    for (int n = 0; n < 2; ++n)
#pragma unroll
                        for (int j = 0; j < 4; ++j) { const float a = acc[ai][0][m][n][j], b = acc[ai][1][m][n][j]; o[4 * n + j] = pn < 8 ? a * b : a * siluf_(b); }
                    u32x4 w; w.x = cvt_pk_bf16(o[0], o[1]); w.y = cvt_pk_bf16(o[2], o[3]); w.z = cvt_pk_bf16(o[4], o[5]); w.w = cvt_pk_bf16(o[6], o[7]);
                    store_wt16(O + (size_t)(row0 + ai * 128 + m * 16) * D, w);
                }
        } else {
            const int g = (pn - 16) >> 2;
            bf16_t* O = SG + (size_t)g * (UNIT / 2) + (size_t)(256 * ((pn - 16) & 3) + 32 * wc + 8 * fq);
#pragma unroll
            for (int ai = 0; ai < 2; ++ai)
#pragma unroll
                for (int m = 0; m < 4; ++m)
#pragma unroll
                    for (int bj = 0; bj < 2; ++bj) {
                        float o[8];
#pragma unroll
                        for (int n = 0; n < 2; ++n)
#pragma unroll
                            for (int j = 0; j < 4; ++j) { const float a = acc[ai][bj][m][n][j]; o[4 * n + j] = g == 2 ? siluf_(a) : sigmoidf_(a); }
                        u32x4 w; w.x = cvt_pk_bf16(o[0], o[1]); w.y = cvt_pk_bf16(o[2], o[3]); w.z = cvt_pk_bf16(o[4], o[5]); w.w = cvt_pk_bf16(o[6], o[7]);
                        store_wt16(O + (size_t)(row0 + ai * 128 + m * 16) * D + bj * 128, w);
                    }
        }
    }
};
struct EpiB {
    static constexpr bool PERM = true, AFTER_DRAIN = false;
    bf16_t* QKV;
    DI void operator()(const f32x4 (&acc)[2][2][4][2], const pg8::Unit& u, int wr, int wc, int fr, int fq) const {
        const int row0 = u.pm * 256 + wr * 64 + fr, pn = u.pn;
        bf16_t* O = QKV + (size_t)(pn >> 2) * (UNIT / 2) + (size_t)(256 * (pn & 3) + 32 * wc + 8 * fq);
#pragma unroll
        for (int ai = 0; ai < 2; ++ai)
#pragma unroll
            for (int m = 0; m < 4; ++m)
#pragma unroll
                for (int bj = 0; bj < 2; ++bj) {
                    const f32x4 v0 = acc[ai][bj][m][0], v1 = acc[ai][bj][m][1];
                    u32x4 w; w.x = cvt_pk_bf16(v0[0], v0[1]); w.y = cvt_pk_bf16(v0[2], v0[3]); w.z = cvt_pk_bf16(v1[0], v1[1]); w.w = cvt_pk_bf16(v1[2], v1[3]);
                    store_wt16(O + (size_t)(row0 + ai * 128 + m * 16) * D + bj * 128, w);
                }
    }
};
struct EpiYa {
    static constexpr bool PERM = true, AFTER_DRAIN = false;
    bf16_t* SGA;
    DI void operator()(const f32x4 (&acc)[2][2][4][2], const pg8::Unit& u, int wr, int wc, int fr, int fq) const {
        const int row0 = u.pm * 256 + wr * 64 + fr; bf16_t* O = SGA + (size_t)(256 * u.pn + 32 * wc + 8 * fq);
#pragma unroll
        for (int ai = 0; ai < 2; ++ai)
#pragma unroll
            for (int m = 0; m < 4; ++m)
#pragma unroll
                for (int bj = 0; bj < 2; ++bj) {
                    u32x4* p = (u32x4*)(O + (size_t)(row0 + ai * 128 + m * 16) * D + bj * 128);
                    const u32x4 s = *p; const f32x4 v0 = acc[ai][bj][m][0], v1 = acc[ai][bj][m][1];
                    u32x4 w; w.x = cvt_pk_bf16(bf_lo(s.x) * v0[0], bf_hi(s.x) * v0[1]); w.y = cvt_pk_bf16(bf_lo(s.y) * v0[2], bf_hi(s.y) * v0[3]);
                    w.z = cvt_pk_bf16(bf_lo(s.z) * v1[0], bf_hi(s.z) * v1[1]); w.w = cvt_pk_bf16(bf_lo(s.w) * v1[2], bf_hi(s.w) * v1[3]);
                    *p = w;
                }
    }
};
struct EpiYb {
    static constexpr bool PERM = true, AFTER_DRAIN = false;
    bf16_t* MA; const bf16_t* SGB;
    DI void operator()(const f32x4 (&acc)[2][2][4][2], const pg8::Unit& u, int wr, int wc, int fr, int fq) const {
        const int row0 = u.pm * 256 + wr * 64 + fr; const size_t c0 = (size_t)(256 * u.pn + 32 * wc + 8 * fq);
#pragma unroll
        for (int ai = 0; ai < 2; ++ai)
#pragma unroll
            for (int m = 0; m < 4; ++m)
#pragma unroll
                for (int bj = 0; bj < 2; ++bj) {
                    const size_t off = (size_t)(row0 + ai * 128 + m * 16) * D + bj * 128 + c0;
                    u32x4* p = (u32x4*)(MA + off); const u32x4 a = *p; const u32x4 s = *(const u32x4*)(SGB + off);
                    const f32x4 v0 = acc[ai][bj][m][0], v1 = acc[ai][bj][m][1];
                    u32x4 w; w.x = cvt_pk_bf16(bf_lo(a.x) + bf_lo(s.x) * v0[0], bf_hi(a.x) + bf_hi(s.x) * v0[1]); w.y = cvt_pk_bf16(bf_lo(a.y) + bf_lo(s.y) * v0[2], bf_hi(a.y) + bf_hi(s.y) * v0[3]);
                    w.z = cvt_pk_bf16(bf_lo(a.z) + bf_lo(s.z) * v1[0], bf_hi(a.z) + bf_hi(s.z) * v1[1]); w.w = cvt_pk_bf16(bf_lo(a.w) + bf_lo(s.w) * v1[2], bf_hi(a.w) + bf_hi(s.w) * v1[3]);
                    store_wt16(p, w);
                }
    }
};
struct EpiOut {
    static constexpr bool PERM = true, AFTER_DRAIN = false;
    const float* X; const float* GATE; float* XN;
    DI void operator()(const f32x4 (&acc)[2][2][4][2], const pg8::Unit& u, int wr, int wc, int fr, int fq) const {
        const int row0 = u.pm * 256 + wr * 64 + fr; const int c0 = 256 * u.pn + 32 * wc + 8 * fq;
        const float* gp = GATE + (size_t)((u.pm * 256) / SEQ) * D + c0;
        f32x4 gt[2][2];
#pragma unroll
        for (int bj = 0; bj < 2; ++bj) { gt[bj][0] = *(const f32x4*)(gp + bj * 128); gt[bj][1] = *(const f32x4*)(gp + bj * 128 + 4); }
#pragma unroll
        for (int ai = 0; ai < 2; ++ai)
#pragma unroll
            for (int m = 0; m < 4; ++m)
#pragma unroll
                for (int bj = 0; bj < 2; ++bj) {
                    const size_t off = (size_t)(row0 + ai * 128 + m * 16) * D + bj * 128 + c0;
                    const f32x4 x0 = *(const f32x4*)(X + off), x1 = *(const f32x4*)(X + off + 4);
                    *(f32x4*)(XN + off) = x0 + gt[bj][0] * acc[ai][bj][m][0]; *(f32x4*)(XN + off + 4) = x1 + gt[bj][1] * acc[ai][bj][m][1];
                }
    }
};

constexpr size_t WS_PCNT = 255 * MiB + 336 * 1024;
constexpr size_t WS_PSS = 255 * MiB + 512 * 1024;
constexpr size_t WS_PCNT2 = 255 * MiB + 352 * 1024;
struct EpiOutFused {
    static constexpr bool PERM = true, AFTER_DRAIN = true;
    const float* X; const float* GATE; const float* FW; float* OUT; float* PSS; unsigned* PCNT;
    DI void operator()(const f32x4 (&)[2][2][4][2], const pg8::Unit&, int, int, int, int) const {}
    DI void fused(f32x4 (&acc)[2][2][4][2], const pg8::Unit& u, int wr, int wc, int fr, int fq, PG8_LAS unsigned char* lds, int wid, int lane) const {
        PG8_LAS float* P = (PG8_LAS float*)lds;
        PG8_LAS float* S = (PG8_LAS float*)(lds + 4096);
        const int row0 = u.pm * 256 + wr * 64 + fr; const int c0 = 256 * u.pn + 32 * wc + 8 * fq;
        const float* gp = GATE + (size_t)((u.pm * 256) / SEQ) * D + c0;
        f32x4 gt[2][2];
#pragma unroll
        for (int bj = 0; bj < 2; ++bj) { gt[bj][0] = *(const f32x4*)(gp + bj * 128); gt[bj][1] = *(const f32x4*)(gp + bj * 128 + 4); }
#pragma unroll
        for (int ai = 0; ai < 2; ++ai)
#pragma unroll
            for (int m = 0; m < 4; ++m) {
                float s = 0.f;
#pragma unroll
                for (int bj = 0; bj < 2; ++bj) {
                    const size_t off = (size_t)(row0 + ai * 128 + m * 16) * D + bj * 128 + c0;
                    const f32x4 v0 = __builtin_nontemporal_load((const f32x4*)(X + off)) + gt[bj][0] * acc[ai][bj][m][0], v1 = __builtin_nontemporal_load((const f32x4*)(X + off + 4)) + gt[bj][1] * acc[ai][bj][m][1];
                    acc[ai][bj][m][0] = v0; acc[ai][bj][m][1] = v1;
                    s += (v0[0] * v0[0] + v0[1] * v0[1]) + (v0[2] * v0[2] + v0[3] * v0[3]) + (v1[0] * v1[0] + v1[1] * v1[1]) + (v1[2] * v1[2] + v1[3] * v1[3]);
                }
                s += __shfl_xor(s, 16); s += __shfl_xor(s, 32);
                if (fq == 0) P[(ai * 128 + wr * 64 + m * 16 + fr) * 4 + wc] = s;
                if (m & 1) __builtin_amdgcn_sched_barrier(0);
            }
        asm volatile("s_waitcnt lgkmcnt(0)" ::: "memory"); __builtin_amdgcn_s_barrier(); asm volatile("" ::: "memory");
        const int row = wid * 32 + (lane & 31);
        if (lane < 32) {
            const float t = (P[row * 4 + 0] + P[row * 4 + 1]) + (P[row * 4 + 2] + P[row * 4 + 3]);
            __hip_atomic_store(PSS + (size_t)(u.pm * 256 + row) * 4 + u.pn, t, __ATOMIC_RELAXED, __HIP_MEMORY_SCOPE_AGENT);
        }
        asm volatile("s_waitcnt vmcnt(0)" ::: "memory");
        if (lane == 0) __hip_atomic_fetch_add(PCNT + 64 * u.pm, 1u, __ATOMIC_RELAXED, __HIP_MEMORY_SCOPE_AGENT);
        if (wid == 0) {
            unsigned sp = 0;
            while ((unsigned)__builtin_amdgcn_readfirstlane(__hip_atomic_load(PCNT + 64 * u.pm, __ATOMIC_RELAXED, __HIP_MEMORY_SCOPE_AGENT)) < 32u) { __builtin_amdgcn_s_sleep(2); if (++sp > (1u << 22)) break; }
            __builtin_amdgcn_fence(__ATOMIC_ACQUIRE, "agent");
        }
        asm volatile("s_waitcnt vmcnt(0) lgkmcnt(0)" ::: "memory"); __builtin_amdgcn_s_barrier(); asm volatile("" ::: "memory");
        if (lane < 32) {
            const float* ps = PSS + (size_t)(u.pm * 256 + row) * 4; float t = 0.f;
#pragma unroll
            for (int k = 0; k < 4; ++k) t += __hip_atomic_load(ps + k, __ATOMIC_RELAXED, __HIP_MEMORY_SCOPE_AGENT);
            S[row] = rsqrtf(t * (1.f / D) + NORM_EPS);
        }
        asm volatile("s_waitcnt vmcnt(0) lgkmcnt(0)" ::: "memory"); __builtin_amdgcn_s_barrier(); asm volatile("" ::: "memory");
        f32x4 fw[2][2];
#pragma unroll
        for (int bj = 0; bj < 2; ++bj) { fw[bj][0] = *(const f32x4*)(FW + c0 + bj * 128); fw[bj][1] = *(const f32x4*)(FW + c0 + bj * 128 + 4); }
#pragma unroll
        for (int ai = 0; ai < 2; ++ai)
#pragma unroll
            for (int m = 0; m < 4; ++m) {
                const float rs = S[ai * 128 + wr * 64 + m * 16 + fr];
#pragma unroll
                for (int bj = 0; bj < 2; ++bj) {
                    const size_t off = (size_t)(row0 + ai * 128 + m * 16) * D + bj * 128 + c0;
                    __builtin_nontemporal_store(acc[ai][bj][m][0] * rs * fw[bj][0], (f32x4*)(OUT + off)); __builtin_nontemporal_store(acc[ai][bj][m][1] * rs * fw[bj][1], (f32x4*)(OUT + off + 4));
                }
            }
    }
};

struct TwoGemmOrder {
    pg8::StaticOrder so;
    DI bool next(int i, pg8::Unit& u) const { if (i >= 2) return false; if (!so.next(0, u)) return false; if (i == 1) { u.pm += 256; u.pn += 4; } return true; }
    DI void a_ready(const pg8::Unit&) const {}
    DI void done(const pg8::Unit&) const {}
};
struct EpiYaYb {
    static constexpr bool PERM = true, AFTER_DRAIN = false;
    bf16_t* MA; const bf16_t* SGB;
    DI void operator()(const f32x4 (&acc)[2][2][4][2], const pg8::Unit& u, int wr, int wc, int fr, int fq) const {
        if (u.pn < 4) { EpiYa e{MA}; e(acc, u, wr, wc, fr, fq); }
        else { EpiYb e{MA, SGB}; pg8::Unit v; v.pm = u.pm - 256; v.pn = u.pn - 4; e(acc, v, wr, wc, fr, fq); }
    }
};

DI void p0_transpose_item(const float* W, int N, bf16_t* WT, int rg, int kg, int lane, bool is_win) {
    const int d = rg * 64 + lane; const int s = is_win ? win_src_col(d) : d; const int k0 = kg * 64;
    bf16_t* o = WT + (size_t)d * D + k0;
    if (s < 0) {
#pragma unroll
        for (int kk = 0; kk < 8; ++kk) *(u32x4*)(o + 8 * kk) = (u32x4){0u, 0u, 0u, 0u};
        return;
    }
    const float* w = W + (size_t)k0 * N + s;
    float v[64];
#pragma unroll
    for (int j = 0; j < 64; ++j) v[j] = __builtin_nontemporal_load(w + (size_t)j * N);
#pragma unroll
    for (int kk = 0; kk < 8; ++kk) {
        u32x4 p; p.x = cvt_pk_bf16(v[8 * kk], v[8 * kk + 1]); p.y = cvt_pk_bf16(v[8 * kk + 2], v[8 * kk + 3]); p.z = cvt_pk_bf16(v[8 * kk + 4], v[8 * kk + 5]); p.w = cvt_pk_bf16(v[8 * kk + 6], v[8 * kk + 7]);
        *(u32x4*)(o + 8 * kk) = p;
    }
}
DI void phase0(const Params& p, int gw, int NGW, int lane) {
    unsigned char* ws = p.ws;
    constexpr int I_WIN = (NPAD / 64) * 16, I_SQ = 16 * 16, I_MOD = 48 * 8, NITEMS = I_WIN + 3 * I_SQ + I_MOD;
    for (int it = gw; it < NITEMS; it += NGW) {
        int r = it;
        if (r < I_WIN) { p0_transpose_item(p.in[5], NIN, (bf16_t*)(ws + WS_WIN), r >> 4, r & 15, lane, true); continue; } r -= I_WIN;
        if (r < I_SQ) { p0_transpose_item(p.in[11], D, (bf16_t*)(ws + WS_WPA), r >> 4, r & 15, lane, false); continue; } r -= I_SQ;
        if (r < I_SQ) { p0_transpose_item(p.in[12], D, (bf16_t*)(ws + WS_WPB), r >> 4, r & 15, lane, false); continue; } r -= I_SQ;
        if (r < I_SQ) { p0_transpose_item(p.in[13], D, (bf16_t*)(ws + WS_WO), r >> 4, r & 15, lane, false); continue; } r -= I_SQ;
        const int cgp = r >> 3, ks = r & 7; const float* c = p.in[1]; const float* wa = p.in[2] + (size_t)(ks * 128) * 3072 + cgp * 64 + lane;
        float a0 = 0.f, a1 = 0.f;
#pragma unroll
        for (int k0 = 0; k0 < 128; k0 += 32) {
            float wv[32];
#pragma unroll
            for (int k = 0; k < 32; ++k) wv[k] = __builtin_nontemporal_load(wa + (size_t)(k0 + k) * 3072);
#pragma unroll
            for (int k = 0; k < 32; ++k) { a0 += siluf_(c[ks * 128 + k0 + k]) * wv[k]; a1 += siluf_(c[D + ks * 128 + k0 + k]) * wv[k]; }
        }
        float* mp = (float*)(ws + WS_MODP) + (size_t)ks * 2 * 3072 + cgp * 64 + lane;
        mp[0] = a0; mp[3072] = a1;
    }
}
DI void phase1(const Params& p, float* ldsf, int gw, int NGW, int lane, int tid) {
    const float* modp = (const float*)(p.ws + WS_MODP); const float* b_ada = p.in[3]; const float* nw = p.in[4];
    float* s_tab = ldsf;
    float* a_tab = ldsf + 2048;
    for (int idx = tid; idx < 2 * 2048; idx += NTHREADS) {
        const int b = idx >> 11, j = idx & 2047; float s = b_ada[j];
#pragma unroll
        for (int q = 0; q < 8; ++q) s += modp[(size_t)q * 2 * 3072 + b * 3072 + j];
        if (j < 1024) s_tab[b * 1024 + j] = s; else a_tab[b * 1024 + j - 1024] = nw[j - 1024] * (1.f + s);
    }
    if (blockIdx.x == 0) {
        float* modf = (float*)(p.ws + WS_MODF);
        for (int idx = tid; idx < 2 * 1024; idx += NTHREADS) {
            const int b = idx >> 10, j = idx & 1023; float s = b_ada[2048 + j];
#pragma unroll
            for (int q = 0; q < 8; ++q) s += modp[(size_t)q * 2 * 3072 + b * 3072 + 2048 + j];
            modf[b * 1024 + j] = s;
        }
    }
    __syncthreads();
    bf16_t* H = (bf16_t*)(p.ws + 0 * UNIT);
    for (int m0 = gw; m0 < M; m0 += 2 * NGW) {
        const int m1 = m0 + NGW < M ? m0 + NGW : m0;
        f32x4 v[2][4]; float s[2] = {0.f, 0.f};
#pragma unroll
        for (int u = 0; u < 2; ++u) { const f32x4* xr = (const f32x4*)(p.in[0] + (size_t)(u ? m1 : m0) * D) + lane;
#pragma unroll
            for (int j = 0; j < 4; ++j) v[u][j] = __builtin_nontemporal_load(xr + 64 * j); }
#pragma unroll
        for (int u = 0; u < 2; ++u) {
#pragma unroll
            for (int j = 0; j < 4; ++j) s[u] += (v[u][j].x * v[u][j].x + v[u][j].y * v[u][j].y) + (v[u][j].z * v[u][j].z + v[u][j].w * v[u][j].w);
            const int m = u ? m1 : m0; const int b = m / SEQ;
            const float rstd = rsqrtf(wave_sum(s[u]) * (1.f / D) + NORM_EPS);
            u32x2* o = (u32x2*)(H + (size_t)m * D) + lane;
#pragma unroll
            for (int j = 0; j < 4; ++j) {
                const f32x4 a = *(const f32x4*)(a_tab + b * 1024 + 4 * lane + 256 * j), sh = *(const f32x4*)(s_tab + b * 1024 + 4 * lane + 256 * j);
                const f32x4 hh = v[u][j] * rstd * a + sh;
                u32x2 w; w.x = cvt_pk_bf16(hh.x, hh.y); w.y = cvt_pk_bf16(hh.z, hh.w); o[64 * j] = w;
            }
        }
    }
    __syncthreads();
}
DI void ab_item(const Params& p, int item, int lane) {
    unsigned char* ws = p.ws; const int il = lane & 15, q = lane >> 4;
    const bf16_t* Hr = (const bf16_t*)(ws + 0 * UNIT) + (size_t)(item * 16 + il) * D + 8 * q;
    const bf16_t* W0 = (const bf16_t*)(ws + WS_WIN) + (size_t)(10240 + il) * D + 8 * q; const bf16_t* W1 = W0 + (size_t)16 * D;
    f32x4 a0 = {0.f, 0.f, 0.f, 0.f}, a1 = {0.f, 0.f, 0.f, 0.f};
#pragma unroll 8
    for (int ks = 0; ks < 32; ++ks) { const bf16x8 hf = *(const bf16x8*)(Hr + 32 * ks);
        a0 = __builtin_amdgcn_mfma_f32_16x16x32_bf16(hf, *(const bf16x8*)(W0 + 32 * ks), a0, 0, 0, 0); a1 = __builtin_amdgcn_mfma_f32_16x16x32_bf16(hf, *(const bf16x8*)(W1 + 32 * ks), a1, 0, 0, 0); }
    float* AB = (float*)(ws + WS_AB) + (size_t)(item * 16 + 4 * q) * 32 + il;
#pragma unroll
    for (int r = 0; r < 4; ++r) { AB[r * 32] = a0[r]; AB[r * 32 + 16] = a1[r]; }
}
DI void phase3_item(const Params& p, int item, int lane) {
    unsigned char* ws = p.ws;
    const bf16_t* Qr = (const bf16_t*)(ws + 1 * UNIT); const bf16_t* Kr = (const bf16_t*)(ws + 2 * UNIT); const bf16_t* Vr = (const bf16_t*)(ws + 3 * UNIT);
    bf16_t* Qn = (bf16_t*)(ws + 4 * UNIT); bf16_t* Kn = (bf16_t*)(ws + 5 * UNIT); bf16_t* Vc = (bf16_t*)p.out;
    const int tg = item & 255, h = (item >> 8) & 7, b = item >> 11; const int t_base = tg * 32; const size_t rb = (size_t)b * SEQ;
    const int col = h * 128 + 2 * lane; const int pcol = h * 128 + permpos(2 * lane);
    const float* cw = p.in[7];
    f32x2 wq[5], wk[5], wv[5];
#pragma unroll
    for (int j = 0; j < 5; ++j) { wq[j] = *(const f32x2*)(cw + j * 3072 + col); wk[j] = *(const f32x2*)(cw + j * 3072 + 1024 + col); wv[j] = *(const f32x2*)(cw + j * 3072 + 2048 + col); }
#pragma unroll
    for (int hf = 0; hf < 2; ++hf) {
        unsigned rq[20], rk[20], rv[20];
#pragma unroll
        for (int j = 0; j < 20; ++j) {
            const int t = t_base + 16 * hf - 2 + j; const bool ok = (t >= 0) && (t < SEQ); const int tc = t < 0 ? 0 : (t >= SEQ ? SEQ - 1 : t);
            const size_t off = (rb + tc) * D + col;
            const unsigned a0 = *(const unsigned*)(Qr + off), a1 = *(const unsigned*)(Kr + off), a2 = *(const unsigned*)(Vr + off);
            rq[j] = ok ? a0 : 0u; rk[j] = ok ? a1 : 0u; rv[j] = ok ? a2 : 0u;
        }
#pragma unroll
        for (int t16 = 0; t16 < 16; ++t16) {
            const int tt = 16 * hf + t16, t = t_base + tt;
            float q0 = 0.f, q1 = 0.f, k0 = 0.f, k1 = 0.f, v0 = 0.f, v1 = 0.f;
#pragma unroll
            for (int j = 0; j < 5; ++j) { q0 += wq[j].x * bf_lo(rq[t16 + j]); q1 += wq[j].y * bf_hi(rq[t16 + j]); k0 += wk[j].x * bf_lo(rk[t16 + j]); k1 += wk[j].y * bf_hi(rk[t16 + j]); v0 += wv[j].x * bf_lo(rv[t16 + j]); v1 += wv[j].y * bf_hi(rv[t16 + j]); }
            q0 = siluf_(q0); q1 = siluf_(q1); k0 = siluf_(k0); k1 = siluf_(k1); v0 = siluf_(v0); v1 = siluf_(v1);
            const float rq_ = rsqrtf(wave_sum(q0 * q0 + q1 * q1) + L2_EPS) * 0.08838834764831845f, rk_ = rsqrtf(wave_sum(k0 * k0 + k1 * k1) + L2_EPS);
            q0 *= rq_; q1 *= rq_; k0 *= rk_; k1 *= rk_;
            const size_t ro = (rb + t) * D;
            *(unsigned*)(Qn + ro + pcol) = cvt_pk_bf16(q0, q1); *(unsigned*)(Kn + ro + pcol) = cvt_pk_bf16(k0, k1); *(unsigned*)(Vc + ro + col) = cvt_pk_bf16(v0, v1);
        }
    }
    { const int i = lane & 31, dir = lane >> 5; const size_t row = rb + t_base + i; const float* AB = (const float*)(ws + WS_AB);
      const float a_raw = AB[row * 32 + dir * 8 + h], b_raw = AB[row * 32 + 16 + dir * 8 + h];
      const float g = -__expf(p.in[8][dir * 8 + h]) * softplusf_(a_raw + p.in[9][dir * 8 + h]);
      ((float*)(ws + WS_G))[row * 16 + dir * 8 + h] = g; ((float*)(ws + WS_BETA))[row * 16 + dir * 8 + h] = sigmoidf_(b_raw); }
}
DI void naive_scan(const Params& p, float* ldsw, int task, int lane) {
    unsigned char* ws = p.ws;
    const bf16_t* Qn = (const bf16_t*)(ws + 4 * UNIT); const bf16_t* Kn = (const bf16_t*)(ws + 5 * UNIT); const bf16_t* Vc = (const bf16_t*)p.out;
    const float* G = (const float*)(ws + WS_G); const float* BE = (const float*)(ws + WS_BETA);
    const int chain = task >> 1, b = chain >> 4, dir = (chain >> 3) & 1, h = chain & 7, e = (task & 1) * 64 + lane;
    bf16_t* O = (dir ? (bf16_t*)(p.out) + (size_t)M * D : (bf16_t*)(ws + 3 * UNIT));
    float* kb = ldsw; float* qb = ldsw + 128;
    float P[128];
#pragma unroll
    for (int d = 0; d < 128; ++d) P[d] = 0.f;
    for (int n = 0; n < SEQ; ++n) {
        const int t = dir ? SEQ - 1 - n : n; const size_t row = (size_t)b * SEQ + t;
        const unsigned ku = *(const unsigned*)(Kn + row * D + h * 128 + 2 * lane), qu = *(const unsigned*)(Qn + row * D + h * 128 + 2 * lane);
        const float v = bf1(Vc[row * D + h * 128 + e]); const float al = __expf(G[row * 16 + dir * 8 + h]), be = BE[row * 16 + dir * 8 + h];
        kb[2 * lane] = bf_lo(ku); kb[2 * lane + 1] = bf_hi(ku); qb[2 * lane] = bf_lo(qu); qb[2 * lane + 1] = bf_hi(qu);
        asm volatile("s_waitcnt lgkmcnt(0)" ::: "memory");
        float sk = 0.f;
#pragma unroll
        for (int d4 = 0; d4 < 32; ++d4) { if ((d4 & 3) == 0) __builtin_amdgcn_sched_barrier(0); const f32x4 k4 = *(const f32x4*)(kb + 4 * d4); sk += P[4 * d4] * k4.x + P[4 * d4 + 1] * k4.y + P[4 * d4 + 2] * k4.z + P[4 * d4 + 3] * k4.w; }
        const float vn = be * (v - al * sk); float o = 0.f;
#pragma unroll
        for (int d4 = 0; d4 < 32; ++d4) { if ((d4 & 3) == 0) __builtin_amdgcn_sched_barrier(0); const f32x4 k4 = *(const f32x4*)(kb + 4 * d4), q4 = *(const f32x4*)(qb + 4 * d4);
            P[4 * d4] = al * P[4 * d4] + k4.x * vn; P[4 * d4 + 1] = al * P[4 * d4 + 1] + k4.y * vn; P[4 * d4 + 2] = al * P[4 * d4 + 2] + k4.z * vn; P[4 * d4 + 3] = al * P[4 * d4 + 3] + k4.w * vn;
            o += P[4 * d4] * q4.x + P[4 * d4 + 1] * q4.y + P[4 * d4 + 2] * q4.z + P[4 * d4 + 3] * q4.w; }
        O[row * D + h * 128 + e] = (bf16_t)(cvt_pk_bf16(o, 0.f) & 0xffffu);
        asm volatile("s_waitcnt lgkmcnt(0)" ::: "memory");
    }
}
DI void ya_acc(float (&acc)[8], const u32x4& pv, const f32x4& wa, const f32x4& wb) {
    acc[0] += wa.x * bf_lo(pv.x); acc[1] += wa.y * bf_hi(pv.x); acc[2] += wa.z * bf_lo(pv.y); acc[3] += wa.w * bf_hi(pv.y);
    acc[4] += wb.x * bf_lo(pv.z); acc[5] += wb.y * bf_hi(pv.z); acc[6] += wb.z * bf_lo(pv.w); acc[7] += wb.w * bf_hi(pv.w);
}
DI void phase7(const Params& p, int gw, int NGW, int lane, int gtid, int NGT) {
    unsigned char* ws = p.ws;
    const bf16_t* Pb = (const bf16_t*)(ws + 1 * UNIT); bf16_t* R = (bf16_t*)(ws + 2 * UNIT); const float* cw = p.in[6];
    for (int it = gtid; it < (M / 4) * 128; it += NGT) {
        const int row0 = (it >> 7) * 4, c8 = (it & 127) * 8, t0 = row0 & (SEQ - 1);
        const u32x4 z = (u32x4){0u, 0u, 0u, 0u};
        u32x4 pv[6], rv[4];
        { const u32x4 t_ = *(const u32x4*)(Pb + (size_t)(t0 > 0 ? row0 - 1 : row0) * D + c8); pv[0] = t0 > 0 ? t_ : z; }
#pragma unroll
        for (int j = 0; j < 4; ++j) { pv[j + 1] = *(const u32x4*)(Pb + (size_t)(row0 + j) * D + c8); rv[j] = *(const u32x4*)(R + (size_t)(row0 + j) * D + c8); }
        { const u32x4 t_ = *(const u32x4*)(Pb + (size_t)(t0 + 4 < SEQ ? row0 + 4 : row0) * D + c8); pv[5] = t0 + 4 < SEQ ? t_ : z; }
        f32x4 wa[3], wb[3];
#pragma unroll
        for (int j = 0; j < 3; ++j) { wa[j] = *(const f32x4*)(cw + j * D + c8); wb[j] = *(const f32x4*)(cw + j * D + c8 + 4); }
#pragma unroll
        for (int j = 0; j < 4; ++j) {
            float acc[8] = {0.f, 0.f, 0.f, 0.f, 0.f, 0.f, 0.f, 0.f};
            ya_acc(acc, pv[j], wa[0], wb[0]); ya_acc(acc, pv[j + 1], wa[1], wb[1]); ya_acc(acc, pv[j + 2], wa[2], wb[2]);
            u32x4 o; const u32x4 r = rv[j];
            o.x = cvt_pk_bf16(bf_lo(r.x) * acc[0], bf_hi(r.x) * acc[1]); o.y = cvt_pk_bf16(bf_lo(r.y) * acc[2], bf_hi(r.y) * acc[3]);
            o.z = cvt_pk_bf16(bf_lo(r.z) * acc[4], bf_hi(r.z) * acc[5]); o.w = cvt_pk_bf16(bf_lo(r.w) * acc[6], bf_hi(r.w) * acc[7]);
            *(u32x4*)(R + (size_t)(row0 + j) * D + c8) = o;
        }
    }
    const bf16_t* Of = (const bf16_t*)(ws + 3 * UNIT); const bf16_t* Ob = (const bf16_t*)p.out + (size_t)M * D; bf16_t* SZ = (bf16_t*)(ws + 6 * UNIT);
    const f32x4 g0 = *(const f32x4*)(p.in[10] + (lane & 15) * 8), g1 = *(const f32x4*)(p.in[10] + (lane & 15) * 8 + 4);
    for (int rp = gw; rp < M / 2; rp += NGW) {
        u32x4 a[4], bb[4], zz[4];
#pragma unroll
        for (int u = 0; u < 4; ++u) { const size_t off = (size_t)(rp * 2 + (u >> 1)) * D + (u & 1) * 512 + lane * 8;
            a[u] = __builtin_nontemporal_load((const u32x4*)(Of + off)); bb[u] = __builtin_nontemporal_load((const u32x4*)(Ob + off)); zz[u] = __builtin_nontemporal_load((const u32x4*)(SZ + off)); }
#pragma unroll
        for (int u = 0; u < 4; ++u) { const size_t off = (size_t)(rp * 2 + (u >> 1)) * D + (u & 1) * 512 + lane * 8;
            float o[8];
            o[0] = bf_lo(a[u].x) + bf_lo(bb[u].x); o[1] = bf_hi(a[u].x) + bf_hi(bb[u].x); o[2] = bf_lo(a[u].y) + bf_lo(bb[u].y); o[3] = bf_hi(a[u].y) + bf_hi(bb[u].y);
            o[4] = bf_lo(a[u].z) + bf_lo(bb[u].z); o[5] = bf_hi(a[u].z) + bf_hi(bb[u].z); o[6] = bf_lo(a[u].w) + bf_lo(bb[u].w); o[7] = bf_hi(a[u].w) + bf_hi(bb[u].w);
            float ss = 0.f;
#pragma unroll
            for (int j = 0; j < 8; ++j) ss += o[j] * o[j];
            ss = row16_sum(ss);
            const float rs = rsqrtf(ss * (1.f / 128.f) + NORM_EPS);
            u32x4 w;
            w.x = cvt_pk_bf16(o[0] * rs * g0.x * bf_lo(zz[u].x), o[1] * rs * g0.y * bf_hi(zz[u].x)); w.y = cvt_pk_bf16(o[2] * rs * g0.z * bf_lo(zz[u].y), o[3] * rs * g0.w * bf_hi(zz[u].y));
            w.z = cvt_pk_bf16(o[4] * rs * g1.x * bf_lo(zz[u].z), o[5] * rs * g1.y * bf_hi(zz[u].z)); w.w = cvt_pk_bf16(o[6] * rs * g1.z * bf_lo(zz[u].w), o[7] * rs * g1.w * bf_hi(zz[u].w));
            *(u32x4*)(SZ + off) = w;
        }
    }
}
DI void phase10(const Params& p, int gw, int NGW, int lane) {
    const float* XN = (const float*)(p.ws + 0 * UNIT); const float* fw = p.in[14];
    f32x4 w[4];
#pragma unroll
    for (int j = 0; j < 4; ++j) w[j] = *((const f32x4*)fw + lane + 64 * j);
    for (int m = gw; m < M; m += NGW) {
        const f32x4* xr = (const f32x4*)(XN + (size_t)m * D) + lane; f32x4 v[4]; float s = 0.f;
#pragma unroll
        for (int j = 0; j < 4; ++j) { v[j] = xr[64 * j]; s += (v[j].x * v[j].x + v[j].y * v[j].y) + (v[j].z * v[j].z + v[j].w * v[j].w); }
        const float rstd = rsqrtf(wave_sum(s) * (1.f / D) + NORM_EPS);
        f32x4* o = (f32x4*)(p.out + (size_t)m * D) + lane;
#pragma unroll
        for (int j = 0; j < 4; ++j) o[64 * j] = v[j] * rstd * w[j];
    }
}
#define MFMA16(a, b, c) __builtin_amdgcn_mfma_f32_16x16x32_bf16((a), (b), (c), 0, 0, 0)
DI void chunk_prep_item(const Params& p, float* Lm, int item, int lane) {
    unsigned char* ws = p.ws;
    const bf16_t* Qn = (const bf16_t*)(ws + 4 * UNIT); const bf16_t* Kn = (const bf16_t*)(ws + 5 * UNIT);
    bf16_t* TF = (bf16_t*)(ws + 1 * UNIT) + (size_t)item * 4096; bf16_t* AF = (bf16_t*)(ws + 2 * UNIT) + (size_t)item * 4096;
    float* csc = (float*)(ws + WS_CSC) + (size_t)item * 192;
    const int c = item & 127, h = (item >> 7) & 7, dir = (item >> 10) & 1, b = item >> 11;
    const size_t rb = (size_t)b * SEQ + c * 64; const int il = lane & 15, q = lane >> 4;
    const int tl = dir ? 63 - lane : lane;
    const float g = ((const float*)(ws + WS_G))[(rb + tl) * 16 + dir * 8 + h], be = ((const float*)(ws + WS_BETA))[(rb + tl) * 16 + dir * 8 + h];
    float gc = g;
#pragma unroll
    for (int o = 1; o < 64; o <<= 1) { const float v = __shfl_up(gc, o); if (lane >= o) gc += v; }
    const float gl = __shfl(gc, 63);
    csc[tl] = __expf(gc); csc[64 + tl] = be; csc[128 + tl] = __expf(gl - gc);
    float gcr[4][4], ber[4][4], gcc[4];
#pragma unroll
    for (int t = 0; t < 4; ++t) { gcc[t] = __shfl(gc, 16 * t + il);
#pragma unroll
        for (int r = 0; r < 4; ++r) { gcr[t][r] = __shfl(gc, 16 * t + 4 * q + r); ber[t][r] = __shfl(be, 16 * t + 4 * q + r); } }
    bf16x8 Kf[4][4];
#pragma unroll
    for (int rt = 0; rt < 4; ++rt) { const int ip = 16 * rt + il; const size_t ro = (rb + (dir ? 63 - ip : ip)) * D + h * 128 + 8 * q;
#pragma unroll
        for (int ks = 0; ks < 4; ++ks) Kf[rt][ks] = *(const bf16x8*)(Kn + ro + 32 * ks); }
#pragma unroll
    for (int it = 0; it < 4; ++it)
#pragma unroll
        for (int jt = 0; jt <= it; ++jt) {
            f32x4 acc = {0.f, 0.f, 0.f, 0.f};
#pragma unroll
            for (int ks = 0; ks < 4; ++ks) acc = MFMA16(Kf[it][ks], Kf[jt][ks], acc);
#pragma unroll
            for (int r = 0; r < 4; ++r) { const int ip = 16 * it + 4 * q + r, jp = 16 * jt + il;
                Lm[ip * 64 + jp] = ip > jp ? ber[it][r] * acc[r] * __expf(gcr[it][r] - gcc[jt]) : 0.f; }
        }
    __builtin_amdgcn_sched_barrier(0);
    bf16x8 Qnext[4];
    { const int ip = il; const size_t ro = (rb + (dir ? 63 - ip : ip)) * D + h * 128 + 8 * q;
#pragma unroll
      for (int ks = 0; ks < 4; ++ks) Qnext[ks] = *(const bf16x8*)(Qn + ro + 32 * ks); }
#pragma unroll
    for (int mt = 0; mt < 4; ++mt) {
        bf16x8 Qf[4];
#pragma unroll
        for (int ks = 0; ks < 4; ++ks) Qf[ks] = Qnext[ks];
        if (mt < 3) { const int ip = 16 * (mt + 1) + il; const size_t ro = (rb + (dir ? 63 - ip : ip)) * D + h * 128 + 8 * q;
#pragma unroll
          for (int ks = 0; ks < 4; ++ks) Qnext[ks] = *(const bf16x8*)(Qn + ro + 32 * ks); }
#pragma unroll
        for (int ks2 = 0; ks2 < 2; ++ks2) {
            float vals[8];
#pragma unroll
            for (int a = 0; a < 2; ++a) { const int jt = 2 * ks2 + a; f32x4 acc = {0.f, 0.f, 0.f, 0.f};
#pragma unroll
                for (int ks = 0; ks < 4; ++ks) acc = MFMA16(Kf[jt][ks], Qf[ks], acc);
#pragma unroll
                for (int r = 0; r < 4; ++r) { const int jp = 16 * jt + 4 * q + r, ip = 16 * mt + il; vals[4 * a + r] = ip >= jp ? acc[r] * __expf(gcc[mt] - gcr[jt][r]) : 0.f; } }
            u32x4 w;
            if (dir) { w.x = cvt_pk_bf16(vals[7], vals[6]); w.y = cvt_pk_bf16(vals[5], vals[4]); w.z = cvt_pk_bf16(vals[3], vals[2]); w.w = cvt_pk_bf16(vals[1], vals[0]); }
            else { w.x = cvt_pk_bf16(vals[0], vals[1]); w.y = cvt_pk_bf16(vals[2], vals[3]); w.z = cvt_pk_bf16(vals[4], vals[5]); w.w = cvt_pk_bf16(vals[6], vals[7]); }
            const int fi = dir ? ((3 - mt) * 2 + (1 - ks2)) : (mt * 2 + ks2), ln = dir ? ((3 - q) * 16 + (15 - il)) : lane;
            *(u32x4*)(AF + (size_t)(fi * 64 + ln) * 8) = w;
        }
        __builtin_amdgcn_sched_barrier(0);
    }
    asm volatile("s_waitcnt lgkmcnt(0)" ::: "memory");
    __builtin_amdgcn_sched_barrier(0);
    float T[64];
#pragma unroll
    for (int i = 0; i < 64; ++i) {
        float s0 = (lane == i) ? 1.f : 0.f, s1 = 0.f;
#pragma unroll
        for (int m4 = 0; m4 < (i + 3) / 4; ++m4) {
            const f32x4 l4 = *(const f32x4*)(Lm + i * 64 + 4 * m4);
            if (4 * m4 + 0 < i) s0 -= l4.x * T[4 * m4 + 0];
            if (4 * m4 + 1 < i) s1 -= l4.y * T[4 * m4 + 1];
            if (4 * m4 + 2 < i) s0 -= l4.z * T[4 * m4 + 2];
            if (4 * m4 + 3 < i) s1 -= l4.w * T[4 * m4 + 3];
        }
        T[i] = s0 + s1;
        if ((i & 3) == 3) __builtin_amdgcn_sched_barrier(0);
    }
    asm volatile("s_waitcnt lgkmcnt(0)" ::: "memory");
    bf16_t* TL = (bf16_t*)Lm;
#pragma unroll
    for (int i = 0; i < 64; ++i) TL[i * 72 + lane] = (bf16_t)(cvt_pk_bf16(T[i], 0.f) & 0xffffu);
    asm volatile("s_waitcnt lgkmcnt(0)" ::: "memory");
#pragma unroll
    for (int mt = 0; mt < 4; ++mt)
#pragma unroll
        for (int ks2 = 0; ks2 < 2; ++ks2) {
            u32x4 w;
            if (dir) {
                const int row = 63 - 16 * mt - il;
                const u32x2 lo = *(const u32x2*)(TL + row * 72 + (60 - 32 * ks2 - 4 * q)), hi = *(const u32x2*)(TL + row * 72 + (44 - 32 * ks2 - 4 * q));
                w.x = (lo.y >> 16) | (lo.y << 16); w.y = (lo.x >> 16) | (lo.x << 16); w.z = (hi.y >> 16) | (hi.y << 16); w.w = (hi.x >> 16) | (hi.x << 16);
            } else {
                const int row = 16 * mt + il;
                const u32x2 lo = *(const u32x2*)(TL + row * 72 + (32 * ks2 + 4 * q)), hi = *(const u32x2*)(TL + row * 72 + (32 * ks2 + 16 + 4 * q));
                w.x = lo.x; w.y = lo.y; w.z = hi.x; w.w = hi.y;
            }
            *(u32x4*)(TF + (size_t)((mt * 2 + ks2) * 64 + lane) * 8) = w;
        }
    asm volatile("s_waitcnt lgkmcnt(0)" ::: "memory");
}
DI bf16x8 pack8(const f32x4& a, const f32x4& b) {
    u32x4 w; w.x = cvt_pk_bf16(a[0], a[1]); w.y = cvt_pk_bf16(a[2], a[3]); w.z = cvt_pk_bf16(b[0], b[1]); w.w = cvt_pk_bf16(b[2], b[3]);
    return __builtin_bit_cast(bf16x8, w);
}
DI void mfma_scan(const Params& p, int chain, int slice, int lane) {
    unsigned char* ws = p.ws;
    const bf16_t* Qn = (const bf16_t*)(ws + 4 * UNIT); const bf16_t* Kn = (const bf16_t*)(ws + 5 * UNIT); const bf16_t* KT = (const bf16_t*)(ws + 6 * UNIT); const bf16_t* Vc = (const bf16_t*)p.out;
    const bf16_t* TFb = (const bf16_t*)(ws + 1 * UNIT); const bf16_t* AFb = (const bf16_t*)(ws + 2 * UNIT); const float* cscb = (const float*)(ws + WS_CSC);
    const int b = chain >> 4, dir = (chain >> 3) & 1, h = chain & 7, il = lane & 15, q = lane >> 4;
    bf16_t* O = (dir ? (bf16_t*)(p.out) + (size_t)M * D : (bf16_t*)(ws + 3 * UNIT));
    f32x4 S[8];
#pragma unroll
    for (int dt = 0; dt < 8; ++dt) S[dt] = (f32x4){0.f, 0.f, 0.f, 0.f};
    for (int n = 0; n < 128; ++n) {
        const int c = dir ? 127 - n : n; const int item = chain * 128 + c; const size_t rowbase = (size_t)b * SEQ + c * 64;
        const bf16_t* TF = TFb + (size_t)item * 4096 + lane * 8; const bf16_t* AF = AFb + (size_t)item * 4096 + lane * 8; const float* csc = cscb + (size_t)item * 192;
        const float gl = csc[dir ? 0 : 63];
        f32x4 EG[4], BE[4], EK[4], V[4];
#pragma unroll
        for (int mt = 0; mt < 4; ++mt) { EG[mt] = *(const f32x4*)(csc + 16 * mt + 4 * q); BE[mt] = *(const f32x4*)(csc + 64 + 16 * mt + 4 * q); EK[mt] = *(const f32x4*)(csc + 128 + 16 * mt + 4 * q);
#pragma unroll
            for (int r = 0; r < 4; ++r) V[mt][r] = bf1(Vc[(rowbase + 16 * mt + 4 * q + r) * D + h * 128 + 16 * slice + il]); }
        bf16x8 Sb[4];
#pragma unroll
        for (int ks = 0; ks < 4; ++ks) Sb[ks] = pack8(S[2 * ks], S[2 * ks + 1]);
        f32x4 KS[4], QS[4];
#pragma unroll
        for (int mt = 0; mt < 4; ++mt) { const size_t ro = (rowbase + 16 * mt + il) * D + h * 128 + 8 * q;
            KS[mt] = (f32x4){0.f, 0.f, 0.f, 0.f}; QS[mt] = (f32x4){0.f, 0.f, 0.f, 0.f};
#pragma unroll
            for (int ks = 0; ks < 4; ++ks) { KS[mt] = MFMA16(*(const bf16x8*)(Kn + ro + 32 * ks), Sb[ks], KS[mt]); QS[mt] = MFMA16(*(const bf16x8*)(Qn + ro + 32 * ks), Sb[ks], QS[mt]); } }
        f32x4 X[4];
#pragma unroll
        for (int mt = 0; mt < 4; ++mt) X[mt] = BE[mt] * (V[mt] - EG[mt] * KS[mt]);
        bf16x8 Xb[2] = {pack8(X[0], X[1]), pack8(X[2], X[3])};
        f32x4 VN[4];
#pragma unroll
        for (int mt = 0; mt < 4; ++mt) { VN[mt] = (f32x4){0.f, 0.f, 0.f, 0.f};
#pragma unroll
            for (int ks2 = 0; ks2 < 2; ++ks2) VN[mt] = MFMA16(*(const bf16x8*)(TF + (size_t)((mt * 2 + ks2) * 64) * 8), Xb[ks2], VN[mt]); }
        bf16x8 VNb[2] = {pack8(VN[0], VN[1]), pack8(VN[2], VN[3])};
        bf16x8 VNs[2] = {pack8(VN[0] * EK[0], VN[1] * EK[1]), pack8(VN[2] * EK[2], VN[3] * EK[3])};
#pragma unroll
        for (int mt = 0; mt < 4; ++mt) { f32x4 o = EG[mt] * QS[mt];
#pragma unroll
            for (int ks2 = 0; ks2 < 2; ++ks2) o = MFMA16(*(const bf16x8*)(AF + (size_t)((mt * 2 + ks2) * 64) * 8), VNb[ks2], o);
#pragma unroll
            for (int r = 0; r < 4; ++r) O[(rowbase + 16 * mt + 4 * q + r) * D + h * 128 + 16 * slice + il] = (bf16_t)(cvt_pk_bf16(o[r], 0.f) & 0xffffu); }
#pragma unroll
        for (int dt = 0; dt < 8; ++dt) { const bf16_t* kt = KT + ((size_t)((b * 8 + h) * 128 + 16 * dt + il)) * SEQ + c * 64 + 8 * q; f32x4 s = S[dt] * gl;
#pragma unroll
            for (int ks2 = 0; ks2 < 2; ++ks2) s = MFMA16(*(const bf16x8*)(kt + 32 * ks2), VNs[ks2], s);
            S[dt] = s; }
    }
}
constexpr int SC_K = 0, SC_Q = 16384, SC_T = 32768, SC_A = 40960, SC_V = 49152, SC_C = 51200, SC_BUF = 52224, SC_NPIECE = 3248, SC_NLD = 384, SC_PPL = 9;
constexpr int SC_SB = 2 * SC_BUF, SC_VB = SC_SB + 2 * 4096, SC_END = SC_VB + 2 * 2048;
static_assert(SC_END <= LDS_BYTES - 256, "scan LDS");
typedef short s16x4_t __attribute__((ext_vector_type(4)));
#define SC_BAR() do { asm volatile("s_waitcnt lgkmcnt(0)" ::: "memory"); __builtin_amdgcn_s_barrier(); asm volatile("" ::: "memory"); } while (0)
DI void scan_task(const Params& p, PG8_LAS unsigned char* lds, int chain, int slice, int tid, int wave, int lane) {
    unsigned char* ws = p.ws;
    const int b = chain >> 4, dir = (chain >> 3) & 1, h = chain & 7, il = lane & 15, q = lane >> 4;
    const int c0 = dir ? 127 : 0; const long sgn = dir ? -1 : 1;
    if (wave >= 2) {
        const int lt = tid - 128; const int wbase = 64 * (wave - 2);
        const unsigned char* gp[SC_PPL]; int gstride[SC_PPL];
        const size_t rowbase0 = (size_t)b * SEQ + c0 * 64; const size_t item0 = (size_t)chain * 128 + c0;
#pragma unroll
        for (int k = 0; k < SC_PPL; ++k) {
            int pid = lt + SC_NLD * k; if (pid >= SC_NPIECE) pid -= 64;
            const unsigned char* g = ws; int st = 0;
            if (pid < 2048) { const int pp = pid & 1023, row = pp >> 4, ch = (pp & 15) ^ (row & 15);
                g = ws + (pid < 1024 ? 5 : 4) * UNIT + ((rowbase0 + row) * D + h * 128) * 2 + ch * 16; st = 64 * D * 2; }
            else if (pid < 3072) { const int pp = pid & 511; const bool isT = pid < 2560;
                g = ws + (isT ? 1 : 2) * UNIT + item0 * 8192 + pp * 16; st = 8192; }
            else if (pid < 3200) { const int pp = pid - 3072, row = pp >> 1, hf = pp & 1;
                g = (const unsigned char*)p.out + ((rowbase0 + row) * D + h * 128 + slice * 16) * 2 + hf * 16; st = 64 * D * 2; }
            else { const int pp = pid - 3200; g = ws + WS_CSC + item0 * 768 + pp * 16; st = 768; }
            gp[k] = g; gstride[k] = st;
        }
#define SC_DMA(bo) do { _Pragma("unroll") for (int k = 0; k < SC_PPL; ++k) { if (wbase + SC_NLD * k < SC_NPIECE) \
            __builtin_amdgcn_global_load_lds((const unsigned*)gp[k], (PG8_LAS unsigned*)(lds + (bo) + (wbase + SC_NLD * k) * 16), 16, 0, 0); gp[k] += sgn * gstride[k]; } } while (0)
        SC_DMA(0u);
        asm volatile("s_waitcnt vmcnt(0)" ::: "memory");
        SC_BAR();
        for (int n = 0; n < 128; ++n) {
            if (n + 1 < 128) SC_DMA((unsigned)(((n + 1) & 1) * SC_BUF));
            asm volatile("s_waitcnt vmcnt(0)" ::: "memory");
            SC_BAR();
        }
#undef SC_DMA
    } else if (wave == 0) {
        f32x4 S[8];
#pragma unroll
        for (int dt = 0; dt < 8; ++dt) S[dt] = (f32x4){0.f, 0.f, 0.f, 0.f};
        bf16x8 Sb[4];
#pragma unroll
        for (int ks = 0; ks < 4; ++ks) { Sb[ks] = pack8(S[2 * ks], S[2 * ks + 1]); *(PG8_LAS bf16x8*)(lds + SC_SB + (ks * 64 + lane) * 16) = Sb[ks]; }
        SC_BAR();
        for (int n = 0; n < 128; ++n) {
            PG8_LAS unsigned char* L = lds + (n & 1) * SC_BUF;
            bf16x8 Kf[4][4];
#pragma unroll
            for (int mt = 0; mt < 4; ++mt)
#pragma unroll
                for (int ks = 0; ks < 4; ++ks) Kf[mt][ks] = *(PG8_LAS bf16x8*)(L + SC_K + (16 * mt + il) * 256 + (((4 * ks + q) ^ il) << 4));
            f32x4 EG[4], BE[4], V[4]; bf16x8 Tf[4][2];
#pragma unroll
            for (int mt = 0; mt < 4; ++mt) { EG[mt] = *(PG8_LAS f32x4*)(L + SC_C + (16 * mt + 4 * q) * 4); BE[mt] = *(PG8_LAS f32x4*)(L + SC_C + 256 + (16 * mt + 4 * q) * 4);
#pragma unroll
                for (int r = 0; r < 4; ++r) V[mt][r] = bf1(*(PG8_LAS bf16_t*)(L + SC_V + (16 * mt + 4 * q + r) * 32 + il * 2));
#pragma unroll
                for (int ks2 = 0; ks2 < 2; ++ks2) Tf[mt][ks2] = *(PG8_LAS bf16x8*)(L + SC_T + ((mt * 2 + ks2) * 64 + lane) * 16); }
            f32x4 KS[4];
#pragma unroll
            for (int mt = 0; mt < 4; ++mt) KS[mt] = (f32x4){0.f, 0.f, 0.f, 0.f};
#pragma unroll
            for (int ks = 0; ks < 4; ++ks)
#pragma unroll
                for (int mt = 0; mt < 4; ++mt) KS[mt] = MFMA16(Kf[mt][ks], Sb[ks], KS[mt]);
            __builtin_amdgcn_sched_barrier(0);
            bf16x8 KTf[8][2]; f32x4 EK[4];
            { const int rr = il >> 2, pc = il & 3;
              PG8_LAS unsigned char* kb = L + SC_K + (4 * q + rr) * 256;
#pragma unroll
              for (int dt = 0; dt < 8; ++dt) {
                const int cho = (((4 * (dt >> 1) + pc) ^ (4 * q + rr)) << 4) + 8 * (dt & 1);
#pragma unroll
                for (int ks2 = 0; ks2 < 2; ++ks2) {
                    const s16x4_t lo_ = __builtin_amdgcn_ds_read_tr16_b64_v4i16((PG8_LAS s16x4_t*)(kb + (32 * ks2) * 256 + cho));
                    const s16x4_t hi_ = __builtin_amdgcn_ds_read_tr16_b64_v4i16((PG8_LAS s16x4_t*)(kb + (32 * ks2 + 16) * 256 + cho));
                    KTf[dt][ks2] = __builtin_shufflevector(lo_, hi_, 0, 1, 2, 3, 4, 5, 6, 7);
                } } }
#pragma unroll
            for (int mt = 0; mt < 4; ++mt) EK[mt] = *(PG8_LAS f32x4*)(L + SC_C + 512 + (16 * mt + 4 * q) * 4);
            const float gl = *(PG8_LAS float*)(L + SC_C + (dir ? 0 : 63) * 4);
            f32x4 X[4];
#pragma unroll
            for (int mt = 0; mt < 4; ++mt) X[mt] = BE[mt] * (V[mt] - EG[mt] * KS[mt]);
            bf16x8 Xb[2] = {pack8(X[0], X[1]), pack8(X[2], X[3])};
            f32x4 VN[4];
#pragma unroll
            for (int mt = 0; mt < 4; ++mt) VN[mt] = (f32x4){0.f, 0.f, 0.f, 0.f};
#pragma unroll
            for (int ks2 = 0; ks2 < 2; ++ks2)
#pragma unroll
                for (int mt = 0; mt < 4; ++mt) VN[mt] = MFMA16(Tf[mt][ks2], Xb[ks2], VN[mt]);
            *(PG8_LAS bf16x8*)(lds + SC_VB + (n & 1) * 2048 + lane * 16) = pack8(VN[0], VN[1]); *(PG8_LAS bf16x8*)(lds + SC_VB + (n & 1) * 2048 + (64 + lane) * 16) = pack8(VN[2], VN[3]);
            bf16x8 VNs[2] = {pack8(VN[0] * EK[0], VN[1] * EK[1]), pack8(VN[2] * EK[2], VN[3] * EK[3])};
#pragma unroll
            for (int dt = 0; dt < 8; ++dt) S[dt] = S[dt] * gl;
#pragma unroll
            for (int ks2 = 0; ks2 < 2; ++ks2)
#pragma unroll
                for (int dt = 0; dt < 8; ++dt) S[dt] = MFMA16(KTf[dt][ks2], VNs[ks2], S[dt]);
#pragma unroll
            for (int ks = 0; ks < 4; ++ks) { Sb[ks] = pack8(S[2 * ks], S[2 * ks + 1]); *(PG8_LAS bf16x8*)(lds + SC_SB + ((n + 1) & 1) * 4096 + (ks * 64 + lane) * 16) = Sb[ks]; }
            SC_BAR();
        }
    } else {
        bf16_t* O = (dir ? (bf16_t*)(p.out) + (size_t)M * D : (bf16_t*)(ws + 3 * UNIT));
        f32x4 Oa[4]; bf16x8 Af[4][2];
#pragma unroll
        for (int mt = 0; mt < 4; ++mt) { Oa[mt] = (f32x4){0.f, 0.f, 0.f, 0.f}; Af[mt][0] = (bf16x8){0, 0, 0, 0, 0, 0, 0, 0}; Af[mt][1] = Af[mt][0]; }
        SC_BAR();
        for (int n = 0; n <= 128; ++n) {
            if (n > 0) {
                const int c = dir ? 128 - n : n - 1; const size_t rowbase = (size_t)b * SEQ + c * 64;
                PG8_LAS unsigned char* vb = lds + SC_VB + ((n - 1) & 1) * 2048;
                bf16x8 VNb[2] = {*(PG8_LAS bf16x8*)(vb + lane * 16), *(PG8_LAS bf16x8*)(vb + (64 + lane) * 16)};
#pragma unroll
                for (int ks2 = 0; ks2 < 2; ++ks2)
#pragma unroll
                    for (int mt = 0; mt < 4; ++mt) Oa[mt] = MFMA16(Af[mt][ks2], VNb[ks2], Oa[mt]);
#pragma unroll
                for (int mt = 0; mt < 4; ++mt)
#pragma unroll
                    for (int r = 0; r < 4; ++r) __builtin_nontemporal_store((bf16_t)(cvt_pk_bf16(Oa[mt][r], 0.f) & 0xffffu), O + (rowbase + 16 * mt + 4 * q + r) * D + h * 128 + 16 * slice + il);
            }
            if (n < 128) {
                PG8_LAS unsigned char* L = lds + (n & 1) * SC_BUF;
                bf16x8 Qf[4][4], Sb[4]; f32x4 EG[4];
#pragma unroll
                for (int ks = 0; ks < 4; ++ks) Sb[ks] = *(PG8_LAS bf16x8*)(lds + SC_SB + (n & 1) * 4096 + (ks * 64 + lane) * 16);
#pragma unroll
                for (int mt = 0; mt < 4; ++mt) {
#pragma unroll
                    for (int ks = 0; ks < 4; ++ks) Qf[mt][ks] = *(PG8_LAS bf16x8*)(L + SC_Q + (16 * mt + il) * 256 + (((4 * ks + q) ^ il) << 4));
                    EG[mt] = *(PG8_LAS f32x4*)(L + SC_C + (16 * mt + 4 * q) * 4);
#pragma unroll
                    for (int ks2 = 0; ks2 < 2; ++ks2) Af[mt][ks2] = *(PG8_LAS bf16x8*)(L + SC_A + ((mt * 2 + ks2) * 64 + lane) * 16); }
                f32x4 QS[4];
#pragma unroll
                for (int mt = 0; mt < 4; ++mt) QS[mt] = (f32x4){0.f, 0.f, 0.f, 0.f};
#pragma unroll
                for (int ks = 0; ks < 4; ++ks)
#pragma unroll
                    for (int mt = 0; mt < 4; ++mt) QS[mt] = MFMA16(Qf[mt][ks], Sb[ks], QS[mt]);
#pragma unroll
                for (int mt = 0; mt < 4; ++mt) Oa[mt] = EG[mt] * QS[mt];
                SC_BAR();
            }
        }
    }
}


typedef const __attribute__((address_space(4))) Params* kparams_t;
#if defined(__HIP_DEVICE_COMPILE__)
DI Params load_params() { kparams_t pp = (kparams_t)__builtin_amdgcn_kernarg_segment_ptr(); asm volatile("" : "+s"(pp)); return *pp; }
#else
DI Params load_params() { return Params{}; }
#endif
#define PP() load_params()
#define XB_TMO      128
#define XB_XCNT(j)  (256  + 64 * (j))
#define XB_XSUB(j)  (1280 + 64 * (j))
#define XB_XGEN(j)  (2304 + 64 * (j))
#define XB_TOP      3328
#define XB_TOPGEN   3392
#define XCD_BAR_WORDS 3456
#define XB_SPIN_CAP (1u << 18)
#define LAS __attribute__((address_space(3)))

__device__ __forceinline__ unsigned xb_ld(unsigned* p)              { return __hip_atomic_load(p, __ATOMIC_RELAXED, __HIP_MEMORY_SCOPE_AGENT); }
__device__ __forceinline__ unsigned xb_add(unsigned* p, unsigned v) { return __hip_atomic_fetch_add(p, v, __ATOMIC_RELAXED, __HIP_MEMORY_SCOPE_AGENT); }
__device__ __forceinline__ unsigned xb_xcc_id() { return (unsigned)__builtin_amdgcn_s_getreg((3 << 11) | 20) & 0xFu; }
#define XB_SPIN(cond, bar) do { unsigned _sp = 0; while (cond) { __builtin_amdgcn_s_sleep(1); \
    if ((++_sp & 255u) == 0u) { if (xb_ld(&(bar)[XB_TMO])) break; if (_sp > XB_SPIN_CAP) { atomicAdd(&(bar)[XB_TMO], 1u); break; } } } } while (0)

struct XcdBarrier {
    unsigned* bar; unsigned x;
    volatile LAS unsigned* st;
};

__device__ __forceinline__ XcdBarrier xcd_barrier_post(unsigned* bar, volatile LAS unsigned* st) {
    XcdBarrier b; b.bar = bar; b.x = xb_xcc_id(); b.st = st;
    if (threadIdx.x == 0) (void)xb_add(&bar[XB_XCNT(b.x)], 1u);
    return b;
}
__device__ __forceinline__ void xcd_barrier_complete(unsigned* bar, unsigned x, unsigned& nloc, unsigned& nx) {
    const unsigned G = gridDim.x * gridDim.y * gridDim.z;
    unsigned sum, cnt, mine, sp = 0u;
    for (;;) {
        sum = 0u; cnt = 0u; mine = 0u;
#pragma unroll
        for (unsigned j = 0; j < 16; ++j) { const unsigned c = xb_ld(&bar[XB_XCNT(j)]); sum += c; cnt += (c > 0u) ? 1u : 0u; mine = (j == x) ? c : mine; }
        if (sum == G) break;
        __builtin_amdgcn_s_sleep(1);
        if ((++sp & 255u) == 0u) { if (xb_ld(&bar[XB_TMO])) break; if (sp > XB_SPIN_CAP) { atomicAdd(&bar[XB_TMO], 1u); break; } }
    }
    nloc = mine > 0u ? mine : 1u; nx = cnt > 0u ? cnt : 1u;
}

__device__ __forceinline__ void xcd_barrier(const XcdBarrier& b) {
    asm volatile("s_waitcnt vmcnt(0)" ::: "memory");
    __syncthreads();
    if (threadIdx.x == 0) {
        unsigned* bar = b.bar;
        __builtin_amdgcn_s_waitcnt(0);
        unsigned nloc = b.st[0], nx = b.st[1];
        if (nloc == 0u) { xcd_barrier_complete(bar, b.x, nloc, nx); b.st[0] = nloc; b.st[1] = nx; }
        const unsigned old = xb_add(&bar[XB_XSUB(b.x)], 1u);
        const unsigned gen = old / nloc;
        if (old + 1u == (gen + 1u) * nloc) {
            __builtin_amdgcn_fence(__ATOMIC_RELEASE, "agent");
            asm volatile("s_waitcnt vmcnt(0)" ::: "memory");
            const unsigned og = xb_add(&bar[XB_TOP], 1u);
            const unsigned tg = og / nx;
            if (og + 1u == (tg + 1u) * nx) xb_add(&bar[XB_TOPGEN], 1u);
            else XB_SPIN(xb_ld(&bar[XB_TOPGEN]) == tg, bar);
            __builtin_amdgcn_fence(__ATOMIC_ACQUIRE, "agent");
            xb_add(&bar[XB_XGEN(b.x)], 1u);
            asm volatile("s_waitcnt vmcnt(0)" ::: "memory");
        } else {
            XB_SPIN(xb_ld(&bar[XB_XGEN(b.x)]) == gen, bar);
            __builtin_amdgcn_fence(__ATOMIC_ACQUIRE, "agent");
            asm volatile("s_waitcnt vmcnt(0)" ::: "memory");
        }
    }
    __syncthreads();
}


constexpr size_t WS_BAR = 255 * MiB + 320 * 1024;
DI int fresh_tid() { int t = threadIdx.x; asm volatile("" : "+v"(t)); return t; }
#define IDS const int tid = fresh_tid(), lane = tid & 63, wave = __builtin_amdgcn_readfirstlane(tid >> 6); const int G = gridDim.x, bx = blockIdx.x; \
    const int gw = bx * NWAVES + wave, NGW = G * NWAVES, gtid = bx * NTHREADS + tid, NGT = G * NTHREADS; (void)lane; (void)gw; (void)NGW; (void)gtid; (void)NGT; (void)wave;
__global__ void __launch_bounds__(NTHREADS, 2) fwd_kernel(Params p) {
    extern __shared__ __attribute__((aligned(16))) unsigned char lds[];
    cg::grid_group grid = cg::this_grid();
    PG8_LAS unsigned char* ldsl = (PG8_LAS unsigned char*)lds;
    if (threadIdx.x < 4) ((PG8_LAS unsigned*)(ldsl + (LDS_BYTES - 256)))[threadIdx.x] = 0u;
    __syncthreads();
    const XcdBarrier bar = xcd_barrier_post((unsigned*)(PP().ws + WS_BAR), (volatile PG8_LAS unsigned*)(ldsl + (LDS_BYTES - 256)));

    { IDS phase0(PP(), gw, NGW, lane); }
    if (PP().ws == nullptr) grid.sync();
    xcd_barrier(bar);
    { IDS phase1(PP(), (float*)lds, gw, NGW, lane, tid); }
    xcd_barrier(bar);
    {
        const Params q = PP(); unsigned char* ws = q.ws; bf16_t* WIN = (bf16_t*)(ws + WS_WIN); const int G = gridDim.x, bx = blockIdx.x;
        pg8::Gemm g{(const bf16_t*)(ws + 0 * UNIT), WIN + (size_t)ROWS_A * D, M, NB_TILES * 256, D}; pg8::StaticOrder S; S.init(M, NB_TILES * 256, G, bx);
        EpiB E{(bf16_t*)(ws + 1 * UNIT)};
        pg8::gemm_phase<EpiB, pg8::StaticOrder, true, true>(ldsl, g, S, E);
    }
    { IDS for (int it = gw; it < M / 16; it += NGW) ab_item(PP(), it, lane); }
    xcd_barrier(bar);
    { IDS for (int it = gw; it < 4096; it += NGW) phase3_item(PP(), it, lane); }
    xcd_barrier(bar);
    { IDS for (int it = gw; it < 4096; it += NGW) chunk_prep_item(PP(), (float*)(lds + wave * 16384), it, lane); }
    xcd_barrier(bar);
    for (int tk = blockIdx.x; tk < 256; tk += gridDim.x) { const int t2 = fresh_tid(); scan_task(PP(), ldsl, (tk & 7) + 8 * (tk >> 6), (tk >> 3) & 7, t2, __builtin_amdgcn_readfirstlane(t2 >> 6), t2 & 63); __syncthreads(); }
    xcd_barrier(bar);
    {
        const Params q = PP(); unsigned char* ws = q.ws; bf16_t* WIN = (bf16_t*)(ws + WS_WIN); const int G = gridDim.x, bx = blockIdx.x;
        pg8::Gemm g{(const bf16_t*)(ws + 0 * UNIT), WIN, M, NA_TILES * 256, D}; pg8::StaticOrder S; S.init(M, NA_TILES * 256, G, bx);
        EpiA E{(bf16_t*)(ws + 1 * UNIT), (bf16_t*)(ws + 4 * UNIT)};
        pg8::gemm_phase<EpiA, pg8::StaticOrder, true, true>(ldsl, g, S, E);
    }
    xcd_barrier(bar);
    { IDS phase7(PP(), gw, NGW, lane, gtid, NGT); }
    xcd_barrier(bar);
    if (gridDim.x == 256) {
        const Params q = PP(); unsigned char* ws = q.ws; const int G = gridDim.x, bx = blockIdx.x;
        static_assert(6 * UNIT - 2 * UNIT == (size_t)256 * 256 * D * 2 && WS_WPB - WS_WPA == (size_t)4 * 256 * D * 2, "TwoGemmOrder address arithmetic");
        TwoGemmOrder S; S.so.init(M, D, G, bx);
        pg8::Gemm g{(const bf16_t*)(ws + 2 * UNIT), (const bf16_t*)(ws + WS_WPA), M, D, D}; EpiYaYb E{(bf16_t*)(ws + 4 * UNIT), (const bf16_t*)(ws + 5 * UNIT)};
        pg8::gemm_phase<EpiYaYb, TwoGemmOrder, true, true>(ldsl, g, S, E);
    } else {
        const Params q = PP(); unsigned char* ws = q.ws; const int G = gridDim.x, bx = blockIdx.x;
        pg8::StaticOrder S; S.init(M, D, G, bx);
        { pg8::Gemm g{(const bf16_t*)(ws + 2 * UNIT), (const bf16_t*)(ws + WS_WPA), M, D, D}; EpiYa E{(bf16_t*)(ws + 4 * UNIT)};
          pg8::gemm_phase<EpiYa, pg8::StaticOrder, true, true>(ldsl, g, S, E); }
        { pg8::Gemm g{(const bf16_t*)(ws + 6 * UNIT), (const bf16_t*)(ws + WS_WPB), M, D, D}; EpiYb E{(bf16_t*)(ws + 4 * UNIT), (const bf16_t*)(ws + 5 * UNIT)};
          pg8::gemm_phase<EpiYb, pg8::StaticOrder, true, true>(ldsl, g, S, E); }
    }
    if (gridDim.x == 256) {
        pg8::StaticOrder S; S.init(M, D, (int)gridDim.x, (int)blockIdx.x); pg8::Unit u; (void)S.next(0, u);
        unsigned* cnt = (unsigned*)(PP().ws + WS_PCNT2) + 64 * u.pm;
        asm volatile("s_waitcnt vmcnt(0)" ::: "memory");
        __syncthreads();
        if (threadIdx.x == 0) __hip_atomic_fetch_add(cnt, 1u, __ATOMIC_RELAXED, __HIP_MEMORY_SCOPE_AGENT);
        if (threadIdx.x < 64) {
            unsigned sp = 0;
            while ((unsigned)__builtin_amdgcn_readfirstlane(__hip_atomic_load(cnt, __ATOMIC_RELAXED, __HIP_MEMORY_SCOPE_AGENT)) < 4u) { __builtin_amdgcn_s_sleep(2); if (++sp > (1u << 22)) break; }
            __builtin_amdgcn_fence(__ATOMIC_ACQUIRE, "agent");
        }
        asm volatile("s_waitcnt vmcnt(0) lgkmcnt(0)" ::: "memory");
        __syncthreads();
    } else {
        xcd_barrier(bar);
    }
    if (gridDim.x == 256) {
        const Params q = PP(); unsigned char* ws = q.ws; const int G = gridDim.x, bx = blockIdx.x;
        pg8::Gemm g{(const bf16_t*)(ws + 4 * UNIT), (const bf16_t*)(ws + WS_WO), M, D, D}; pg8::StaticOrder S; S.init(M, D, G, bx);
        EpiOutFused E{q.in[0], (const float*)(ws + WS_MODF), q.in[14], q.out, (float*)(ws + WS_PSS), (unsigned*)(ws + WS_PCNT)};
        pg8::gemm_phase<EpiOutFused, pg8::StaticOrder, true, true>(ldsl, g, S, E);
    } else {
        {
            const Params q = PP(); unsigned char* ws = q.ws; const int G = gridDim.x, bx = blockIdx.x;
            pg8::Gemm g{(const bf16_t*)(ws + 4 * UNIT), (const bf16_t*)(ws + WS_WO), M, D, D}; pg8::StaticOrder S; S.init(M, D, G, bx);
            EpiOut E{q.in[0], (const float*)(ws + WS_MODF), (float*)(ws + 0 * UNIT)};
            pg8::gemm_phase<EpiOut, pg8::StaticOrder, true, true>(ldsl, g, S, E);
        }
        xcd_barrier(bar);
        { IDS phase10(PP(), gw, NGW, lane); }
    }
}

extern "C" void kernel_launch(void* const* d_in, const int* in_sizes, int n_in, void* d_out, int out_size, void* d_ws, size_t ws_size, hipStream_t stream) {
    static int grid = 0;
    if (grid == 0) {
        int dev = 0, cus = 0, per_cu = 0;
        if (n_in != 15 || out_size != M * D || ws_size < 256 * MiB) { fprintf(stderr, "kernel_launch: unexpected shapes (n_in %d out %d ws %zu)\n", n_in, out_size, ws_size); grid = -1; return; }
        hipGetDevice(&dev); hipDeviceGetAttribute(&cus, hipDeviceAttributeMultiprocessorCount, dev);
        if (hipFuncSetAttribute((const void*)fwd_kernel, hipFuncAttributeMaxDynamicSharedMemorySize, LDS_BYTES) != hipSuccess) { fprintf(stderr, "kernel_launch: hipFuncSetAttribute failed\n"); grid = -1; return; }
        hipOccupancyMaxActiveBlocksPerMultiprocessor(&per_cu, (const void*)fwd_kernel, NTHREADS, LDS_BYTES);
        if (per_cu < 1) { fprintf(stderr, "kernel_launch: occupancy query says %d blocks/CU\n", per_cu); per_cu = 1; }
        (void)hipGetLastError();
        grid = cus;
    }
    if (grid < 0) return;
    if (hipMemsetAsync((char*)d_ws + WS_BAR, 0, 49152, stream) != hipSuccess) { fprintf(stderr, "kernel_launch: memset of barrier words failed\n"); return; }
    Params p{};
    for (int i = 0; i < 15; ++i) p.in[i] = (const float*)d_in[i];
    p.out = (float*)d_out; p.ws = (unsigned char*)d_ws;
    void* args[] = {&p};
    hipError_t e = hipLaunchCooperativeKernel((const void*)fwd_kernel, dim3(grid), dim3(NTHREADS), args, LDS_BYTES, stream);
    if (e != hipSuccess) fprintf(stderr, "cooperative launch failed: %s (grid %d)\n", hipGetErrorString(e), grid);
}
```

```cpp
#include <hip/hip_runtime.h>
#include <hip/hip_cooperative_groups.h>
#include <cstdio>
#include <cstdint>
namespace cg = cooperative_groups;

#define DI __device__ __forceinline__
#define PG8_LAS __attribute__((address_space(3)))
typedef unsigned short bf16_t;
typedef short bf16x8 __attribute__((ext_vector_type(8)));
typedef float f32x4 __attribute__((ext_vector_type(4)));
typedef float f32x2 __attribute__((ext_vector_type(2)));
typedef unsigned u32x4 __attribute__((ext_vector_type(4)));
typedef unsigned u32x2 __attribute__((ext_vector_type(2)));

namespace pg8 {
constexpr int BM = 256, BK = 64, HALF = 128, HTB = HALF * BK * 2, STAGE_BYTES = 8 * HTB, NXCD = 8, WGM = 8;
__host__ __device__ __forceinline__ int lds_byte(int r, int c) { const int st = (r >> 4) * 2 + (c >> 5), rr = r & 15, cc = c & 31, ob = rr * 64 + cc * 2; return st * 1024 + (ob ^ (((ob >> 9) & 1) << 5)); }
__host__ __device__ __forceinline__ void stage_rc(int b, int& R, int& C) { const int st = b / 1024, sb = b % 1024, swz = sb ^ (((sb >> 9) & 1) << 5); R = (st >> 1) * 16 + swz / 64; C = (st & 1) * 32 + (swz % 64) / 2; }
__host__ __device__ __forceinline__ int perm32(int rho) { const int n = rho >> 4, i = rho & 15; return 8 * (i >> 2) + 4 * n + (i & 3); }
struct Unit { int pm, pn; };
struct Gemm { const bf16_t* A; const bf16_t* Bt; int M, N, K; };
struct StaticOrder {
    int nM, nN, nwg, G, c;
    __host__ __device__ void init(int M, int N, int G_, int c_) { nM = M / BM; nN = N / BM; nwg = nM * nN; G = G_; c = c_; }
    __host__ __device__ bool next(int i, Unit& u) const {
        const long L = (long)i * G + c; if (L >= nwg) return false;
        int wgid = (int)L; { const int q = nwg / NXCD, r = nwg % NXCD, xcd = wgid % NXCD, off = wgid / NXCD; wgid = (xcd < r ? xcd * (q + 1) : r * (q + 1) + (xcd - r) * q) + off; }
        const int nig = WGM * nN, gid = wgid / nig, fm = gid * WGM, gsz = (nM - fm) < WGM ? (nM - fm) : WGM;
        u.pm = fm + ((wgid % nig) % gsz); u.pn = (wgid % nig) / gsz; return true;
    }
    __device__ __forceinline__ void a_ready(const Unit&) const {}
    __device__ __forceinline__ void done(const Unit&) const {}
};
template <class Epi, class Sched, bool ALIGN_EPI = false, bool SP2 = false>
__device__ __forceinline__ void gemm_phase(PG8_LAS unsigned char* lds, const Gemm g, const Sched& S, const Epi& E) {
    int tid = threadIdx.x; asm volatile("" : "+v"(tid)); const int wid = __builtin_amdgcn_readfirstlane(tid >> 6), lane = tid & 63, wr = wid >> 2, wc = wid & 3, fr = lane & 15, fq = lane >> 4;
    const int K = g.K, nt = K / BK;
    unsigned voffA[2], voffB[2];
#pragma unroll
    for (int i = 0; i < 2; ++i) { int R, C; stage_rc(tid * 16 + i * 8192, R, C); const int Rb = Epi::PERM ? ((R & ~31) + perm32(R & 31)) : R;
        voffA[i] = (unsigned)(R * K + C) * 2u; voffB[i] = (unsigned)(Rb * K + C) * 2u; }
    const size_t kstep = (size_t)(BK * 2);
    const size_t hstep = (size_t)HALF * K * 2;
    const size_t tstep = 2 * hstep;
    const unsigned ldsw = (unsigned)wid * 1024u;
    const int aoff = lds_byte(wr * 64 + fr, fq * 8), boff = lds_byte(wc * 32 + fr, fq * 8);
#define PG8_SA(b, h) (((b) * 2 + (h)) * HTB)
#define PG8_SB(b, h) ((4 + (b) * 2 + (h)) * HTB)
#define PG8_STAGE(bufoff, gbase, voff) do { _Pragma("unroll") for (int _i = 0; _i < 2; ++_i) \
        __builtin_amdgcn_global_load_lds((const unsigned*)((const char*)(gbase) + (voff)[_i]), (PG8_LAS unsigned*)(lds + (bufoff) + ldsw + _i * 8192), 16, 0, 0); } while (0)
#define PG8_LDA(dst, b, h) do { _Pragma("unroll") for (int m = 0; m < 4; ++m) _Pragma("unroll") for (int k = 0; k < 2; ++k) dst[m][k] = *(const PG8_LAS bf16x8*)(lds + PG8_SA(b, h) + aoff + m * 2048 + k * 1024); } while (0)
#define PG8_LDB(dst, b, h) do { _Pragma("unroll") for (int n = 0; n < 2; ++n) _Pragma("unroll") for (int k = 0; k < 2; ++k) dst[n][k] = *(const PG8_LAS bf16x8*)(lds + PG8_SB(b, h) + boff + n * 2048 + k * 1024); } while (0)
#define PG8_MMA(ai, bj, At, Bt) do { __builtin_amdgcn_s_setprio(1); _Pragma("unroll") for (int m = 0; m < 4; ++m) _Pragma("unroll") for (int n = 0; n < 2; ++n) _Pragma("unroll") for (int k = 0; k < 2; ++k) \
        acc[ai][bj][m][n] = __builtin_amdgcn_mfma_f32_16x16x32_bf16(Bt[n][k], At[m][k], acc[ai][bj][m][n], 0, 0, 0); __builtin_amdgcn_s_setprio(0); } while (0)
#define PG8_WAIT_V(n) asm volatile("s_waitcnt vmcnt(" #n ")" ::: "memory")
#define PG8_WAIT_L(n) asm volatile("s_waitcnt lgkmcnt(" #n ")" ::: "memory")
#define PG8_BAR __builtin_amdgcn_s_barrier()
#define PG8_SCHED __builtin_amdgcn_sched_barrier(0)
    Unit cur, nxt; int ui = 0;
    if (!S.next(0, cur)) return;
    f32x4 acc[2][2][4][2];
#pragma unroll
    for (int a = 0; a < 2; ++a)
#pragma unroll
        for (int b = 0; b < 2; ++b)
#pragma unroll
            for (int m = 0; m < 4; ++m)
#pragma unroll
                for (int n = 0; n < 2; ++n) acc[a][b][m][n] = (f32x4){0.f, 0.f, 0.f, 0.f};
    bf16x8 At[4][2], B0[2][2], B1[2][2];
    const char* cA = (const char*)g.A + (size_t)cur.pm * tstep; const char* cB = (const char*)g.Bt + (size_t)cur.pn * tstep;
    S.a_ready(cur);
    if constexpr (SP2) {
        PG8_STAGE(PG8_SB(0, 0), cB, voffB); PG8_STAGE(PG8_SB(0, 1), cB + hstep, voffB); PG8_STAGE(PG8_SA(0, 0), cA, voffA); PG8_STAGE(PG8_SA(0, 1), cA + hstep, voffA);
        if (wr == 1) PG8_BAR;
        PG8_WAIT_V(2); PG8_BAR;
        PG8_STAGE(PG8_SB(1, 0), cB + kstep, voffB); PG8_STAGE(PG8_SA(1, 0), cA + kstep, voffA); PG8_STAGE(PG8_SB(1, 1), cB + hstep + kstep, voffB);
        PG8_WAIT_V(6); PG8_BAR;
    } else {
        PG8_STAGE(PG8_SB(0, 0), cB, voffB); PG8_STAGE(PG8_SA(0, 0), cA, voffA); PG8_STAGE(PG8_SB(0, 1), cB + hstep, voffB); PG8_STAGE(PG8_SA(0, 1), cA + hstep, voffA);
        if (wr == 1) PG8_BAR;
        PG8_WAIT_V(4); PG8_BAR;
        PG8_STAGE(PG8_SB(1, 0), cB + kstep, voffB); PG8_STAGE(PG8_SA(1, 0), cA + kstep, voffA); PG8_STAGE(PG8_SB(1, 1), cB + hstep + kstep, voffB);
        PG8_WAIT_V(6); PG8_BAR;
    }
    for (;;) {
        const bool has_next = S.next(ui + 1, nxt);
        const char* nA = has_next ? (const char*)g.A + (size_t)nxt.pm * tstep : cA; const char* nB = has_next ? (const char*)g.Bt + (size_t)nxt.pn * tstep : cB;
        for (int t = 0; t < nt; t += 2) {
            const bool last = (t == nt - 2);
            const char* a1 = cA + (size_t)(t + 1) * kstep;
            const char* a2 = last ? nA : cA + (size_t)(t + 2) * kstep; const char* b2 = last ? nB : cB + (size_t)(t + 2) * kstep;
            const char* a3 = a2 + kstep; const char* b3 = b2 + kstep;
            if (last && has_next) S.a_ready(nxt);
            if constexpr (SP2) {
            PG8_LDB(B0, 0, 0); PG8_LDB(B1, 0, 1); PG8_SCHED; PG8_LDA(At, 0, 0); PG8_STAGE(PG8_SA(1, 1), a1 + hstep, voffA);
            PG8_WAIT_V(8); PG8_WAIT_L(0); PG8_BAR; PG8_MMA(0, 0, At, B0); PG8_MMA(0, 1, At, B1); PG8_BAR; PG8_SCHED;
            PG8_LDA(At, 0, 1); PG8_STAGE(PG8_SB(0, 0), b2, voffB); PG8_STAGE(PG8_SB(0, 1), b2 + hstep, voffB); PG8_STAGE(PG8_SA(0, 0), a2, voffA);
            PG8_WAIT_V(8); PG8_WAIT_L(0); PG8_BAR; PG8_MMA(1, 0, At, B0); PG8_MMA(1, 1, At, B1); PG8_BAR; PG8_SCHED;
            PG8_LDB(B0, 1, 0); PG8_LDB(B1, 1, 1); PG8_SCHED; PG8_LDA(At, 1, 0); PG8_STAGE(PG8_SA(0, 1), a2 + hstep, voffA);
            PG8_WAIT_V(8); PG8_WAIT_L(0); PG8_BAR; PG8_MMA(0, 0, At, B0); PG8_MMA(0, 1, At, B1); PG8_BAR; PG8_SCHED;
            PG8_LDA(At, 1, 1); PG8_STAGE(PG8_SB(1, 0), b3, voffB); PG8_STAGE(PG8_SB(1, 1), b3 + hstep, voffB); PG8_STAGE(PG8_SA(1, 0), a3, voffA);
            PG8_WAIT_V(8); PG8_WAIT_L(0); PG8_BAR; PG8_MMA(1, 0, At, B0); PG8_MMA(1, 1, At, B1); PG8_BAR; PG8_SCHED;
            } else {
            PG8_LDB(B0, 0, 0); PG8_SCHED; PG8_LDA(At, 0, 0); PG8_STAGE(PG8_SA(1, 1), a1 + hstep, voffA);
            PG8_WAIT_L(8); PG8_BAR; PG8_WAIT_L(0); PG8_MMA(0, 0, At, B0); PG8_BAR; PG8_SCHED;
            PG8_LDB(B1, 0, 1); PG8_STAGE(PG8_SB(0, 0), b2, voffB);
            PG8_BAR; PG8_WAIT_L(0); PG8_MMA(0, 1, At, B1); PG8_BAR;
            PG8_LDA(At, 0, 1); PG8_STAGE(PG8_SA(0, 0), a2, voffA);
            PG8_BAR; PG8_WAIT_L(0); PG8_MMA(1, 0, At, B0); PG8_BAR; PG8_SCHED;
            PG8_STAGE(PG8_SB(0, 1), b2 + hstep, voffB);
            PG8_WAIT_V(6); PG8_BAR; PG8_MMA(1, 1, At, B1); PG8_BAR;
            PG8_LDB(B0, 1, 0); PG8_SCHED; PG8_LDA(At, 1, 0); PG8_STAGE(PG8_SA(0, 1), a2 + hstep, voffA);
            PG8_WAIT_L(8); PG8_BAR; PG8_WAIT_L(0); PG8_MMA(0, 0, At, B0); PG8_BAR; PG8_SCHED;
            PG8_LDB(B1, 1, 1); PG8_STAGE(PG8_SB(1, 0), b3, voffB);
            PG8_BAR; PG8_WAIT_L(0); PG8_MMA(0, 1, At, B1); PG8_BAR;
            PG8_LDA(At, 1, 1); PG8_STAGE(PG8_SA(1, 0), a3, voffA);
            PG8_BAR; PG8_WAIT_L(0); PG8_MMA(1, 0, At, B0); PG8_BAR; PG8_SCHED;
            PG8_STAGE(PG8_SB(1, 1), b3 + hstep, voffB);
            PG8_WAIT_V(6); PG8_BAR; PG8_MMA(1, 1, At, B1); PG8_BAR;
            }
        }
        if constexpr (ALIGN_EPI) { if (wr == 0) PG8_BAR; }
        if constexpr (!Epi::AFTER_DRAIN) { E(acc, cur, wr, wc, fr, fq); S.done(cur); }
        if (!has_next) break;
#pragma unroll
        for (int a = 0; a < 2; ++a)
#pragma unroll
            for (int b = 0; b < 2; ++b)
#pragma unroll
                for (int m = 0; m < 4; ++m)
#pragma unroll
                    for (int n = 0; n < 2; ++n) acc[a][b][m][n] = (f32x4){0.f, 0.f, 0.f, 0.f};
        cur = nxt; cA = nA; cB = nB; ++ui;
        if constexpr (ALIGN_EPI) { if (wr == 1) PG8_BAR; }
    }
    PG8_WAIT_V(0);
    if constexpr (!ALIGN_EPI) { if (wr == 0) PG8_BAR; }
    PG8_BAR;
    if constexpr (Epi::AFTER_DRAIN) { E.fused(acc, cur, wr, wc, fr, fq, lds, wid, lane); S.done(cur); }
#undef PG8_SA
#undef PG8_SB
#undef PG8_STAGE
#undef PG8_LDA
#undef PG8_LDB
#undef PG8_MMA
#undef PG8_WAIT_V
#undef PG8_WAIT_L
#undef PG8_BAR
#undef PG8_SCHED
}}

constexpr int SEQ = 8192, NB = 2, M = NB * SEQ, D = 1024, NIN = 10272, NPAD = 10496;
constexpr int NA_TILES = 28, NB_TILES = 12, ROWS_A = NA_TILES * 256;
constexpr size_t MiB = 1u << 20;
constexpr size_t UNIT = 32 * MiB;
constexpr size_t WS_WIN = 224 * MiB, WS_WPA = 245 * MiB, WS_WPB = 247 * MiB, WS_WO = 249 * MiB, WS_AB = 251 * MiB, WS_G = 253 * MiB, WS_BETA = 254 * MiB;
constexpr size_t WS_MODP = 255 * MiB, WS_MODF = 255 * MiB + 256 * 1024;
constexpr size_t WS_CSC = 239 * MiB;
constexpr int LDS_BYTES = 155648;
constexpr int NWAVES = 8, NTHREADS = 512;
constexpr float NORM_EPS = 1e-6f, L2_EPS = 1e-6f;

struct Params { const float* in[15]; float* out; unsigned char* ws; };

typedef __bf16 bf16v2_t __attribute__((ext_vector_type(2)));
DI unsigned cvt_pk_bf16(float lo, float hi) { const f32x2 v = {lo, hi}; const bf16v2_t r = __builtin_convertvector(v, bf16v2_t); return __builtin_bit_cast(unsigned, r); }
DI void store_wt16(void* p, const u32x4& v) { asm volatile("global_store_dwordx4 %0, %1, off sc1\n\ts_nop 1" :: "v"(p), "v"(v) : "memory"); }
DI float bf_lo(unsigned u) { return __uint_as_float(u << 16); }
DI float bf_hi(unsigned u) { return __uint_as_float(u & 0xffff0000u); }
DI float bf1(bf16_t u) { return __uint_as_float(((unsigned)u) << 16); }
DI float sigmoidf_(float x) { return __builtin_amdgcn_rcpf(1.0f + __expf(-x)); }
DI float siluf_(float x) { return x * __builtin_amdgcn_rcpf(1.0f + __expf(-x)); }
DI float softplusf_(float x) { return fmaxf(x, 0.f) + log1pf(__expf(-fabsf(x))); }
#define DPP_F(v, ctrl) __builtin_bit_cast(float, __builtin_amdgcn_mov_dpp(__builtin_bit_cast(int, (v)), (ctrl), 0xF, 0xF, true))
DI float row16_sum(float v) {
    v += DPP_F(v, 0xB1);
    v += DPP_F(v, 0x4E);
    v += DPP_F(v, 0x141);
    v += DPP_F(v, 0x140);
    return v;
}
DI float wave_sum(float v) {
    v = row16_sum(v);
    return __builtin_bit_cast(float, __builtin_amdgcn_readlane(__builtin_bit_cast(int, v), 0)) + __builtin_bit_cast(float, __builtin_amdgcn_readlane(__builtin_bit_cast(int, v), 16))
         + __builtin_bit_cast(float, __builtin_amdgcn_readlane(__builtin_bit_cast(int, v), 32)) + __builtin_bit_cast(float, __builtin_amdgcn_readlane(__builtin_bit_cast(int, v), 48));
}
DI int permpos(int dk) { const int loc = dk & 31; return (dk & ~31) + 8 * ((loc >> 2) & 3) + 4 * (loc >> 4) + (loc & 3); }
DI int win_src_col(int d) {
    if (d < 2048) { const int i = d >> 8, w = d & 255; return w < 128 ? (128 * i + w) : (2048 + 128 * i + (w - 128)); }
    if (d < 4096) { const int i = (d - 2048) >> 8, w = d & 255; return w < 128 ? (1024 + 128 * i + w) : (3072 + 128 * i + (w - 128)); }
    if (d < 5120) return 8224 + (d - 4096);
    if (d < 6144) return 9248 + (d - 5120);
    if (d < 7168) return 7168 + (d - 6144);
    if (d < 10240) return 4096 + (d - 7168);
    if (d < 10272) return 8192 + (d - 10240);
    return -1;
}

struct EpiA {
    static constexpr bool PERM = true, AFTER_DRAIN = false;
    bf16_t *PR, *SG;
    DI void operator()(const f32x4 (&acc)[2][2][4][2], const pg8::Unit& u, int wr, int wc, int fr, int fq) const {
        const int row0 = u.pm * 256 + wr * 64 + fr, pn = u.pn;
        if (pn < 16) {
            bf16_t* O = PR + (size_t)(pn >> 3) * (UNIT / 2) + (size_t)(128 * (pn & 7) + 32 * wc + 8 * fq);
#pragma unroll
            for (int ai = 0; ai < 2; ++ai)
#pragma unroll
                for (int m = 0; m < 4; ++m) {
                    float o[8];
#pragma unroll
                    for (int n = 0; n < 2; ++n)
#pragma unroll
                        for (int j = 0; j < 4; ++j) { const float a = acc[ai][0][m][n][j], b = acc[ai][1][m][n][j]; o[4 * n + j] = pn < 8 ? a * b : a * siluf_(b); }
                    u32x4 w; w.x = cvt_pk_bf16(o[0], o[1]); w.y = cvt_pk_bf16(o[2], o[3]); w.z = cvt_pk_bf16(o[4], o[5]); w.w = cvt_pk_bf16(o[6], o[7]);
                    store_wt16(O + (size_t)(row0 + ai * 128 + m * 16) * D, w);
                }
        } else {
            const int g = (pn - 16) >> 2;
            bf16_t* O = SG + (size_t)g * (UNIT / 2) + (size_t)(256 * ((pn - 16) & 3) + 32 * wc + 8 * fq);
#pragma unroll
            for (int ai = 0; ai < 2; ++ai)
#pragma unroll
                for (int m = 0; m < 4; ++m)
#pragma unroll
                    for (int bj = 0; bj < 2; ++bj) {
                        float o[8];
#pragma unroll
                        for (int n = 0; n < 2; ++n)
#pragma unroll
                            for (int j = 0; j < 4; ++j) { const float a = acc[ai][bj][m][n][j]; o[4 * n + j] = g == 2 ? siluf_(a) : sigmoidf_(a); }
                        u32x4 w; w.x = cvt_pk_bf16(o[0], o[1]); w.y = cvt_pk_bf16(o[2], o[3]); w.z = cvt_pk_bf16(o[4], o[5]); w.w = cvt_pk_bf16(o[6], o[7]);
                        store_wt16(O + (size_t)(row0 + ai * 128 + m * 16) * D + bj * 128, w);
                    }
        }
    }
};
struct EpiB {
    static constexpr bool PERM = true, AFTER_DRAIN = false;
    bf16_t* QKV;
    DI void operator()(const f32x4 (&acc)[2][2][4][2], const pg8::Unit& u, int wr, int wc, int fr, int fq) const {
        const int row0 = u.pm * 256 + wr * 64 + fr, pn = u.pn;
        bf16_t* O = QKV + (size_t)(pn >> 2) * (UNIT / 2) + (size_t)(256 * (pn & 3) + 32 * wc + 8 * fq);
#pragma unroll
        for (int ai = 0; ai < 2; ++ai)
#pragma unroll
            for (int m = 0; m < 4; ++m)
#pragma unroll
                for (int bj = 0; bj < 2; ++bj) {
                    const f32x4 v0 = acc[ai][bj][m][0], v1 = acc[ai][bj][m][1];
                    u32x4 w; w.x = cvt_pk_bf16(v0[0], v0[1]); w.y = cvt_pk_bf16(v0[2], v0[3]); w.z = cvt_pk_bf16(v1[0], v1[1]); w.w = cvt_pk_bf16(v1[2], v1[3]);
                    store_wt16(O + (size_t)(row0 + ai * 128 + m * 16) * D + bj * 128, w);
                }
    }
};
struct EpiYa {
    static constexpr bool PERM = true, AFTER_DRAIN = false;
    bf16_t* SGA;
    DI void operator()(const f32x4 (&acc)[2][2][4][2], const pg8::Unit& u, int wr, int wc, int fr, int fq) const {
        const int row0 = u.pm * 256 + wr * 64 + fr; bf16_t* O = SGA + (size_t)(256 * u.pn + 32 * wc + 8 * fq);
#pragma unroll
        for (int ai = 0; ai < 2; ++ai)
#pragma unroll
            for (int m = 0; m < 4; ++m)
#pragma unroll
                for (int bj = 0; bj < 2; ++bj) {
                    u32x4* p = (u32x4*)(O + (size_t)(row0 + ai * 128 + m * 16) * D + bj * 128);
                    const u32x4 s = *p; const f32x4 v0 = acc[ai][bj][m][0], v1 = acc[ai][bj][m][1];
                    u32x4 w; w.x = cvt_pk_bf16(bf_lo(s.x) * v0[0], bf_hi(s.x) * v0[1]); w.y = cvt_pk_bf16(bf_lo(s.y) * v0[2], bf_hi(s.y) * v0[3]);
                    w.z = cvt_pk_bf16(bf_lo(s.z) * v1[0], bf_hi(s.z) * v1[1]); w.w = cvt_pk_bf16(bf_lo(s.w) * v1[2], bf_hi(s.w) * v1[3]);
                    *p = w;
                }
    }
};
struct EpiYb {
    static constexpr bool PERM = true, AFTER_DRAIN = false;
    bf16_t* MA; const bf16_t* SGB;
    DI void operator()(const f32x4 (&acc)[2][2][4][2], const pg8::Unit& u, int wr, int wc, int fr, int fq) const {
        const int row0 = u.pm * 256 + wr * 64 + fr; const size_t c0 = (size_t)(256 * u.pn + 32 * wc + 8 * fq);
#pragma unroll
        for (int ai = 0; ai < 2; ++ai)
#pragma unroll
            for (int m = 0; m < 4; ++m)
#pragma unroll
                for (int bj = 0; bj < 2; ++bj) {
                    const size_t off = (size_t)(row0 + ai * 128 + m * 16) * D + bj * 128 + c0;
                    u32x4* p = (u32x4*)(MA + off); const u32x4 a = *p; const u32x4 s = *(const u32x4*)(SGB + off);
                    const f32x4 v0 = acc[ai][bj][m][0], v1 = acc[ai][bj][m][1];
                    u32x4 w; w.x = cvt_pk_bf16(bf_lo(a.x) + bf_lo(s.x) * v0[0], bf_hi(a.x) + bf_hi(s.x) * v0[1]); w.y = cvt_pk_bf16(bf_lo(a.y) + bf_lo(s.y) * v0[2], bf_hi(a.y) + bf_hi(s.y) * v0[3]);
                    w.z = cvt_pk_bf16(bf_lo(a.z) + bf_lo(s.z) * v1[0], bf_hi(a.z) + bf_hi(s.z) * v1[1]); w.w = cvt_pk_bf16(bf_lo(a.w) + bf_lo(s.w) * v1[2], bf_hi(a.w) + bf_hi(s.w) * v1[3]);
                    store_wt16(p, w);
                }
    }
};
struct EpiOut {
    static constexpr bool PERM = true, AFTER_DRAIN = false;
    const float* X; const float* GATE; float* XN;
    DI void operator()(const f32x4 (&acc)[2][2][4][2], const pg8::Unit& u, int wr, int wc, int fr, int fq) const {
        const int row0 = u.pm * 256 + wr * 64 + fr; const int c0 = 256 * u.pn + 32 * wc + 8 * fq;
        const float* gp = GATE + (size_t)((u.pm * 256) / SEQ) * D + c0;
        f32x4 gt[2][2];
#pragma unroll
        for (int bj = 0; bj < 2; ++bj) { gt[bj][0] = *(const f32x4*)(gp + bj * 128); gt[bj][1] = *(const f32x4*)(gp + bj * 128 + 4); }
#pragma unroll
        for (int ai = 0; ai < 2; ++ai)
#pragma unroll
            for (int m = 0; m < 4; ++m)
#pragma unroll
                for (int bj = 0; bj < 2; ++bj) {
                    const size_t off = (size_t)(row0 + ai * 128 + m * 16) * D + bj * 128 + c0;
                    const f32x4 x0 = *(const f32x4*)(X + off), x1 = *(const f32x4*)(X + off + 4);
                    *(f32x4*)(XN + off) = x0 + gt[bj][0] * acc[ai][bj][m][0]; *(f32x4*)(XN + off + 4) = x1 + gt[bj][1] * acc[ai][bj][m][1];
                }
    }
};

constexpr size_t WS_PCNT = 255 * MiB + 336 * 1024;
constexpr size_t WS_PSS = 255 * MiB + 512 * 1024;
constexpr size_t WS_PCNT3 = 255 * MiB + 368 * 1024;
constexpr size_t WS_PCNT2 = 255 * MiB + 352 * 1024;
struct EpiOutFused {
    static constexpr bool PERM = true, AFTER_DRAIN = true;
    const float* X; const float* GATE; const float* FW; float* OUT; float* PSS; unsigned* PCNT;
    DI void operator()(const f32x4 (&)[2][2][4][2], const pg8::Unit&, int, int, int, int) const {}
    DI void fused(f32x4 (&acc)[2][2][4][2], const pg8::Unit& u, int wr, int wc, int fr, int fq, PG8_LAS unsigned char* lds, int wid, int lane) const {
        PG8_LAS float* P = (PG8_LAS float*)lds;
        PG8_LAS float* S = (PG8_LAS float*)(lds + 4096);
        const int row0 = u.pm * 256 + wr * 64 + fr; const int c0 = 256 * u.pn + 32 * wc + 8 * fq;
        const float* gp = GATE + (size_t)((u.pm * 256) / SEQ) * D + c0;
        f32x4 gt[2][2];
#pragma unroll
        for (int bj = 0; bj < 2; ++bj) { gt[bj][0] = *(const f32x4*)(gp + bj * 128); gt[bj][1] = *(const f32x4*)(gp + bj * 128 + 4); }
#pragma unroll
        for (int ai = 0; ai < 2; ++ai)
#pragma unroll
            for (int m = 0; m < 4; ++m) {
                float s = 0.f;
#pragma unroll
                for (int bj = 0; bj < 2; ++bj) {
                    const size_t off = (size_t)(row0 + ai * 128 + m * 16) * D + bj * 128 + c0;
                    const f32x4 v0 = __builtin_nontemporal_load((const f32x4*)(X + off)) + gt[bj][0] * acc[ai][bj][m][0], v1 = __builtin_nontemporal_load((const f32x4*)(X + off + 4)) + gt[bj][1] * acc[ai][bj][m][1];
                    acc[ai][bj][m][0] = v0; acc[ai][bj][m][1] = v1;
                    s += (v0[0] * v0[0] + v0[1] * v0[1]) + (v0[2] * v0[2] + v0[3] * v0[3]) + (v1[0] * v1[0] + v1[1] * v1[1]) + (v1[2] * v1[2] + v1[3] * v1[3]);
                }
                s += __shfl_xor(s, 16); s += __shfl_xor(s, 32);
                if (fq == 0) P[(ai * 128 + wr * 64 + m * 16 + fr) * 4 + wc] = s;
                if (m & 1) __builtin_amdgcn_sched_barrier(0);
            }
        asm volatile("s_waitcnt lgkmcnt(0)" ::: "memory"); __builtin_amdgcn_s_barrier(); asm volatile("" ::: "memory");
        const int row = wid * 32 + (lane & 31);
        if (lane < 32) {
            const float t = (P[row * 4 + 0] + P[row * 4 + 1]) + (P[row * 4 + 2] + P[row * 4 + 3]);
            __hip_atomic_store(PSS + (size_t)(u.pm * 256 + row) * 4 + u.pn, t, __ATOMIC_RELAXED, __HIP_MEMORY_SCOPE_AGENT);
        }
        asm volatile("s_waitcnt vmcnt(0)" ::: "memory");
        if (lane == 0) __hip_atomic_fetch_add(PCNT + 64 * u.pm, 1u, __ATOMIC_RELAXED, __HIP_MEMORY_SCOPE_AGENT);
        if (wid == 0) {
            unsigned sp = 0;
            while ((unsigned)__builtin_amdgcn_readfirstlane(__hip_atomic_load(PCNT + 64 * u.pm, __ATOMIC_RELAXED, __HIP_MEMORY_SCOPE_AGENT)) < 32u) { __builtin_amdgcn_s_sleep(2); if (++sp > (1u << 22)) break; }
            __builtin_amdgcn_fence(__ATOMIC_ACQUIRE, "agent");
        }
        asm volatile("s_waitcnt vmcnt(0) lgkmcnt(0)" ::: "memory"); __builtin_amdgcn_s_barrier(); asm volatile("" ::: "memory");
        if (lane < 32) {
            const float* ps = PSS + (size_t)(u.pm * 256 + row) * 4; float t = 0.f;
#pragma unroll
            for (int k = 0; k < 4; ++k) t += __hip_atomic_load(ps + k, __ATOMIC_RELAXED, __HIP_MEMORY_SCOPE_AGENT);
            S[row] = rsqrtf(t * (1.f / D) + NORM_EPS);
        }
        asm volatile("s_waitcnt vmcnt(0) lgkmcnt(0)" ::: "memory"); __builtin_amdgcn_s_barrier(); asm volatile("" ::: "memory");
        f32x4 fw[2][2];
#pragma unroll
        for (int bj = 0; bj < 2; ++bj) { fw[bj][0] = *(const f32x4*)(FW + c0 + bj * 128); fw[bj][1] = *(const f32x4*)(FW + c0 + bj * 128 + 4); }
#pragma unroll
        for (int ai = 0; ai < 2; ++ai)
#pragma unroll
            for (int m = 0; m < 4; ++m) {
                const float rs = S[ai * 128 + wr * 64 + m * 16 + fr];
#pragma unroll
                for (int bj = 0; bj < 2; ++bj) {
                    const size_t off = (size_t)(row0 + ai * 128 + m * 16) * D + bj * 128 + c0;
                    __builtin_nontemporal_store(acc[ai][bj][m][0] * rs * fw[bj][0], (f32x4*)(OUT + off)); __builtin_nontemporal_store(acc[ai][bj][m][1] * rs * fw[bj][1], (f32x4*)(OUT + off + 4));
                }
            }
    }
};

struct TwoGemmOrder {
    pg8::StaticOrder so;
    DI bool next(int i, pg8::Unit& u) const { if (i >= 2) return false; if (!so.next(0, u)) return false; if (i == 1) { u.pm += 256; u.pn += 4; } return true; }
    DI void a_ready(const pg8::Unit&) const {}
    DI void done(const pg8::Unit&) const {}
};
struct EpiYaYb {
    static constexpr bool PERM = true, AFTER_DRAIN = false;
    bf16_t* MA; const bf16_t* SGB;
    DI void operator()(const f32x4 (&acc)[2][2][4][2], const pg8::Unit& u, int wr, int wc, int fr, int fq) const {
        if (u.pn < 4) { EpiYa e{MA}; e(acc, u, wr, wc, fr, fq); }
        else { EpiYb e{MA, SGB}; pg8::Unit v; v.pm = u.pm - 256; v.pn = u.pn - 4; e(acc, v, wr, wc, fr, fq); }
    }
};

DI void p0_transpose_item(const float* W, int N, bf16_t* WT, int rg, int kg, int lane, bool is_win) {
    const int d = rg * 64 + lane; const int s = is_win ? win_src_col(d) : d; const int k0 = kg * 64;
    bf16_t* o = WT + (size_t)d * D + k0;
    if (s < 0) {
#pragma unroll
        for (int kk = 0; kk < 8; ++kk) *(u32x4*)(o + 8 * kk) = (u32x4){0u, 0u, 0u, 0u};
        return;
    }
    const float* w = W + (size_t)k0 * N + s;
    float v[64];
#pragma unroll
    for (int j = 0; j < 64; ++j) v[j] = __builtin_nontemporal_load(w + (size_t)j * N);
#pragma unroll
    for (int kk = 0; kk < 8; ++kk) {
        u32x4 p; p.x = cvt_pk_bf16(v[8 * kk], v[8 * kk + 1]); p.y = cvt_pk_bf16(v[8 * kk + 2], v[8 * kk + 3]); p.z = cvt_pk_bf16(v[8 * kk + 4], v[8 * kk + 5]); p.w = cvt_pk_bf16(v[8 * kk + 6], v[8 * kk + 7]);
        *(u32x4*)(o + 8 * kk) = p;
    }
}
DI void phase0(const Params& p, int gw, int NGW, int lane) {
    unsigned char* ws = p.ws;
    constexpr int I_WIN = (NPAD / 64) * 16, I_SQ = 16 * 16, I_MOD = 48 * 8, NITEMS = I_WIN + 3 * I_SQ + I_MOD;
    for (int it = gw; it < NITEMS; it += NGW) {
        int r = it;
        if (r < I_WIN) { p0_transpose_item(p.in[5], NIN, (bf16_t*)(ws + WS_WIN), r >> 4, r & 15, lane, true); continue; } r -= I_WIN;
        if (r < I_SQ) { p0_transpose_item(p.in[11], D, (bf16_t*)(ws + WS_WPA), r >> 4, r & 15, lane, false); continue; } r -= I_SQ;
        if (r < I_SQ) { p0_transpose_item(p.in[12], D, (bf16_t*)(ws + WS_WPB), r >> 4, r & 15, lane, false); continue; } r -= I_SQ;
        if (r < I_SQ) { p0_transpose_item(p.in[13], D, (bf16_t*)(ws + WS_WO), r >> 4, r & 15, lane, false); continue; } r -= I_SQ;
        const int cgp = r >> 3, ks = r & 7; const float* c = p.in[1]; const float* wa = p.in[2] + (size_t)(ks * 128) * 3072 + cgp * 64 + lane;
        float a0 = 0.f, a1 = 0.f;
#pragma unroll
        for (int k0 = 0; k0 < 128; k0 += 32) {
            float wv[32];
#pragma unroll
            for (int k = 0; k < 32; ++k) wv[k] = __builtin_nontemporal_load(wa + (size_t)(k0 + k) * 3072);
#pragma unroll
            for (int k = 0; k < 32; ++k) { a0 += siluf_(c[ks * 128 + k0 + k]) * wv[k]; a1 += siluf_(c[D + ks * 128 + k0 + k]) * wv[k]; }
        }
        float* mp = (float*)(ws + WS_MODP) + (size_t)ks * 2 * 3072 + cgp * 64 + lane;
        mp[0] = a0; mp[3072] = a1;
    }
}
DI void phase1(const Params& p, float* ldsf, int gw, int NGW, int lane, int tid) {
    const float* modp = (const float*)(p.ws + WS_MODP); const float* b_ada = p.in[3]; const float* nw = p.in[4];
    float* s_tab = ldsf;
    float* a_tab = ldsf + 2048;
    for (int idx = tid; idx < 2 * 2048; idx += NTHREADS) {
        const int b = idx >> 11, j = idx & 2047; float s = b_ada[j];
#pragma unroll
        for (int q = 0; q < 8; ++q) s += modp[(size_t)q * 2 * 3072 + b * 3072 + j];
        if (j < 1024) s_tab[b * 1024 + j] = s; else a_tab[b * 1024 + j - 1024] = nw[j - 1024] * (1.f + s);
    }
    if (blockIdx.x == 0) {
        float* modf = (float*)(p.ws + WS_MODF);
        for (int idx = tid; idx < 2 * 1024; idx += NTHREADS) {
            const int b = idx >> 10, j = idx & 1023; float s = b_ada[2048 + j];
#pragma unroll
            for (int q = 0; q < 8; ++q) s += modp[(size_t)q * 2 * 3072 + b * 3072 + 2048 + j];
            modf[b * 1024 + j] = s;
        }
    }
    __syncthreads();
    bf16_t* H = (bf16_t*)(p.ws + 0 * UNIT);
    for (int m0 = gw; m0 < M; m0 += 2 * NGW) {
        const int m1 = m0 + NGW < M ? m0 + NGW : m0;
        f32x4 v[2][4]; float s[2] = {0.f, 0.f};
#pragma unroll
        for (int u = 0; u < 2; ++u) { const f32x4* xr = (const f32x4*)(p.in[0] + (size_t)(u ? m1 : m0) * D) + lane;
#pragma unroll
            for (int j = 0; j < 4; ++j) v[u][j] = __builtin_nontemporal_load(xr + 64 * j); }
#pragma unroll
        for (int u = 0; u < 2; ++u) {
#pragma unroll
            for (int j = 0; j < 4; ++j) s[u] += (v[u][j].x * v[u][j].x + v[u][j].y * v[u][j].y) + (v[u][j].z * v[u][j].z + v[u][j].w * v[u][j].w);
            const int m = u ? m1 : m0; const int b = m / SEQ;
            const float rstd = rsqrtf(wave_sum(s[u]) * (1.f / D) + NORM_EPS);
            u32x2* o = (u32x2*)(H + (size_t)m * D) + lane;
#pragma unroll
            for (int j = 0; j < 4; ++j) {
                const f32x4 a = *(const f32x4*)(a_tab + b * 1024 + 4 * lane + 256 * j), sh = *(const f32x4*)(s_tab + b * 1024 + 4 * lane + 256 * j);
                const f32x4 hh = v[u][j] * rstd * a + sh;
                u32x2 w; w.x = cvt_pk_bf16(hh.x, hh.y); w.y = cvt_pk_bf16(hh.z, hh.w); o[64 * j] = w;
            }
        }
    }
    __syncthreads();
}
DI void ab_item(const Params& p, int item, int lane) {
    unsigned char* ws = p.ws; const int il = lane & 15, q = lane >> 4;
    const bf16_t* Hr = (const bf16_t*)(ws + 0 * UNIT) + (size_t)(item * 16 + il) * D + 8 * q;
    const bf16_t* W0 = (const bf16_t*)(ws + WS_WIN) + (size_t)(10240 + il) * D + 8 * q; const bf16_t* W1 = W0 + (size_t)16 * D;
    f32x4 a0 = {0.f, 0.f, 0.f, 0.f}, a1 = {0.f, 0.f, 0.f, 0.f};
#pragma unroll 8
    for (int ks = 0; ks < 32; ++ks) { const bf16x8 hf = *(const bf16x8*)(Hr + 32 * ks);
        a0 = __builtin_amdgcn_mfma_f32_16x16x32_bf16(hf, *(const bf16x8*)(W0 + 32 * ks), a0, 0, 0, 0); a1 = __builtin_amdgcn_mfma_f32_16x16x32_bf16(hf, *(const bf16x8*)(W1 + 32 * ks), a1, 0, 0, 0); }
    float* AB = (float*)(ws + WS_AB) + (size_t)(item * 16 + 4 * q) * 32 + il;
#pragma unroll
    for (int r = 0; r < 4; ++r) { AB[r * 32] = a0[r]; AB[r * 32 + 16] = a1[r]; }
}
DI void phase3_item(const Params& p, int item, int lane) {
    unsigned char* ws = p.ws;
    const bf16_t* Qr = (const bf16_t*)(ws + 1 * UNIT); const bf16_t* Kr = (const bf16_t*)(ws + 2 * UNIT); const bf16_t* Vr = (const bf16_t*)(ws + 3 * UNIT);
    bf16_t* Qn = (bf16_t*)(ws + 4 * UNIT); bf16_t* Kn = (bf16_t*)(ws + 5 * UNIT); bf16_t* Vc = (bf16_t*)p.out;
    const int tg = item & 255, h = (item >> 8) & 7, b = item >> 11; const int t_base = tg * 32; const size_t rb = (size_t)b * SEQ;
    const int col = h * 128 + 2 * lane; const int pcol = h * 128 + permpos(2 * lane);
    const float* cw = p.in[7];
    f32x2 wq[5], wk[5], wv[5];
#pragma unroll
    for (int j = 0; j < 5; ++j) { wq[j] = *(const f32x2*)(cw + j * 3072 + col); wk[j] = *(const f32x2*)(cw + j * 3072 + 1024 + col); wv[j] = *(const f32x2*)(cw + j * 3072 + 2048 + col); }
#pragma unroll
    for (int hf = 0; hf < 2; ++hf) {
        unsigned rq[20], rk[20], rv[20];
#pragma unroll
        for (int j = 0; j < 20; ++j) {
            const int t = t_base + 16 * hf - 2 + j; const bool ok = (t >= 0) && (t < SEQ); const int tc = t < 0 ? 0 : (t >= SEQ ? SEQ - 1 : t);
            const size_t off = (rb + tc) * D + col;
            const unsigned a0 = *(const unsigned*)(Qr + off), a1 = *(const unsigned*)(Kr + off), a2 = *(const unsigned*)(Vr + off);
            rq[j] = ok ? a0 : 0u; rk[j] = ok ? a1 : 0u; rv[j] = ok ? a2 : 0u;
        }
#pragma unroll
        for (int t16 = 0; t16 < 16; ++t16) {
            const int tt = 16 * hf + t16, t = t_base + tt;
            float q0 = 0.f, q1 = 0.f, k0 = 0.f, k1 = 0.f, v0 = 0.f, v1 = 0.f;
#pragma unroll
            for (int j = 0; j < 5; ++j) { q0 += wq[j].x * bf_lo(rq[t16 + j]); q1 += wq[j].y * bf_hi(rq[t16 + j]); k0 += wk[j].x * bf_lo(rk[t16 + j]); k1 += wk[j].y * bf_hi(rk[t16 + j]); v0 += wv[j].x * bf_lo(rv[t16 + j]); v1 += wv[j].y * bf_hi(rv[t16 + j]); }
            q0 = siluf_(q0); q1 = siluf_(q1); k0 = siluf_(k0); k1 = siluf_(k1); v0 = siluf_(v0); v1 = siluf_(v1);
            const float rq_ = rsqrtf(wave_sum(q0 * q0 + q1 * q1) + L2_EPS) * 0.08838834764831845f, rk_ = rsqrtf(wave_sum(k0 * k0 + k1 * k1) + L2_EPS);
            q0 *= rq_; q1 *= rq_; k0 *= rk_; k1 *= rk_;
            const size_t ro = (rb + t) * D;
            *(unsigned*)(Qn + ro + pcol) = cvt_pk_bf16(q0, q1); *(unsigned*)(Kn + ro + pcol) = cvt_pk_bf16(k0, k1); *(unsigned*)(Vc + ro + col) = cvt_pk_bf16(v0, v1);
        }
    }
    { const int i = lane & 31, dir = lane >> 5; const size_t row = rb + t_base + i; const float* AB = (const float*)(ws + WS_AB);
      const float a_raw = AB[row * 32 + dir * 8 + h], b_raw = AB[row * 32 + 16 + dir * 8 + h];
      const float g = -__expf(p.in[8][dir * 8 + h]) * softplusf_(a_raw + p.in[9][dir * 8 + h]);
      ((float*)(ws + WS_G))[row * 16 + dir * 8 + h] = g; ((float*)(ws + WS_BETA))[row * 16 + dir * 8 + h] = sigmoidf_(b_raw); }
}
DI void naive_scan(const Params& p, float* ldsw, int task, int lane) {
    unsigned char* ws = p.ws;
    const bf16_t* Qn = (const bf16_t*)(ws + 4 * UNIT); const bf16_t* Kn = (const bf16_t*)(ws + 5 * UNIT); const bf16_t* Vc = (const bf16_t*)p.out;
    const float* G = (const float*)(ws + WS_G); const float* BE = (const float*)(ws + WS_BETA);
    const int chain = task >> 1, b = chain >> 4, dir = (chain >> 3) & 1, h = chain & 7, e = (task & 1) * 64 + lane;
    bf16_t* O = (dir ? (bf16_t*)(p.out) + (size_t)M * D : (bf16_t*)(ws + 3 * UNIT));
    float* kb = ldsw; float* qb = ldsw + 128;
    float P[128];
#pragma unroll
    for (int d = 0; d < 128; ++d) P[d] = 0.f;
    for (int n = 0; n < SEQ; ++n) {
        const int t = dir ? SEQ - 1 - n : n; const size_t row = (size_t)b * SEQ + t;
        const unsigned ku = *(const unsigned*)(Kn + row * D + h * 128 + 2 * lane), qu = *(const unsigned*)(Qn + row * D + h * 128 + 2 * lane);
        const float v = bf1(Vc[row * D + h * 128 + e]); const float al = __expf(G[row * 16 + dir * 8 + h]), be = BE[row * 16 + dir * 8 + h];
        kb[2 * lane] = bf_lo(ku); kb[2 * lane + 1] = bf_hi(ku); qb[2 * lane] = bf_lo(qu); qb[2 * lane + 1] = bf_hi(qu);
        asm volatile("s_waitcnt lgkmcnt(0)" ::: "memory");
        float sk = 0.f;
#pragma unroll
        for (int d4 = 0; d4 < 32; ++d4) { if ((d4 & 3) == 0) __builtin_amdgcn_sched_barrier(0); const f32x4 k4 = *(const f32x4*)(kb + 4 * d4); sk += P[4 * d4] * k4.x + P[4 * d4 + 1] * k4.y + P[4 * d4 + 2] * k4.z + P[4 * d4 + 3] * k4.w; }
        const float vn = be * (v - al * sk); float o = 0.f;
#pragma unroll
        for (int d4 = 0; d4 < 32; ++d4) { if ((d4 & 3) == 0) __builtin_amdgcn_sched_barrier(0); const f32x4 k4 = *(const f32x4*)(kb + 4 * d4), q4 = *(const f32x4*)(qb + 4 * d4);
            P[4 * d4] = al * P[4 * d4] + k4.x * vn; P[4 * d4 + 1] = al * P[4 * d4 + 1] + k4.y * vn; P[4 * d4 + 2] = al * P[4 * d4 + 2] + k4.z * vn; P[4 * d4 + 3] = al * P[4 * d4 + 3] + k4.w * vn;
            o += P[4 * d4] * q4.x + P[4 * d4 + 1] * q4.y + P[4 * d4 + 2] * q4.z + P[4 * d4 + 3] * q4.w; }
        O[row * D + h * 128 + e] = (bf16_t)(cvt_pk_bf16(o, 0.f) & 0xffffu);
        asm volatile("s_waitcnt lgkmcnt(0)" ::: "memory");
    }
}
DI void ya_acc(float (&acc)[8], const u32x4& pv, const f32x4& wa, const f32x4& wb) {
    acc[0] += wa.x * bf_lo(pv.x); acc[1] += wa.y * bf_hi(pv.x); acc[2] += wa.z * bf_lo(pv.y); acc[3] += wa.w * bf_hi(pv.y);
    acc[4] += wb.x * bf_lo(pv.z); acc[5] += wb.y * bf_hi(pv.z); acc[6] += wb.z * bf_lo(pv.w); acc[7] += wb.w * bf_hi(pv.w);
}
DI void phase7(const Params& p, int gw, int NGW, int lane, int gtid, int NGT) {
    unsigned char* ws = p.ws;
    const bf16_t* Pb = (const bf16_t*)(ws + 1 * UNIT); bf16_t* R = (bf16_t*)(ws + 2 * UNIT); const float* cw = p.in[6];
    for (int it = gtid; it < (M / 4) * 128; it += NGT) {
        const int row0 = (it >> 7) * 4, c8 = (it & 127) * 8, t0 = row0 & (SEQ - 1);
        const u32x4 z = (u32x4){0u, 0u, 0u, 0u};
        u32x4 pv[6], rv[4];
        { const u32x4 t_ = *(const u32x4*)(Pb + (size_t)(t0 > 0 ? row0 - 1 : row0) * D + c8); pv[0] = t0 > 0 ? t_ : z; }
#pragma unroll
        for (int j = 0; j < 4; ++j) { pv[j + 1] = *(const u32x4*)(Pb + (size_t)(row0 + j) * D + c8); rv[j] = *(const u32x4*)(R + (size_t)(row0 + j) * D + c8); }
        { const u32x4 t_ = *(const u32x4*)(Pb + (size_t)(t0 + 4 < SEQ ? row0 + 4 : row0) * D + c8); pv[5] = t0 + 4 < SEQ ? t_ : z; }
        f32x4 wa[3], wb[3];
#pragma unroll
        for (int j = 0; j < 3; ++j) { wa[j] = *(const f32x4*)(cw + j * D + c8); wb[j] = *(const f32x4*)(cw + j * D + c8 + 4); }
#pragma unroll
        for (int j = 0; j < 4; ++j) {
            float acc[8] = {0.f, 0.f, 0.f, 0.f, 0.f, 0.f, 0.f, 0.f};
            ya_acc(acc, pv[j], wa[0], wb[0]); ya_acc(acc, pv[j + 1], wa[1], wb[1]); ya_acc(acc, pv[j + 2], wa[2], wb[2]);
            u32x4 o; const u32x4 r = rv[j];
            o.x = cvt_pk_bf16(bf_lo(r.x) * acc[0], bf_hi(r.x) * acc[1]); o.y = cvt_pk_bf16(bf_lo(r.y) * acc[2], bf_hi(r.y) * acc[3]);
            o.z = cvt_pk_bf16(bf_lo(r.z) * acc[4], bf_hi(r.z) * acc[5]); o.w = cvt_pk_bf16(bf_lo(r.w) * acc[6], bf_hi(r.w) * acc[7]);
            *(u32x4*)(R + (size_t)(row0 + j) * D + c8) = o;
        }
    }
    const bf16_t* Of = (const bf16_t*)(ws + 3 * UNIT); const bf16_t* Ob = (const bf16_t*)p.out + (size_t)M * D; bf16_t* SZ = (bf16_t*)(ws + 6 * UNIT);
    const f32x4 g0 = *(const f32x4*)(p.in[10] + (lane & 15) * 8), g1 = *(const f32x4*)(p.in[10] + (lane & 15) * 8 + 4);
    for (int rp = gw; rp < M / 2; rp += NGW) {
        u32x4 a[4], bb[4], zz[4];
#pragma unroll
        for (int u = 0; u < 4; ++u) { const size_t off = (size_t)(rp * 2 + (u >> 1)) * D + (u & 1) * 512 + lane * 8;
            a[u] = __builtin_nontemporal_load((const u32x4*)(Of + off)); bb[u] = __builtin_nontemporal_load((const u32x4*)(Ob + off)); zz[u] = __builtin_nontemporal_load((const u32x4*)(SZ + off)); }
#pragma unroll
        for (int u = 0; u < 4; ++u) { const size_t off = (size_t)(rp * 2 + (u >> 1)) * D + (u & 1) * 512 + lane * 8;
            float o[8];
            o[0] = bf_lo(a[u].x) + bf_lo(bb[u].x); o[1] = bf_hi(a[u].x) + bf_hi(bb[u].x); o[2] = bf_lo(a[u].y) + bf_lo(bb[u].y); o[3] = bf_hi(a[u].y) + bf_hi(bb[u].y);
            o[4] = bf_lo(a[u].z) + bf_lo(bb[u].z); o[5] = bf_hi(a[u].z) + bf_hi(bb[u].z); o[6] = bf_lo(a[u].w) + bf_lo(bb[u].w); o[7] = bf_hi(a[u].w) + bf_hi(bb[u].w);
            float ss = 0.f;
#pragma unroll
            for (int j = 0; j < 8; ++j) ss += o[j] * o[j];
            ss = row16_sum(ss);
            const float rs = rsqrtf(ss * (1.f / 128.f) + NORM_EPS);
            u32x4 w;
            w.x = cvt_pk_bf16(o[0] * rs * g0.x * bf_lo(zz[u].x), o[1] * rs * g0.y * bf_hi(zz[u].x)); w.y = cvt_pk_bf16(o[2] * rs * g0.z * bf_lo(zz[u].y), o[3] * rs * g0.w * bf_hi(zz[u].y));
            w.z = cvt_pk_bf16(o[4] * rs * g1.x * bf_lo(zz[u].z), o[5] * rs * g1.y * bf_hi(zz[u].z)); w.w = cvt_pk_bf16(o[6] * rs * g1.z * bf_lo(zz[u].w), o[7] * rs * g1.w * bf_hi(zz[u].w));
            *(u32x4*)(SZ + off) = w;
        }
    }
}
DI void phase7_panel(const Params& p, int pm, int pn, int tid, int lane, int wave) {
    unsigned char* ws = p.ws;
    const bf16_t* Pb = (const bf16_t*)(ws + 1 * UNIT); bf16_t* R = (bf16_t*)(ws + 2 * UNIT); const float* cw = p.in[6];
#pragma unroll 1
    for (int i = 0; i < 4; ++i) {
        const int it = tid + NTHREADS * i; const int row0 = 256 * pm + 4 * (it >> 5), c8 = 256 * pn + 8 * (it & 31), t0 = row0 & (SEQ - 1);
        const u32x4 z = (u32x4){0u, 0u, 0u, 0u};
        u32x4 pv[6], rv[4];
        { const u32x4 t_ = *(const u32x4*)(Pb + (size_t)(t0 > 0 ? row0 - 1 : row0) * D + c8); pv[0] = t0 > 0 ? t_ : z; }
#pragma unroll
        for (int j = 0; j < 4; ++j) { pv[j + 1] = *(const u32x4*)(Pb + (size_t)(row0 + j) * D + c8); rv[j] = *(const u32x4*)(R + (size_t)(row0 + j) * D + c8); }
        { const u32x4 t_ = *(const u32x4*)(Pb + (size_t)(t0 + 4 < SEQ ? row0 + 4 : row0) * D + c8); pv[5] = t0 + 4 < SEQ ? t_ : z; }
        f32x4 wa[3], wb[3];
#pragma unroll
        for (int j = 0; j < 3; ++j) { wa[j] = *(const f32x4*)(cw + j * D + c8); wb[j] = *(const f32x4*)(cw + j * D + c8 + 4); }
#pragma unroll
        for (int j = 0; j < 4; ++j) {
            float acc[8] = {0.f, 0.f, 0.f, 0.f, 0.f, 0.f, 0.f, 0.f};
            ya_acc(acc, pv[j], wa[0], wb[0]); ya_acc(acc, pv[j + 1], wa[1], wb[1]); ya_acc(acc, pv[j + 2], wa[2], wb[2]);
            u32x4 o; const u32x4 r = rv[j];
            o.x = cvt_pk_bf16(bf_lo(r.x) * acc[0], bf_hi(r.x) * acc[1]); o.y = cvt_pk_bf16(bf_lo(r.y) * acc[2], bf_hi(r.y) * acc[3]);
            o.z = cvt_pk_bf16(bf_lo(r.z) * acc[4], bf_hi(r.z) * acc[5]); o.w = cvt_pk_bf16(bf_lo(r.w) * acc[6], bf_hi(r.w) * acc[7]);
            *(u32x4*)(R + (size_t)(row0 + j) * D + c8) = o;
        }
    }
    const bf16_t* Of = (const bf16_t*)(ws + 3 * UNIT); const bf16_t* Ob = (const bf16_t*)p.out + (size_t)M * D; bf16_t* SZ = (bf16_t*)(ws + 6 * UNIT);
    const f32x4 g0 = *(const f32x4*)(p.in[10] + (lane & 15) * 8), g1 = *(const f32x4*)(p.in[10] + (lane & 15) * 8 + 4);
#pragma unroll 1
    for (int i = 0; i < 4; ++i) {
        u32x4 a[4], bb[4], zz[4];
#pragma unroll
        for (int u = 0; u < 4; ++u) { const size_t off = (size_t)(256 * pm + 32 * wave + 8 * i + 2 * u + (lane >> 5)) * D + 256 * pn + (lane & 31) * 8;
            a[u] = __builtin_nontemporal_load((const u32x4*)(Of + off)); bb[u] = __builtin_nontemporal_load((const u32x4*)(Ob + off)); zz[u] = __builtin_nontemporal_load((const u32x4*)(SZ + off)); }
#pragma unroll
        for (int u = 0; u < 4; ++u) { const size_t off = (size_t)(256 * pm + 32 * wave + 8 * i + 2 * u + (lane >> 5)) * D + 256 * pn + (lane & 31) * 8;
            float o[8];
            o[0] = bf_lo(a[u].x) + bf_lo(bb[u].x); o[1] = bf_hi(a[u].x) + bf_hi(bb[u].x); o[2] = bf_lo(a[u].y) + bf_lo(bb[u].y); o[3] = bf_hi(a[u].y) + bf_hi(bb[u].y);
            o[4] = bf_lo(a[u].z) + bf_lo(bb[u].z); o[5] = bf_hi(a[u].z) + bf_hi(bb[u].z); o[6] = bf_lo(a[u].w) + bf_lo(bb[u].w); o[7] = bf_hi(a[u].w) + bf_hi(bb[u].w);
            float ss = 0.f;
#pragma unroll
            for (int j = 0; j < 8; ++j) ss += o[j] * o[j];
            ss = row16_sum(ss);
            const float rs = rsqrtf(ss * (1.f / 128.f) + NORM_EPS);
            u32x4 w;
            w.x = cvt_pk_bf16(o[0] * rs * g0.x * bf_lo(zz[u].x), o[1] * rs * g0.y * bf_hi(zz[u].x)); w.y = cvt_pk_bf16(o[2] * rs * g0.z * bf_lo(zz[u].y), o[3] * rs * g0.w * bf_hi(zz[u].y));
            w.z = cvt_pk_bf16(o[4] * rs * g1.x * bf_lo(zz[u].z), o[5] * rs * g1.y * bf_hi(zz[u].z)); w.w = cvt_pk_bf16(o[6] * rs * g1.z * bf_lo(zz[u].w), o[7] * rs * g1.w * bf_hi(zz[u].w));
            *(u32x4*)(SZ + off) = w;
        }
    }
}
DI void phase10(const Params& p, int gw, int NGW, int lane) {
    const float* XN = (const float*)(p.ws + 0 * UNIT); const float* fw = p.in[14];
    f32x4 w[4];
#pragma unroll
    for (int j = 0; j < 4; ++j) w[j] = *((const f32x4*)fw + lane + 64 * j);
    for (int m = gw; m < M; m += NGW) {
        const f32x4* xr = (const f32x4*)(XN + (size_t)m * D) + lane; f32x4 v[4]; float s = 0.f;
#pragma unroll
        for (int j = 0; j < 4; ++j) { v[j] = xr[64 * j]; s += (v[j].x * v[j].x + v[j].y * v[j].y) + (v[j].z * v[j].z + v[j].w * v[j].w); }
        const float rstd = rsqrtf(wave_sum(s) * (1.f / D) + NORM_EPS);
        f32x4* o = (f32x4*)(p.out + (size_t)m * D) + lane;
#pragma unroll
        for (int j = 0; j < 4; ++j) o[64 * j] = v[j] * rstd * w[j];
    }
}
#define MFMA16(a, b, c) __builtin_amdgcn_mfma_f32_16x16x32_bf16((a), (b), (c), 0, 0, 0)
DI void chunk_prep_item(const Params& p, float* Lm, int item, int lane) {
    unsigned char* ws = p.ws;
    const bf16_t* Qn = (const bf16_t*)(ws + 4 * UNIT); const bf16_t* Kn = (const bf16_t*)(ws + 5 * UNIT);
    bf16_t* TF = (bf16_t*)(ws + 1 * UNIT) + (size_t)item * 4096; bf16_t* AF = (bf16_t*)(ws + 2 * UNIT) + (size_t)item * 4096;
    float* csc = (float*)(ws + WS_CSC) + (size_t)item * 192;
    const int c = item & 127, h = (item >> 7) & 7, dir = (item >> 10) & 1, b = item >> 11;
    const size_t rb = (size_t)b * SEQ + c * 64; const int il = lane & 15, q = lane >> 4;
    const int tl = dir ? 63 - lane : lane;
    const float g = ((const float*)(ws + WS_G))[(rb + tl) * 16 + dir * 8 + h], be = ((const float*)(ws + WS_BETA))[(rb + tl) * 16 + dir * 8 + h];
    float gc = g;
#pragma unroll
    for (int o = 1; o < 64; o <<= 1) { const float v = __shfl_up(gc, o); if (lane >= o) gc += v; }
    const float gl = __shfl(gc, 63);
    csc[tl] = __expf(gc); csc[64 + tl] = be; csc[128 + tl] = __expf(gl - gc);
    float gcr[4][4], ber[4][4], gcc[4];
#pragma unroll
    for (int t = 0; t < 4; ++t) { gcc[t] = __shfl(gc, 16 * t + il);
#pragma unroll
        for (int r = 0; r < 4; ++r) { gcr[t][r] = __shfl(gc, 16 * t + 4 * q + r); ber[t][r] = __shfl(be, 16 * t + 4 * q + r); } }
    bf16x8 Kf[4][4];
#pragma unroll
    for (int rt = 0; rt < 4; ++rt) { const int ip = 16 * rt + il; const size_t ro = (rb + (dir ? 63 - ip : ip)) * D + h * 128 + 8 * q;
#pragma unroll
        for (int ks = 0; ks < 4; ++ks) Kf[rt][ks] = *(const bf16x8*)(Kn + ro + 32 * ks); }
#pragma unroll
    for (int it = 0; it < 4; ++it)
#pragma unroll
        for (int jt = 0; jt <= it; ++jt) {
            f32x4 acc = {0.f, 0.f, 0.f, 0.f};
#pragma unroll
            for (int ks = 0; ks < 4; ++ks) acc = MFMA16(Kf[it][ks], Kf[jt][ks], acc);
#pragma unroll
            for (int r = 0; r < 4; ++r) { const int ip = 16 * it + 4 * q + r, jp = 16 * jt + il;
                Lm[ip * 64 + jp] = ip > jp ? ber[it][r] * acc[r] * __expf(gcr[it][r] - gcc[jt]) : 0.f; }
        }
    __builtin_amdgcn_sched_barrier(0);
    bf16x8 Qnext[4];
    { const int ip = il; const size_t ro = (rb + (dir ? 63 - ip : ip)) * D + h * 128 + 8 * q;
#pragma unroll
      for (int ks = 0; ks < 4; ++ks) Qnext[ks] = *(const bf16x8*)(Qn + ro + 32 * ks); }
#pragma unroll
    for (int mt = 0; mt < 4; ++mt) {
        bf16x8 Qf[4];
#pragma unroll
        for (int ks = 0; ks < 4; ++ks) Qf[ks] = Qnext[ks];
        if (mt < 3) { const int ip = 16 * (mt + 1) + il; const size_t ro = (rb + (dir ? 63 - ip : ip)) * D + h * 128 + 8 * q;
#pragma unroll
          for (int ks = 0; ks < 4; ++ks) Qnext[ks] = *(const bf16x8*)(Qn + ro + 32 * ks); }
#pragma unroll
        for (int ks2 = 0; ks2 < 2; ++ks2) {
            float vals[8];
#pragma unroll
            for (int a = 0; a < 2; ++a) { const int jt = 2 * ks2 + a; f32x4 acc = {0.f, 0.f, 0.f, 0.f};
#pragma unroll
                for (int ks = 0; ks < 4; ++ks) acc = MFMA16(Kf[jt][ks], Qf[ks], acc);
#pragma unroll
                for (int r = 0; r < 4; ++r) { const int jp = 16 * jt + 4 * q + r, ip = 16 * mt + il; vals[4 * a + r] = ip >= jp ? acc[r] * __expf(gcc[mt] - gcr[jt][r]) : 0.f; } }
            u32x4 w;
            if (dir) { w.x = cvt_pk_bf16(vals[7], vals[6]); w.y = cvt_pk_bf16(vals[5], vals[4]); w.z = cvt_pk_bf16(vals[3], vals[2]); w.w = cvt_pk_bf16(vals[1], vals[0]); }
            else { w.x = cvt_pk_bf16(vals[0], vals[1]); w.y = cvt_pk_bf16(vals[2], vals[3]); w.z = cvt_pk_bf16(vals[4], vals[5]); w.w = cvt_pk_bf16(vals[6], vals[7]); }
            const int fi = dir ? ((3 - mt) * 2 + (1 - ks2)) : (mt * 2 + ks2), ln = dir ? ((3 - q) * 16 + (15 - il)) : lane;
            *(u32x4*)(AF + (size_t)(fi * 64 + ln) * 8) = w;
        }
        __builtin_amdgcn_sched_barrier(0);
    }
    asm volatile("s_waitcnt lgkmcnt(0)" ::: "memory");
    __builtin_amdgcn_sched_barrier(0);
    float T[64];
#pragma unroll
    for (int i = 0; i < 64; ++i) {
        float s0 = (lane == i) ? 1.f : 0.f, s1 = 0.f;
#pragma unroll
        for (int m4 = 0; m4 < (i + 3) / 4; ++m4) {
            const f32x4 l4 = *(const f32x4*)(Lm + i * 64 + 4 * m4);
            if (4 * m4 + 0 < i) s0 -= l4.x * T[4 * m4 + 0];
            if (4 * m4 + 1 < i) s1 -= l4.y * T[4 * m4 + 1];
            if (4 * m4 + 2 < i) s0 -= l4.z * T[4 * m4 + 2];
            if (4 * m4 + 3 < i) s1 -= l4.w * T[4 * m4 + 3];
        }
        T[i] = s0 + s1;
        if ((i & 3) == 3) __builtin_amdgcn_sched_barrier(0);
    }
    asm volatile("s_waitcnt lgkmcnt(0)" ::: "memory");
    bf16_t* TL = (bf16_t*)Lm;
#pragma unroll
    for (int i = 0; i < 64; ++i) TL[i * 72 + lane] = (bf16_t)(cvt_pk_bf16(T[i], 0.f) & 0xffffu);
    asm volatile("s_waitcnt lgkmcnt(0)" ::: "memory");
#pragma unroll
    for (int mt = 0; mt < 4; ++mt)
#pragma unroll
        for (int ks2 = 0; ks2 < 2; ++ks2) {
            u32x4 w;
            if (dir) {
                const int row = 63 - 16 * mt - il;
                const u32x2 lo = *(const u32x2*)(TL + row * 72 + (60 - 32 * ks2 - 4 * q)), hi = *(const u32x2*)(TL + row * 72 + (44 - 32 * ks2 - 4 * q));
                w.x = (lo.y >> 16) | (lo.y << 16); w.y = (lo.x >> 16) | (lo.x << 16); w.z = (hi.y >> 16) | (hi.y << 16); w.w = (hi.x >> 16) | (hi.x << 16);
            } else {
                const int row = 16 * mt + il;
                const u32x2 lo = *(const u32x2*)(TL + row * 72 + (32 * ks2 + 4 * q)), hi = *(const u32x2*)(TL + row * 72 + (32 * ks2 + 16 + 4 * q));
                w.x = lo.x; w.y = lo.y; w.z = hi.x; w.w = hi.y;
            }
            *(u32x4*)(TF + (size_t)((mt * 2 + ks2) * 64 + lane) * 8) = w;
        }
    asm volatile("s_waitcnt lgkmcnt(0)" ::: "memory");
}
DI bf16x8 pack8(const f32x4& a, const f32x4& b) {
    u32x4 w; w.x = cvt_pk_bf16(a[0], a[1]); w.y = cvt_pk_bf16(a[2], a[3]); w.z = cvt_pk_bf16(b[0], b[1]); w.w = cvt_pk_bf16(b[2], b[3]);
    return __builtin_bit_cast(bf16x8, w);
}
DI void mfma_scan(const Params& p, int chain, int slice, int lane) {
    unsigned char* ws = p.ws;
    const bf16_t* Qn = (const bf16_t*)(ws + 4 * UNIT); const bf16_t* Kn = (const bf16_t*)(ws + 5 * UNIT); const bf16_t* KT = (const bf16_t*)(ws + 6 * UNIT); const bf16_t* Vc = (const bf16_t*)p.out;
    const bf16_t* TFb = (const bf16_t*)(ws + 1 * UNIT); const bf16_t* AFb = (const bf16_t*)(ws + 2 * UNIT); const float* cscb = (const float*)(ws + WS_CSC);
    const int b = chain >> 4, dir = (chain >> 3) & 1, h = chain & 7, il = lane & 15, q = lane >> 4;
    bf16_t* O = (dir ? (bf16_t*)(p.out) + (size_t)M * D : (bf16_t*)(ws + 3 * UNIT));
    f32x4 S[8];
#pragma unroll
    for (int dt = 0; dt < 8; ++dt) S[dt] = (f32x4){0.f, 0.f, 0.f, 0.f};
    for (int n = 0; n < 128; ++n) {
        const int c = dir ? 127 - n : n; const int item = chain * 128 + c; const size_t rowbase = (size_t)b * SEQ + c * 64;
        const bf16_t* TF = TFb + (size_t)item * 4096 + lane * 8; const bf16_t* AF = AFb + (size_t)item * 4096 + lane * 8; const float* csc = cscb + (size_t)item * 192;
        const float gl = csc[dir ? 0 : 63];
        f32x4 EG[4], BE[4], EK[4], V[4];
#pragma unroll
        for (int mt = 0; mt < 4; ++mt) { EG[mt] = *(const f32x4*)(csc + 16 * mt + 4 * q); BE[mt] = *(const f32x4*)(csc + 64 + 16 * mt + 4 * q); EK[mt] = *(const f32x4*)(csc + 128 + 16 * mt + 4 * q);
#pragma unroll
            for (int r = 0; r < 4; ++r) V[mt][r] = bf1(Vc[(rowbase + 16 * mt + 4 * q + r) * D + h * 128 + 16 * slice + il]); }
        bf16x8 Sb[4];
#pragma unroll
        for (int ks = 0; ks < 4; ++ks) Sb[ks] = pack8(S[2 * ks], S[2 * ks + 1]);
        f32x4 KS[4], QS[4];
#pragma unroll
        for (int mt = 0; mt < 4; ++mt) { const size_t ro = (rowbase + 16 * mt + il) * D + h * 128 + 8 * q;
            KS[mt] = (f32x4){0.f, 0.f, 0.f, 0.f}; QS[mt] = (f32x4){0.f, 0.f, 0.f, 0.f};
#pragma unroll
            for (int ks = 0; ks < 4; ++ks) { KS[mt] = MFMA16(*(const bf16x8*)(Kn + ro + 32 * ks), Sb[ks], KS[mt]); QS[mt] = MFMA16(*(const bf16x8*)(Qn + ro + 32 * ks), Sb[ks], QS[mt]); } }
        f32x4 X[4];
#pragma unroll
        for (int mt = 0; mt < 4; ++mt) X[mt] = BE[mt] * (V[mt] - EG[mt] * KS[mt]);
        bf16x8 Xb[2] = {pack8(X[0], X[1]), pack8(X[2], X[3])};
        f32x4 VN[4];
#pragma unroll
        for (int mt = 0; mt < 4; ++mt) { VN[mt] = (f32x4){0.f, 0.f, 0.f, 0.f};
#pragma unroll
            for (int ks2 = 0; ks2 < 2; ++ks2) VN[mt] = MFMA16(*(const bf16x8*)(TF + (size_t)((mt * 2 + ks2) * 64) * 8), Xb[ks2], VN[mt]); }
        bf16x8 VNb[2] = {pack8(VN[0], VN[1]), pack8(VN[2], VN[3])};
        bf16x8 VNs[2] = {pack8(VN[0] * EK[0], VN[1] * EK[1]), pack8(VN[2] * EK[2], VN[3] * EK[3])};
#pragma unroll
        for (int mt = 0; mt < 4; ++mt) { f32x4 o = EG[mt] * QS[mt];
#pragma unroll
            for (int ks2 = 0; ks2 < 2; ++ks2) o = MFMA16(*(const bf16x8*)(AF + (size_t)((mt * 2 + ks2) * 64) * 8), VNb[ks2], o);
#pragma unroll
            for (int r = 0; r < 4; ++r) O[(rowbase + 16 * mt + 4 * q + r) * D + h * 128 + 16 * slice + il] = (bf16_t)(cvt_pk_bf16(o[r], 0.f) & 0xffffu); }
#pragma unroll
        for (int dt = 0; dt < 8; ++dt) { const bf16_t* kt = KT + ((size_t)((b * 8 + h) * 128 + 16 * dt + il)) * SEQ + c * 64 + 8 * q; f32x4 s = S[dt] * gl;
#pragma unroll
            for (int ks2 = 0; ks2 < 2; ++ks2) s = MFMA16(*(const bf16x8*)(kt + 32 * ks2), VNs[ks2], s);
            S[dt] = s; }
    }
}
constexpr int SC_K = 0, SC_Q = 16384, SC_T = 32768, SC_A = 40960, SC_V = 49152, SC_C = 51200, SC_BUF = 52224, SC_NPIECE = 3248, SC_NLD = 384, SC_PPL = 9;
constexpr int SC_SB = 2 * SC_BUF, SC_VB = SC_SB + 2 * 4096, SC_END = SC_VB + 2 * 2048;
static_assert(SC_END <= LDS_BYTES - 256, "scan LDS");
typedef short s16x4_t __attribute__((ext_vector_type(4)));
#define SC_BAR() do { asm volatile("s_waitcnt lgkmcnt(0)" ::: "memory"); __builtin_amdgcn_s_barrier(); asm volatile("" ::: "memory"); } while (0)
DI void scan_task(const Params& p, PG8_LAS unsigned char* lds, int chain, int slice, int tid, int wave, int lane) {
    unsigned char* ws = p.ws;
    const int b = chain >> 4, dir = (chain >> 3) & 1, h = chain & 7, il = lane & 15, q = lane >> 4;
    const int c0 = dir ? 127 : 0; const long sgn = dir ? -1 : 1;
    if (wave >= 2) {
        const int lt = tid - 128; const int wbase = 64 * (wave - 2);
        const unsigned char* gp[SC_PPL]; int gstride[SC_PPL];
        const size_t rowbase0 = (size_t)b * SEQ + c0 * 64; const size_t item0 = (size_t)chain * 128 + c0;
#pragma unroll
        for (int k = 0; k < SC_PPL; ++k) {
            int pid = lt + SC_NLD * k; if (pid >= SC_NPIECE) pid -= 64;
            const unsigned char* g = ws; int st = 0;
            if (pid < 2048) { const int pp = pid & 1023, row = pp >> 4, ch = (pp & 15) ^ (row & 15);
                g = ws + (pid < 1024 ? 5 : 4) * UNIT + ((rowbase0 + row) * D + h * 128) * 2 + ch * 16; st = 64 * D * 2; }
            else if (pid < 3072) { const int pp = pid & 511; const bool isT = pid < 2560;
                g = ws + (isT ? 1 : 2) * UNIT + item0 * 8192 + pp * 16; st = 8192; }
            else if (pid < 3200) { const int pp = pid - 3072, row = pp >> 1, hf = pp & 1;
                g = (const unsigned char*)p.out + ((rowbase0 + row) * D + h * 128 + slice * 16) * 2 + hf * 16; st = 64 * D * 2; }
            else { const int pp = pid - 3200; g = ws + WS_CSC + item0 * 768 + pp * 16; st = 768; }
            gp[k] = g; gstride[k] = st;
        }
#define SC_DMA(bo) do { _Pragma("unroll") for (int k = 0; k < SC_PPL; ++k) { if (wbase + SC_NLD * k < SC_NPIECE) \
            __builtin_amdgcn_global_load_lds((const unsigned*)gp[k], (PG8_LAS unsigned*)(lds + (bo) + (wbase + SC_NLD * k) * 16), 16, 0, 0); gp[k] += sgn * gstride[k]; } } while (0)
        SC_DMA(0u);
        asm volatile("s_waitcnt vmcnt(0)" ::: "memory");
        SC_BAR();
        for (int n = 0; n < 128; ++n) {
            if (n + 1 < 128) SC_DMA((unsigned)(((n + 1) & 1) * SC_BUF));
            asm volatile("s_waitcnt vmcnt(0)" ::: "memory");
            SC_BAR();
        }
#undef SC_DMA
    } else if (wave == 0) {
        f32x4 S[8];
#pragma unroll
        for (int dt = 0; dt < 8; ++dt) S[dt] = (f32x4){0.f, 0.f, 0.f, 0.f};
        bf16x8 Sb[4];
#pragma unroll
        for (int ks = 0; ks < 4; ++ks) { Sb[ks] = pack8(S[2 * ks], S[2 * ks + 1]); *(PG8_LAS bf16x8*)(lds + SC_SB + (ks * 64 + lane) * 16) = Sb[ks]; }
        SC_BAR();
        for (int n = 0; n < 128; ++n) {
            PG8_LAS unsigned char* L = lds + (n & 1) * SC_BUF;
            bf16x8 Kf[4][4];
#pragma unroll
            for (int mt = 0; mt < 4; ++mt)
#pragma unroll
                for (int ks = 0; ks < 4; ++ks) Kf[mt][ks] = *(PG8_LAS bf16x8*)(L + SC_K + (16 * mt + il) * 256 + (((4 * ks + q) ^ il) << 4));
            f32x4 EG[4], BE[4], V[4]; bf16x8 Tf[4][2];
#pragma unroll
            for (int mt = 0; mt < 4; ++mt) { EG[mt] = *(PG8_LAS f32x4*)(L + SC_C + (16 * mt + 4 * q) * 4); BE[mt] = *(PG8_LAS f32x4*)(L + SC_C + 256 + (16 * mt + 4 * q) * 4);
#pragma unroll
                for (int r = 0; r < 4; ++r) V[mt][r] = bf1(*(PG8_LAS bf16_t*)(L + SC_V + (16 * mt + 4 * q + r) * 32 + il * 2));
#pragma unroll
                for (int ks2 = 0; ks2 < 2; ++ks2) Tf[mt][ks2] = *(PG8_LAS bf16x8*)(L + SC_T + ((mt * 2 + ks2) * 64 + lane) * 16); }
            f32x4 KS[4];
#pragma unroll
            for (int mt = 0; mt < 4; ++mt) KS[mt] = (f32x4){0.f, 0.f, 0.f, 0.f};
#pragma unroll
            for (int ks = 0; ks < 4; ++ks)
#pragma unroll
                for (int mt = 0; mt < 4; ++mt) KS[mt] = MFMA16(Kf[mt][ks], Sb[ks], KS[mt]);
            __builtin_amdgcn_sched_barrier(0);
            bf16x8 KTf[8][2]; f32x4 EK[4];
            { const int rr = il >> 2, pc = il & 3;
              PG8_LAS unsigned char* kb = L + SC_K + (4 * q + rr) * 256;
#pragma unroll
              for (int dt = 0; dt < 8; ++dt) {
                const int cho = (((4 * (dt >> 1) + pc) ^ (4 * q + rr)) << 4) + 8 * (dt & 1);
#pragma unroll
                for (int ks2 = 0; ks2 < 2; ++ks2) {
                    const s16x4_t lo_ = __builtin_amdgcn_ds_read_tr16_b64_v4i16((PG8_LAS s16x4_t*)(kb + (32 * ks2) * 256 + cho));
                    const s16x4_t hi_ = __builtin_amdgcn_ds_read_tr16_b64_v4i16((PG8_LAS s16x4_t*)(kb + (32 * ks2 + 16) * 256 + cho));
                    KTf[dt][ks2] = __builtin_shufflevector(lo_, hi_, 0, 1, 2, 3, 4, 5, 6, 7);
                } } }
#pragma unroll
            for (int mt = 0; mt < 4; ++mt) EK[mt] = *(PG8_LAS f32x4*)(L + SC_C + 512 + (16 * mt + 4 * q) * 4);
            const float gl = *(PG8_LAS float*)(L + SC_C + (dir ? 0 : 63) * 4);
            f32x4 X[4];
#pragma unroll
            for (int mt = 0; mt < 4; ++mt) X[mt] = BE[mt] * (V[mt] - EG[mt] * KS[mt]);
            bf16x8 Xb[2] = {pack8(X[0], X[1]), pack8(X[2], X[3])};
            f32x4 VN[4];
#pragma unroll
            for (int mt = 0; mt < 4; ++mt) VN[mt] = (f32x4){0.f, 0.f, 0.f, 0.f};
#pragma unroll
            for (int ks2 = 0; ks2 < 2; ++ks2)
#pragma unroll
                for (int mt = 0; mt < 4; ++mt) VN[mt] = MFMA16(Tf[mt][ks2], Xb[ks2], VN[mt]);
            *(PG8_LAS bf16x8*)(lds + SC_VB + (n & 1) * 2048 + lane * 16) = pack8(VN[0], VN[1]); *(PG8_LAS bf16x8*)(lds + SC_VB + (n & 1) * 2048 + (64 + lane) * 16) = pack8(VN[2], VN[3]);
            bf16x8 VNs[2] = {pack8(VN[0] * EK[0], VN[1] * EK[1]), pack8(VN[2] * EK[2], VN[3] * EK[3])};
#pragma unroll
            for (int dt = 0; dt < 8; ++dt) S[dt] = S[dt] * gl;
#pragma unroll
            for (int ks2 = 0; ks2 < 2; ++ks2)
#pragma unroll
                for (int dt = 0; dt < 8; ++dt) S[dt] = MFMA16(KTf[dt][ks2], VNs[ks2], S[dt]);
#pragma unroll
            for (int ks = 0; ks < 4; ++ks) { Sb[ks] = pack8(S[2 * ks], S[2 * ks + 1]); *(PG8_LAS bf16x8*)(lds + SC_SB + ((n + 1) & 1) * 4096 + (ks * 64 + lane) * 16) = Sb[ks]; }
            SC_BAR();
        }
    } else {
        bf16_t* O = (dir ? (bf16_t*)(p.out) + (size_t)M * D : (bf16_t*)(ws + 3 * UNIT));
        f32x4 Oa[4]; bf16x8 Af[4][2];
#pragma unroll
        for (int mt = 0; mt < 4; ++mt) { Oa[mt] = (f32x4){0.f, 0.f, 0.f, 0.f}; Af[mt][0] = (bf16x8){0, 0, 0, 0, 0, 0, 0, 0}; Af[mt][1] = Af[mt][0]; }
        SC_BAR();
        for (int n = 0; n <= 128; ++n) {
            if (n > 0) {
                const int c = dir ? 128 - n : n - 1; const size_t rowbase = (size_t)b * SEQ + c * 64;
                PG8_LAS unsigned char* vb = lds + SC_VB + ((n - 1) & 1) * 2048;
                bf16x8 VNb[2] = {*(PG8_LAS bf16x8*)(vb + lane * 16), *(PG8_LAS bf16x8*)(vb + (64 + lane) * 16)};
#pragma unroll
                for (int ks2 = 0; ks2 < 2; ++ks2)
#pragma unroll
                    for (int mt = 0; mt < 4; ++mt) Oa[mt] = MFMA16(Af[mt][ks2], VNb[ks2], Oa[mt]);
#pragma unroll
                for (int mt = 0; mt < 4; ++mt)
#pragma unroll
                    for (int r = 0; r < 4; ++r) __builtin_nontemporal_store((bf16_t)(cvt_pk_bf16(Oa[mt][r], 0.f) & 0xffffu), O + (rowbase + 16 * mt + 4 * q + r) * D + h * 128 + 16 * slice + il);
            }
            if (n < 128) {
                PG8_LAS unsigned char* L = lds + (n & 1) * SC_BUF;
                bf16x8 Qf[4][4], Sb[4]; f32x4 EG[4];
#pragma unroll
                for (int ks = 0; ks < 4; ++ks) Sb[ks] = *(PG8_LAS bf16x8*)(lds + SC_SB + (n & 1) * 4096 + (ks * 64 + lane) * 16);
#pragma unroll
                for (int mt = 0; mt < 4; ++mt) {
#pragma unroll
                    for (int ks = 0; ks < 4; ++ks) Qf[mt][ks] = *(PG8_LAS bf16x8*)(L + SC_Q + (16 * mt + il) * 256 + (((4 * ks + q) ^ il) << 4));
                    EG[mt] = *(PG8_LAS f32x4*)(L + SC_C + (16 * mt + 4 * q) * 4);
#pragma unroll
                    for (int ks2 = 0; ks2 < 2; ++ks2) Af[mt][ks2] = *(PG8_LAS bf16x8*)(L + SC_A + ((mt * 2 + ks2) * 64 + lane) * 16); }
                f32x4 QS[4];
#pragma unroll
                for (int mt = 0; mt < 4; ++mt) QS[mt] = (f32x4){0.f, 0.f, 0.f, 0.f};
#pragma unroll
                for (int ks = 0; ks < 4; ++ks)
#pragma unroll
                    for (int mt = 0; mt < 4; ++mt) QS[mt] = MFMA16(Qf[mt][ks], Sb[ks], QS[mt]);
#pragma unroll
                for (int mt = 0; mt < 4; ++mt) Oa[mt] = EG[mt] * QS[mt];
                SC_BAR();
            }
        }
    }
}


typedef const __attribute__((address_space(4))) Params* kparams_t;
#if defined(__HIP_DEVICE_COMPILE__)
DI Params load_params() { kparams_t pp = (kparams_t)__builtin_amdgcn_kernarg_segment_ptr(); asm volatile("" : "+s"(pp)); return *pp; }
#else
DI Params load_params() { return Params{}; }
#endif
#define PP() load_params()
#define XB_TMO      128
#define XB_XCNT(j)  (256  + 64 * (j))
#define XB_XSUB(j)  (1280 + 64 * (j))
#define XB_XGEN(j)  (2304 + 64 * (j))
#define XB_TOP      3328
#define XB_TOPGEN   3392
#define XCD_BAR_WORDS 3456
#define XB_SPIN_CAP (1u << 18)
#define LAS __attribute__((address_space(3)))

__device__ __forceinline__ unsigned xb_ld(unsigned* p)              { return __hip_atomic_load(p, __ATOMIC_RELAXED, __HIP_MEMORY_SCOPE_AGENT); }
__device__ __forceinline__ unsigned xb_add(unsigned* p, unsigned v) { return __hip_atomic_fetch_add(p, v, __ATOMIC_RELAXED, __HIP_MEMORY_SCOPE_AGENT); }
__device__ __forceinline__ unsigned xb_xcc_id() { return (unsigned)__builtin_amdgcn_s_getreg((3 << 11) | 20) & 0xFu; }
#define XB_SPIN(cond, bar) do { unsigned _sp = 0; while (cond) { __builtin_amdgcn_s_sleep(1); \
    if ((++_sp & 255u) == 0u) { if (xb_ld(&(bar)[XB_TMO])) break; if (_sp > XB_SPIN_CAP) { atomicAdd(&(bar)[XB_TMO], 1u); break; } } } } while (0)

struct XcdBarrier {
    unsigned* bar; unsigned x;
    volatile LAS unsigned* st;
};

__device__ __forceinline__ XcdBarrier xcd_barrier_post(unsigned* bar, volatile LAS unsigned* st) {
    XcdBarrier b; b.bar = bar; b.x = xb_xcc_id(); b.st = st;
    if (threadIdx.x == 0) (void)xb_add(&bar[XB_XCNT(b.x)], 1u);
    return b;
}
__device__ __forceinline__ void xcd_barrier_complete(unsigned* bar, unsigned x, unsigned& nloc, unsigned& nx) {
    const unsigned G = gridDim.x * gridDim.y * gridDim.z;
    unsigned sum, cnt, mine, sp = 0u;
    for (;;) {
        sum = 0u; cnt = 0u; mine = 0u;
#pragma unroll
        for (unsigned j = 0; j < 16; ++j) { const unsigned c = xb_ld(&bar[XB_XCNT(j)]); sum += c; cnt += (c > 0u) ? 1u : 0u; mine = (j == x) ? c : mine; }
        if (sum == G) break;
        __builtin_amdgcn_s_sleep(1);
        if ((++sp & 255u) == 0u) { if (xb_ld(&bar[XB_TMO])) break; if (sp > XB_SPIN_CAP) { atomicAdd(&bar[XB_TMO], 1u); break; } }
    }
    nloc = mine > 0u ? mine : 1u; nx = cnt > 0u ? cnt : 1u;
}

__device__ __forceinline__ void xcd_barrier(const XcdBarrier& b) {
    asm volatile("s_waitcnt vmcnt(0)" ::: "memory");
    __syncthreads();
    if (threadIdx.x == 0) {
        unsigned* bar = b.bar;
        __builtin_amdgcn_s_waitcnt(0);
        unsigned nloc = b.st[0], nx = b.st[1];
        if (nloc == 0u) { xcd_barrier_complete(bar, b.x, nloc, nx); b.st[0] = nloc; b.st[1] = nx; }
        const unsigned old = xb_add(&bar[XB_XSUB(b.x)], 1u);
        const unsigned gen = old / nloc;
        if (old + 1u == (gen + 1u) * nloc) {
            __builtin_amdgcn_fence(__ATOMIC_RELEASE, "agent");
            asm volatile("s_waitcnt vmcnt(0)" ::: "memory");
            const unsigned og = xb_add(&bar[XB_TOP], 1u);
            const unsigned tg = og / nx;
            if (og + 1u == (tg + 1u) * nx) xb_add(&bar[XB_TOPGEN], 1u);
            else XB_SPIN(xb_ld(&bar[XB_TOPGEN]) == tg, bar);
            __builtin_amdgcn_fence(__ATOMIC_ACQUIRE, "agent");
            xb_add(&bar[XB_XGEN(b.x)], 1u);
            asm volatile("s_waitcnt vmcnt(0)" ::: "memory");
        } else {
            XB_SPIN(xb_ld(&bar[XB_XGEN(b.x)]) == gen, bar);
            __builtin_amdgcn_fence(__ATOMIC_ACQUIRE, "agent");
            asm volatile("s_waitcnt vmcnt(0)" ::: "memory");
        }
    }
    __syncthreads();
}


constexpr size_t WS_BAR = 255 * MiB + 320 * 1024;
DI int fresh_tid() { int t = threadIdx.x; asm volatile("" : "+v"(t)); return t; }
#define IDS const int tid = fresh_tid(), lane = tid & 63, wave = __builtin_amdgcn_readfirstlane(tid >> 6); const int G = gridDim.x, bx = blockIdx.x; \
    const int gw = bx * NWAVES + wave, NGW = G * NWAVES, gtid = bx * NTHREADS + tid, NGT = G * NTHREADS; (void)lane; (void)gw; (void)NGW; (void)gtid; (void)NGT; (void)wave;
__global__ void __launch_bounds__(NTHREADS, 2) fwd_kernel(Params p) {
    extern __shared__ __attribute__((aligned(16))) unsigned char lds[];
    cg::grid_group grid = cg::this_grid();
    PG8_LAS unsigned char* ldsl = (PG8_LAS unsigned char*)lds;
    if (threadIdx.x < 4) ((PG8_LAS unsigned*)(ldsl + (LDS_BYTES - 256)))[threadIdx.x] = 0u;
    __syncthreads();
    const XcdBarrier bar = xcd_barrier_post((unsigned*)(PP().ws + WS_BAR), (volatile PG8_LAS unsigned*)(ldsl + (LDS_BYTES - 256)));

    { IDS phase0(PP(), gw, NGW, lane); }
    if (PP().ws == nullptr) grid.sync();
    xcd_barrier(bar);
    { IDS phase1(PP(), (float*)lds, gw, NGW, lane, tid); }
    xcd_barrier(bar);
    {
        const Params q = PP(); unsigned char* ws = q.ws; bf16_t* WIN = (bf16_t*)(ws + WS_WIN); const int G = gridDim.x, bx = blockIdx.x;
        pg8::Gemm g{(const bf16_t*)(ws + 0 * UNIT), WIN + (size_t)ROWS_A * D, M, NB_TILES * 256, D}; pg8::StaticOrder S; S.init(M, NB_TILES * 256, G, bx);
        EpiB E{(bf16_t*)(ws + 1 * UNIT)};
        pg8::gemm_phase<EpiB, pg8::StaticOrder, true, true>(ldsl, g, S, E);
    }
    { IDS for (int it = gw; it < M / 16; it += NGW) ab_item(PP(), it, lane); }
    xcd_barrier(bar);
    { IDS for (int it = gw; it < 4096; it += NGW) phase3_item(PP(), it, lane); }
    xcd_barrier(bar);
    { IDS for (int it = gw; it < 4096; it += NGW) chunk_prep_item(PP(), (float*)(lds + wave * 16384), it, lane); }
    xcd_barrier(bar);
    for (int tk = blockIdx.x; tk < 256; tk += gridDim.x) { const int t2 = fresh_tid(); scan_task(PP(), ldsl, (tk & 7) + 8 * (tk >> 6), (tk >> 3) & 7, t2, __builtin_amdgcn_readfirstlane(t2 >> 6), t2 & 63); __syncthreads(); }
    xcd_barrier(bar);
    {
        const Params q = PP(); unsigned char* ws = q.ws; bf16_t* WIN = (bf16_t*)(ws + WS_WIN); const int G = gridDim.x, bx = blockIdx.x;
        pg8::Gemm g{(const bf16_t*)(ws + 0 * UNIT), WIN, M, NA_TILES * 256, D}; pg8::StaticOrder S; S.init(M, NA_TILES * 256, G, bx);
        EpiA E{(bf16_t*)(ws + 1 * UNIT), (bf16_t*)(ws + 4 * UNIT)};
        pg8::gemm_phase<EpiA, pg8::StaticOrder, true, true>(ldsl, g, S, E);
    }
    if (gridDim.x == 256) {
        IDS
        pg8::StaticOrder S7; S7.init(M, D, G, bx); pg8::Unit u7; (void)S7.next(0, u7);
        unsigned* cntA = (unsigned*)(PP().ws + WS_PCNT3);
        asm volatile("s_waitcnt vmcnt(0)" ::: "memory");
        __syncthreads();
        if (threadIdx.x == 0) __hip_atomic_fetch_add(cntA + 64 * u7.pm, 1u, __ATOMIC_RELAXED, __HIP_MEMORY_SCOPE_AGENT);
        if (threadIdx.x < 64) {
            const int plo = u7.pm > 0 ? u7.pm - 1 : 0, phi = u7.pm < 63 ? u7.pm + 1 : 63;
            for (int pp = plo; pp <= phi; ++pp) { unsigned sp = 0;
                while ((unsigned)__builtin_amdgcn_readfirstlane(__hip_atomic_load(cntA + 64 * pp, __ATOMIC_RELAXED, __HIP_MEMORY_SCOPE_AGENT)) < 4u) { __builtin_amdgcn_s_sleep(2); if (++sp > (1u << 22)) break; } }
            __builtin_amdgcn_fence(__ATOMIC_ACQUIRE, "agent");
        }
        asm volatile("s_waitcnt vmcnt(0) lgkmcnt(0)" ::: "memory");
        __syncthreads();
        phase7_panel(PP(), u7.pm, u7.pn, tid, lane, wave);
    } else {
        xcd_barrier(bar);
        { IDS phase7(PP(), gw, NGW, lane, gtid, NGT); }
    }
    xcd_barrier(bar);
    if (gridDim.x == 256) {
        const Params q = PP(); unsigned char* ws = q.ws; const int G = gridDim.x, bx = blockIdx.x;
        static_assert(6 * UNIT - 2 * UNIT == (size_t)256 * 256 * D * 2 && WS_WPB - WS_WPA == (size_t)4 * 256 * D * 2, "TwoGemmOrder address arithmetic");
        TwoGemmOrder S; S.so.init(M, D, G, bx);
        pg8::Gemm g{(const bf16_t*)(ws + 2 * UNIT), (const bf16_t*)(ws + WS_WPA), M, D, D}; EpiYaYb E{(bf16_t*)(ws + 4 * UNIT), (const bf16_t*)(ws + 5 * UNIT)};
        pg8::gemm_phase<EpiYaYb, TwoGemmOrder, true, true>(ldsl, g, S, E);
    } else {
        const Params q = PP(); unsigned char* ws = q.ws; const int G = gridDim.x, bx = blockIdx.x;
        pg8::StaticOrder S; S.init(M, D, G, bx);
        { pg8::Gemm g{(const bf16_t*)(ws + 2 * UNIT), (const bf16_t*)(ws + WS_WPA), M, D, D}; EpiYa E{(bf16_t*)(ws + 4 * UNIT)};
          pg8::gemm_phase<EpiYa, pg8::StaticOrder, true, true>(ldsl, g, S, E); }
        { pg8::Gemm g{(const bf16_t*)(ws + 6 * UNIT), (const bf16_t*)(ws + WS_WPB), M, D, D}; EpiYb E{(bf16_t*)(ws + 4 * UNIT), (const bf16_t*)(ws + 5 * UNIT)};
          pg8::gemm_phase<EpiYb, pg8::StaticOrder, true, true>(ldsl, g, S, E); }
    }
    if (gridDim.x == 256) {
        pg8::StaticOrder S; S.init(M, D, (int)gridDim.x, (int)blockIdx.x); pg8::Unit u; (void)S.next(0, u);
        unsigned* cnt = (unsigned*)(PP().ws + WS_PCNT2) + 64 * u.pm;
        asm volatile("s_waitcnt vmcnt(0)" ::: "memory");
        __syncthreads();
        if (threadIdx.x == 0) __hip_atomic_fetch_add(cnt, 1u, __ATOMIC_RELAXED, __HIP_MEMORY_SCOPE_AGENT);
        if (threadIdx.x < 64) {
            unsigned sp = 0;
            while ((unsigned)__builtin_amdgcn_readfirstlane(__hip_atomic_load(cnt, __ATOMIC_RELAXED, __HIP_MEMORY_SCOPE_AGENT)) < 4u) { __builtin_amdgcn_s_sleep(2); if (++sp > (1u << 22)) break; }
            __builtin_amdgcn_fence(__ATOMIC_ACQUIRE, "agent");
        }
        asm volatile("s_waitcnt vmcnt(0) lgkmcnt(0)" ::: "memory");
        __syncthreads();
    } else {
        xcd_barrier(bar);
    }
    if (gridDim.x == 256) {
        const Params q = PP(); unsigned char* ws = q.ws; const int G = gridDim.x, bx = blockIdx.x;
        pg8::Gemm g{(const bf16_t*)(ws + 4 * UNIT), (const bf16_t*)(ws + WS_WO), M, D, D}; pg8::StaticOrder S; S.init(M, D, G, bx);
        EpiOutFused E{q.in[0], (const float*)(ws + WS_MODF), q.in[14], q.out, (float*)(ws + WS_PSS), (unsigned*)(ws + WS_PCNT)};
        pg8::gemm_phase<EpiOutFused, pg8::StaticOrder, true, true>(ldsl, g, S, E);
    } else {
        {
            const Params q = PP(); unsigned char* ws = q.ws; const int G = gridDim.x, bx = blockIdx.x;
            pg8::Gemm g{(const bf16_t*)(ws + 4 * UNIT), (const bf16_t*)(ws + WS_WO), M, D, D}; pg8::StaticOrder S; S.init(M, D, G, bx);
            EpiOut E{q.in[0], (const float*)(ws + WS_MODF), (float*)(ws + 0 * UNIT)};
            pg8::gemm_phase<EpiOut, pg8::StaticOrder, true, true>(ldsl, g, S, E);
        }
        xcd_barrier(bar);
        { IDS phase10(PP(), gw, NGW, lane); }
    }
}

extern "C" void kernel_launch(void* const* d_in, const int* in_sizes, int n_in, void* d_out, int out_size, void* d_ws, size_t ws_size, hipStream_t stream) {
    static int grid = 0;
    if (grid == 0) {
        int dev = 0, cus = 0, per_cu = 0;
        if (n_in != 15 || out_size != M * D || ws_size < 256 * MiB) { fprintf(stderr, "kernel_launch: unexpected shapes (n_in %d out %d ws %zu)\n", n_in, out_size, ws_size); grid = -1; return; }
        hipGetDevice(&dev); hipDeviceGetAttribute(&cus, hipDeviceAttributeMultiprocessorCount, dev);
        if (hipFuncSetAttribute((const void*)fwd_kernel, hipFuncAttributeMaxDynamicSharedMemorySize, LDS_BYTES) != hipSuccess) { fprintf(stderr, "kernel_launch: hipFuncSetAttribute failed\n"); grid = -1; return; }
        hipOccupancyMaxActiveBlocksPerMultiprocessor(&per_cu, (const void*)fwd_kernel, NTHREADS, LDS_BYTES);
        if (per_cu < 1) { fprintf(stderr, "kernel_launch: occupancy query says %d blocks/CU\n", per_cu); per_cu = 1; }
        (void)hipGetLastError();
        grid = cus;
    }
    if (grid < 0) return;
    if (hipMemsetAsync((char*)d_ws + WS_BAR, 0, 65536, stream) != hipSuccess) { fprintf(stderr, "kernel_launch: memset of barrier words failed\n"); return; }
    Params p{};
    for (int i = 0; i < 15; ++i) p.in[i] = (const float*)d_in[i];
    p.out = (float*)d_out; p.ws = (unsigned char*)d_ws;
    void* args[] = {&p};
    hipError_t e = hipLaunchCooperativeKernel((const void*)fwd_kernel, dim3(grid), dim3(NTHREADS), args, LDS_BYTES, stream);
    if (e != hipSuccess) fprintf(stderr, "cooperative launch failed: %s (grid %d)\n", hipGetErrorString(e), grid);
}
```

```cpp
#include <hip/hip_runtime.h>
#include <hip/hip_cooperative_groups.h>
#include <cstdio>
#include <cstdint>
namespace cg = cooperative_groups;

#define DI __device__ __forceinline__
#define PG8_LAS __attribute__((address_space(3)))
typedef unsigned short bf16_t;
typedef short bf16x8 __attribute__((ext_vector_type(8)));
typedef float f32x4 __attribute__((ext_vector_type(4)));
typedef float f32x2 __attribute__((ext_vector_type(2)));
typedef unsigned u32x4 __attribute__((ext_vector_type(4)));
typedef unsigned u32x2 __attribute__((ext_vector_type(2)));

namespace pg8 {
constexpr int BM = 256, BK = 64, HALF = 128, HTB = HALF * BK * 2, STAGE_BYTES = 8 * HTB, NXCD = 8, WGM = 8;
__host__ __device__ __forceinline__ int lds_byte(int r, int c) { const int st = (r >> 4) * 2 + (c >> 5), rr = r & 15, cc = c & 31, ob = rr * 64 + cc * 2; return st * 1024 + (ob ^ (((ob >> 9) & 1) << 5)); }
__host__ __device__ __forceinline__ void stage_rc(int b, int& R, int& C) { const int st = b / 1024, sb = b % 1024, swz = sb ^ (((sb >> 9) & 1) << 5); R = (st >> 1) * 16 + swz / 64; C = (st & 1) * 32 + (swz % 64) / 2; }
__host__ __device__ __forceinline__ int perm32(int rho) { const int n = rho >> 4, i = rho & 15; return 8 * (i >> 2) + 4 * n + (i & 3); }
struct Unit { int pm, pn; };
struct Gemm { const bf16_t* A; const bf16_t* Bt; int M, N, K; };
struct StaticOrder {
    int nM, nN, nwg, G, c;
    __host__ __device__ void init(int M, int N, int G_, int c_) { nM = M / BM; nN = N / BM; nwg = nM * nN; G = G_; c = c_; }
    __host__ __device__ bool next(int i, Unit& u) const {
        const long L = (long)i * G + c; if (L >= nwg) return false;
        int wgid = (int)L; { const int q = nwg / NXCD, r = nwg % NXCD, xcd = wgid % NXCD, off = wgid / NXCD; wgid = (xcd < r ? xcd * (q + 1) : r * (q + 1) + (xcd - r) * q) + off; }
        const int nig = WGM * nN, gid = wgid / nig, fm = gid * WGM, gsz = (nM - fm) < WGM ? (nM - fm) : WGM;
        u.pm = fm + ((wgid % nig) % gsz); u.pn = (wgid % nig) / gsz; return true;
    }
    __device__ __forceinline__ void a_ready(const Unit&) const {}
    __device__ __forceinline__ void done(const Unit&) const {}
};
template <class Epi, class Sched, bool ALIGN_EPI = false, bool SP2 = false>
__device__ __forceinline__ void gemm_phase(PG8_LAS unsigned char* lds, const Gemm g, const Sched& S, const Epi& E) {
    int tid = threadIdx.x; asm volatile("" : "+v"(tid)); const int wid = __builtin_amdgcn_readfirstlane(tid >> 6), lane = tid & 63, wr = wid >> 2, wc = wid & 3, fr = lane & 15, fq = lane >> 4;
    const int K = g.K, nt = K / BK;
    unsigned voffA[2], voffB[2];
#pragma unroll
    for (int i = 0; i < 2; ++i) { int R, C; stage_rc(tid * 16 + i * 8192, R, C); const int Rb = Epi::PERM ? ((R & ~31) + perm32(R & 31)) : R;
        voffA[i] = (unsigned)(R * K + C) * 2u; voffB[i] = (unsigned)(Rb * K + C) * 2u; }
    const size_t kstep = (size_t)(BK * 2);
    const size_t hstep = (size_t)HALF * K * 2;
    const size_t tstep = 2 * hstep;
    const unsigned ldsw = (unsigned)wid * 1024u;
    const int aoff = lds_byte(wr * 64 + fr, fq * 8), boff = lds_byte(wc * 32 + fr, fq * 8);
#define PG8_SA(b, h) (((b) * 2 + (h)) * HTB)
#define PG8_SB(b, h) ((4 + (b) * 2 + (h)) * HTB)
#define PG8_STAGE(bufoff, gbase, voff) do { _Pragma("unroll") for (int _i = 0; _i < 2; ++_i) \
        __builtin_amdgcn_global_load_lds((const unsigned*)((const char*)(gbase) + (voff)[_i]), (PG8_LAS unsigned*)(lds + (bufoff) + ldsw + _i * 8192), 16, 0, 0); } while (0)
#define PG8_LDA(dst, b, h) do { _Pragma("unroll") for (int m = 0; m < 4; ++m) _Pragma("unroll") for (int k = 0; k < 2; ++k) dst[m][k] = *(const PG8_LAS bf16x8*)(lds + PG8_SA(b, h) + aoff + m * 2048 + k * 1024); } while (0)
#define PG8_LDB(dst, b, h) do { _Pragma("unroll") for (int n = 0; n < 2; ++n) _Pragma("unroll") for (int k = 0; k < 2; ++k) dst[n][k] = *(const PG8_LAS bf16x8*)(lds + PG8_SB(b, h) + boff + n * 2048 + k * 1024); } while (0)
#define PG8_MMA(ai, bj, At, Bt) do { __builtin_amdgcn_s_setprio(1); _Pragma("unroll") for (int m = 0; m < 4; ++m) _Pragma("unroll") for (int n = 0; n < 2; ++n) _Pragma("unroll") for (int k = 0; k < 2; ++k) \
        acc[ai][bj][m][n] = __builtin_amdgcn_mfma_f32_16x16x32_bf16(Bt[n][k], At[m][k], acc[ai][bj][m][n], 0, 0, 0); __builtin_amdgcn_s_setprio(0); } while (0)
#define PG8_WAIT_V(n) asm volatile("s_waitcnt vmcnt(" #n ")" ::: "memory")
#define PG8_WAIT_L(n) asm volatile("s_waitcnt lgkmcnt(" #n ")" ::: "memory")
#define PG8_BAR __builtin_amdgcn_s_barrier()
#define PG8_SCHED __builtin_amdgcn_sched_barrier(0)
    Unit cur, nxt; int ui = 0;
    if (!S.next(0, cur)) return;
    f32x4 acc[2][2][4][2];
#pragma unroll
    for (int a = 0; a < 2; ++a)
#pragma unroll
        for (int b = 0; b < 2; ++b)
#pragma unroll
            for (int m = 0; m < 4; ++m)
#pragma unroll
                for (int n = 0; n < 2; ++n) acc[a][b][m][n] = (f32x4){0.f, 0.f, 0.f, 0.f};
    bf16x8 At[4][2], B0[2][2], B1[2][2];
    const char* cA = (const char*)g.A + (size_t)cur.pm * tstep; const char* cB = (const char*)g.Bt + (size_t)cur.pn * tstep;
    S.a_ready(cur);
    if constexpr (SP2) {
        PG8_STAGE(PG8_SB(0, 0), cB, voffB); PG8_STAGE(PG8_SB(0, 1), cB + hstep, voffB); PG8_STAGE(PG8_SA(0, 0), cA, voffA); PG8_STAGE(PG8_SA(0, 1), cA + hstep, voffA);
        if (wr == 1) PG8_BAR;
        PG8_WAIT_V(2); PG8_BAR;
        PG8_STAGE(PG8_SB(1, 0), cB + kstep, voffB); PG8_STAGE(PG8_SA(1, 0), cA + kstep, voffA); PG8_STAGE(PG8_SB(1, 1), cB + hstep + kstep, voffB);
        PG8_WAIT_V(6); PG8_BAR;
    } else {
        PG8_STAGE(PG8_SB(0, 0), cB, voffB); PG8_STAGE(PG8_SA(0, 0), cA, voffA); PG8_STAGE(PG8_SB(0, 1), cB + hstep, voffB); PG8_STAGE(PG8_SA(0, 1), cA + hstep, voffA);
        if (wr == 1) PG8_BAR;
        PG8_WAIT_V(4); PG8_BAR;
        PG8_STAGE(PG8_SB(1, 0), cB + kstep, voffB); PG8_STAGE(PG8_SA(1, 0), cA + kstep, voffA); PG8_STAGE(PG8_SB(1, 1), cB + hstep + kstep, voffB);
        PG8_WAIT_V(6); PG8_BAR;
    }
    for (;;) {
        const bool has_next = S.next(ui + 1, nxt);
        const char* nA = has_next ? (const char*)g.A + (size_t)nxt.pm * tstep : cA; const char* nB = has_next ? (const char*)g.Bt + (size_t)nxt.pn * tstep : cB;
        for (int t = 0; t < nt; t += 2) {
            const bool last = (t == nt - 2);
            const char* a1 = cA + (size_t)(t + 1) * kstep;
            const char* a2 = last ? nA : cA + (size_t)(t + 2) * kstep; const char* b2 = last ? nB : cB + (size_t)(t + 2) * kstep;
            const char* a3 = a2 + kstep; const char* b3 = b2 + kstep;
            if (last && has_next) S.a_ready(nxt);
            if constexpr (SP2) {
            PG8_LDB(B0, 0, 0); PG8_LDB(B1, 0, 1); PG8_SCHED; PG8_LDA(At, 0, 0); PG8_STAGE(PG8_SA(1, 1), a1 + hstep, voffA);
            PG8_WAIT_V(8); PG8_WAIT_L(0); PG8_BAR; PG8_MMA(0, 0, At, B0); PG8_MMA(0, 1, At, B1); PG8_BAR; PG8_SCHED;
            PG8_LDA(At, 0, 1); PG8_STAGE(PG8_SB(0, 0), b2, voffB); PG8_STAGE(PG8_SB(0, 1), b2 + hstep, voffB); PG8_STAGE(PG8_SA(0, 0), a2, voffA);
            PG8_WAIT_V(8); PG8_WAIT_L(0); PG8_BAR; PG8_MMA(1, 0, At, B0); PG8_MMA(1, 1, At, B1); PG8_BAR; PG8_SCHED;
            PG8_LDB(B0, 1, 0); PG8_LDB(B1, 1, 1); PG8_SCHED; PG8_LDA(At, 1, 0); PG8_STAGE(PG8_SA(0, 1), a2 + hstep, voffA);
            PG8_WAIT_V(8); PG8_WAIT_L(0); PG8_BAR; PG8_MMA(0, 0, At, B0); PG8_MMA(0, 1, At, B1); PG8_BAR; PG8_SCHED;
            PG8_LDA(At, 1, 1); PG8_STAGE(PG8_SB(1, 0), b3, voffB); PG8_STAGE(PG8_SB(1, 1), b3 + hstep, voffB); PG8_STAGE(PG8_SA(1, 0), a3, voffA);
            PG8_WAIT_V(8); PG8_WAIT_L(0); PG8_BAR; PG8_MMA(1, 0, At, B0); PG8_MMA(1, 1, At, B1); PG8_BAR; PG8_SCHED;
            } else {
            PG8_LDB(B0, 0, 0); PG8_SCHED; PG8_LDA(At, 0, 0); PG8_STAGE(PG8_SA(1, 1), a1 + hstep, voffA);
            PG8_WAIT_L(8); PG8_BAR; PG8_WAIT_L(0); PG8_MMA(0, 0, At, B0); PG8_BAR; PG8_SCHED;
            PG8_LDB(B1, 0, 1); PG8_STAGE(PG8_SB(0, 0), b2, voffB);
            PG8_BAR; PG8_WAIT_L(0); PG8_MMA(0, 1, At, B1); PG8_BAR;
            PG8_LDA(At, 0, 1); PG8_STAGE(PG8_SA(0, 0), a2, voffA);
            PG8_BAR; PG8_WAIT_L(0); PG8_MMA(1, 0, At, B0); PG8_BAR; PG8_SCHED;
            PG8_STAGE(PG8_SB(0, 1), b2 + hstep, voffB);
            PG8_WAIT_V(6); PG8_BAR; PG8_MMA(1, 1, At, B1); PG8_BAR;
            PG8_LDB(B0, 1, 0); PG8_SCHED; PG8_LDA(At, 1, 0); PG8_STAGE(PG8_SA(0, 1), a2 + hstep, voffA);
            PG8_WAIT_L(8); PG8_BAR; PG8_WAIT_L(0); PG8_MMA(0, 0, At, B0); PG8_BAR; PG8_SCHED;
            PG8_LDB(B1, 1, 1); PG8_STAGE(PG8_SB(1, 0), b3, voffB);
            PG8_BAR; PG8_WAIT_L(0); PG8_MMA(0, 1, At, B1); PG8_BAR;
            PG8_LDA(At, 1, 1); PG8_STAGE(PG8_SA(1, 0), a3, voffA);
            PG8_BAR; PG8_WAIT_L(0); PG8_MMA(1, 0, At, B0); PG8_BAR; PG8_SCHED;
            PG8_STAGE(PG8_SB(1, 1), b3 + hstep, voffB);
            PG8_WAIT_V(6); PG8_BAR; PG8_MMA(1, 1, At, B1); PG8_BAR;
            }
        }
        if constexpr (ALIGN_EPI) { if (wr == 0) PG8_BAR; }
        if constexpr (!Epi::AFTER_DRAIN) { E(acc, cur, wr, wc, fr, fq); S.done(cur); }
        if (!has_next) break;
#pragma unroll
        for (int a = 0; a < 2; ++a)
#pragma unroll
            for (int b = 0; b < 2; ++b)
#pragma unroll
                for (int m = 0; m < 4; ++m)
#pragma unroll
                    for (int n = 0; n < 2; ++n) acc[a][b][m][n] = (f32x4){0.f, 0.f, 0.f, 0.f};
        cur = nxt; cA = nA; cB = nB; ++ui;
        if constexpr (ALIGN_EPI) { if (wr == 1) PG8_BAR; }
    }
    PG8_WAIT_V(0);
    if constexpr (!ALIGN_EPI) { if (wr == 0) PG8_BAR; }
    PG8_BAR;
    if constexpr (Epi::AFTER_DRAIN) { E.fused(acc, cur, wr, wc, fr, fq, lds, wid, lane); S.done(cur); }
#undef PG8_SA
#undef PG8_SB
#undef PG8_STAGE
#undef PG8_LDA
#undef PG8_LDB
#undef PG8_MMA
#undef PG8_WAIT_V
#undef PG8_WAIT_L
#undef PG8_BAR
#undef PG8_SCHED
}}

constexpr int SEQ = 8192, NB = 2, M = NB * SEQ, D = 1024, NIN = 10272, NPAD = 10496;
constexpr int NA_TILES = 28, NB_TILES = 12, ROWS_A = NA_TILES * 256;
constexpr size_t MiB = 1u << 20;
constexpr size_t UNIT = 32 * MiB;
constexpr size_t WS_WIN = 224 * MiB, WS_WPA = 245 * MiB, WS_WPB = 247 * MiB, WS_WO = 249 * MiB, WS_AB = 251 * MiB, WS_G = 253 * MiB, WS_BETA = 254 * MiB;
constexpr size_t WS_MODP = 255 * MiB, WS_MODF = 255 * MiB + 256 * 1024;
constexpr size_t WS_CSC = 239 * MiB;
constexpr int LDS_BYTES = 155648;
constexpr int NWAVES = 8, NTHREADS = 512;
constexpr float NORM_EPS = 1e-6f, L2_EPS = 1e-6f;

struct Params { const float* in[15]; float* out; unsigned char* ws; };

typedef __bf16 bf16v2_t __attribute__((ext_vector_type(2)));
DI unsigned cvt_pk_bf16(float lo, float hi) { const f32x2 v = {lo, hi}; const bf16v2_t r = __builtin_convertvector(v, bf16v2_t); return __builtin_bit_cast(unsigned, r); }
DI void store_wt16(void* p, const u32x4& v) { asm volatile("global_store_dwordx4 %0, %1, off sc1\n\ts_nop 1" :: "v"(p), "v"(v) : "memory"); }
DI float bf_lo(unsigned u) { return __uint_as_float(u << 16); }
DI float bf_hi(unsigned u) { return __uint_as_float(u & 0xffff0000u); }
DI float bf1(bf16_t u) { return __uint_as_float(((unsigned)u) << 16); }
DI float sigmoidf_(float x) { return __builtin_amdgcn_rcpf(1.0f + __expf(-x)); }
DI float siluf_(float x) { return x * __builtin_amdgcn_rcpf(1.0f + __expf(-x)); }
DI float softplusf_(float x) { return fmaxf(x, 0.f) + log1pf(__expf(-fabsf(x))); }
#define DPP_F(v, ctrl) __builtin_bit_cast(float, __builtin_amdgcn_mov_dpp(__builtin_bit_cast(int, (v)), (ctrl), 0xF, 0xF, true))
DI float row16_sum(float v) {
    v += DPP_F(v, 0xB1);
    v += DPP_F(v, 0x4E);
    v += DPP_F(v, 0x141);
    v += DPP_F(v, 0x140);
    return v;
}
DI float wave_sum(float v) {
    v = row16_sum(v);
    return __builtin_bit_cast(float, __builtin_amdgcn_readlane(__builtin_bit_cast(int, v), 0)) + __builtin_bit_cast(float, __builtin_amdgcn_readlane(__builtin_bit_cast(int, v), 16))
         + __builtin_bit_cast(float, __builtin_amdgcn_readlane(__builtin_bit_cast(int, v), 32)) + __builtin_bit_cast(float, __builtin_amdgcn_readlane(__builtin_bit_cast(int, v), 48));
}
DI int permpos(int dk) { const int loc = dk & 31; return (dk & ~31) + 8 * ((loc >> 2) & 3) + 4 * (loc >> 4) + (loc & 3); }
DI int win_src_col(int d) {
    if (d < 2048) { const int i = d >> 8, w = d & 255; return w < 128 ? (128 * i + w) : (2048 + 128 * i + (w - 128)); }
    if (d < 4096) { const int i = (d - 2048) >> 8, w = d & 255; return w < 128 ? (1024 + 128 * i + w) : (3072 + 128 * i + (w - 128)); }
    if (d < 5120) return 8224 + (d - 4096);
    if (d < 6144) return 9248 + (d - 5120);
    if (d < 7168) return 7168 + (d - 6144);
    if (d < 10240) return 4096 + (d - 7168);
    if (d < 10272) return 8192 + (d - 10240);
    return -1;
}

struct EpiA {
    static constexpr bool PERM = true, AFTER_DRAIN = false;
    bf16_t *PR, *SG;
    DI void operator()(const f32x4 (&acc)[2][2][4][2], const pg8::Unit& u, int wr, int wc, int fr, int fq) const {
        const int row0 = u.pm * 256 + wr * 64 + fr, pn = u.pn;
        if (pn < 16) {
            bf16_t* O = PR + (size_t)(pn >> 3) * (UNIT / 2) + (size_t)(128 * (pn & 7) + 32 * wc + 8 * fq);
#pragma unroll
            for (int ai = 0; ai < 2; ++ai)
#pragma unroll
                for (int m = 0; m < 4; ++m) {
                    float o[8];
#pragma unroll
                    for (int n = 0; n < 2; ++n)
#pragma unroll
                        for (int j = 0; j < 4; ++j) { const float a = acc[ai][0][m][n][j], b = acc[ai][1][m][n][j]; o[4 * n + j] = pn < 8 ? a * b : a * siluf_(b); }
                    u32x4 w; w.x = cvt_pk_bf16(o[0], o[1]); w.y = cvt_pk_bf16(o[2], o[3]); w.z = cvt_pk_bf16(o[4], o[5]); w.w = cvt_pk_bf16(o[6], o[7]);
                    store_wt16(O + (size_t)(row0 + ai * 128 + m * 16) * D, w);
                }
        } else {
            const int g = (pn - 16) >> 2;
            bf16_t* O = SG + (size_t)g * (UNIT / 2) + (size_t)(256 * ((pn - 16) & 3) + 32 * wc + 8 * fq);
#pragma unroll
            for (int ai = 0; ai < 2; ++ai)
#pragma unroll
                for (int m = 0; m < 4; ++m)
#pragma unroll
                    for (int bj = 0; bj < 2; ++bj) {
                        float o[8];
#pragma unroll
                        for (int n = 0; n < 2; ++n)
#pragma unroll
                            for (int j = 0; j < 4; ++j) { const float a = acc[ai][bj][m][n][j]; o[4 * n + j] = g == 2 ? siluf_(a) : sigmoidf_(a); }
                        u32x4 w; w.x = cvt_pk_bf16(o[0], o[1]); w.y = cvt_pk_bf16(o[2], o[3]); w.z = cvt_pk_bf16(o[4], o[5]); w.w = cvt_pk_bf16(o[6], o[7]);
                        store_wt16(O + (size_t)(row0 + ai * 128 + m * 16) * D + bj * 128, w);
                    }
        }
    }
};
struct EpiB {
    static constexpr bool PERM = true, AFTER_DRAIN = false;
    bf16_t* QKV;
    DI void operator()(const f32x4 (&acc)[2][2][4][2], const pg8::Unit& u, int wr, int wc, int fr, int fq) const {
        const int row0 = u.pm * 256 + wr * 64 + fr, pn = u.pn;
        bf16_t* O = QKV + (size_t)(pn >> 2) * (UNIT / 2) + (size_t)(256 * (pn & 3) + 32 * wc + 8 * fq);
#pragma unroll
        for (int ai = 0; ai < 2; ++ai)
#pragma unroll
            for (int m = 0; m < 4; ++m)
#pragma unroll
                for (int bj = 0; bj < 2; ++bj) {
                    const f32x4 v0 = acc[ai][bj][m][0], v1 = acc[ai][bj][m][1];
                    u32x4 w; w.x = cvt_pk_bf16(v0[0], v0[1]); w.y = cvt_pk_bf16(v0[2], v0[3]); w.z = cvt_pk_bf16(v1[0], v1[1]); w.w = cvt_pk_bf16(v1[2], v1[3]);
                    store_wt16(O + (size_t)(row0 + ai * 128 + m * 16) * D + bj * 128, w);
                }
    }
};
struct EpiYa {
    static constexpr bool PERM = true, AFTER_DRAIN = false;
    bf16_t* SGA;
    DI void operator()(const f32x4 (&acc)[2][2][4][2], const pg8::Unit& u, int wr, int wc, int fr, int fq) const {
        const int row0 = u.pm * 256 + wr * 64 + fr; bf16_t* O = SGA + (size_t)(256 * u.pn + 32 * wc + 8 * fq);
#pragma unroll
        for (int ai = 0; ai < 2; ++ai)
#pragma unroll
            for (int m = 0; m < 4; ++m)
#pragma unroll
                for (int bj = 0; bj < 2; ++bj) {
                    u32x4* p = (u32x4*)(O + (size_t)(row0 + ai * 128 + m * 16) * D + bj * 128);
                    const u32x4 s = *p; const f32x4 v0 = acc[ai][bj][m][0], v1 = acc[ai][bj][m][1];
                    u32x4 w; w.x = cvt_pk_bf16(bf_lo(s.x) * v0[0], bf_hi(s.x) * v0[1]); w.y = cvt_pk_bf16(bf_lo(s.y) * v0[2], bf_hi(s.y) * v0[3]);
                    w.z = cvt_pk_bf16(bf_lo(s.z) * v1[0], bf_hi(s.z) * v1[1]); w.w = cvt_pk_bf16(bf_lo(s.w) * v1[2], bf_hi(s.w) * v1[3]);
                    *p = w;
                }
    }
};
struct EpiYb {
    static constexpr bool PERM = true, AFTER_DRAIN = false;
    bf16_t* MA; const bf16_t* SGB;
    DI void operator()(const f32x4 (&acc)[2][2][4][2], const pg8::Unit& u, int wr, int wc, int fr, int fq) const {
        const int row0 = u.pm * 256 + wr * 64 + fr; const size_t c0 = (size_t)(256 * u.pn + 32 * wc + 8 * fq);
#pragma unroll
        for (int ai = 0; ai < 2; ++ai)
#pragma unroll
            for (int m = 0; m < 4; ++m)
#pragma unroll
                for (int bj = 0; bj < 2; ++bj) {
                    const size_t off = (size_t)(row0 + ai * 128 + m * 16) * D + bj * 128 + c0;
                    u32x4* p = (u32x4*)(MA + off); const u32x4 a = *p; const u32x4 s = *(const u32x4*)(SGB + off);
                    const f32x4 v0 = acc[ai][bj][m][0], v1 = acc[ai][bj][m][1];
                    u32x4 w; w.x = cvt_pk_bf16(bf_lo(a.x) + bf_lo(s.x) * v0[0], bf_hi(a.x) + bf_hi(s.x) * v0[1]); w.y = cvt_pk_bf16(bf_lo(a.y) + bf_lo(s.y) * v0[2], bf_hi(a.y) + bf_hi(s.y) * v0[3]);
                    w.z = cvt_pk_bf16(bf_lo(a.z) + bf_lo(s.z) * v1[0], bf_hi(a.z) + bf_hi(s.z) * v1[1]); w.w = cvt_pk_bf16(bf_lo(a.w) + bf_lo(s.w) * v1[2], bf_hi(a.w) + bf_hi(s.w) * v1[3]);
                    store_wt16(p, w);
                }
    }
};
struct EpiOut {
    static constexpr bool PERM = true, AFTER_DRAIN = false;
    const float* X; const float* GATE; float* XN;
    DI void operator()(const f32x4 (&acc)[2][2][4][2], const pg8::Unit& u, int wr, int wc, int fr, int fq) const {
        const int row0 = u.pm * 256 + wr * 64 + fr; const int c0 = 256 * u.pn + 32 * wc + 8 * fq;
        const float* gp = GATE + (size_t)((u.pm * 256) / SEQ) * D + c0;
        f32x4 gt[2][2];
#pragma unroll
        for (int bj = 0; bj < 2; ++bj) { gt[bj][0] = *(const f32x4*)(gp + bj * 128); gt[bj][1] = *(const f32x4*)(gp + bj * 128 + 4); }
#pragma unroll
        for (int ai = 0; ai < 2; ++ai)
#pragma unroll
            for (int m = 0; m < 4; ++m)
#pragma unroll
                for (int bj = 0; bj < 2; ++bj) {
                    const size_t off = (size_t)(row0 + ai * 128 + m * 16) * D + bj * 128 + c0;
                    const f32x4 x0 = *(const f32x4*)(X + off), x1 = *(const f32x4*)(X + off + 4);
                    *(f32x4*)(XN + off) = x0 + gt[bj][0] * acc[ai][bj][m][0]; *(f32x4*)(XN + off + 4) = x1 + gt[bj][1] * acc[ai][bj][m][1];
                }
    }
};

constexpr size_t WS_PCNT = 255 * MiB + 336 * 1024;
constexpr size_t WS_PSS = 255 * MiB + 512 * 1024;
constexpr size_t WS_PCNT3 = 255 * MiB + 368 * 1024;
constexpr size_t WS_PCNT4 = 255 * MiB + 384 * 1024;
constexpr size_t WS_PCNT2 = 255 * MiB + 352 * 1024;
struct EpiOutFused {
    static constexpr bool PERM = true, AFTER_DRAIN = true;
    const float* X; const float* GATE; const float* FW; float* OUT; float* PSS; unsigned* PCNT;
    DI void operator()(const f32x4 (&)[2][2][4][2], const pg8::Unit&, int, int, int, int) const {}
    DI void fused(f32x4 (&acc)[2][2][4][2], const pg8::Unit& u, int wr, int wc, int fr, int fq, PG8_LAS unsigned char* lds, int wid, int lane) const {
        PG8_LAS float* P = (PG8_LAS float*)lds;
        PG8_LAS float* S = (PG8_LAS float*)(lds + 4096);
        const int row0 = u.pm * 256 + wr * 64 + fr; const int c0 = 256 * u.pn + 32 * wc + 8 * fq;
        const float* gp = GATE + (size_t)((u.pm * 256) / SEQ) * D + c0;
        f32x4 gt[2][2];
#pragma unroll
        for (int bj = 0; bj < 2; ++bj) { gt[bj][0] = *(const f32x4*)(gp + bj * 128); gt[bj][1] = *(const f32x4*)(gp + bj * 128 + 4); }
#pragma unroll
        for (int ai = 0; ai < 2; ++ai)
#pragma unroll
            for (int m = 0; m < 4; ++m) {
                float s = 0.f;
#pragma unroll
                for (int bj = 0; bj < 2; ++bj) {
                    const size_t off = (size_t)(row0 + ai * 128 + m * 16) * D + bj * 128 + c0;
                    const f32x4 v0 = __builtin_nontemporal_load((const f32x4*)(X + off)) + gt[bj][0] * acc[ai][bj][m][0], v1 = __builtin_nontemporal_load((const f32x4*)(X + off + 4)) + gt[bj][1] * acc[ai][bj][m][1];
                    acc[ai][bj][m][0] = v0; acc[ai][bj][m][1] = v1;
                    s += (v0[0] * v0[0] + v0[1] * v0[1]) + (v0[2] * v0[2] + v0[3] * v0[3]) + (v1[0] * v1[0] + v1[1] * v1[1]) + (v1[2] * v1[2] + v1[3] * v1[3]);
                }
                s += __shfl_xor(s, 16); s += __shfl_xor(s, 32);
                if (fq == 0) P[(ai * 128 + wr * 64 + m * 16 + fr) * 4 + wc] = s;
                if (m & 1) __builtin_amdgcn_sched_barrier(0);
            }
        asm volatile("s_waitcnt lgkmcnt(0)" ::: "memory"); __builtin_amdgcn_s_barrier(); asm volatile("" ::: "memory");
        const int row = wid * 32 + (lane & 31);
        if (lane < 32) {
            const float t = (P[row * 4 + 0] + P[row * 4 + 1]) + (P[row * 4 + 2] + P[row * 4 + 3]);
            __hip_atomic_store(PSS + (size_t)(u.pm * 256 + row) * 4 + u.pn, t, __ATOMIC_RELAXED, __HIP_MEMORY_SCOPE_AGENT);
        }
        asm volatile("s_waitcnt vmcnt(0)" ::: "memory");
        if (lane == 0) __hip_atomic_fetch_add(PCNT + 64 * u.pm, 1u, __ATOMIC_RELAXED, __HIP_MEMORY_SCOPE_AGENT);
        if (wid == 0) {
            unsigned sp = 0;
            while ((unsigned)__builtin_amdgcn_readfirstlane(__hip_atomic_load(PCNT + 64 * u.pm, __ATOMIC_RELAXED, __HIP_MEMORY_SCOPE_AGENT)) < 32u) { __builtin_amdgcn_s_sleep(2); if (++sp > (1u << 22)) break; }
            __builtin_amdgcn_fence(__ATOMIC_ACQUIRE, "agent");
        }
        asm volatile("s_waitcnt vmcnt(0) lgkmcnt(0)" ::: "memory"); __builtin_amdgcn_s_barrier(); asm volatile("" ::: "memory");
        if (lane < 32) {
            const float* ps = PSS + (size_t)(u.pm * 256 + row) * 4; float t = 0.f;
#pragma unroll
            for (int k = 0; k < 4; ++k) t += __hip_atomic_load(ps + k, __ATOMIC_RELAXED, __HIP_MEMORY_SCOPE_AGENT);
            S[row] = rsqrtf(t * (1.f / D) + NORM_EPS);
        }
        asm volatile("s_waitcnt vmcnt(0) lgkmcnt(0)" ::: "memory"); __builtin_amdgcn_s_barrier(); asm volatile("" ::: "memory");
        f32x4 fw[2][2];
#pragma unroll
        for (int bj = 0; bj < 2; ++bj) { fw[bj][0] = *(const f32x4*)(FW + c0 + bj * 128); fw[bj][1] = *(const f32x4*)(FW + c0 + bj * 128 + 4); }
#pragma unroll
        for (int ai = 0; ai < 2; ++ai)
#pragma unroll
            for (int m = 0; m < 4; ++m) {
                const float rs = S[ai * 128 + wr * 64 + m * 16 + fr];
#pragma unroll
                for (int bj = 0; bj < 2; ++bj) {
                    const size_t off = (size_t)(row0 + ai * 128 + m * 16) * D + bj * 128 + c0;
                    __builtin_nontemporal_store(acc[ai][bj][m][0] * rs * fw[bj][0], (f32x4*)(OUT + off)); __builtin_nontemporal_store(acc[ai][bj][m][1] * rs * fw[bj][1], (f32x4*)(OUT + off + 4));
                }
            }
    }
};

struct TwoGemmOrder {
    pg8::StaticOrder so;
    DI bool next(int i, pg8::Unit& u) const { if (i >= 2) return false; if (!so.next(0, u)) return false; if (i == 1) { u.pm += 256; u.pn += 4; } return true; }
    DI void a_ready(const pg8::Unit&) const {}
    DI void done(const pg8::Unit&) const {}
};
struct EpiYaYb {
    static constexpr bool PERM = true, AFTER_DRAIN = false;
    bf16_t* MA; const bf16_t* SGB;
    DI void operator()(const f32x4 (&acc)[2][2][4][2], const pg8::Unit& u, int wr, int wc, int fr, int fq) const {
        if (u.pn < 4) { EpiYa e{MA}; e(acc, u, wr, wc, fr, fq); }
        else { EpiYb e{MA, SGB}; pg8::Unit v; v.pm = u.pm - 256; v.pn = u.pn - 4; e(acc, v, wr, wc, fr, fq); }
    }
};

DI void p0_transpose_item(const float* W, int N, bf16_t* WT, int rg, int kg, int lane, bool is_win) {
    const int d = rg * 64 + lane; const int s = is_win ? win_src_col(d) : d; const int k0 = kg * 64;
    bf16_t* o = WT + (size_t)d * D + k0;
    if (s < 0) {
#pragma unroll
        for (int kk = 0; kk < 8; ++kk) *(u32x4*)(o + 8 * kk) = (u32x4){0u, 0u, 0u, 0u};
        return;
    }
    const float* w = W + (size_t)k0 * N + s;
    float v[64];
#pragma unroll
    for (int j = 0; j < 64; ++j) v[j] = __builtin_nontemporal_load(w + (size_t)j * N);
#pragma unroll
    for (int kk = 0; kk < 8; ++kk) {
        u32x4 p; p.x = cvt_pk_bf16(v[8 * kk], v[8 * kk + 1]); p.y = cvt_pk_bf16(v[8 * kk + 2], v[8 * kk + 3]); p.z = cvt_pk_bf16(v[8 * kk + 4], v[8 * kk + 5]); p.w = cvt_pk_bf16(v[8 * kk + 6], v[8 * kk + 7]);
        *(u32x4*)(o + 8 * kk) = p;
    }
}
DI void phase0(const Params& p, int gw, int NGW, int lane) {
    unsigned char* ws = p.ws;
    constexpr int I_WIN = (NPAD / 64) * 16, I_SQ = 16 * 16, I_MOD = 48 * 8, NITEMS = I_WIN + 3 * I_SQ + I_MOD;
    for (int it = gw; it < NITEMS; it += NGW) {
        int r = it;
        if (r < I_WIN) { p0_transpose_item(p.in[5], NIN, (bf16_t*)(ws + WS_WIN), r >> 4, r & 15, lane, true); continue; } r -= I_WIN;
        if (r < I_SQ) { p0_transpose_item(p.in[11], D, (bf16_t*)(ws + WS_WPA), r >> 4, r & 15, lane, false); continue; } r -= I_SQ;
        if (r < I_SQ) { p0_transpose_item(p.in[12], D, (bf16_t*)(ws + WS_WPB), r >> 4, r & 15, lane, false); continue; } r -= I_SQ;
        if (r < I_SQ) { p0_transpose_item(p.in[13], D, (bf16_t*)(ws + WS_WO), r >> 4, r & 15, lane, false); continue; } r -= I_SQ;
        const int cgp = r >> 3, ks = r & 7; const float* c = p.in[1]; const float* wa = p.in[2] + (size_t)(ks * 128) * 3072 + cgp * 64 + lane;
        float a0 = 0.f, a1 = 0.f;
#pragma unroll
        for (int k0 = 0; k0 < 128; k0 += 32) {
            float wv[32];
#pragma unroll
            for (int k = 0; k < 32; ++k) wv[k] = __builtin_nontemporal_load(wa + (size_t)(k0 + k) * 3072);
#pragma unroll
            for (int k = 0; k < 32; ++k) { a0 += siluf_(c[ks * 128 + k0 + k]) * wv[k]; a1 += siluf_(c[D + ks * 128 + k0 + k]) * wv[k]; }
        }
        float* mp = (float*)(ws + WS_MODP) + (size_t)ks * 2 * 3072 + cgp * 64 + lane;
        mp[0] = a0; mp[3072] = a1;
    }
}
DI void phase1(const Params& p, float* ldsf, int gw, int NGW, int lane, int tid, int row_base) {
    const float* modp = (const float*)(p.ws + WS_MODP); const float* b_ada = p.in[3]; const float* nw = p.in[4];
    float* s_tab = ldsf;
    float* a_tab = ldsf + 2048;
    for (int idx = tid; idx < 2 * 2048; idx += NTHREADS) {
        const int b = idx >> 11, j = idx & 2047; float s = b_ada[j];
#pragma unroll
        for (int q = 0; q < 8; ++q) s += modp[(size_t)q * 2 * 3072 + b * 3072 + j];
        if (j < 1024) s_tab[b * 1024 + j] = s; else a_tab[b * 1024 + j - 1024] = nw[j - 1024] * (1.f + s);
    }
    if (blockIdx.x == 0) {
        float* modf = (float*)(p.ws + WS_MODF);
        for (int idx = tid; idx < 2 * 1024; idx += NTHREADS) {
            const int b = idx >> 10, j = idx & 1023; float s = b_ada[2048 + j];
#pragma unroll
            for (int q = 0; q < 8; ++q) s += modp[(size_t)q * 2 * 3072 + b * 3072 + 2048 + j];
            modf[b * 1024 + j] = s;
        }
    }
    __syncthreads();
    bf16_t* H = (bf16_t*)(p.ws + 0 * UNIT);
    const bool pmode = row_base >= 0; const int pw = (tid >> 6) * 8;
    for (int m0 = pmode ? row_base + pw : gw; pmode ? (m0 < row_base + pw + 8) : (m0 < M); m0 += pmode ? 2 : 2 * NGW) {
        const int m1 = pmode ? m0 + 1 : (m0 + NGW < M ? m0 + NGW : m0);
        f32x4 v[2][4]; float s[2] = {0.f, 0.f};
#pragma unroll
        for (int u = 0; u < 2; ++u) { const f32x4* xr = (const f32x4*)(p.in[0] + (size_t)(u ? m1 : m0) * D) + lane;
#pragma unroll
            for (int j = 0; j < 4; ++j) v[u][j] = __builtin_nontemporal_load(xr + 64 * j); }
#pragma unroll
        for (int u = 0; u < 2; ++u) {
#pragma unroll
            for (int j = 0; j < 4; ++j) s[u] += (v[u][j].x * v[u][j].x + v[u][j].y * v[u][j].y) + (v[u][j].z * v[u][j].z + v[u][j].w * v[u][j].w);
            const int m = u ? m1 : m0; const int b = m / SEQ;
            const float rstd = rsqrtf(wave_sum(s[u]) * (1.f / D) + NORM_EPS);
            u32x2* o = (u32x2*)(H + (size_t)m * D) + lane;
#pragma unroll
            for (int j = 0; j < 4; ++j) {
                const f32x4 a = *(const f32x4*)(a_tab + b * 1024 + 4 * lane + 256 * j), sh = *(const f32x4*)(s_tab + b * 1024 + 4 * lane + 256 * j);
                const f32x4 hh = v[u][j] * rstd * a + sh;
                u32x2 w; w.x = cvt_pk_bf16(hh.x, hh.y); w.y = cvt_pk_bf16(hh.z, hh.w);
                __hip_atomic_store((unsigned long long*)(o + 64 * j), ((unsigned long long)w.y << 32) | w.x, __ATOMIC_RELAXED, __HIP_MEMORY_SCOPE_AGENT);
            }
        }
    }
    __syncthreads();
}
DI void ab_item(const Params& p, int item, int lane) {
    unsigned char* ws = p.ws; const int il = lane & 15, q = lane >> 4;
    const bf16_t* Hr = (const bf16_t*)(ws + 0 * UNIT) + (size_t)(item * 16 + il) * D + 8 * q;
    const bf16_t* W0 = (const bf16_t*)(ws + WS_WIN) + (size_t)(10240 + il) * D + 8 * q; const bf16_t* W1 = W0 + (size_t)16 * D;
    f32x4 a0 = {0.f, 0.f, 0.f, 0.f}, a1 = {0.f, 0.f, 0.f, 0.f};
#pragma unroll 8
    for (int ks = 0; ks < 32; ++ks) { const bf16x8 hf = *(const bf16x8*)(Hr + 32 * ks);
        a0 = __builtin_amdgcn_mfma_f32_16x16x32_bf16(hf, *(const bf16x8*)(W0 + 32 * ks), a0, 0, 0, 0); a1 = __builtin_amdgcn_mfma_f32_16x16x32_bf16(hf, *(const bf16x8*)(W1 + 32 * ks), a1, 0, 0, 0); }
    float* AB = (float*)(ws + WS_AB) + (size_t)(item * 16 + 4 * q) * 32 + il;
#pragma unroll
    for (int r = 0; r < 4; ++r) { AB[r * 32] = a0[r]; AB[r * 32 + 16] = a1[r]; }
}
DI void phase3_item(const Params& p, int item, int lane) {
    unsigned char* ws = p.ws;
    const bf16_t* Qr = (const bf16_t*)(ws + 1 * UNIT); const bf16_t* Kr = (const bf16_t*)(ws + 2 * UNIT); const bf16_t* Vr = (const bf16_t*)(ws + 3 * UNIT);
    bf16_t* Qn = (bf16_t*)(ws + 4 * UNIT); bf16_t* Kn = (bf16_t*)(ws + 5 * UNIT); bf16_t* Vc = (bf16_t*)p.out;
    const int tg = item & 255, h = (item >> 8) & 7, b = item >> 11; const int t_base = tg * 32; const size_t rb = (size_t)b * SEQ;
    const int col = h * 128 + 2 * lane; const int pcol = h * 128 + permpos(2 * lane);
    const float* cw = p.in[7];
    f32x2 wq[5], wk[5], wv[5];
#pragma unroll
    for (int j = 0; j < 5; ++j) { wq[j] = *(const f32x2*)(cw + j * 3072 + col); wk[j] = *(const f32x2*)(cw + j * 3072 + 1024 + col); wv[j] = *(const f32x2*)(cw + j * 3072 + 2048 + col); }
#pragma unroll
    for (int hf = 0; hf < 2; ++hf) {
        unsigned rq[20], rk[20], rv[20];
#pragma unroll
        for (int j = 0; j < 20; ++j) {
            const int t = t_base + 16 * hf - 2 + j; const bool ok = (t >= 0) && (t < SEQ); const int tc = t < 0 ? 0 : (t >= SEQ ? SEQ - 1 : t);
            const size_t off = (rb + tc) * D + col;
            const unsigned a0 = *(const unsigned*)(Qr + off), a1 = *(const unsigned*)(Kr + off), a2 = *(const unsigned*)(Vr + off);
            rq[j] = ok ? a0 : 0u; rk[j] = ok ? a1 : 0u; rv[j] = ok ? a2 : 0u;
        }
#pragma unroll
        for (int t16 = 0; t16 < 16; ++t16) {
            const int tt = 16 * hf + t16, t = t_base + tt;
            float q0 = 0.f, q1 = 0.f, k0 = 0.f, k1 = 0.f, v0 = 0.f, v1 = 0.f;
#pragma unroll
            for (int j = 0; j < 5; ++j) { q0 += wq[j].x * bf_lo(rq[t16 + j]); q1 += wq[j].y * bf_hi(rq[t16 + j]); k0 += wk[j].x * bf_lo(rk[t16 + j]); k1 += wk[j].y * bf_hi(rk[t16 + j]); v0 += wv[j].x * bf_lo(rv[t16 + j]); v1 += wv[j].y * bf_hi(rv[t16 + j]); }
            q0 = siluf_(q0); q1 = siluf_(q1); k0 = siluf_(k0); k1 = siluf_(k1); v0 = siluf_(v0); v1 = siluf_(v1);
            const float rq_ = rsqrtf(wave_sum(q0 * q0 + q1 * q1) + L2_EPS) * 0.08838834764831845f, rk_ = rsqrtf(wave_sum(k0 * k0 + k1 * k1) + L2_EPS);
            q0 *= rq_; q1 *= rq_; k0 *= rk_; k1 *= rk_;
            const size_t ro = (rb + t) * D;
            *(unsigned*)(Qn + ro + pcol) = cvt_pk_bf16(q0, q1); *(unsigned*)(Kn + ro + pcol) = cvt_pk_bf16(k0, k1); *(unsigned*)(Vc + ro + col) = cvt_pk_bf16(v0, v1);
        }
    }
    { const int i = lane & 31, dir = lane >> 5; const size_t row = rb + t_base + i; const float* AB = (const float*)(ws + WS_AB);
      const float a_raw = AB[row * 32 + dir * 8 + h], b_raw = AB[row * 32 + 16 + dir * 8 + h];
      const float g = -__expf(p.in[8][dir * 8 + h]) * softplusf_(a_raw + p.in[9][dir * 8 + h]);
      ((float*)(ws + WS_G))[row * 16 + dir * 8 + h] = g; ((float*)(ws + WS_BETA))[row * 16 + dir * 8 + h] = sigmoidf_(b_raw); }
}
DI void naive_scan(const Params& p, float* ldsw, int task, int lane) {
    unsigned char* ws = p.ws;
    const bf16_t* Qn = (const bf16_t*)(ws + 4 * UNIT); const bf16_t* Kn = (const bf16_t*)(ws + 5 * UNIT); const bf16_t* Vc = (const bf16_t*)p.out;
    const float* G = (const float*)(ws + WS_G); const float* BE = (const float*)(ws + WS_BETA);
    const int chain = task >> 1, b = chain >> 4, dir = (chain >> 3) & 1, h = chain & 7, e = (task & 1) * 64 + lane;
    bf16_t* O = (dir ? (bf16_t*)(p.out) + (size_t)M * D : (bf16_t*)(ws + 3 * UNIT));
    float* kb = ldsw; float* qb = ldsw + 128;
    float P[128];
#pragma unroll
    for (int d = 0; d < 128; ++d) P[d] = 0.f;
    for (int n = 0; n < SEQ; ++n) {
        const int t = dir ? SEQ - 1 - n : n; const size_t row = (size_t)b * SEQ + t;
        const unsigned ku = *(const unsigned*)(Kn + row * D + h * 128 + 2 * lane), qu = *(const unsigned*)(Qn + row * D + h * 128 + 2 * lane);
        const float v = bf1(Vc[row * D + h * 128 + e]); const float al = __expf(G[row * 16 + dir * 8 + h]), be = BE[row * 16 + dir * 8 + h];
        kb[2 * lane] = bf_lo(ku); kb[2 * lane + 1] = bf_hi(ku); qb[2 * lane] = bf_lo(qu); qb[2 * lane + 1] = bf_hi(qu);
        asm volatile("s_waitcnt lgkmcnt(0)" ::: "memory");
        float sk = 0.f;
#pragma unroll
        for (int d4 = 0; d4 < 32; ++d4) { if ((d4 & 3) == 0) __builtin_amdgcn_sched_barrier(0); const f32x4 k4 = *(const f32x4*)(kb + 4 * d4); sk += P[4 * d4] * k4.x + P[4 * d4 + 1] * k4.y + P[4 * d4 + 2] * k4.z + P[4 * d4 + 3] * k4.w; }
        const float vn = be * (v - al * sk); float o = 0.f;
#pragma unroll
        for (int d4 = 0; d4 < 32; ++d4) { if ((d4 & 3) == 0) __builtin_amdgcn_sched_barrier(0); const f32x4 k4 = *(const f32x4*)(kb + 4 * d4), q4 = *(const f32x4*)(qb + 4 * d4);
            P[4 * d4] = al * P[4 * d4] + k4.x * vn; P[4 * d4 + 1] = al * P[4 * d4 + 1] + k4.y * vn; P[4 * d4 + 2] = al * P[4 * d4 + 2] + k4.z * vn; P[4 * d4 + 3] = al * P[4 * d4 + 3] + k4.w * vn;
            o += P[4 * d4] * q4.x + P[4 * d4 + 1] * q4.y + P[4 * d4 + 2] * q4.z + P[4 * d4 + 3] * q4.w; }
        O[row * D + h * 128 + e] = (bf16_t)(cvt_pk_bf16(o, 0.f) & 0xffffu);
        asm volatile("s_waitcnt lgkmcnt(0)" ::: "memory");
    }
}
DI void ya_acc(float (&acc)[8], const u32x4& pv, const f32x4& wa, const f32x4& wb) {
    acc[0] += wa.x * bf_lo(pv.x); acc[1] += wa.y * bf_hi(pv.x); acc[2] += wa.z * bf_lo(pv.y); acc[3] += wa.w * bf_hi(pv.y);
    acc[4] += wb.x * bf_lo(pv.z); acc[5] += wb.y * bf_hi(pv.z); acc[6] += wb.z * bf_lo(pv.w); acc[7] += wb.w * bf_hi(pv.w);
}
DI void phase7(const Params& p, int gw, int NGW, int lane, int gtid, int NGT) {
    unsigned char* ws = p.ws;
    const bf16_t* Pb = (const bf16_t*)(ws + 1 * UNIT); bf16_t* R = (bf16_t*)(ws + 2 * UNIT); const float* cw = p.in[6];
    for (int it = gtid; it < (M / 4) * 128; it += NGT) {
        const int row0 = (it >> 7) * 4, c8 = (it & 127) * 8, t0 = row0 & (SEQ - 1);
        const u32x4 z = (u32x4){0u, 0u, 0u, 0u};
        u32x4 pv[6], rv[4];
        { const u32x4 t_ = *(const u32x4*)(Pb + (size_t)(t0 > 0 ? row0 - 1 : row0) * D + c8); pv[0] = t0 > 0 ? t_ : z; }
#pragma unroll
        for (int j = 0; j < 4; ++j) { pv[j + 1] = *(const u32x4*)(Pb + (size_t)(row0 + j) * D + c8); rv[j] = *(const u32x4*)(R + (size_t)(row0 + j) * D + c8); }
        { const u32x4 t_ = *(const u32x4*)(Pb + (size_t)(t0 + 4 < SEQ ? row0 + 4 : row0) * D + c8); pv[5] = t0 + 4 < SEQ ? t_ : z; }
        f32x4 wa[3], wb[3];
#pragma unroll
        for (int j = 0; j < 3; ++j) { wa[j] = *(const f32x4*)(cw + j * D + c8); wb[j] = *(const f32x4*)(cw + j * D + c8 + 4); }
#pragma unroll
        for (int j = 0; j < 4; ++j) {
            float acc[8] = {0.f, 0.f, 0.f, 0.f, 0.f, 0.f, 0.f, 0.f};
            ya_acc(acc, pv[j], wa[0], wb[0]); ya_acc(acc, pv[j + 1], wa[1], wb[1]); ya_acc(acc, pv[j + 2], wa[2], wb[2]);
            u32x4 o; const u32x4 r = rv[j];
            o.x = cvt_pk_bf16(bf_lo(r.x) * acc[0], bf_hi(r.x) * acc[1]); o.y = cvt_pk_bf16(bf_lo(r.y) * acc[2], bf_hi(r.y) * acc[3]);
            o.z = cvt_pk_bf16(bf_lo(r.z) * acc[4], bf_hi(r.z) * acc[5]); o.w = cvt_pk_bf16(bf_lo(r.w) * acc[6], bf_hi(r.w) * acc[7]);
            *(u32x4*)(R + (size_t)(row0 + j) * D + c8) = o;
        }
    }
    const bf16_t* Of = (const bf16_t*)(ws + 3 * UNIT); const bf16_t* Ob = (const bf16_t*)p.out + (size_t)M * D; bf16_t* SZ = (bf16_t*)(ws + 6 * UNIT);
    const f32x4 g0 = *(const f32x4*)(p.in[10] + (lane & 15) * 8), g1 = *(const f32x4*)(p.in[10] + (lane & 15) * 8 + 4);
    for (int rp = gw; rp < M / 2; rp += NGW) {
        u32x4 a[4], bb[4], zz[4];
#pragma unroll
        for (int u = 0; u < 4; ++u) { const size_t off = (size_t)(rp * 2 + (u >> 1)) * D + (u & 1) * 512 + lane * 8;
            a[u] = __builtin_nontemporal_load((const u32x4*)(Of + off)); bb[u] = __builtin_nontemporal_load((const u32x4*)(Ob + off)); zz[u] = __builtin_nontemporal_load((const u32x4*)(SZ + off)); }
#pragma unroll
        for (int u = 0; u < 4; ++u) { const size_t off = (size_t)(rp * 2 + (u >> 1)) * D + (u & 1) * 512 + lane * 8;
            float o[8];
            o[0] = bf_lo(a[u].x) + bf_lo(bb[u].x); o[1] = bf_hi(a[u].x) + bf_hi(bb[u].x); o[2] = bf_lo(a[u].y) + bf_lo(bb[u].y); o[3] = bf_hi(a[u].y) + bf_hi(bb[u].y);
            o[4] = bf_lo(a[u].z) + bf_lo(bb[u].z); o[5] = bf_hi(a[u].z) + bf_hi(bb[u].z); o[6] = bf_lo(a[u].w) + bf_lo(bb[u].w); o[7] = bf_hi(a[u].w) + bf_hi(bb[u].w);
            float ss = 0.f;
#pragma unroll
            for (int j = 0; j < 8; ++j) ss += o[j] * o[j];
            ss = row16_sum(ss);
            const float rs = rsqrtf(ss * (1.f / 128.f) + NORM_EPS);
            u32x4 w;
            w.x = cvt_pk_bf16(o[0] * rs * g0.x * bf_lo(zz[u].x), o[1] * rs * g0.y * bf_hi(zz[u].x)); w.y = cvt_pk_bf16(o[2] * rs * g0.z * bf_lo(zz[u].y), o[3] * rs * g0.w * bf_hi(zz[u].y));
            w.z = cvt_pk_bf16(o[4] * rs * g1.x * bf_lo(zz[u].z), o[5] * rs * g1.y * bf_hi(zz[u].z)); w.w = cvt_pk_bf16(o[6] * rs * g1.z * bf_lo(zz[u].w), o[7] * rs * g1.w * bf_hi(zz[u].w));
            *(u32x4*)(SZ + off) = w;
        }
    }
}
DI void phase7_panel(const Params& p, int pm, int pn, int tid, int lane, int wave) {
    unsigned char* ws = p.ws;
    const bf16_t* Pb = (const bf16_t*)(ws + 1 * UNIT); bf16_t* R = (bf16_t*)(ws + 2 * UNIT); const float* cw = p.in[6];
#pragma unroll 1
    for (int i = 0; i < 4; ++i) {
        const int it = tid + NTHREADS * i; const int row0 = 256 * pm + 4 * (it >> 5), c8 = 256 * pn + 8 * (it & 31), t0 = row0 & (SEQ - 1);
        const u32x4 z = (u32x4){0u, 0u, 0u, 0u};
        u32x4 pv[6], rv[4];
        { const u32x4 t_ = *(const u32x4*)(Pb + (size_t)(t0 > 0 ? row0 - 1 : row0) * D + c8); pv[0] = t0 > 0 ? t_ : z; }
#pragma unroll
        for (int j = 0; j < 4; ++j) { pv[j + 1] = *(const u32x4*)(Pb + (size_t)(row0 + j) * D + c8); rv[j] = *(const u32x4*)(R + (size_t)(row0 + j) * D + c8); }
        { const u32x4 t_ = *(const u32x4*)(Pb + (size_t)(t0 + 4 < SEQ ? row0 + 4 : row0) * D + c8); pv[5] = t0 + 4 < SEQ ? t_ : z; }
        f32x4 wa[3], wb[3];
#pragma unroll
        for (int j = 0; j < 3; ++j) { wa[j] = *(const f32x4*)(cw + j * D + c8); wb[j] = *(const f32x4*)(cw + j * D + c8 + 4); }
#pragma unroll
        for (int j = 0; j < 4; ++j) {
            float acc[8] = {0.f, 0.f, 0.f, 0.f, 0.f, 0.f, 0.f, 0.f};
            ya_acc(acc, pv[j], wa[0], wb[0]); ya_acc(acc, pv[j + 1], wa[1], wb[1]); ya_acc(acc, pv[j + 2], wa[2], wb[2]);
            u32x4 o; const u32x4 r = rv[j];
            o.x = cvt_pk_bf16(bf_lo(r.x) * acc[0], bf_hi(r.x) * acc[1]); o.y = cvt_pk_bf16(bf_lo(r.y) * acc[2], bf_hi(r.y) * acc[3]);
            o.z = cvt_pk_bf16(bf_lo(r.z) * acc[4], bf_hi(r.z) * acc[5]); o.w = cvt_pk_bf16(bf_lo(r.w) * acc[6], bf_hi(r.w) * acc[7]);
            *(u32x4*)(R + (size_t)(row0 + j) * D + c8) = o;
        }
    }
    const bf16_t* Of = (const bf16_t*)(ws + 3 * UNIT); const bf16_t* Ob = (const bf16_t*)p.out + (size_t)M * D; bf16_t* SZ = (bf16_t*)(ws + 6 * UNIT);
    const f32x4 g0 = *(const f32x4*)(p.in[10] + (lane & 15) * 8), g1 = *(const f32x4*)(p.in[10] + (lane & 15) * 8 + 4);
#pragma unroll 1
    for (int i = 0; i < 4; ++i) {
        u32x4 a[4], bb[4], zz[4];
#pragma unroll
        for (int u = 0; u < 4; ++u) { const size_t off = (size_t)(256 * pm + 32 * wave + 8 * i + 2 * u + (lane >> 5)) * D + 256 * pn + (lane & 31) * 8;
            a[u] = __builtin_nontemporal_load((const u32x4*)(Of + off)); bb[u] = __builtin_nontemporal_load((const u32x4*)(Ob + off)); zz[u] = __builtin_nontemporal_load((const u32x4*)(SZ + off)); }
#pragma unroll
        for (int u = 0; u < 4; ++u) { const size_t off = (size_t)(256 * pm + 32 * wave + 8 * i + 2 * u + (lane >> 5)) * D + 256 * pn + (lane & 31) * 8;
            float o[8];
            o[0] = bf_lo(a[u].x) + bf_lo(bb[u].x); o[1] = bf_hi(a[u].x) + bf_hi(bb[u].x); o[2] = bf_lo(a[u].y) + bf_lo(bb[u].y); o[3] = bf_hi(a[u].y) + bf_hi(bb[u].y);
            o[4] = bf_lo(a[u].z) + bf_lo(bb[u].z); o[5] = bf_hi(a[u].z) + bf_hi(bb[u].z); o[6] = bf_lo(a[u].w) + bf_lo(bb[u].w); o[7] = bf_hi(a[u].w) + bf_hi(bb[u].w);
            float ss = 0.f;
#pragma unroll
            for (int j = 0; j < 8; ++j) ss += o[j] * o[j];
            ss = row16_sum(ss);
            const float rs = rsqrtf(ss * (1.f / 128.f) + NORM_EPS);
            u32x4 w;
            w.x = cvt_pk_bf16(o[0] * rs * g0.x * bf_lo(zz[u].x), o[1] * rs * g0.y * bf_hi(zz[u].x)); w.y = cvt_pk_bf16(o[2] * rs * g0.z * bf_lo(zz[u].y), o[3] * rs * g0.w * bf_hi(zz[u].y));
            w.z = cvt_pk_bf16(o[4] * rs * g1.x * bf_lo(zz[u].z), o[5] * rs * g1.y * bf_hi(zz[u].z)); w.w = cvt_pk_bf16(o[6] * rs * g1.z * bf_lo(zz[u].w), o[7] * rs * g1.w * bf_hi(zz[u].w));
            *(u32x4*)(SZ + off) = w;
        }
    }
}
DI void phase10(const Params& p, int gw, int NGW, int lane) {
    const float* XN = (const float*)(p.ws + 0 * UNIT); const float* fw = p.in[14];
    f32x4 w[4];
#pragma unroll
    for (int j = 0; j < 4; ++j) w[j] = *((const f32x4*)fw + lane + 64 * j);
    for (int m = gw; m < M; m += NGW) {
        const f32x4* xr = (const f32x4*)(XN + (size_t)m * D) + lane; f32x4 v[4]; float s = 0.f;
#pragma unroll
        for (int j = 0; j < 4; ++j) { v[j] = xr[64 * j]; s += (v[j].x * v[j].x + v[j].y * v[j].y) + (v[j].z * v[j].z + v[j].w * v[j].w); }
        const float rstd = rsqrtf(wave_sum(s) * (1.f / D) + NORM_EPS);
        f32x4* o = (f32x4*)(p.out + (size_t)m * D) + lane;
#pragma unroll
        for (int j = 0; j < 4; ++j) o[64 * j] = v[j] * rstd * w[j];
    }
}
#define MFMA16(a, b, c) __builtin_amdgcn_mfma_f32_16x16x32_bf16((a), (b), (c), 0, 0, 0)
DI void chunk_prep_item(const Params& p, float* Lm, int item, int lane) {
    unsigned char* ws = p.ws;
    const bf16_t* Qn = (const bf16_t*)(ws + 4 * UNIT); const bf16_t* Kn = (const bf16_t*)(ws + 5 * UNIT);
    bf16_t* TF = (bf16_t*)(ws + 1 * UNIT) + (size_t)item * 4096; bf16_t* AF = (bf16_t*)(ws + 2 * UNIT) + (size_t)item * 4096;
    float* csc = (float*)(ws + WS_CSC) + (size_t)item * 192;
    const int c = item & 127, h = (item >> 7) & 7, dir = (item >> 10) & 1, b = item >> 11;
    const size_t rb = (size_t)b * SEQ + c * 64; const int il = lane & 15, q = lane >> 4;
    const int tl = dir ? 63 - lane : lane;
    const float g = ((const float*)(ws + WS_G))[(rb + tl) * 16 + dir * 8 + h], be = ((const float*)(ws + WS_BETA))[(rb + tl) * 16 + dir * 8 + h];
    float gc = g;
#pragma unroll
    for (int o = 1; o < 64; o <<= 1) { const float v = __shfl_up(gc, o); if (lane >= o) gc += v; }
    const float gl = __shfl(gc, 63);
    csc[tl] = __expf(gc); csc[64 + tl] = be; csc[128 + tl] = __expf(gl - gc);
    float gcr[4][4], ber[4][4], gcc[4];
#pragma unroll
    for (int t = 0; t < 4; ++t) { gcc[t] = __shfl(gc, 16 * t + il);
#pragma unroll
        for (int r = 0; r < 4; ++r) { gcr[t][r] = __shfl(gc, 16 * t + 4 * q + r); ber[t][r] = __shfl(be, 16 * t + 4 * q + r); } }
    bf16x8 Kf[4][4];
#pragma unroll
    for (int rt = 0; rt < 4; ++rt) { const int ip = 16 * rt + il; const size_t ro = (rb + (dir ? 63 - ip : ip)) * D + h * 128 + 8 * q;
#pragma unroll
        for (int ks = 0; ks < 4; ++ks) Kf[rt][ks] = *(const bf16x8*)(Kn + ro + 32 * ks); }
#pragma unroll
    for (int it = 0; it < 4; ++it)
#pragma unroll
        for (int jt = 0; jt <= it; ++jt) {
            f32x4 acc = {0.f, 0.f, 0.f, 0.f};
#pragma unroll
            for (int ks = 0; ks < 4; ++ks) acc = MFMA16(Kf[it][ks], Kf[jt][ks], acc);
#pragma unroll
            for (int r = 0; r < 4; ++r) { const int ip = 16 * it + 4 * q + r, jp = 16 * jt + il;
                Lm[ip * 64 + jp] = ip > jp ? ber[it][r] * acc[r] * __expf(gcr[it][r] - gcc[jt]) : 0.f; }
        }
    __builtin_amdgcn_sched_barrier(0);
    bf16x8 Qnext[4];
    { const int ip = il; const size_t ro = (rb + (dir ? 63 - ip : ip)) * D + h * 128 + 8 * q;
#pragma unroll
      for (int ks = 0; ks < 4; ++ks) Qnext[ks] = *(const bf16x8*)(Qn + ro + 32 * ks); }
#pragma unroll
    for (int mt = 0; mt < 4; ++mt) {
        bf16x8 Qf[4];
#pragma unroll
        for (int ks = 0; ks < 4; ++ks) Qf[ks] = Qnext[ks];
        if (mt < 3) { const int ip = 16 * (mt + 1) + il; const size_t ro = (rb + (dir ? 63 - ip : ip)) * D + h * 128 + 8 * q;
#pragma unroll
          for (int ks = 0; ks < 4; ++ks) Qnext[ks] = *(const bf16x8*)(Qn + ro + 32 * ks); }
#pragma unroll
        for (int ks2 = 0; ks2 < 2; ++ks2) {
            float vals[8];
#pragma unroll
            for (int a = 0; a < 2; ++a) { const int jt = 2 * ks2 + a; f32x4 acc = {0.f, 0.f, 0.f, 0.f};
#pragma unroll
                for (int ks = 0; ks < 4; ++ks) acc = MFMA16(Kf[jt][ks], Qf[ks], acc);
#pragma unroll
                for (int r = 0; r < 4; ++r) { const int jp = 16 * jt + 4 * q + r, ip = 16 * mt + il; vals[4 * a + r] = ip >= jp ? acc[r] * __expf(gcc[mt] - gcr[jt][r]) : 0.f; } }
            u32x4 w;
            if (dir) { w.x = cvt_pk_bf16(vals[7], vals[6]); w.y = cvt_pk_bf16(vals[5], vals[4]); w.z = cvt_pk_bf16(vals[3], vals[2]); w.w = cvt_pk_bf16(vals[1], vals[0]); }
            else { w.x = cvt_pk_bf16(vals[0], vals[1]); w.y = cvt_pk_bf16(vals[2], vals[3]); w.z = cvt_pk_bf16(vals[4], vals[5]); w.w = cvt_pk_bf16(vals[6], vals[7]); }
            const int fi = dir ? ((3 - mt) * 2 + (1 - ks2)) : (mt * 2 + ks2), ln = dir ? ((3 - q) * 16 + (15 - il)) : lane;
            *(u32x4*)(AF + (size_t)(fi * 64 + ln) * 8) = w;
        }
        __builtin_amdgcn_sched_barrier(0);
    }
    asm volatile("s_waitcnt lgkmcnt(0)" ::: "memory");
    __builtin_amdgcn_sched_barrier(0);
    float T[64];
#pragma unroll
    for (int i = 0; i < 64; ++i) {
        float s0 = (lane == i) ? 1.f : 0.f, s1 = 0.f;
#pragma unroll
        for (int m4 = 0; m4 < (i + 3) / 4; ++m4) {
            const f32x4 l4 = *(const f32x4*)(Lm + i * 64 + 4 * m4);
            if (4 * m4 + 0 < i) s0 -= l4.x * T[4 * m4 + 0];
            if (4 * m4 + 1 < i) s1 -= l4.y * T[4 * m4 + 1];
            if (4 * m4 + 2 < i) s0 -= l4.z * T[4 * m4 + 2];
            if (4 * m4 + 3 < i) s1 -= l4.w * T[4 * m4 + 3];
        }
        T[i] = s0 + s1;
        if ((i & 3) == 3) __builtin_amdgcn_sched_barrier(0);
    }
    asm volatile("s_waitcnt lgkmcnt(0)" ::: "memory");
    bf16_t* TL = (bf16_t*)Lm;
#pragma unroll
    for (int i = 0; i < 64; ++i) TL[i * 72 + lane] = (bf16_t)(cvt_pk_bf16(T[i], 0.f) & 0xffffu);
    asm volatile("s_waitcnt lgkmcnt(0)" ::: "memory");
#pragma unroll
    for (int mt = 0; mt < 4; ++mt)
#pragma unroll
        for (int ks2 = 0; ks2 < 2; ++ks2) {
            u32x4 w;
            if (dir) {
                const int row = 63 - 16 * mt - il;
                const u32x2 lo = *(const u32x2*)(TL + row * 72 + (60 - 32 * ks2 - 4 * q)), hi = *(const u32x2*)(TL + row * 72 + (44 - 32 * ks2 - 4 * q));
                w.x = (lo.y >> 16) | (lo.y << 16); w.y = (lo.x >> 16) | (lo.x << 16); w.z = (hi.y >> 16) | (hi.y << 16); w.w = (hi.x >> 16) | (hi.x << 16);
            } else {
                const int row = 16 * mt + il;
                const u32x2 lo = *(const u32x2*)(TL + row * 72 + (32 * ks2 + 4 * q)), hi = *(const u32x2*)(TL + row * 72 + (32 * ks2 + 16 + 4 * q));
                w.x = lo.x; w.y = lo.y; w.z = hi.x; w.w = hi.y;
            }
            *(u32x4*)(TF + (size_t)((mt * 2 + ks2) * 64 + lane) * 8) = w;
        }
    asm volatile("s_waitcnt lgkmcnt(0)" ::: "memory");
}
DI bf16x8 pack8(const f32x4& a, const f32x4& b) {
    u32x4 w; w.x = cvt_pk_bf16(a[0], a[1]); w.y = cvt_pk_bf16(a[2], a[3]); w.z = cvt_pk_bf16(b[0], b[1]); w.w = cvt_pk_bf16(b[2], b[3]);
    return __builtin_bit_cast(bf16x8, w);
}
DI void mfma_scan(const Params& p, int chain, int slice, int lane) {
    unsigned char* ws = p.ws;
    const bf16_t* Qn = (const bf16_t*)(ws + 4 * UNIT); const bf16_t* Kn = (const bf16_t*)(ws + 5 * UNIT); const bf16_t* KT = (const bf16_t*)(ws + 6 * UNIT); const bf16_t* Vc = (const bf16_t*)p.out;
    const bf16_t* TFb = (const bf16_t*)(ws + 1 * UNIT); const bf16_t* AFb = (const bf16_t*)(ws + 2 * UNIT); const float* cscb = (const float*)(ws + WS_CSC);
    const int b = chain >> 4, dir = (chain >> 3) & 1, h = chain & 7, il = lane & 15, q = lane >> 4;
    bf16_t* O = (dir ? (bf16_t*)(p.out) + (size_t)M * D : (bf16_t*)(ws + 3 * UNIT));
    f32x4 S[8];
#pragma unroll
    for (int dt = 0; dt < 8; ++dt) S[dt] = (f32x4){0.f, 0.f, 0.f, 0.f};
    for (int n = 0; n < 128; ++n) {
        const int c = dir ? 127 - n : n; const int item = chain * 128 + c; const size_t rowbase = (size_t)b * SEQ + c * 64;
        const bf16_t* TF = TFb + (size_t)item * 4096 + lane * 8; const bf16_t* AF = AFb + (size_t)item * 4096 + lane * 8; const float* csc = cscb + (size_t)item * 192;
        const float gl = csc[dir ? 0 : 63];
        f32x4 EG[4], BE[4], EK[4], V[4];
#pragma unroll
        for (int mt = 0; mt < 4; ++mt) { EG[mt] = *(const f32x4*)(csc + 16 * mt + 4 * q); BE[mt] = *(const f32x4*)(csc + 64 + 16 * mt + 4 * q); EK[mt] = *(const f32x4*)(csc + 128 + 16 * mt + 4 * q);
#pragma unroll
            for (int r = 0; r < 4; ++r) V[mt][r] = bf1(Vc[(rowbase + 16 * mt + 4 * q + r) * D + h * 128 + 16 * slice + il]); }
        bf16x8 Sb[4];
#pragma unroll
        for (int ks = 0; ks < 4; ++ks) Sb[ks] = pack8(S[2 * ks], S[2 * ks + 1]);
        f32x4 KS[4], QS[4];
#pragma unroll
        for (int mt = 0; mt < 4; ++mt) { const size_t ro = (rowbase + 16 * mt + il) * D + h * 128 + 8 * q;
            KS[mt] = (f32x4){0.f, 0.f, 0.f, 0.f}; QS[mt] = (f32x4){0.f, 0.f, 0.f, 0.f};
#pragma unroll
            for (int ks = 0; ks < 4; ++ks) { KS[mt] = MFMA16(*(const bf16x8*)(Kn + ro + 32 * ks), Sb[ks], KS[mt]); QS[mt] = MFMA16(*(const bf16x8*)(Qn + ro + 32 * ks), Sb[ks], QS[mt]); } }
        f32x4 X[4];
#pragma unroll
        for (int mt = 0; mt < 4; ++mt) X[mt] = BE[mt] * (V[mt] - EG[mt] * KS[mt]);
        bf16x8 Xb[2] = {pack8(X[0], X[1]), pack8(X[2], X[3])};
        f32x4 VN[4];
#pragma unroll
        for (int mt = 0; mt < 4; ++mt) { VN[mt] = (f32x4){0.f, 0.f, 0.f, 0.f};
#pragma unroll
            for (int ks2 = 0; ks2 < 2; ++ks2) VN[mt] = MFMA16(*(const bf16x8*)(TF + (size_t)((mt * 2 + ks2) * 64) * 8), Xb[ks2], VN[mt]); }
        bf16x8 VNb[2] = {pack8(VN[0], VN[1]), pack8(VN[2], VN[3])};
        bf16x8 VNs[2] = {pack8(VN[0] * EK[0], VN[1] * EK[1]), pack8(VN[2] * EK[2], VN[3] * EK[3])};
#pragma unroll
        for (int mt = 0; mt < 4; ++mt) { f32x4 o = EG[mt] * QS[mt];
#pragma unroll
            for (int ks2 = 0; ks2 < 2; ++ks2) o = MFMA16(*(const bf16x8*)(AF + (size_t)((mt * 2 + ks2) * 64) * 8), VNb[ks2], o);
#pragma unroll
            for (int r = 0; r < 4; ++r) O[(rowbase + 16 * mt + 4 * q + r) * D + h * 128 + 16 * slice + il] = (bf16_t)(cvt_pk_bf16(o[r], 0.f) & 0xffffu); }
#pragma unroll
        for (int dt = 0; dt < 8; ++dt) { const bf16_t* kt = KT + ((size_t)((b * 8 + h) * 128 + 16 * dt + il)) * SEQ + c * 64 + 8 * q; f32x4 s = S[dt] * gl;
#pragma unroll
            for (int ks2 = 0; ks2 < 2; ++ks2) s = MFMA16(*(const bf16x8*)(kt + 32 * ks2), VNs[ks2], s);
            S[dt] = s; }
    }
}
constexpr int SC_K = 0, SC_Q = 16384, SC_T = 32768, SC_A = 40960, SC_V = 49152, SC_C = 51200, SC_BUF = 52224, SC_NPIECE = 3248, SC_NLD = 384, SC_PPL = 9;
constexpr int SC_SB = 2 * SC_BUF, SC_VB = SC_SB + 2 * 4096, SC_END = SC_VB + 2 * 2048;
static_assert(SC_END <= LDS_BYTES - 256, "scan LDS");
typedef short s16x4_t __attribute__((ext_vector_type(4)));
#define SC_BAR() do { asm volatile("s_waitcnt lgkmcnt(0)" ::: "memory"); __builtin_amdgcn_s_barrier(); asm volatile("" ::: "memory"); } while (0)
DI void scan_task(const Params& p, PG8_LAS unsigned char* lds, int chain, int slice, int tid, int wave, int lane) {
    unsigned char* ws = p.ws;
    const int b = chain >> 4, dir = (chain >> 3) & 1, h = chain & 7, il = lane & 15, q = lane >> 4;
    const int c0 = dir ? 127 : 0; const long sgn = dir ? -1 : 1;
    if (wave >= 2) {
        const int lt = tid - 128; const int wbase = 64 * (wave - 2);
        const unsigned char* gp[SC_PPL]; int gstride[SC_PPL];
        const size_t rowbase0 = (size_t)b * SEQ + c0 * 64; const size_t item0 = (size_t)chain * 128 + c0;
#pragma unroll
        for (int k = 0; k < SC_PPL; ++k) {
            int pid = lt + SC_NLD * k; if (pid >= SC_NPIECE) pid -= 64;
            const unsigned char* g = ws; int st = 0;
            if (pid < 2048) { const int pp = pid & 1023, row = pp >> 4, ch = (pp & 15) ^ (row & 15);
                g = ws + (pid < 1024 ? 5 : 4) * UNIT + ((rowbase0 + row) * D + h * 128) * 2 + ch * 16; st = 64 * D * 2; }
            else if (pid < 3072) { const int pp = pid & 511; const bool isT = pid < 2560;
                g = ws + (isT ? 1 : 2) * UNIT + item0 * 8192 + pp * 16; st = 8192; }
            else if (pid < 3200) { const int pp = pid - 3072, row = pp >> 1, hf = pp & 1;
                g = (const unsigned char*)p.out + ((rowbase0 + row) * D + h * 128 + slice * 16) * 2 + hf * 16; st = 64 * D * 2; }
            else { const int pp = pid - 3200; g = ws + WS_CSC + item0 * 768 + pp * 16; st = 768; }
            gp[k] = g; gstride[k] = st;
        }
#define SC_DMA(bo) do { _Pragma("unroll") for (int k = 0; k < SC_PPL; ++k) { if (wbase + SC_NLD * k < SC_NPIECE) \
            __builtin_amdgcn_global_load_lds((const unsigned*)gp[k], (PG8_LAS unsigned*)(lds + (bo) + (wbase + SC_NLD * k) * 16), 16, 0, 0); gp[k] += sgn * gstride[k]; } } while (0)
        SC_DMA(0u);
        asm volatile("s_waitcnt vmcnt(0)" ::: "memory");
        SC_BAR();
        for (int n = 0; n < 128; ++n) {
            if (n + 1 < 128) SC_DMA((unsigned)(((n + 1) & 1) * SC_BUF));
            asm volatile("s_waitcnt vmcnt(0)" ::: "memory");
            SC_BAR();
        }
#undef SC_DMA
    } else if (wave == 0) {
        f32x4 S[8];
#pragma unroll
        for (int dt = 0; dt < 8; ++dt) S[dt] = (f32x4){0.f, 0.f, 0.f, 0.f};
        bf16x8 Sb[4];
#pragma unroll
        for (int ks = 0; ks < 4; ++ks) { Sb[ks] = pack8(S[2 * ks], S[2 * ks + 1]); *(PG8_LAS bf16x8*)(lds + SC_SB + (ks * 64 + lane) * 16) = Sb[ks]; }
        SC_BAR();
        for (int n = 0; n < 128; ++n) {
            PG8_LAS unsigned char* L = lds + (n & 1) * SC_BUF;
            bf16x8 Kf[4][4];
#pragma unroll
            for (int mt = 0; mt < 4; ++mt)
#pragma unroll
                for (int ks = 0; ks < 4; ++ks) Kf[mt][ks] = *(PG8_LAS bf16x8*)(L + SC_K + (16 * mt + il) * 256 + (((4 * ks + q) ^ il) << 4));
            f32x4 EG[4], BE[4], V[4]; bf16x8 Tf[4][2];
#pragma unroll
            for (int mt = 0; mt < 4; ++mt) { EG[mt] = *(PG8_LAS f32x4*)(L + SC_C + (16 * mt + 4 * q) * 4); BE[mt] = *(PG8_LAS f32x4*)(L + SC_C + 256 + (16 * mt + 4 * q) * 4);
#pragma unroll
                for (int r = 0; r < 4; ++r) V[mt][r] = bf1(*(PG8_LAS bf16_t*)(L + SC_V + (16 * mt + 4 * q + r) * 32 + il * 2));
#pragma unroll
                for (int ks2 = 0; ks2 < 2; ++ks2) Tf[mt][ks2] = *(PG8_LAS bf16x8*)(L + SC_T + ((mt * 2 + ks2) * 64 + lane) * 16); }
            f32x4 KS[4];
#pragma unroll
            for (int mt = 0; mt < 4; ++mt) KS[mt] = (f32x4){0.f, 0.f, 0.f, 0.f};
#pragma unroll
            for (int ks = 0; ks < 4; ++ks)
#pragma unroll
                for (int mt = 0; mt < 4; ++mt) KS[mt] = MFMA16(Kf[mt][ks], Sb[ks], KS[mt]);
            __builtin_amdgcn_sched_barrier(0);
            bf16x8 KTf[8][2]; f32x4 EK[4];
            { const int rr = il >> 2, pc = il & 3;
              PG8_LAS unsigned char* kb = L + SC_K + (4 * q + rr) * 256;
#pragma unroll
              for (int dt = 0; dt < 8; ++dt) {
                const int cho = (((4 * (dt >> 1) + pc) ^ (4 * q + rr)) << 4) + 8 * (dt & 1);
#pragma unroll
                for (int ks2 = 0; ks2 < 2; ++ks2) {
                    const s16x4_t lo_ = __builtin_amdgcn_ds_read_tr16_b64_v4i16((PG8_LAS s16x4_t*)(kb + (32 * ks2) * 256 + cho));
                    const s16x4_t hi_ = __builtin_amdgcn_ds_read_tr16_b64_v4i16((PG8_LAS s16x4_t*)(kb + (32 * ks2 + 16) * 256 + cho));
                    KTf[dt][ks2] = __builtin_shufflevector(lo_, hi_, 0, 1, 2, 3, 4, 5, 6, 7);
                } } }
#pragma unroll
            for (int mt = 0; mt < 4; ++mt) EK[mt] = *(PG8_LAS f32x4*)(L + SC_C + 512 + (16 * mt + 4 * q) * 4);
            const float gl = *(PG8_LAS float*)(L + SC_C + (dir ? 0 : 63) * 4);
            f32x4 X[4];
#pragma unroll
            for (int mt = 0; mt < 4; ++mt) X[mt] = BE[mt] * (V[mt] - EG[mt] * KS[mt]);
            bf16x8 Xb[2] = {pack8(X[0], X[1]), pack8(X[2], X[3])};
            f32x4 VN[4];
#pragma unroll
            for (int mt = 0; mt < 4; ++mt) VN[mt] = (f32x4){0.f, 0.f, 0.f, 0.f};
#pragma unroll
            for (int ks2 = 0; ks2 < 2; ++ks2)
#pragma unroll
                for (int mt = 0; mt < 4; ++mt) VN[mt] = MFMA16(Tf[mt][ks2], Xb[ks2], VN[mt]);
            *(PG8_LAS bf16x8*)(lds + SC_VB + (n & 1) * 2048 + lane * 16) = pack8(VN[0], VN[1]); *(PG8_LAS bf16x8*)(lds + SC_VB + (n & 1) * 2048 + (64 + lane) * 16) = pack8(VN[2], VN[3]);
            bf16x8 VNs[2] = {pack8(VN[0] * EK[0], VN[1] * EK[1]), pack8(VN[2] * EK[2], VN[3] * EK[3])};
#pragma unroll
            for (int dt = 0; dt < 8; ++dt) S[dt] = S[dt] * gl;
#pragma unroll
            for (int ks2 = 0; ks2 < 2; ++ks2)
#pragma unroll
                for (int dt = 0; dt < 8; ++dt) S[dt] = MFMA16(KTf[dt][ks2], VNs[ks2], S[dt]);
#pragma unroll
            for (int ks = 0; ks < 4; ++ks) { Sb[ks] = pack8(S[2 * ks], S[2 * ks + 1]); *(PG8_LAS bf16x8*)(lds + SC_SB + ((n + 1) & 1) * 4096 + (ks * 64 + lane) * 16) = Sb[ks]; }
            SC_BAR();
        }
    } else {
        bf16_t* O = (dir ? (bf16_t*)(p.out) + (size_t)M * D : (bf16_t*)(ws + 3 * UNIT));
        f32x4 Oa[4]; bf16x8 Af[4][2];
#pragma unroll
        for (int mt = 0; mt < 4; ++mt) { Oa[mt] = (f32x4){0.f, 0.f, 0.f, 0.f}; Af[mt][0] = (bf16x8){0, 0, 0, 0, 0, 0, 0, 0}; Af[mt][1] = Af[mt][0]; }
        SC_BAR();
        for (int n = 0; n <= 128; ++n) {
            if (n > 0) {
                const int c = dir ? 128 - n : n - 1; const size_t rowbase = (size_t)b * SEQ + c * 64;
                PG8_LAS unsigned char* vb = lds + SC_VB + ((n - 1) & 1) * 2048;
                bf16x8 VNb[2] = {*(PG8_LAS bf16x8*)(vb + lane * 16), *(PG8_LAS bf16x8*)(vb + (64 + lane) * 16)};
#pragma unroll
                for (int ks2 = 0; ks2 < 2; ++ks2)
#pragma unroll
                    for (int mt = 0; mt < 4; ++mt) Oa[mt] = MFMA16(Af[mt][ks2], VNb[ks2], Oa[mt]);
#pragma unroll
                for (int mt = 0; mt < 4; ++mt)
#pragma unroll
                    for (int r = 0; r < 4; ++r) __builtin_nontemporal_store((bf16_t)(cvt_pk_bf16(Oa[mt][r], 0.f) & 0xffffu), O + (rowbase + 16 * mt + 4 * q + r) * D + h * 128 + 16 * slice + il);
            }
            if (n < 128) {
                PG8_LAS unsigned char* L = lds + (n & 1) * SC_BUF;
                bf16x8 Qf[4][4], Sb[4]; f32x4 EG[4];
#pragma unroll
                for (int ks = 0; ks < 4; ++ks) Sb[ks] = *(PG8_LAS bf16x8*)(lds + SC_SB + (n & 1) * 4096 + (ks * 64 + lane) * 16);
#pragma unroll
                for (int mt = 0; mt < 4; ++mt) {
#pragma unroll
                    for (int ks = 0; ks < 4; ++ks) Qf[mt][ks] = *(PG8_LAS bf16x8*)(L + SC_Q + (16 * mt + il) * 256 + (((4 * ks + q) ^ il) << 4));
                    EG[mt] = *(PG8_LAS f32x4*)(L + SC_C + (16 * mt + 4 * q) * 4);
#pragma unroll
                    for (int ks2 = 0; ks2 < 2; ++ks2) Af[mt][ks2] = *(PG8_LAS bf16x8*)(L + SC_A + ((mt * 2 + ks2) * 64 + lane) * 16); }
                f32x4 QS[4];
#pragma unroll
                for (int mt = 0; mt < 4; ++mt) QS[mt] = (f32x4){0.f, 0.f, 0.f, 0.f};
#pragma unroll
                for (int ks = 0; ks < 4; ++ks)
#pragma unroll
                    for (int mt = 0; mt < 4; ++mt) QS[mt] = MFMA16(Qf[mt][ks], Sb[ks], QS[mt]);
#pragma unroll
                for (int mt = 0; mt < 4; ++mt) Oa[mt] = EG[mt] * QS[mt];
                SC_BAR();
            }
        }
    }
}


typedef const __attribute__((address_space(4))) Params* kparams_t;
#if defined(__HIP_DEVICE_COMPILE__)
DI Params load_params() { kparams_t pp = (kparams_t)__builtin_amdgcn_kernarg_segment_ptr(); asm volatile("" : "+s"(pp)); return *pp; }
#else
DI Params load_params() { return Params{}; }
#endif
#define PP() load_params()
#define XB_TMO      128
#define XB_XCNT(j)  (256  + 64 * (j))
#define XB_XSUB(j)  (1280 + 64 * (j))
#define XB_XGEN(j)  (2304 + 64 * (j))
#define XB_TOP      3328
#define XB_TOPGEN   3392
#define XCD_BAR_WORDS 3456
#define XB_SPIN_CAP (1u << 18)
#define LAS __attribute__((address_space(3)))

__device__ __forceinline__ unsigned xb_ld(unsigned* p)              { return __hip_atomic_load(p, __ATOMIC_RELAXED, __HIP_MEMORY_SCOPE_AGENT); }
__device__ __forceinline__ unsigned xb_add(unsigned* p, unsigned v) { return __hip_atomic_fetch_add(p, v, __ATOMIC_RELAXED, __HIP_MEMORY_SCOPE_AGENT); }
__device__ __forceinline__ unsigned xb_xcc_id() { return (unsigned)__builtin_amdgcn_s_getreg((3 << 11) | 20) & 0xFu; }
#define XB_SPIN(cond, bar) do { unsigned _sp = 0; while (cond) { __builtin_amdgcn_s_sleep(1); \
    if ((++_sp & 255u) == 0u) { if (xb_ld(&(bar)[XB_TMO])) break; if (_sp > XB_SPIN_CAP) { atomicAdd(&(bar)[XB_TMO], 1u); break; } } } } while (0)

struct XcdBarrier {
    unsigned* bar; unsigned x;
    volatile LAS unsigned* st;
};

__device__ __forceinline__ XcdBarrier xcd_barrier_post(unsigned* bar, volatile LAS unsigned* st) {
    XcdBarrier b; b.bar = bar; b.x = xb_xcc_id(); b.st = st;
    if (threadIdx.x == 0) (void)xb_add(&bar[XB_XCNT(b.x)], 1u);
    return b;
}
__device__ __forceinline__ void xcd_barrier_complete(unsigned* bar, unsigned x, unsigned& nloc, unsigned& nx) {
    const unsigned G = gridDim.x * gridDim.y * gridDim.z;
    unsigned sum, cnt, mine, sp = 0u;
    for (;;) {
        sum = 0u; cnt = 0u; mine = 0u;
#pragma unroll
        for (unsigned j = 0; j < 16; ++j) { const unsigned c = xb_ld(&bar[XB_XCNT(j)]); sum += c; cnt += (c > 0u) ? 1u : 0u; mine = (j == x) ? c : mine; }
        if (sum == G) break;
        __builtin_amdgcn_s_sleep(1);
        if ((++sp & 255u) == 0u) { if (xb_ld(&bar[XB_TMO])) break; if (sp > XB_SPIN_CAP) { atomicAdd(&bar[XB_TMO], 1u); break; } }
    }
    nloc = mine > 0u ? mine : 1u; nx = cnt > 0u ? cnt : 1u;
}

__device__ __forceinline__ void xcd_barrier(const XcdBarrier& b) {
    asm volatile("s_waitcnt vmcnt(0)" ::: "memory");
    __syncthreads();
    if (threadIdx.x == 0) {
        unsigned* bar = b.bar;
        __builtin_amdgcn_s_waitcnt(0);
        unsigned nloc = b.st[0], nx = b.st[1];
        if (nloc == 0u) { xcd_barrier_complete(bar, b.x, nloc, nx); b.st[0] = nloc; b.st[1] = nx; }
        const unsigned old = xb_add(&bar[XB_XSUB(b.x)], 1u);
        const unsigned gen = old / nloc;
        if (old + 1u == (gen + 1u) * nloc) {
            __builtin_amdgcn_fence(__ATOMIC_RELEASE, "agent");
            asm volatile("s_waitcnt vmcnt(0)" ::: "memory");
            const unsigned og = xb_add(&bar[XB_TOP], 1u);
            const unsigned tg = og / nx;
            if (og + 1u == (tg + 1u) * nx) xb_add(&bar[XB_TOPGEN], 1u);
            else XB_SPIN(xb_ld(&bar[XB_TOPGEN]) == tg, bar);
            __builtin_amdgcn_fence(__ATOMIC_ACQUIRE, "agent");
            xb_add(&bar[XB_XGEN(b.x)], 1u);
            asm volatile("s_waitcnt vmcnt(0)" ::: "memory");
        } else {
            XB_SPIN(xb_ld(&bar[XB_XGEN(b.x)]) == gen, bar);
            __builtin_amdgcn_fence(__ATOMIC_ACQUIRE, "agent");
            asm volatile("s_waitcnt vmcnt(0)" ::: "memory");
        }
    }
    __syncthreads();
}


constexpr size_t WS_BAR = 255 * MiB + 320 * 1024;
DI int fresh_tid() { int t = threadIdx.x; asm volatile("" : "+v"(t)); return t; }
#define IDS const int tid = fresh_tid(), lane = tid & 63, wave = __builtin_amdgcn_readfirstlane(tid >> 6); const int G = gridDim.x, bx = blockIdx.x; \
    const int gw = bx * NWAVES + wave, NGW = G * NWAVES, gtid = bx * NTHREADS + tid, NGT = G * NTHREADS; (void)lane; (void)gw; (void)NGW; (void)gtid; (void)NGT; (void)wave;
__global__ void __launch_bounds__(NTHREADS, 2) fwd_kernel(Params p) {
    extern __shared__ __attribute__((aligned(16))) unsigned char lds[];
    cg::grid_group grid = cg::this_grid();
    PG8_LAS unsigned char* ldsl = (PG8_LAS unsigned char*)lds;
    if (threadIdx.x < 4) ((PG8_LAS unsigned*)(ldsl + (LDS_BYTES - 256)))[threadIdx.x] = 0u;
    __syncthreads();
    const XcdBarrier bar = xcd_barrier_post((unsigned*)(PP().ws + WS_BAR), (volatile PG8_LAS unsigned*)(ldsl + (LDS_BYTES - 256)));

    { IDS phase0(PP(), gw, NGW, lane); }
    if (PP().ws == nullptr) grid.sync();
    xcd_barrier(bar);
    if (gridDim.x == 256) {
        IDS
        pg8::StaticOrder S1; S1.init(M, D, G, bx); pg8::Unit u1; (void)S1.next(0, u1);
        phase1(PP(), (float*)lds, gw, NGW, lane, tid, 256 * u1.pm + 64 * u1.pn);
        unsigned* cnt = (unsigned*)(PP().ws + WS_PCNT4) + 64 * u1.pm;
        asm volatile("s_waitcnt vmcnt(0)" ::: "memory");
        __syncthreads();
        if (threadIdx.x == 0) __hip_atomic_fetch_add(cnt, 1u, __ATOMIC_RELAXED, __HIP_MEMORY_SCOPE_AGENT);
        if (threadIdx.x < 64) {
            unsigned sp = 0;
            while ((unsigned)__builtin_amdgcn_readfirstlane(__hip_atomic_load(cnt, __ATOMIC_RELAXED, __HIP_MEMORY_SCOPE_AGENT)) < 4u) { __builtin_amdgcn_s_sleep(2); if (++sp > (1u << 22)) break; }
            __builtin_amdgcn_fence(__ATOMIC_ACQUIRE, "agent");
        }
        asm volatile("s_waitcnt vmcnt(0) lgkmcnt(0)" ::: "memory");
        __syncthreads();
    } else {
        { IDS phase1(PP(), (float*)lds, gw, NGW, lane, tid, -1); }
        xcd_barrier(bar);
    }
    {
        const Params q = PP(); unsigned char* ws = q.ws; bf16_t* WIN = (bf16_t*)(ws + WS_WIN); const int G = gridDim.x, bx = blockIdx.x;
        pg8::Gemm g{(const bf16_t*)(ws + 0 * UNIT), WIN + (size_t)ROWS_A * D, M, NB_TILES * 256, D}; pg8::StaticOrder S; S.init(M, NB_TILES * 256, G, bx);
        EpiB E{(bf16_t*)(ws + 1 * UNIT)};
        pg8::gemm_phase<EpiB, pg8::StaticOrder, true, true>(ldsl, g, S, E);
    }
    if (gridDim.x == 256) {
        IDS
        pg8::StaticOrder S1; S1.init(M, D, G, bx); pg8::Unit u1; (void)S1.next(0, u1);
        if (wave < 4) ab_item(PP(), 16 * u1.pm + 4 * u1.pn + wave, lane);
    } else { IDS for (int it = gw; it < M / 16; it += NGW) ab_item(PP(), it, lane); }
    xcd_barrier(bar);
    { IDS for (int it = gw; it < 4096; it += NGW) phase3_item(PP(), it, lane); }
    xcd_barrier(bar);
    { IDS for (int it = gw; it < 4096; it += NGW) chunk_prep_item(PP(), (float*)(lds + wave * 16384), it, lane); }
    xcd_barrier(bar);
    for (int tk = blockIdx.x; tk < 256; tk += gridDim.x) { const int t2 = fresh_tid(); scan_task(PP(), ldsl, (tk & 7) + 8 * (tk >> 6), (tk >> 3) & 7, t2, __builtin_amdgcn_readfirstlane(t2 >> 6), t2 & 63); __syncthreads(); }
    xcd_barrier(bar);
    {
        const Params q = PP(); unsigned char* ws = q.ws; bf16_t* WIN = (bf16_t*)(ws + WS_WIN); const int G = gridDim.x, bx = blockIdx.x;
        pg8::Gemm g{(const bf16_t*)(ws + 0 * UNIT), WIN, M, NA_TILES * 256, D}; pg8::StaticOrder S; S.init(M, NA_TILES * 256, G, bx);
        EpiA E{(bf16_t*)(ws + 1 * UNIT), (bf16_t*)(ws + 4 * UNIT)};
        pg8::gemm_phase<EpiA, pg8::StaticOrder, true, true>(ldsl, g, S, E);
    }
    if (gridDim.x == 256) {
        IDS
        pg8::StaticOrder S7; S7.init(M, D, G, bx); pg8::Unit u7; (void)S7.next(0, u7);
        unsigned* cntA = (unsigned*)(PP().ws + WS_PCNT3);
        asm volatile("s_waitcnt vmcnt(0)" ::: "memory");
        __syncthreads();
        if (threadIdx.x == 0) __hip_atomic_fetch_add(cntA + 64 * u7.pm, 1u, __ATOMIC_RELAXED, __HIP_MEMORY_SCOPE_AGENT);
        if (threadIdx.x < 64) {
            const int plo = u7.pm > 0 ? u7.pm - 1 : 0, phi = u7.pm < 63 ? u7.pm + 1 : 63;
            for (int pp = plo; pp <= phi; ++pp) { unsigned sp = 0;
                while ((unsigned)__builtin_amdgcn_readfirstlane(__hip_atomic_load(cntA + 64 * pp, __ATOMIC_RELAXED, __HIP_MEMORY_SCOPE_AGENT)) < 4u) { __builtin_amdgcn_s_sleep(2); if (++sp > (1u << 22)) break; } }
            __builtin_amdgcn_fence(__ATOMIC_ACQUIRE, "agent");
        }
        asm volatile("s_waitcnt vmcnt(0) lgkmcnt(0)" ::: "memory");
        __syncthreads();
        phase7_panel(PP(), u7.pm, u7.pn, tid, lane, wave);
    } else {
        xcd_barrier(bar);
        { IDS phase7(PP(), gw, NGW, lane, gtid, NGT); }
    }
    xcd_barrier(bar);
    if (gridDim.x == 256) {
        const Params q = PP(); unsigned char* ws = q.ws; const int G = gridDim.x, bx = blockIdx.x;
        static_assert(6 * UNIT - 2 * UNIT == (size_t)256 * 256 * D * 2 && WS_WPB - WS_WPA == (size_t)4 * 256 * D * 2, "TwoGemmOrder address arithmetic");
        TwoGemmOrder S; S.so.init(M, D, G, bx);
        pg8::Gemm g{(const bf16_t*)(ws + 2 * UNIT), (const bf16_t*)(ws + WS_WPA), M, D, D}; EpiYaYb E{(bf16_t*)(ws + 4 * UNIT), (const bf16_t*)(ws + 5 * UNIT)};
        pg8::gemm_phase<EpiYaYb, TwoGemmOrder, true, true>(ldsl, g, S, E);
    } else {
        const Params q = PP(); unsigned char* ws = q.ws; const int G = gridDim.x, bx = blockIdx.x;
        pg8::StaticOrder S; S.init(M, D, G, bx);
        { pg8::Gemm g{(const bf16_t*)(ws + 2 * UNIT), (const bf16_t*)(ws + WS_WPA), M, D, D}; EpiYa E{(bf16_t*)(ws + 4 * UNIT)};
          pg8::gemm_phase<EpiYa, pg8::StaticOrder, true, true>(ldsl, g, S, E); }
        { pg8::Gemm g{(const bf16_t*)(ws + 6 * UNIT), (const bf16_t*)(ws + WS_WPB), M, D, D}; EpiYb E{(bf16_t*)(ws + 4 * UNIT), (const bf16_t*)(ws + 5 * UNIT)};
          pg8::gemm_phase<EpiYb, pg8::StaticOrder, true, true>(ldsl, g, S, E); }
    }
    if (gridDim.x == 256) {
        pg8::StaticOrder S; S.init(M, D, (int)gridDim.x, (int)blockIdx.x); pg8::Unit u; (void)S.next(0, u);
        unsigned* cnt = (unsigned*)(PP().ws + WS_PCNT2) + 64 * u.pm;
        asm volatile("s_waitcnt vmcnt(0)" ::: "memory");
        __syncthreads();
        if (threadIdx.x == 0) __hip_atomic_fetch_add(cnt, 1u, __ATOMIC_RELAXED, __HIP_MEMORY_SCOPE_AGENT);
        if (threadIdx.x < 64) {
            unsigned sp = 0;
            while ((unsigned)__builtin_amdgcn_readfirstlane(__hip_atomic_load(cnt, __ATOMIC_RELAXED, __HIP_MEMORY_SCOPE_AGENT)) < 4u) { __builtin_amdgcn_s_sleep(2); if (++sp > (1u << 22)) break; }
            __builtin_amdgcn_fence(__ATOMIC_ACQUIRE, "agent");
        }
        asm volatile("s_waitcnt vmcnt(0) lgkmcnt(0)" ::: "memory");
        __syncthreads();
    } else {
        xcd_barrier(bar);
    }
    if (gridDim.x == 256) {
        const Params q = PP(); unsigned char* ws = q.ws; const int G = gridDim.x, bx = blockIdx.x;
        pg8::Gemm g{(const bf16_t*)(ws + 4 * UNIT), (const bf16_t*)(ws + WS_WO), M, D, D}; pg8::StaticOrder S; S.init(M, D, G, bx);
        EpiOutFused E{q.in[0], (const float*)(ws + WS_MODF), q.in[14], q.out, (float*)(ws + WS_PSS), (unsigned*)(ws + WS_PCNT)};
        pg8::gemm_phase<EpiOutFused, pg8::StaticOrder, true, true>(ldsl, g, S, E);
    } else {
        {
            const Params q = PP(); unsigned char* ws = q.ws; const int G = gridDim.x, bx = blockIdx.x;
            pg8::Gemm g{(const bf16_t*)(ws + 4 * UNIT), (const bf16_t*)(ws + WS_WO), M, D, D}; pg8::StaticOrder S; S.init(M, D, G, bx);
            EpiOut E{q.in[0], (const float*)(ws + WS_MODF), (float*)(ws + 0 * UNIT)};
            pg8::gemm_phase<EpiOut, pg8::StaticOrder, true, true>(ldsl, g, S, E);
        }
        xcd_barrier(bar);
        { IDS phase10(PP(), gw, NGW, lane); }
    }
}

extern "C" void kernel_launch(void* const* d_in, const int* in_sizes, int n_in, void* d_out, int out_size, void* d_ws, size_t ws_size, hipStream_t stream) {
    static int grid = 0;
    if (grid == 0) {
        int dev = 0, cus = 0, per_cu = 0;
        if (n_in != 15 || out_size != M * D || ws_size < 256 * MiB) { fprintf(stderr, "kernel_launch: unexpected shapes (n_in %d out %d ws %zu)\n", n_in, out_size, ws_size); grid = -1; return; }
        hipGetDevice(&dev); hipDeviceGetAttribute(&cus, hipDeviceAttributeMultiprocessorCount, dev);
        if (hipFuncSetAttribute((const void*)fwd_kernel, hipFuncAttributeMaxDynamicSharedMemorySize, LDS_BYTES) != hipSuccess) { fprintf(stderr, "kernel_launch: hipFuncSetAttribute failed\n"); grid = -1; return; }
        hipOccupancyMaxActiveBlocksPerMultiprocessor(&per_cu, (const void*)fwd_kernel, NTHREADS, LDS_BYTES);
        if (per_cu < 1) { fprintf(stderr, "kernel_launch: occupancy query says %d blocks/CU\n", per_cu); per_cu = 1; }
        (void)hipGetLastError();
        grid = cus;
    }
    if (grid < 0) return;
    if (hipMemsetAsync((char*)d_ws + WS_BAR, 0, 81920, stream) != hipSuccess) { fprintf(stderr, "kernel_launch: memset of barrier words failed\n"); return; }
    Params p{};
    for (int i = 0; i < 15; ++i) p.in[i] = (const float*)d_in[i];
    p.out = (float*)d_out; p.ws = (unsigned char*)d_ws;
    void* args[] = {&p};
    hipError_t e = hipLaunchCooperativeKernel((const void*)fwd_kernel, dim3(grid), dim3(NTHREADS), args, LDS_BYTES, stream);
    if (e != hipSuccess) fprintf(stderr, "cooperative launch failed: %s (grid %d)\n", hipGetErrorString(e), grid);
}
```

```cpp
#include <hip/hip_runtime.h>
#include <hip/hip_cooperative_groups.h>
#include <cstdio>
#include <cstdint>
namespace cg = cooperative_groups;

#define DI __device__ __forceinline__
#define PG8_LAS __attribute__((address_space(3)))
typedef unsigned short bf16_t;
typedef short bf16x8 __attribute__((ext_vector_type(8)));
typedef float f32x4 __attribute__((ext_vector_type(4)));
typedef float f32x2 __attribute__((ext_vector_type(2)));
typedef unsigned u32x4 __attribute__((ext_vector_type(4)));
typedef unsigned u32x2 __attribute__((ext_vector_type(2)));

namespace pg8 {
constexpr int BM = 256, BK = 64, HALF = 128, HTB = HALF * BK * 2, STAGE_BYTES = 8 * HTB, NXCD = 8, WGM = 8;
__host__ __device__ __forceinline__ int lds_byte(int r, int c) { const int st = (r >> 4) * 2 + (c >> 5), rr = r & 15, cc = c & 31, ob = rr * 64 + cc * 2; return st * 1024 + (ob ^ (((ob >> 9) & 1) << 5)); }
__host__ __device__ __forceinline__ void stage_rc(int b, int& R, int& C) { const int st = b / 1024, sb = b % 1024, swz = sb ^ (((sb >> 9) & 1) << 5); R = (st >> 1) * 16 + swz / 64; C = (st & 1) * 32 + (swz % 64) / 2; }
__host__ __device__ __forceinline__ int perm32(int rho) { const int n = rho >> 4, i = rho & 15; return 8 * (i >> 2) + 4 * n + (i & 3); }
struct Unit { int pm, pn; };
struct Gemm { const bf16_t* A; const bf16_t* Bt; int M, N, K; };
struct StaticOrder {
    int nM, nN, nwg, G, c;
    __host__ __device__ void init(int M, int N, int G_, int c_) { nM = M / BM; nN = N / BM; nwg = nM * nN; G = G_; c = c_; }
    __host__ __device__ bool next(int i, Unit& u) const {
        const long L = (long)i * G + c; if (L >= nwg) return false;
        int wgid = (int)L; { const int q = nwg / NXCD, r = nwg % NXCD, xcd = wgid % NXCD, off = wgid / NXCD; wgid = (xcd < r ? xcd * (q + 1) : r * (q + 1) + (xcd - r) * q) + off; }
        const int nig = WGM * nN, gid = wgid / nig, fm = gid * WGM, gsz = (nM - fm) < WGM ? (nM - fm) : WGM;
        u.pm = fm + ((wgid % nig) % gsz); u.pn = (wgid % nig) / gsz; return true;
    }
    __device__ __forceinline__ void a_ready(const Unit&) const {}
    __device__ __forceinline__ void done(const Unit&) const {}
};
template <class Epi, class Sched, bool ALIGN_EPI = false, bool SP2 = false>
__device__ __forceinline__ void gemm_phase(PG8_LAS unsigned char* lds, const Gemm g, const Sched& S, const Epi& E) {
    int tid = threadIdx.x; asm volatile("" : "+v"(tid)); const int wid = __builtin_amdgcn_readfirstlane(tid >> 6), lane = tid & 63, wr = wid >> 2, wc = wid & 3, fr = lane & 15, fq = lane >> 4;
    const int K = g.K, nt = K / BK;
    unsigned voffA[2], voffB[2];
#pragma unroll
    for (int i = 0; i < 2; ++i) { int R, C; stage_rc(tid * 16 + i * 8192, R, C); const int Rb = Epi::PERM ? ((R & ~31) + perm32(R & 31)) : R;
        voffA[i] = (unsigned)(R * K + C) * 2u; voffB[i] = (unsigned)(Rb * K + C) * 2u; }
    const size_t kstep = (size_t)(BK * 2);
    const size_t hstep = (size_t)HALF * K * 2;
    const size_t tstep = 2 * hstep;
    const unsigned ldsw = (unsigned)wid * 1024u;
    const int aoff = lds_byte(wr * 64 + fr, fq * 8), boff = lds_byte(wc * 32 + fr, fq * 8);
#define PG8_SA(b, h) (((b) * 2 + (h)) * HTB)
#define PG8_SB(b, h) ((4 + (b) * 2 + (h)) * HTB)
#define PG8_STAGE(bufoff, gbase, voff) do { _Pragma("unroll") for (int _i = 0; _i < 2; ++_i) \
        __builtin_amdgcn_global_load_lds((const unsigned*)((const char*)(gbase) + (voff)[_i]), (PG8_LAS unsigned*)(lds + (bufoff) + ldsw + _i * 8192), 16, 0, 0); } while (0)
#define PG8_LDA(dst, b, h) do { _Pragma("unroll") for (int m = 0; m < 4; ++m) _Pragma("unroll") for (int k = 0; k < 2; ++k) dst[m][k] = *(const PG8_LAS bf16x8*)(lds + PG8_SA(b, h) + aoff + m * 2048 + k * 1024); } while (0)
#define PG8_LDB(dst, b, h) do { _Pragma("unroll") for (int n = 0; n < 2; ++n) _Pragma("unroll") for (int k = 0; k < 2; ++k) dst[n][k] = *(const PG8_LAS bf16x8*)(lds + PG8_SB(b, h) + boff + n * 2048 + k * 1024); } while (0)
#define PG8_MMA(ai, bj, At, Bt) do { __builtin_amdgcn_s_setprio(1); _Pragma("unroll") for (int m = 0; m < 4; ++m) _Pragma("unroll") for (int n = 0; n < 2; ++n) _Pragma("unroll") for (int k = 0; k < 2; ++k) \
        acc[ai][bj][m][n] = __builtin_amdgcn_mfma_f32_16x16x32_bf16(Bt[n][k], At[m][k], acc[ai][bj][m][n], 0, 0, 0); __builtin_amdgcn_s_setprio(0); } while (0)
#define PG8_WAIT_V(n) asm volatile("s_waitcnt vmcnt(" #n ")" ::: "memory")
#define PG8_WAIT_L(n) asm volatile("s_waitcnt lgkmcnt(" #n ")" ::: "memory")
#define PG8_BAR __builtin_amdgcn_s_barrier()
#define PG8_SCHED __builtin_amdgcn_sched_barrier(0)
    Unit cur, nxt; int ui = 0;
    if (!S.next(0, cur)) return;
    f32x4 acc[2][2][4][2];
#pragma unroll
    for (int a = 0; a < 2; ++a)
#pragma unroll
        for (int b = 0; b < 2; ++b)
#pragma unroll
            for (int m = 0; m < 4; ++m)
#pragma unroll
                for (int n = 0; n < 2; ++n) acc[a][b][m][n] = (f32x4){0.f, 0.f, 0.f, 0.f};
    bf16x8 At[4][2], B0[2][2], B1[2][2];
    const char* cA = (const char*)g.A + (size_t)cur.pm * tstep; const char* cB = (const char*)g.Bt + (size_t)cur.pn * tstep;
    S.a_ready(cur);
    if constexpr (SP2) {
        PG8_STAGE(PG8_SB(0, 0), cB, voffB); PG8_STAGE(PG8_SB(0, 1), cB + hstep, voffB); PG8_STAGE(PG8_SA(0, 0), cA, voffA); PG8_STAGE(PG8_SA(0, 1), cA + hstep, voffA);
        if (wr == 1) PG8_BAR;
        PG8_WAIT_V(2); PG8_BAR;
        PG8_STAGE(PG8_SB(1, 0), cB + kstep, voffB); PG8_STAGE(PG8_SA(1, 0), cA + kstep, voffA); PG8_STAGE(PG8_SB(1, 1), cB + hstep + kstep, voffB);
        PG8_WAIT_V(6); PG8_BAR;
    } else {
        PG8_STAGE(PG8_SB(0, 0), cB, voffB); PG8_STAGE(PG8_SA(0, 0), cA, voffA); PG8_STAGE(PG8_SB(0, 1), cB + hstep, voffB); PG8_STAGE(PG8_SA(0, 1), cA + hstep, voffA);
        if (wr == 1) PG8_BAR;
        PG8_WAIT_V(4); PG8_BAR;
        PG8_STAGE(PG8_SB(1, 0), cB + kstep, voffB); PG8_STAGE(PG8_SA(1, 0), cA + kstep, voffA); PG8_STAGE(PG8_SB(1, 1), cB + hstep + kstep, voffB);
        PG8_WAIT_V(6); PG8_BAR;
    }
    for (;;) {
        const bool has_next = S.next(ui + 1, nxt);
        const char* nA = has_next ? (const char*)g.A + (size_t)nxt.pm * tstep : cA; const char* nB = has_next ? (const char*)g.Bt + (size_t)nxt.pn * tstep : cB;
        for (int t = 0; t < nt; t += 2) {
            const bool last = (t == nt - 2);
            const char* a1 = cA + (size_t)(t + 1) * kstep;
            const char* a2 = last ? nA : cA + (size_t)(t + 2) * kstep; const char* b2 = last ? nB : cB + (size_t)(t + 2) * kstep;
            const char* a3 = a2 + kstep; const char* b3 = b2 + kstep;
            if (last && has_next) S.a_ready(nxt);
            if constexpr (SP2) {
            PG8_LDB(B0, 0, 0); PG8_LDB(B1, 0, 1); PG8_SCHED; PG8_LDA(At, 0, 0); PG8_STAGE(PG8_SA(1, 1), a1 + hstep, voffA);
            PG8_WAIT_V(8); PG8_WAIT_L(0); PG8_BAR; PG8_MMA(0, 0, At, B0); PG8_MMA(0, 1, At, B1); PG8_BAR; PG8_SCHED;
            PG8_LDA(At, 0, 1); PG8_STAGE(PG8_SB(0, 0), b2, voffB); PG8_STAGE(PG8_SB(0, 1), b2 + hstep, voffB); PG8_STAGE(PG8_SA(0, 0), a2, voffA);
            PG8_WAIT_V(8); PG8_WAIT_L(0); PG8_BAR; PG8_MMA(1, 0, At, B0); PG8_MMA(1, 1, At, B1); PG8_BAR; PG8_SCHED;
            PG8_LDB(B0, 1, 0); PG8_LDB(B1, 1, 1); PG8_SCHED; PG8_LDA(At, 1, 0); PG8_STAGE(PG8_SA(0, 1), a2 + hstep, voffA);
            PG8_WAIT_V(8); PG8_WAIT_L(0); PG8_BAR; PG8_MMA(0, 0, At, B0); PG8_MMA(0, 1, At, B1); PG8_BAR; PG8_SCHED;
            PG8_LDA(At, 1, 1); PG8_STAGE(PG8_SB(1, 0), b3, voffB); PG8_STAGE(PG8_SB(1, 1), b3 + hstep, voffB); PG8_STAGE(PG8_SA(1, 0), a3, voffA);
            PG8_WAIT_V(8); PG8_WAIT_L(0); PG8_BAR; PG8_MMA(1, 0, At, B0); PG8_MMA(1, 1, At, B1); PG8_BAR; PG8_SCHED;
            } else {
            PG8_LDB(B0, 0, 0); PG8_SCHED; PG8_LDA(At, 0, 0); PG8_STAGE(PG8_SA(1, 1), a1 + hstep, voffA);
            PG8_WAIT_L(8); PG8_BAR; PG8_WAIT_L(0); PG8_MMA(0, 0, At, B0); PG8_BAR; PG8_SCHED;
            PG8_LDB(B1, 0, 1); PG8_STAGE(PG8_SB(0, 0), b2, voffB);
            PG8_BAR; PG8_WAIT_L(0); PG8_MMA(0, 1, At, B1); PG8_BAR;
            PG8_LDA(At, 0, 1); PG8_STAGE(PG8_SA(0, 0), a2, voffA);
            PG8_BAR; PG8_WAIT_L(0); PG8_MMA(1, 0, At, B0); PG8_BAR; PG8_SCHED;
            PG8_STAGE(PG8_SB(0, 1), b2 + hstep, voffB);
            PG8_WAIT_V(6); PG8_BAR; PG8_MMA(1, 1, At, B1); PG8_BAR;
            PG8_LDB(B0, 1, 0); PG8_SCHED; PG8_LDA(At, 1, 0); PG8_STAGE(PG8_SA(0, 1), a2 + hstep, voffA);
            PG8_WAIT_L(8); PG8_BAR; PG8_WAIT_L(0); PG8_MMA(0, 0, At, B0); PG8_BAR; PG8_SCHED;
            PG8_LDB(B1, 1, 1); PG8_STAGE(PG8_SB(1, 0), b3, voffB);
            PG8_BAR; PG8_WAIT_L(0); PG8_MMA(0, 1, At, B1); PG8_BAR;
            PG8_LDA(At, 1, 1); PG8_STAGE(PG8_SA(1, 0), a3, voffA);
            PG8_BAR; PG8_WAIT_L(0); PG8_MMA(1, 0, At, B0); PG8_BAR; PG8_SCHED;
            PG8_STAGE(PG8_SB(1, 1), b3 + hstep, voffB);
            PG8_WAIT_V(6); PG8_BAR; PG8_MMA(1, 1, At, B1); PG8_BAR;
            }
        }
        if constexpr (ALIGN_EPI) { if (wr == 0) PG8_BAR; }
        if constexpr (!Epi::AFTER_DRAIN) { E(acc, cur, wr, wc, fr, fq); S.done(cur); }
        if (!has_next) break;
#pragma unroll
        for (int a = 0; a < 2; ++a)
#pragma unroll
            for (int b = 0; b < 2; ++b)
#pragma unroll
                for (int m = 0; m < 4; ++m)
#pragma unroll
                    for (int n = 0; n < 2; ++n) acc[a][b][m][n] = (f32x4){0.f, 0.f, 0.f, 0.f};
        cur = nxt; cA = nA; cB = nB; ++ui;
        if constexpr (ALIGN_EPI) { if (wr == 1) PG8_BAR; }
    }
    PG8_WAIT_V(0);
    if constexpr (!ALIGN_EPI) { if (wr == 0) PG8_BAR; }
    PG8_BAR;
    if constexpr (Epi::AFTER_DRAIN) { E.fused(acc, cur, wr, wc, fr, fq, lds, wid, lane); S.done(cur); }
#undef PG8_SA
#undef PG8_SB
#undef PG8_STAGE
#undef PG8_LDA
#undef PG8_LDB
#undef PG8_MMA
#undef PG8_WAIT_V
#undef PG8_WAIT_L
#undef PG8_BAR
#undef PG8_SCHED
}}

constexpr int SEQ = 8192, NB = 2, M = NB * SEQ, D = 1024, NIN = 10272, NPAD = 10496;
constexpr int NA_TILES = 28, NB_TILES = 12, ROWS_A = NA_TILES * 256;
constexpr size_t MiB = 1u << 20;
constexpr size_t UNIT = 32 * MiB;
constexpr size_t WS_WIN = 224 * MiB, WS_WPA = 245 * MiB, WS_WPB = 247 * MiB, WS_WO = 249 * MiB, WS_AB = 251 * MiB, WS_G = 253 * MiB, WS_BETA = 254 * MiB;
constexpr size_t WS_MODP = 255 * MiB, WS_MODF = 255 * MiB + 256 * 1024;
constexpr size_t WS_CSC = 239 * MiB;
constexpr int LDS_BYTES = 155648;
constexpr int NWAVES = 8, NTHREADS = 512;
constexpr float NORM_EPS = 1e-6f, L2_EPS = 1e-6f;

struct Params { const float* in[15]; float* out; unsigned char* ws; };

typedef __bf16 bf16v2_t __attribute__((ext_vector_type(2)));
DI unsigned cvt_pk_bf16(float lo, float hi) { const f32x2 v = {lo, hi}; const bf16v2_t r = __builtin_convertvector(v, bf16v2_t); return __builtin_bit_cast(unsigned, r); }
DI void store_wt16(void* p, const u32x4& v) { asm volatile("global_store_dwordx4 %0, %1, off sc1\n\ts_nop 1" :: "v"(p), "v"(v) : "memory"); }
DI float bf_lo(unsigned u) { return __uint_as_float(u << 16); }
DI float bf_hi(unsigned u) { return __uint_as_float(u & 0xffff0000u); }
DI float bf1(bf16_t u) { return __uint_as_float(((unsigned)u) << 16); }
DI float sigmoidf_(float x) { return __builtin_amdgcn_rcpf(1.0f + __expf(-x)); }
DI float siluf_(float x) { return x * __builtin_amdgcn_rcpf(1.0f + __expf(-x)); }
DI float softplusf_(float x) { return fmaxf(x, 0.f) + log1pf(__expf(-fabsf(x))); }
#define DPP_F(v, ctrl) __builtin_bit_cast(float, __builtin_amdgcn_mov_dpp(__builtin_bit_cast(int, (v)), (ctrl), 0xF, 0xF, true))
DI float row16_sum(float v) {
    v += DPP_F(v, 0xB1);
    v += DPP_F(v, 0x4E);
    v += DPP_F(v, 0x141);
    v += DPP_F(v, 0x140);
    return v;
}
DI float wave_sum(float v) {
    v = row16_sum(v);
    return __builtin_bit_cast(float, __builtin_amdgcn_readlane(__builtin_bit_cast(int, v), 0)) + __builtin_bit_cast(float, __builtin_amdgcn_readlane(__builtin_bit_cast(int, v), 16))
         + __builtin_bit_cast(float, __builtin_amdgcn_readlane(__builtin_bit_cast(int, v), 32)) + __builtin_bit_cast(float, __builtin_amdgcn_readlane(__builtin_bit_cast(int, v), 48));
}
DI int permpos(int dk) { const int loc = dk & 31; return (dk & ~31) + 8 * ((loc >> 2) & 3) + 4 * (loc >> 4) + (loc & 3); }
DI int win_src_col(int d) {
    if (d < 2048) { const int i = d >> 8, w = d & 255; return w < 128 ? (128 * i + w) : (2048 + 128 * i + (w - 128)); }
    if (d < 4096) { const int i = (d - 2048) >> 8, w = d & 255; return w < 128 ? (1024 + 128 * i + w) : (3072 + 128 * i + (w - 128)); }
    if (d < 5120) return 8224 + (d - 4096);
    if (d < 6144) return 9248 + (d - 5120);
    if (d < 7168) return 7168 + (d - 6144);
    if (d < 10240) return 4096 + (d - 7168);
    if (d < 10272) return 8192 + (d - 10240);
    return -1;
}

struct EpiA {
    static constexpr bool PERM = true, AFTER_DRAIN = false;
    bf16_t *PR, *SG;
    DI void operator()(const f32x4 (&acc)[2][2][4][2], const pg8::Unit& u, int wr, int wc, int fr, int fq) const {
        const int row0 = u.pm * 256 + wr * 64 + fr, pn = u.pn;
        if (pn < 16) {
            bf16_t* O = PR + (size_t)(pn >> 3) * (UNIT / 2) + (size_t)(128 * (pn & 7) + 32 * wc + 8 * fq);
#pragma unroll
            for (int ai = 0; ai < 2; ++ai)
#pragma unroll
                for (int m = 0; m < 4; ++m) {
                    float o[8];
#pragma unroll
                    for (int n = 0; n < 2; ++n)
#pragma unroll
                        for (int j = 0; j < 4; ++j) { const float a = acc[ai][0][m][n][j], b = acc[ai][1][m][n][j]; o[4 * n + j] = pn < 8 ? a * b : a * siluf_(b); }
                    u32x4 w; w.x = cvt_pk_bf16(o[0], o[1]); w.y = cvt_pk_bf16(o[2], o[3]); w.z = cvt_pk_bf16(o[4], o[5]); w.w = cvt_pk_bf16(o[6], o[7]);
                    store_wt16(O + (size_t)(row0 + ai * 128 + m * 16) * D, w);
                }
        } else {
            const int g = (pn - 16) >> 2;
            bf16_t* O = SG + (size_t)g * (UNIT / 2) + (size_t)(256 * ((pn - 16) & 3) + 32 * wc + 8 * fq);
#pragma unroll
            for (int ai = 0; ai < 2; ++ai)
#pragma unroll
                for (int m = 0; m < 4; ++m)
#pragma unroll
                    for (int bj = 0; bj < 2; ++bj) {
                        float o[8];
#pragma unroll
                        for (int n = 0; n < 2; ++n)
#pragma unroll
                            for (int j = 0; j < 4; ++j) { const float a = acc[ai][bj][m][n][j]; o[4 * n + j] = g == 2 ? siluf_(a) : sigmoidf_(a); }
                        u32x4 w; w.x = cvt_pk_bf16(o[0], o[1]); w.y = cvt_pk_bf16(o[2], o[3]); w.z = cvt_pk_bf16(o[4], o[5]); w.w = cvt_pk_bf16(o[6], o[7]);
                        store_wt16(O + (size_t)(row0 + ai * 128 + m * 16) * D + bj * 128, w);
                    }
        }
    }
};
struct EpiB {
    static constexpr bool PERM = true, AFTER_DRAIN = false;
    bf16_t* QKV;
    DI void operator()(const f32x4 (&acc)[2][2][4][2], const pg8::Unit& u, int wr, int wc, int fr, int fq) const {
        const int row0 = u.pm * 256 + wr * 64 + fr, pn = u.pn;
        bf16_t* O = QKV + (size_t)(pn >> 2) * (UNIT / 2) + (size_t)(256 * (pn & 3) + 32 * wc + 8 * fq);
#pragma unroll
        for (int ai = 0; ai < 2; ++ai)
#pragma unroll
            for (int m = 0; m < 4; ++m)
#pragma unroll
                for (int bj = 0; bj < 2; ++bj) {
                    const f32x4 v0 = acc[ai][bj][m][0], v1 = acc[ai][bj][m][1];
                    u32x4 w; w.x = cvt_pk_bf16(v0[0], v0[1]); w.y = cvt_pk_bf16(v0[2], v0[3]); w.z = cvt_pk_bf16(v1[0], v1[1]); w.w = cvt_pk_bf16(v1[2], v1[3]);
                    store_wt16(O + (size_t)(row0 + ai * 128 + m * 16) * D + bj * 128, w);
                }
    }
};
struct EpiYa {
    static constexpr bool PERM = true, AFTER_DRAIN = false;
    bf16_t* SGA;
    DI void operator()(const f32x4 (&acc)[2][2][4][2], const pg8::Unit& u, int wr, int wc, int fr, int fq) const {
        const int row0 = u.pm * 256 + wr * 64 + fr; bf16_t* O = SGA + (size_t)(256 * u.pn + 32 * wc + 8 * fq);
#pragma unroll
        for (int ai = 0; ai < 2; ++ai)
#pragma unroll
            for (int m = 0; m < 4; ++m)
#pragma unroll
                for (int bj = 0; bj < 2; ++bj) {
                    u32x4* p = (u32x4*)(O + (size_t)(row0 + ai * 128 + m * 16) * D + bj * 128);
                    const u32x4 s = *p; const f32x4 v0 = acc[ai][bj][m][0], v1 = acc[ai][bj][m][1];
                    u32x4 w; w.x = cvt_pk_bf16(bf_lo(s.x) * v0[0], bf_hi(s.x) * v0[1]); w.y = cvt_pk_bf16(bf_lo(s.y) * v0[2], bf_hi(s.y) * v0[3]);
                    w.z = cvt_pk_bf16(bf_lo(s.z) * v1[0], bf_hi(s.z) * v1[1]); w.w = cvt_pk_bf16(bf_lo(s.w) * v1[2], bf_hi(s.w) * v1[3]);
                    *p = w;
                }
    }
};
struct EpiYb {
    static constexpr bool PERM = true, AFTER_DRAIN = false;
    bf16_t* MA; const bf16_t* SGB;
    DI void operator()(const f32x4 (&acc)[2][2][4][2], const pg8::Unit& u, int wr, int wc, int fr, int fq) const {
        const int row0 = u.pm * 256 + wr * 64 + fr; const size_t c0 = (size_t)(256 * u.pn + 32 * wc + 8 * fq);
#pragma unroll
        for (int ai = 0; ai < 2; ++ai)
#pragma unroll
            for (int m = 0; m < 4; ++m)
#pragma unroll
                for (int bj = 0; bj < 2; ++bj) {
                    const size_t off = (size_t)(row0 + ai * 128 + m * 16) * D + bj * 128 + c0;
                    u32x4* p = (u32x4*)(MA + off); const u32x4 a = *p; const u32x4 s = *(const u32x4*)(SGB + off);
                    const f32x4 v0 = acc[ai][bj][m][0], v1 = acc[ai][bj][m][1];
                    u32x4 w; w.x = cvt_pk_bf16(bf_lo(a.x) + bf_lo(s.x) * v0[0], bf_hi(a.x) + bf_hi(s.x) * v0[1]); w.y = cvt_pk_bf16(bf_lo(a.y) + bf_lo(s.y) * v0[2], bf_hi(a.y) + bf_hi(s.y) * v0[3]);
                    w.z = cvt_pk_bf16(bf_lo(a.z) + bf_lo(s.z) * v1[0], bf_hi(a.z) + bf_hi(s.z) * v1[1]); w.w = cvt_pk_bf16(bf_lo(a.w) + bf_lo(s.w) * v1[2], bf_hi(a.w) + bf_hi(s.w) * v1[3]);
                    store_wt16(p, w);
                }
    }
};
struct EpiOut {
    static constexpr bool PERM = true, AFTER_DRAIN = false;
    const float* X; const float* GATE; float* XN;
    DI void operator()(const f32x4 (&acc)[2][2][4][2], const pg8::Unit& u, int wr, int wc, int fr, int fq) const {
        const int row0 = u.pm * 256 + wr * 64 + fr; const int c0 = 256 * u.pn + 32 * wc + 8 * fq;
        const float* gp = GATE + (size_t)((u.pm * 256) / SEQ) * D + c0;
        f32x4 gt[2][2];
#pragma unroll
        for (int bj = 0; bj < 2; ++bj) { gt[bj][0] = *(const f32x4*)(gp + bj * 128); gt[bj][1] = *(const f32x4*)(gp + bj * 128 + 4); }
#pragma unroll
        for (int ai = 0; ai < 2; ++ai)
#pragma unroll
            for (int m = 0; m < 4; ++m)
#pragma unroll
                for (int bj = 0; bj < 2; ++bj) {
                    const size_t off = (size_t)(row0 + ai * 128 + m * 16) * D + bj * 128 + c0;
                    const f32x4 x0 = *(const f32x4*)(X + off), x1 = *(const f32x4*)(X + off + 4);
                    *(f32x4*)(XN + off) = x0 + gt[bj][0] * acc[ai][bj][m][0]; *(f32x4*)(XN + off + 4) = x1 + gt[bj][1] * acc[ai][bj][m][1];
                }
    }
};

constexpr size_t WS_PCNT = 255 * MiB + 336 * 1024;
constexpr size_t WS_PSS = 255 * MiB + 512 * 1024;
constexpr size_t WS_PCNT3 = 255 * MiB + 368 * 1024;
constexpr size_t WS_PCNT4 = 255 * MiB + 384 * 1024;
constexpr size_t WS_PCNT5 = 255 * MiB + 400 * 1024;
constexpr size_t WS_PCNT2 = 255 * MiB + 352 * 1024;
struct EpiOutFused {
    static constexpr bool PERM = true, AFTER_DRAIN = true;
    const float* X; const float* GATE; const float* FW; float* OUT; float* PSS; unsigned* PCNT;
    DI void operator()(const f32x4 (&)[2][2][4][2], const pg8::Unit&, int, int, int, int) const {}
    DI void fused(f32x4 (&acc)[2][2][4][2], const pg8::Unit& u, int wr, int wc, int fr, int fq, PG8_LAS unsigned char* lds, int wid, int lane) const {
        PG8_LAS float* P = (PG8_LAS float*)lds;
        PG8_LAS float* S = (PG8_LAS float*)(lds + 4096);
        const int row0 = u.pm * 256 + wr * 64 + fr; const int c0 = 256 * u.pn + 32 * wc + 8 * fq;
        const float* gp = GATE + (size_t)((u.pm * 256) / SEQ) * D + c0;
        f32x4 gt[2][2];
#pragma unroll
        for (int bj = 0; bj < 2; ++bj) { gt[bj][0] = *(const f32x4*)(gp + bj * 128); gt[bj][1] = *(const f32x4*)(gp + bj * 128 + 4); }
#pragma unroll
        for (int ai = 0; ai < 2; ++ai)
#pragma unroll
            for (int m = 0; m < 4; ++m) {
                float s = 0.f;
#pragma unroll
                for (int bj = 0; bj < 2; ++bj) {
                    const size_t off = (size_t)(row0 + ai * 128 + m * 16) * D + bj * 128 + c0;
                    const f32x4 v0 = __builtin_nontemporal_load((const f32x4*)(X + off)) + gt[bj][0] * acc[ai][bj][m][0], v1 = __builtin_nontemporal_load((const f32x4*)(X + off + 4)) + gt[bj][1] * acc[ai][bj][m][1];
                    acc[ai][bj][m][0] = v0; acc[ai][bj][m][1] = v1;
                    s += (v0[0] * v0[0] + v0[1] * v0[1]) + (v0[2] * v0[2] + v0[3] * v0[3]) + (v1[0] * v1[0] + v1[1] * v1[1]) + (v1[2] * v1[2] + v1[3] * v1[3]);
                }
                s += __shfl_xor(s, 16); s += __shfl_xor(s, 32);
                if (fq == 0) P[(ai * 128 + wr * 64 + m * 16 + fr) * 4 + wc] = s;
                if (m & 1) __builtin_amdgcn_sched_barrier(0);
            }
        asm volatile("s_waitcnt lgkmcnt(0)" ::: "memory"); __builtin_amdgcn_s_barrier(); asm volatile("" ::: "memory");
        const int row = wid * 32 + (lane & 31);
        if (lane < 32) {
            const float t = (P[row * 4 + 0] + P[row * 4 + 1]) + (P[row * 4 + 2] + P[row * 4 + 3]);
            __hip_atomic_store(PSS + (size_t)(u.pm * 256 + row) * 4 + u.pn, t, __ATOMIC_RELAXED, __HIP_MEMORY_SCOPE_AGENT);
        }
        asm volatile("s_waitcnt vmcnt(0)" ::: "memory");
        if (lane == 0) __hip_atomic_fetch_add(PCNT + 64 * u.pm, 1u, __ATOMIC_RELAXED, __HIP_MEMORY_SCOPE_AGENT);
        if (wid == 0) {
            unsigned sp = 0;
            while ((unsigned)__builtin_amdgcn_readfirstlane(__hip_atomic_load(PCNT + 64 * u.pm, __ATOMIC_RELAXED, __HIP_MEMORY_SCOPE_AGENT)) < 32u) { __builtin_amdgcn_s_sleep(2); if (++sp > (1u << 22)) break; }
            __builtin_amdgcn_fence(__ATOMIC_ACQUIRE, "agent");
        }
        asm volatile("s_waitcnt vmcnt(0) lgkmcnt(0)" ::: "memory"); __builtin_amdgcn_s_barrier(); asm volatile("" ::: "memory");
        if (lane < 32) {
            const float* ps = PSS + (size_t)(u.pm * 256 + row) * 4; float t = 0.f;
#pragma unroll
            for (int k = 0; k < 4; ++k) t += __hip_atomic_load(ps + k, __ATOMIC_RELAXED, __HIP_MEMORY_SCOPE_AGENT);
            S[row] = rsqrtf(t * (1.f / D) + NORM_EPS);
        }
        asm volatile("s_waitcnt vmcnt(0) lgkmcnt(0)" ::: "memory"); __builtin_amdgcn_s_barrier(); asm volatile("" ::: "memory");
        f32x4 fw[2][2];
#pragma unroll
        for (int bj = 0; bj < 2; ++bj) { fw[bj][0] = *(const f32x4*)(FW + c0 + bj * 128); fw[bj][1] = *(const f32x4*)(FW + c0 + bj * 128 + 4); }
#pragma unroll
        for (int ai = 0; ai < 2; ++ai)
#pragma unroll
            for (int m = 0; m < 4; ++m) {
                const float rs = S[ai * 128 + wr * 64 + m * 16 + fr];
#pragma unroll
                for (int bj = 0; bj < 2; ++bj) {
                    const size_t off = (size_t)(row0 + ai * 128 + m * 16) * D + bj * 128 + c0;
                    __builtin_nontemporal_store(acc[ai][bj][m][0] * rs * fw[bj][0], (f32x4*)(OUT + off)); __builtin_nontemporal_store(acc[ai][bj][m][1] * rs * fw[bj][1], (f32x4*)(OUT + off + 4));
                }
            }
    }
};

struct TwoGemmOrder {
    pg8::StaticOrder so;
    DI bool next(int i, pg8::Unit& u) const { if (i >= 2) return false; if (!so.next(0, u)) return false; if (i == 1) { u.pm += 256; u.pn += 4; } return true; }
    DI void a_ready(const pg8::Unit&) const {}
    DI void done(const pg8::Unit&) const {}
};
struct EpiYaYb {
    static constexpr bool PERM = true, AFTER_DRAIN = false;
    bf16_t* MA; const bf16_t* SGB;
    DI void operator()(const f32x4 (&acc)[2][2][4][2], const pg8::Unit& u, int wr, int wc, int fr, int fq) const {
        if (u.pn < 4) { EpiYa e{MA}; e(acc, u, wr, wc, fr, fq); }
        else { EpiYb e{MA, SGB}; pg8::Unit v; v.pm = u.pm - 256; v.pn = u.pn - 4; e(acc, v, wr, wc, fr, fq); }
    }
};

DI void p0_transpose_item(const float* W, int N, bf16_t* WT, int rg, int kg, int lane, bool is_win) {
    const int d = rg * 64 + lane; const int s = is_win ? win_src_col(d) : d; const int k0 = kg * 64;
    bf16_t* o = WT + (size_t)d * D + k0;
    if (s < 0) {
#pragma unroll
        for (int kk = 0; kk < 8; ++kk) *(u32x4*)(o + 8 * kk) = (u32x4){0u, 0u, 0u, 0u};
        return;
    }
    const float* w = W + (size_t)k0 * N + s;
    float v[64];
#pragma unroll
    for (int j = 0; j < 64; ++j) v[j] = __builtin_nontemporal_load(w + (size_t)j * N);
#pragma unroll
    for (int kk = 0; kk < 8; ++kk) {
        u32x4 p; p.x = cvt_pk_bf16(v[8 * kk], v[8 * kk + 1]); p.y = cvt_pk_bf16(v[8 * kk + 2], v[8 * kk + 3]); p.z = cvt_pk_bf16(v[8 * kk + 4], v[8 * kk + 5]); p.w = cvt_pk_bf16(v[8 * kk + 6], v[8 * kk + 7]);
        *(u32x4*)(o + 8 * kk) = p;
    }
}
DI void phase0(const Params& p, int gw, int NGW, int lane) {
    unsigned char* ws = p.ws;
    constexpr int I_WIN = (NPAD / 64) * 16, I_SQ = 16 * 16, I_MOD = 48 * 8, NITEMS = I_WIN + 3 * I_SQ + I_MOD;
    for (int it = gw; it < NITEMS; it += NGW) {
        int r = it;
        if (r < I_WIN) { p0_transpose_item(p.in[5], NIN, (bf16_t*)(ws + WS_WIN), r >> 4, r & 15, lane, true); continue; } r -= I_WIN;
        if (r < I_SQ) { p0_transpose_item(p.in[11], D, (bf16_t*)(ws + WS_WPA), r >> 4, r & 15, lane, false); continue; } r -= I_SQ;
        if (r < I_SQ) { p0_transpose_item(p.in[12], D, (bf16_t*)(ws + WS_WPB), r >> 4, r & 15, lane, false); continue; } r -= I_SQ;
        if (r < I_SQ) { p0_transpose_item(p.in[13], D, (bf16_t*)(ws + WS_WO), r >> 4, r & 15, lane, false); continue; } r -= I_SQ;
        const int cgp = r >> 3, ks = r & 7; const float* c = p.in[1]; const float* wa = p.in[2] + (size_t)(ks * 128) * 3072 + cgp * 64 + lane;
        float a0 = 0.f, a1 = 0.f;
#pragma unroll
        for (int k0 = 0; k0 < 128; k0 += 32) {
            float wv[32];
#pragma unroll
            for (int k = 0; k < 32; ++k) wv[k] = __builtin_nontemporal_load(wa + (size_t)(k0 + k) * 3072);
#pragma unroll
            for (int k = 0; k < 32; ++k) { a0 += siluf_(c[ks * 128 + k0 + k]) * wv[k]; a1 += siluf_(c[D + ks * 128 + k0 + k]) * wv[k]; }
        }
        float* mp = (float*)(ws + WS_MODP) + (size_t)ks * 2 * 3072 + cgp * 64 + lane;
        mp[0] = a0; mp[3072] = a1;
    }
}
DI void phase1(const Params& p, float* ldsf, int gw, int NGW, int lane, int tid, int row_base) {
    const float* modp = (const float*)(p.ws + WS_MODP); const float* b_ada = p.in[3]; const float* nw = p.in[4];
    float* s_tab = ldsf;
    float* a_tab = ldsf + 2048;
    for (int idx = tid; idx < 2 * 2048; idx += NTHREADS) {
        const int b = idx >> 11, j = idx & 2047; float s = b_ada[j];
#pragma unroll
        for (int q = 0; q < 8; ++q) s += modp[(size_t)q * 2 * 3072 + b * 3072 + j];
        if (j < 1024) s_tab[b * 1024 + j] = s; else a_tab[b * 1024 + j - 1024] = nw[j - 1024] * (1.f + s);
    }
    if (blockIdx.x == 0) {
        float* modf = (float*)(p.ws + WS_MODF);
        for (int idx = tid; idx < 2 * 1024; idx += NTHREADS) {
            const int b = idx >> 10, j = idx & 1023; float s = b_ada[2048 + j];
#pragma unroll
            for (int q = 0; q < 8; ++q) s += modp[(size_t)q * 2 * 3072 + b * 3072 + 2048 + j];
            modf[b * 1024 + j] = s;
        }
    }
    __syncthreads();
    bf16_t* H = (bf16_t*)(p.ws + 0 * UNIT);
    const bool pmode = row_base >= 0; const int pw = (tid >> 6) * 8;
    for (int m0 = pmode ? row_base + pw : gw; pmode ? (m0 < row_base + pw + 8) : (m0 < M); m0 += pmode ? 2 : 2 * NGW) {
        const int m1 = pmode ? m0 + 1 : (m0 + NGW < M ? m0 + NGW : m0);
        f32x4 v[2][4]; float s[2] = {0.f, 0.f};
#pragma unroll
        for (int u = 0; u < 2; ++u) { const f32x4* xr = (const f32x4*)(p.in[0] + (size_t)(u ? m1 : m0) * D) + lane;
#pragma unroll
            for (int j = 0; j < 4; ++j) v[u][j] = __builtin_nontemporal_load(xr + 64 * j); }
#pragma unroll
        for (int u = 0; u < 2; ++u) {
#pragma unroll
            for (int j = 0; j < 4; ++j) s[u] += (v[u][j].x * v[u][j].x + v[u][j].y * v[u][j].y) + (v[u][j].z * v[u][j].z + v[u][j].w * v[u][j].w);
            const int m = u ? m1 : m0; const int b = m / SEQ;
            const float rstd = rsqrtf(wave_sum(s[u]) * (1.f / D) + NORM_EPS);
            u32x2* o = (u32x2*)(H + (size_t)m * D) + lane;
#pragma unroll
            for (int j = 0; j < 4; ++j) {
                const f32x4 a = *(const f32x4*)(a_tab + b * 1024 + 4 * lane + 256 * j), sh = *(const f32x4*)(s_tab + b * 1024 + 4 * lane + 256 * j);
                const f32x4 hh = v[u][j] * rstd * a + sh;
                u32x2 w; w.x = cvt_pk_bf16(hh.x, hh.y); w.y = cvt_pk_bf16(hh.z, hh.w);
                __hip_atomic_store((unsigned long long*)(o + 64 * j), ((unsigned long long)w.y << 32) | w.x, __ATOMIC_RELAXED, __HIP_MEMORY_SCOPE_AGENT);
            }
        }
    }
    __syncthreads();
}
DI void ab_item(const Params& p, int item, int lane) {
    unsigned char* ws = p.ws; const int il = lane & 15, q = lane >> 4;
    const bf16_t* Hr = (const bf16_t*)(ws + 0 * UNIT) + (size_t)(item * 16 + il) * D + 8 * q;
    const bf16_t* W0 = (const bf16_t*)(ws + WS_WIN) + (size_t)(10240 + il) * D + 8 * q; const bf16_t* W1 = W0 + (size_t)16 * D;
    f32x4 a0 = {0.f, 0.f, 0.f, 0.f}, a1 = {0.f, 0.f, 0.f, 0.f};
#pragma unroll 8
    for (int ks = 0; ks < 32; ++ks) { const bf16x8 hf = *(const bf16x8*)(Hr + 32 * ks);
        a0 = __builtin_amdgcn_mfma_f32_16x16x32_bf16(hf, *(const bf16x8*)(W0 + 32 * ks), a0, 0, 0, 0); a1 = __builtin_amdgcn_mfma_f32_16x16x32_bf16(hf, *(const bf16x8*)(W1 + 32 * ks), a1, 0, 0, 0); }
    float* AB = (float*)(ws + WS_AB) + (size_t)(item * 16 + 4 * q) * 32 + il;
#pragma unroll
    for (int r = 0; r < 4; ++r) { AB[r * 32] = a0[r]; AB[r * 32 + 16] = a1[r]; }
}
DI void phase3_item(const Params& p, int item, int lane) {
    unsigned char* ws = p.ws;
    const bf16_t* Qr = (const bf16_t*)(ws + 1 * UNIT); const bf16_t* Kr = (const bf16_t*)(ws + 2 * UNIT); const bf16_t* Vr = (const bf16_t*)(ws + 3 * UNIT);
    bf16_t* Qn = (bf16_t*)(ws + 4 * UNIT); bf16_t* Kn = (bf16_t*)(ws + 5 * UNIT); bf16_t* Vc = (bf16_t*)p.out;
    const int tg = item & 255, h = (item >> 8) & 7, b = item >> 11; const int t_base = tg * 32; const size_t rb = (size_t)b * SEQ;
    const int col = h * 128 + 2 * lane; const int pcol = h * 128 + permpos(2 * lane);
    const float* cw = p.in[7];
    f32x2 wq[5], wk[5], wv[5];
#pragma unroll
    for (int j = 0; j < 5; ++j) { wq[j] = *(const f32x2*)(cw + j * 3072 + col); wk[j] = *(const f32x2*)(cw + j * 3072 + 1024 + col); wv[j] = *(const f32x2*)(cw + j * 3072 + 2048 + col); }
#pragma unroll
    for (int hf = 0; hf < 2; ++hf) {
        unsigned rq[20], rk[20], rv[20];
#pragma unroll
        for (int j = 0; j < 20; ++j) {
            const int t = t_base + 16 * hf - 2 + j; const bool ok = (t >= 0) && (t < SEQ); const int tc = t < 0 ? 0 : (t >= SEQ ? SEQ - 1 : t);
            const size_t off = (rb + tc) * D + col;
            const unsigned a0 = *(const unsigned*)(Qr + off), a1 = *(const unsigned*)(Kr + off), a2 = *(const unsigned*)(Vr + off);
            rq[j] = ok ? a0 : 0u; rk[j] = ok ? a1 : 0u; rv[j] = ok ? a2 : 0u;
        }
#pragma unroll
        for (int t16 = 0; t16 < 16; ++t16) {
            const int tt = 16 * hf + t16, t = t_base + tt;
            float q0 = 0.f, q1 = 0.f, k0 = 0.f, k1 = 0.f, v0 = 0.f, v1 = 0.f;
#pragma unroll
            for (int j = 0; j < 5; ++j) { q0 += wq[j].x * bf_lo(rq[t16 + j]); q1 += wq[j].y * bf_hi(rq[t16 + j]); k0 += wk[j].x * bf_lo(rk[t16 + j]); k1 += wk[j].y * bf_hi(rk[t16 + j]); v0 += wv[j].x * bf_lo(rv[t16 + j]); v1 += wv[j].y * bf_hi(rv[t16 + j]); }
            q0 = siluf_(q0); q1 = siluf_(q1); k0 = siluf_(k0); k1 = siluf_(k1); v0 = siluf_(v0); v1 = siluf_(v1);
            const float rq_ = rsqrtf(wave_sum(q0 * q0 + q1 * q1) + L2_EPS) * 0.08838834764831845f, rk_ = rsqrtf(wave_sum(k0 * k0 + k1 * k1) + L2_EPS);
            q0 *= rq_; q1 *= rq_; k0 *= rk_; k1 *= rk_;
            const size_t ro = (rb + t) * D;
            *(unsigned*)(Qn + ro + pcol) = cvt_pk_bf16(q0, q1); *(unsigned*)(Kn + ro + pcol) = cvt_pk_bf16(k0, k1); *(unsigned*)(Vc + ro + col) = cvt_pk_bf16(v0, v1);
        }
    }
    { const int i = lane & 31, dir = lane >> 5; const size_t row = rb + t_base + i; const float* AB = (const float*)(ws + WS_AB);
      const float a_raw = AB[row * 32 + dir * 8 + h], b_raw = AB[row * 32 + 16 + dir * 8 + h];
      const float g = -__expf(p.in[8][dir * 8 + h]) * softplusf_(a_raw + p.in[9][dir * 8 + h]);
      ((float*)(ws + WS_G))[row * 16 + dir * 8 + h] = g; ((float*)(ws + WS_BETA))[row * 16 + dir * 8 + h] = sigmoidf_(b_raw); }
}
DI void naive_scan(const Params& p, float* ldsw, int task, int lane) {
    unsigned char* ws = p.ws;
    const bf16_t* Qn = (const bf16_t*)(ws + 4 * UNIT); const bf16_t* Kn = (const bf16_t*)(ws + 5 * UNIT); const bf16_t* Vc = (const bf16_t*)p.out;
    const float* G = (const float*)(ws + WS_G); const float* BE = (const float*)(ws + WS_BETA);
    const int chain = task >> 1, b = chain >> 4, dir = (chain >> 3) & 1, h = chain & 7, e = (task & 1) * 64 + lane;
    bf16_t* O = (dir ? (bf16_t*)(p.out) + (size_t)M * D : (bf16_t*)(ws + 3 * UNIT));
    float* kb = ldsw; float* qb = ldsw + 128;
    float P[128];
#pragma unroll
    for (int d = 0; d < 128; ++d) P[d] = 0.f;
    for (int n = 0; n < SEQ; ++n) {
        const int t = dir ? SEQ - 1 - n : n; const size_t row = (size_t)b * SEQ + t;
        const unsigned ku = *(const unsigned*)(Kn + row * D + h * 128 + 2 * lane), qu = *(const unsigned*)(Qn + row * D + h * 128 + 2 * lane);
        const float v = bf1(Vc[row * D + h * 128 + e]); const float al = __expf(G[row * 16 + dir * 8 + h]), be = BE[row * 16 + dir * 8 + h];
        kb[2 * lane] = bf_lo(ku); kb[2 * lane + 1] = bf_hi(ku); qb[2 * lane] = bf_lo(qu); qb[2 * lane + 1] = bf_hi(qu);
        asm volatile("s_waitcnt lgkmcnt(0)" ::: "memory");
        float sk = 0.f;
#pragma unroll
        for (int d4 = 0; d4 < 32; ++d4) { if ((d4 & 3) == 0) __builtin_amdgcn_sched_barrier(0); const f32x4 k4 = *(const f32x4*)(kb + 4 * d4); sk += P[4 * d4] * k4.x + P[4 * d4 + 1] * k4.y + P[4 * d4 + 2] * k4.z + P[4 * d4 + 3] * k4.w; }
        const float vn = be * (v - al * sk); float o = 0.f;
#pragma unroll
        for (int d4 = 0; d4 < 32; ++d4) { if ((d4 & 3) == 0) __builtin_amdgcn_sched_barrier(0); const f32x4 k4 = *(const f32x4*)(kb + 4 * d4), q4 = *(const f32x4*)(qb + 4 * d4);
            P[4 * d4] = al * P[4 * d4] + k4.x * vn; P[4 * d4 + 1] = al * P[4 * d4 + 1] + k4.y * vn; P[4 * d4 + 2] = al * P[4 * d4 + 2] + k4.z * vn; P[4 * d4 + 3] = al * P[4 * d4 + 3] + k4.w * vn;
            o += P[4 * d4] * q4.x + P[4 * d4 + 1] * q4.y + P[4 * d4 + 2] * q4.z + P[4 * d4 + 3] * q4.w; }
        O[row * D + h * 128 + e] = (bf16_t)(cvt_pk_bf16(o, 0.f) & 0xffffu);
        asm volatile("s_waitcnt lgkmcnt(0)" ::: "memory");
    }
}
DI void ya_acc(float (&acc)[8], const u32x4& pv, const f32x4& wa, const f32x4& wb) {
    acc[0] += wa.x * bf_lo(pv.x); acc[1] += wa.y * bf_hi(pv.x); acc[2] += wa.z * bf_lo(pv.y); acc[3] += wa.w * bf_hi(pv.y);
    acc[4] += wb.x * bf_lo(pv.z); acc[5] += wb.y * bf_hi(pv.z); acc[6] += wb.z * bf_lo(pv.w); acc[7] += wb.w * bf_hi(pv.w);
}
DI void phase7(const Params& p, int gw, int NGW, int lane, int gtid, int NGT) {
    unsigned char* ws = p.ws;
    const bf16_t* Pb = (const bf16_t*)(ws + 1 * UNIT); bf16_t* R = (bf16_t*)(ws + 2 * UNIT); const float* cw = p.in[6];
    for (int it = gtid; it < (M / 4) * 128; it += NGT) {
        const int row0 = (it >> 7) * 4, c8 = (it & 127) * 8, t0 = row0 & (SEQ - 1);
        const u32x4 z = (u32x4){0u, 0u, 0u, 0u};
        u32x4 pv[6], rv[4];
        { const u32x4 t_ = *(const u32x4*)(Pb + (size_t)(t0 > 0 ? row0 - 1 : row0) * D + c8); pv[0] = t0 > 0 ? t_ : z; }
#pragma unroll
        for (int j = 0; j < 4; ++j) { pv[j + 1] = *(const u32x4*)(Pb + (size_t)(row0 + j) * D + c8); rv[j] = *(const u32x4*)(R + (size_t)(row0 + j) * D + c8); }
        { const u32x4 t_ = *(const u32x4*)(Pb + (size_t)(t0 + 4 < SEQ ? row0 + 4 : row0) * D + c8); pv[5] = t0 + 4 < SEQ ? t_ : z; }
        f32x4 wa[3], wb[3];
#pragma unroll
        for (int j = 0; j < 3; ++j) { wa[j] = *(const f32x4*)(cw + j * D + c8); wb[j] = *(const f32x4*)(cw + j * D + c8 + 4); }
#pragma unroll
        for (int j = 0; j < 4; ++j) {
            float acc[8] = {0.f, 0.f, 0.f, 0.f, 0.f, 0.f, 0.f, 0.f};
            ya_acc(acc, pv[j], wa[0], wb[0]); ya_acc(acc, pv[j + 1], wa[1], wb[1]); ya_acc(acc, pv[j + 2], wa[2], wb[2]);
            u32x4 o; const u32x4 r = rv[j];
            o.x = cvt_pk_bf16(bf_lo(r.x) * acc[0], bf_hi(r.x) * acc[1]); o.y = cvt_pk_bf16(bf_lo(r.y) * acc[2], bf_hi(r.y) * acc[3]);
            o.z = cvt_pk_bf16(bf_lo(r.z) * acc[4], bf_hi(r.z) * acc[5]); o.w = cvt_pk_bf16(bf_lo(r.w) * acc[6], bf_hi(r.w) * acc[7]);
            *(u32x4*)(R + (size_t)(row0 + j) * D + c8) = o;
        }
    }
    const bf16_t* Of = (const bf16_t*)(ws + 3 * UNIT); const bf16_t* Ob = (const bf16_t*)p.out + (size_t)M * D; bf16_t* SZ = (bf16_t*)(ws + 6 * UNIT);
    const f32x4 g0 = *(const f32x4*)(p.in[10] + (lane & 15) * 8), g1 = *(const f32x4*)(p.in[10] + (lane & 15) * 8 + 4);
    for (int rp = gw; rp < M / 2; rp += NGW) {
        u32x4 a[4], bb[4], zz[4];
#pragma unroll
        for (int u = 0; u < 4; ++u) { const size_t off = (size_t)(rp * 2 + (u >> 1)) * D + (u & 1) * 512 + lane * 8;
            a[u] = __builtin_nontemporal_load((const u32x4*)(Of + off)); bb[u] = __builtin_nontemporal_load((const u32x4*)(Ob + off)); zz[u] = __builtin_nontemporal_load((const u32x4*)(SZ + off)); }
#pragma unroll
        for (int u = 0; u < 4; ++u) { const size_t off = (size_t)(rp * 2 + (u >> 1)) * D + (u & 1) * 512 + lane * 8;
            float o[8];
            o[0] = bf_lo(a[u].x) + bf_lo(bb[u].x); o[1] = bf_hi(a[u].x) + bf_hi(bb[u].x); o[2] = bf_lo(a[u].y) + bf_lo(bb[u].y); o[3] = bf_hi(a[u].y) + bf_hi(bb[u].y);
            o[4] = bf_lo(a[u].z) + bf_lo(bb[u].z); o[5] = bf_hi(a[u].z) + bf_hi(bb[u].z); o[6] = bf_lo(a[u].w) + bf_lo(bb[u].w); o[7] = bf_hi(a[u].w) + bf_hi(bb[u].w);
            float ss = 0.f;
#pragma unroll
            for (int j = 0; j < 8; ++j) ss += o[j] * o[j];
            ss = row16_sum(ss);
            const float rs = rsqrtf(ss * (1.f / 128.f) + NORM_EPS);
            u32x4 w;
            w.x = cvt_pk_bf16(o[0] * rs * g0.x * bf_lo(zz[u].x), o[1] * rs * g0.y * bf_hi(zz[u].x)); w.y = cvt_pk_bf16(o[2] * rs * g0.z * bf_lo(zz[u].y), o[3] * rs * g0.w * bf_hi(zz[u].y));
            w.z = cvt_pk_bf16(o[4] * rs * g1.x * bf_lo(zz[u].z), o[5] * rs * g1.y * bf_hi(zz[u].z)); w.w = cvt_pk_bf16(o[6] * rs * g1.z * bf_lo(zz[u].w), o[7] * rs * g1.w * bf_hi(zz[u].w));
            *(u32x4*)(SZ + off) = w;
        }
    }
}
DI void phase7_panel(const Params& p, int pm, int pn, int tid, int lane, int wave) {
    unsigned char* ws = p.ws;
    const bf16_t* Pb = (const bf16_t*)(ws + 1 * UNIT); bf16_t* R = (bf16_t*)(ws + 2 * UNIT); const float* cw = p.in[6];
#pragma unroll 1
    for (int i = 0; i < 4; ++i) {
        const int it = tid + NTHREADS * i; const int row0 = 256 * pm + 4 * (it >> 5), c8 = 256 * pn + 8 * (it & 31), t0 = row0 & (SEQ - 1);
        const u32x4 z = (u32x4){0u, 0u, 0u, 0u};
        u32x4 pv[6], rv[4];
        { const u32x4 t_ = *(const u32x4*)(Pb + (size_t)(t0 > 0 ? row0 - 1 : row0) * D + c8); pv[0] = t0 > 0 ? t_ : z; }
#pragma unroll
        for (int j = 0; j < 4; ++j) { pv[j + 1] = *(const u32x4*)(Pb + (size_t)(row0 + j) * D + c8); rv[j] = *(const u32x4*)(R + (size_t)(row0 + j) * D + c8); }
        { const u32x4 t_ = *(const u32x4*)(Pb + (size_t)(t0 + 4 < SEQ ? row0 + 4 : row0) * D + c8); pv[5] = t0 + 4 < SEQ ? t_ : z; }
        f32x4 wa[3], wb[3];
#pragma unroll
        for (int j = 0; j < 3; ++j) { wa[j] = *(const f32x4*)(cw + j * D + c8); wb[j] = *(const f32x4*)(cw + j * D + c8 + 4); }
#pragma unroll
        for (int j = 0; j < 4; ++j) {
            float acc[8] = {0.f, 0.f, 0.f, 0.f, 0.f, 0.f, 0.f, 0.f};
            ya_acc(acc, pv[j], wa[0], wb[0]); ya_acc(acc, pv[j + 1], wa[1], wb[1]); ya_acc(acc, pv[j + 2], wa[2], wb[2]);
            u32x4 o; const u32x4 r = rv[j];
            o.x = cvt_pk_bf16(bf_lo(r.x) * acc[0], bf_hi(r.x) * acc[1]); o.y = cvt_pk_bf16(bf_lo(r.y) * acc[2], bf_hi(r.y) * acc[3]);
            o.z = cvt_pk_bf16(bf_lo(r.z) * acc[4], bf_hi(r.z) * acc[5]); o.w = cvt_pk_bf16(bf_lo(r.w) * acc[6], bf_hi(r.w) * acc[7]);
            *(u32x4*)(R + (size_t)(row0 + j) * D + c8) = o;
        }
    }
    const bf16_t* Of = (const bf16_t*)(ws + 3 * UNIT); const bf16_t* Ob = (const bf16_t*)p.out + (size_t)M * D; bf16_t* SZ = (bf16_t*)(ws + 6 * UNIT);
    const f32x4 g0 = *(const f32x4*)(p.in[10] + (lane & 15) * 8), g1 = *(const f32x4*)(p.in[10] + (lane & 15) * 8 + 4);
#pragma unroll 1
    for (int i = 0; i < 4; ++i) {
        u32x4 a[4], bb[4], zz[4];
#pragma unroll
        for (int u = 0; u < 4; ++u) { const size_t off = (size_t)(256 * pm + 32 * wave + 8 * i + 2 * u + (lane >> 5)) * D + 256 * pn + (lane & 31) * 8;
            a[u] = __builtin_nontemporal_load((const u32x4*)(Of + off)); bb[u] = __builtin_nontemporal_load((const u32x4*)(Ob + off)); zz[u] = __builtin_nontemporal_load((const u32x4*)(SZ + off)); }
#pragma unroll
        for (int u = 0; u < 4; ++u) { const size_t off = (size_t)(256 * pm + 32 * wave + 8 * i + 2 * u + (lane >> 5)) * D + 256 * pn + (lane & 31) * 8;
            float o[8];
            o[0] = bf_lo(a[u].x) + bf_lo(bb[u].x); o[1] = bf_hi(a[u].x) + bf_hi(bb[u].x); o[2] = bf_lo(a[u].y) + bf_lo(bb[u].y); o[3] = bf_hi(a[u].y) + bf_hi(bb[u].y);
            o[4] = bf_lo(a[u].z) + bf_lo(bb[u].z); o[5] = bf_hi(a[u].z) + bf_hi(bb[u].z); o[6] = bf_lo(a[u].w) + bf_lo(bb[u].w); o[7] = bf_hi(a[u].w) + bf_hi(bb[u].w);
            float ss = 0.f;
#pragma unroll
            for (int j = 0; j < 8; ++j) ss += o[j] * o[j];
            ss = row16_sum(ss);
            const float rs = rsqrtf(ss * (1.f / 128.f) + NORM_EPS);
            u32x4 w;
            w.x = cvt_pk_bf16(o[0] * rs * g0.x * bf_lo(zz[u].x), o[1] * rs * g0.y * bf_hi(zz[u].x)); w.y = cvt_pk_bf16(o[2] * rs * g0.z * bf_lo(zz[u].y), o[3] * rs * g0.w * bf_hi(zz[u].y));
            w.z = cvt_pk_bf16(o[4] * rs * g1.x * bf_lo(zz[u].z), o[5] * rs * g1.y * bf_hi(zz[u].z)); w.w = cvt_pk_bf16(o[6] * rs * g1.z * bf_lo(zz[u].w), o[7] * rs * g1.w * bf_hi(zz[u].w));
            *(u32x4*)(SZ + off) = w;
        }
    }
}
DI void phase10(const Params& p, int gw, int NGW, int lane) {
    const float* XN = (const float*)(p.ws + 0 * UNIT); const float* fw = p.in[14];
    f32x4 w[4];
#pragma unroll
    for (int j = 0; j < 4; ++j) w[j] = *((const f32x4*)fw + lane + 64 * j);
    for (int m = gw; m < M; m += NGW) {
        const f32x4* xr = (const f32x4*)(XN + (size_t)m * D) + lane; f32x4 v[4]; float s = 0.f;
#pragma unroll
        for (int j = 0; j < 4; ++j) { v[j] = xr[64 * j]; s += (v[j].x * v[j].x + v[j].y * v[j].y) + (v[j].z * v[j].z + v[j].w * v[j].w); }
        const float rstd = rsqrtf(wave_sum(s) * (1.f / D) + NORM_EPS);
        f32x4* o = (f32x4*)(p.out + (size_t)m * D) + lane;
#pragma unroll
        for (int j = 0; j < 4; ++j) o[64 * j] = v[j] * rstd * w[j];
    }
}
#define MFMA16(a, b, c) __builtin_amdgcn_mfma_f32_16x16x32_bf16((a), (b), (c), 0, 0, 0)
DI void chunk_prep_item(const Params& p, float* Lm, int item, int lane) {
    unsigned char* ws = p.ws;
    const bf16_t* Qn = (const bf16_t*)(ws + 4 * UNIT); const bf16_t* Kn = (const bf16_t*)(ws + 5 * UNIT);
    bf16_t* TF = (bf16_t*)(ws + 1 * UNIT) + (size_t)item * 4096; bf16_t* AF = (bf16_t*)(ws + 2 * UNIT) + (size_t)item * 4096;
    float* csc = (float*)(ws + WS_CSC) + (size_t)item * 192;
    const int c = item & 127, h = (item >> 7) & 7, dir = (item >> 10) & 1, b = item >> 11;
    const size_t rb = (size_t)b * SEQ + c * 64; const int il = lane & 15, q = lane >> 4;
    const int tl = dir ? 63 - lane : lane;
    const float g = ((const float*)(ws + WS_G))[(rb + tl) * 16 + dir * 8 + h], be = ((const float*)(ws + WS_BETA))[(rb + tl) * 16 + dir * 8 + h];
    float gc = g;
#pragma unroll
    for (int o = 1; o < 64; o <<= 1) { const float v = __shfl_up(gc, o); if (lane >= o) gc += v; }
    const float gl = __shfl(gc, 63);
    csc[tl] = __expf(gc); csc[64 + tl] = be; csc[128 + tl] = __expf(gl - gc);
    float gcr[4][4], ber[4][4], gcc[4];
#pragma unroll
    for (int t = 0; t < 4; ++t) { gcc[t] = __shfl(gc, 16 * t + il);
#pragma unroll
        for (int r = 0; r < 4; ++r) { gcr[t][r] = __shfl(gc, 16 * t + 4 * q + r); ber[t][r] = __shfl(be, 16 * t + 4 * q + r); } }
    bf16x8 Kf[4][4];
#pragma unroll
    for (int rt = 0; rt < 4; ++rt) { const int ip = 16 * rt + il; const size_t ro = (rb + (dir ? 63 - ip : ip)) * D + h * 128 + 8 * q;
#pragma unroll
        for (int ks = 0; ks < 4; ++ks) Kf[rt][ks] = *(const bf16x8*)(Kn + ro + 32 * ks); }
#pragma unroll
    for (int it = 0; it < 4; ++it)
#pragma unroll
        for (int jt = 0; jt <= it; ++jt) {
            f32x4 acc = {0.f, 0.f, 0.f, 0.f};
#pragma unroll
            for (int ks = 0; ks < 4; ++ks) acc = MFMA16(Kf[it][ks], Kf[jt][ks], acc);
#pragma unroll
            for (int r = 0; r < 4; ++r) { const int ip = 16 * it + 4 * q + r, jp = 16 * jt + il;
                Lm[ip * 64 + jp] = ip > jp ? ber[it][r] * acc[r] * __expf(gcr[it][r] - gcc[jt]) : 0.f; }
        }
    __builtin_amdgcn_sched_barrier(0);
    bf16x8 Qnext[4];
    { const int ip = il; const size_t ro = (rb + (dir ? 63 - ip : ip)) * D + h * 128 + 8 * q;
#pragma unroll
      for (int ks = 0; ks < 4; ++ks) Qnext[ks] = *(const bf16x8*)(Qn + ro + 32 * ks); }
#pragma unroll
    for (int mt = 0; mt < 4; ++mt) {
        bf16x8 Qf[4];
#pragma unroll
        for (int ks = 0; ks < 4; ++ks) Qf[ks] = Qnext[ks];
        if (mt < 3) { const int ip = 16 * (mt + 1) + il; const size_t ro = (rb + (dir ? 63 - ip : ip)) * D + h * 128 + 8 * q;
#pragma unroll
          for (int ks = 0; ks < 4; ++ks) Qnext[ks] = *(const bf16x8*)(Qn + ro + 32 * ks); }
#pragma unroll
        for (int ks2 = 0; ks2 < 2; ++ks2) {
            float vals[8];
#pragma unroll
            for (int a = 0; a < 2; ++a) { const int jt = 2 * ks2 + a; f32x4 acc = {0.f, 0.f, 0.f, 0.f};
#pragma unroll
                for (int ks = 0; ks < 4; ++ks) acc = MFMA16(Kf[jt][ks], Qf[ks], acc);
#pragma unroll
                for (int r = 0; r < 4; ++r) { const int jp = 16 * jt + 4 * q + r, ip = 16 * mt + il; vals[4 * a + r] = ip >= jp ? acc[r] * __expf(gcc[mt] - gcr[jt][r]) : 0.f; } }
            u32x4 w;
            if (dir) { w.x = cvt_pk_bf16(vals[7], vals[6]); w.y = cvt_pk_bf16(vals[5], vals[4]); w.z = cvt_pk_bf16(vals[3], vals[2]); w.w = cvt_pk_bf16(vals[1], vals[0]); }
            else { w.x = cvt_pk_bf16(vals[0], vals[1]); w.y = cvt_pk_bf16(vals[2], vals[3]); w.z = cvt_pk_bf16(vals[4], vals[5]); w.w = cvt_pk_bf16(vals[6], vals[7]); }
            const int fi = dir ? ((3 - mt) * 2 + (1 - ks2)) : (mt * 2 + ks2), ln = dir ? ((3 - q) * 16 + (15 - il)) : lane;
            *(u32x4*)(AF + (size_t)(fi * 64 + ln) * 8) = w;
        }
        __builtin_amdgcn_sched_barrier(0);
    }
    asm volatile("s_waitcnt lgkmcnt(0)" ::: "memory");
    __builtin_amdgcn_sched_barrier(0);
    float T[64];
#pragma unroll
    for (int i = 0; i < 64; ++i) {
        float s0 = (lane == i) ? 1.f : 0.f, s1 = 0.f;
#pragma unroll
        for (int m4 = 0; m4 < (i + 3) / 4; ++m4) {
            const f32x4 l4 = *(const f32x4*)(Lm + i * 64 + 4 * m4);
            if (4 * m4 + 0 < i) s0 -= l4.x * T[4 * m4 + 0];
            if (4 * m4 + 1 < i) s1 -= l4.y * T[4 * m4 + 1];
            if (4 * m4 + 2 < i) s0 -= l4.z * T[4 * m4 + 2];
            if (4 * m4 + 3 < i) s1 -= l4.w * T[4 * m4 + 3];
        }
        T[i] = s0 + s1;
        if ((i & 3) == 3) __builtin_amdgcn_sched_barrier(0);
    }
    asm volatile("s_waitcnt lgkmcnt(0)" ::: "memory");
    bf16_t* TL = (bf16_t*)Lm;
#pragma unroll
    for (int i = 0; i < 64; ++i) TL[i * 72 + lane] = (bf16_t)(cvt_pk_bf16(T[i], 0.f) & 0xffffu);
    asm volatile("s_waitcnt lgkmcnt(0)" ::: "memory");
#pragma unroll
    for (int mt = 0; mt < 4; ++mt)
#pragma unroll
        for (int ks2 = 0; ks2 < 2; ++ks2) {
            u32x4 w;
            if (dir) {
                const int row = 63 - 16 * mt - il;
                const u32x2 lo = *(const u32x2*)(TL + row * 72 + (60 - 32 * ks2 - 4 * q)), hi = *(const u32x2*)(TL + row * 72 + (44 - 32 * ks2 - 4 * q));
                w.x = (lo.y >> 16) | (lo.y << 16); w.y = (lo.x >> 16) | (lo.x << 16); w.z = (hi.y >> 16) | (hi.y << 16); w.w = (hi.x >> 16) | (hi.x << 16);
            } else {
                const int row = 16 * mt + il;
                const u32x2 lo = *(const u32x2*)(TL + row * 72 + (32 * ks2 + 4 * q)), hi = *(const u32x2*)(TL + row * 72 + (32 * ks2 + 16 + 4 * q));
                w.x = lo.x; w.y = lo.y; w.z = hi.x; w.w = hi.y;
            }
            *(u32x4*)(TF + (size_t)((mt * 2 + ks2) * 64 + lane) * 8) = w;
        }
    asm volatile("s_waitcnt lgkmcnt(0)" ::: "memory");
}
DI bf16x8 pack8(const f32x4& a, const f32x4& b) {
    u32x4 w; w.x = cvt_pk_bf16(a[0], a[1]); w.y = cvt_pk_bf16(a[2], a[3]); w.z = cvt_pk_bf16(b[0], b[1]); w.w = cvt_pk_bf16(b[2], b[3]);
    return __builtin_bit_cast(bf16x8, w);
}
DI void mfma_scan(const Params& p, int chain, int slice, int lane) {
    unsigned char* ws = p.ws;
    const bf16_t* Qn = (const bf16_t*)(ws + 4 * UNIT); const bf16_t* Kn = (const bf16_t*)(ws + 5 * UNIT); const bf16_t* KT = (const bf16_t*)(ws + 6 * UNIT); const bf16_t* Vc = (const bf16_t*)p.out;
    const bf16_t* TFb = (const bf16_t*)(ws + 1 * UNIT); const bf16_t* AFb = (const bf16_t*)(ws + 2 * UNIT); const float* cscb = (const float*)(ws + WS_CSC);
    const int b = chain >> 4, dir = (chain >> 3) & 1, h = chain & 7, il = lane & 15, q = lane >> 4;
    bf16_t* O = (dir ? (bf16_t*)(p.out) + (size_t)M * D : (bf16_t*)(ws + 3 * UNIT));
    f32x4 S[8];
#pragma unroll
    for (int dt = 0; dt < 8; ++dt) S[dt] = (f32x4){0.f, 0.f, 0.f, 0.f};
    for (int n = 0; n < 128; ++n) {
        const int c = dir ? 127 - n : n; const int item = chain * 128 + c; const size_t rowbase = (size_t)b * SEQ + c * 64;
        const bf16_t* TF = TFb + (size_t)item * 4096 + lane * 8; const bf16_t* AF = AFb + (size_t)item * 4096 + lane * 8; const float* csc = cscb + (size_t)item * 192;
        const float gl = csc[dir ? 0 : 63];
        f32x4 EG[4], BE[4], EK[4], V[4];
#pragma unroll
        for (int mt = 0; mt < 4; ++mt) { EG[mt] = *(const f32x4*)(csc + 16 * mt + 4 * q); BE[mt] = *(const f32x4*)(csc + 64 + 16 * mt + 4 * q); EK[mt] = *(const f32x4*)(csc + 128 + 16 * mt + 4 * q);
#pragma unroll
            for (int r = 0; r < 4; ++r) V[mt][r] = bf1(Vc[(rowbase + 16 * mt + 4 * q + r) * D + h * 128 + 16 * slice + il]); }
        bf16x8 Sb[4];
#pragma unroll
        for (int ks = 0; ks < 4; ++ks) Sb[ks] = pack8(S[2 * ks], S[2 * ks + 1]);
        f32x4 KS[4], QS[4];
#pragma unroll
        for (int mt = 0; mt < 4; ++mt) { const size_t ro = (rowbase + 16 * mt + il) * D + h * 128 + 8 * q;
            KS[mt] = (f32x4){0.f, 0.f, 0.f, 0.f}; QS[mt] = (f32x4){0.f, 0.f, 0.f, 0.f};
#pragma unroll
            for (int ks = 0; ks < 4; ++ks) { KS[mt] = MFMA16(*(const bf16x8*)(Kn + ro + 32 * ks), Sb[ks], KS[mt]); QS[mt] = MFMA16(*(const bf16x8*)(Qn + ro + 32 * ks), Sb[ks], QS[mt]); } }
        f32x4 X[4];
#pragma unroll
        for (int mt = 0; mt < 4; ++mt) X[mt] = BE[mt] * (V[mt] - EG[mt] * KS[mt]);
        bf16x8 Xb[2] = {pack8(X[0], X[1]), pack8(X[2], X[3])};
        f32x4 VN[4];
#pragma unroll
        for (int mt = 0; mt < 4; ++mt) { VN[mt] = (f32x4){0.f, 0.f, 0.f, 0.f};
#pragma unroll
            for (int ks2 = 0; ks2 < 2; ++ks2) VN[mt] = MFMA16(*(const bf16x8*)(TF + (size_t)((mt * 2 + ks2) * 64) * 8), Xb[ks2], VN[mt]); }
        bf16x8 VNb[2] = {pack8(VN[0], VN[1]), pack8(VN[2], VN[3])};
        bf16x8 VNs[2] = {pack8(VN[0] * EK[0], VN[1] * EK[1]), pack8(VN[2] * EK[2], VN[3] * EK[3])};
#pragma unroll
        for (int mt = 0; mt < 4; ++mt) { f32x4 o = EG[mt] * QS[mt];
#pragma unroll
            for (int ks2 = 0; ks2 < 2; ++ks2) o = MFMA16(*(const bf16x8*)(AF + (size_t)((mt * 2 + ks2) * 64) * 8), VNb[ks2], o);
#pragma unroll
            for (int r = 0; r < 4; ++r) O[(rowbase + 16 * mt + 4 * q + r) * D + h * 128 + 16 * slice + il] = (bf16_t)(cvt_pk_bf16(o[r], 0.f) & 0xffffu); }
#pragma unroll
        for (int dt = 0; dt < 8; ++dt) { const bf16_t* kt = KT + ((size_t)((b * 8 + h) * 128 + 16 * dt + il)) * SEQ + c * 64 + 8 * q; f32x4 s = S[dt] * gl;
#pragma unroll
            for (int ks2 = 0; ks2 < 2; ++ks2) s = MFMA16(*(const bf16x8*)(kt + 32 * ks2), VNs[ks2], s);
            S[dt] = s; }
    }
}
constexpr int SC_K = 0, SC_Q = 16384, SC_T = 32768, SC_A = 40960, SC_V = 49152, SC_C = 51200, SC_BUF = 52224, SC_NPIECE = 3248, SC_NLD = 384, SC_PPL = 9;
constexpr int SC_SB = 2 * SC_BUF, SC_VB = SC_SB + 2 * 4096, SC_END = SC_VB + 2 * 2048;
static_assert(SC_END <= LDS_BYTES - 256, "scan LDS");
typedef short s16x4_t __attribute__((ext_vector_type(4)));
#define SC_BAR() do { asm volatile("s_waitcnt lgkmcnt(0)" ::: "memory"); __builtin_amdgcn_s_barrier(); asm volatile("" ::: "memory"); } while (0)
DI void scan_task(const Params& p, PG8_LAS unsigned char* lds, int chain, int slice, int tid, int wave, int lane) {
    unsigned char* ws = p.ws;
    const int b = chain >> 4, dir = (chain >> 3) & 1, h = chain & 7, il = lane & 15, q = lane >> 4;
    const int c0 = dir ? 127 : 0; const long sgn = dir ? -1 : 1;
    if (wave >= 2) {
        const int lt = tid - 128; const int wbase = 64 * (wave - 2);
        const unsigned char* gp[SC_PPL]; int gstride[SC_PPL];
        const size_t rowbase0 = (size_t)b * SEQ + c0 * 64; const size_t item0 = (size_t)chain * 128 + c0;
#pragma unroll
        for (int k = 0; k < SC_PPL; ++k) {
            int pid = lt + SC_NLD * k; if (pid >= SC_NPIECE) pid -= 64;
            const unsigned char* g = ws; int st = 0;
            if (pid < 2048) { const int pp = pid & 1023, row = pp >> 4, ch = (pp & 15) ^ (row & 15);
                g = ws + (pid < 1024 ? 5 : 4) * UNIT + ((rowbase0 + row) * D + h * 128) * 2 + ch * 16; st = 64 * D * 2; }
            else if (pid < 3072) { const int pp = pid & 511; const bool isT = pid < 2560;
                g = ws + (isT ? 1 : 2) * UNIT + item0 * 8192 + pp * 16; st = 8192; }
            else if (pid < 3200) { const int pp = pid - 3072, row = pp >> 1, hf = pp & 1;
                g = (const unsigned char*)p.out + ((rowbase0 + row) * D + h * 128 + slice * 16) * 2 + hf * 16; st = 64 * D * 2; }
            else { const int pp = pid - 3200; g = ws + WS_CSC + item0 * 768 + pp * 16; st = 768; }
            gp[k] = g; gstride[k] = st;
        }
#define SC_DMA(bo) do { _Pragma("unroll") for (int k = 0; k < SC_PPL; ++k) { if (wbase + SC_NLD * k < SC_NPIECE) \
            __builtin_amdgcn_global_load_lds((const unsigned*)gp[k], (PG8_LAS unsigned*)(lds + (bo) + (wbase + SC_NLD * k) * 16), 16, 0, 0); gp[k] += sgn * gstride[k]; } } while (0)
        SC_DMA(0u);
        asm volatile("s_waitcnt vmcnt(0)" ::: "memory");
        SC_BAR();
        for (int n = 0; n < 128; ++n) {
            if (n + 1 < 128) SC_DMA((unsigned)(((n + 1) & 1) * SC_BUF));
            asm volatile("s_waitcnt vmcnt(0)" ::: "memory");
            SC_BAR();
        }
#undef SC_DMA
    } else if (wave == 0) {
        f32x4 S[8];
#pragma unroll
        for (int dt = 0; dt < 8; ++dt) S[dt] = (f32x4){0.f, 0.f, 0.f, 0.f};
        bf16x8 Sb[4];
#pragma unroll
        for (int ks = 0; ks < 4; ++ks) { Sb[ks] = pack8(S[2 * ks], S[2 * ks + 1]); *(PG8_LAS bf16x8*)(lds + SC_SB + (ks * 64 + lane) * 16) = Sb[ks]; }
        SC_BAR();
        for (int n = 0; n < 128; ++n) {
            PG8_LAS unsigned char* L = lds + (n & 1) * SC_BUF;
            bf16x8 Kf[4][4];
#pragma unroll
            for (int mt = 0; mt < 4; ++mt)
#pragma unroll
                for (int ks = 0; ks < 4; ++ks) Kf[mt][ks] = *(PG8_LAS bf16x8*)(L + SC_K + (16 * mt + il) * 256 + (((4 * ks + q) ^ il) << 4));
            f32x4 EG[4], BE[4], V[4]; bf16x8 Tf[4][2];
#pragma unroll
            for (int mt = 0; mt < 4; ++mt) { EG[mt] = *(PG8_LAS f32x4*)(L + SC_C + (16 * mt + 4 * q) * 4); BE[mt] = *(PG8_LAS f32x4*)(L + SC_C + 256 + (16 * mt + 4 * q) * 4);
#pragma unroll
                for (int r = 0; r < 4; ++r) V[mt][r] = bf1(*(PG8_LAS bf16_t*)(L + SC_V + (16 * mt + 4 * q + r) * 32 + il * 2));
#pragma unroll
                for (int ks2 = 0; ks2 < 2; ++ks2) Tf[mt][ks2] = *(PG8_LAS bf16x8*)(L + SC_T + ((mt * 2 + ks2) * 64 + lane) * 16); }
            f32x4 KS[4];
#pragma unroll
            for (int mt = 0; mt < 4; ++mt) KS[mt] = (f32x4){0.f, 0.f, 0.f, 0.f};
#pragma unroll
            for (int ks = 0; ks < 4; ++ks)
#pragma unroll
                for (int mt = 0; mt < 4; ++mt) KS[mt] = MFMA16(Kf[mt][ks], Sb[ks], KS[mt]);
            __builtin_amdgcn_sched_barrier(0);
            bf16x8 KTf[8][2]; f32x4 EK[4];
            { const int rr = il >> 2, pc = il & 3;
              PG8_LAS unsigned char* kb = L + SC_K + (4 * q + rr) * 256;
#pragma unroll
              for (int dt = 0; dt < 8; ++dt) {
                const int cho = (((4 * (dt >> 1) + pc) ^ (4 * q + rr)) << 4) + 8 * (dt & 1);
#pragma unroll
                for (int ks2 = 0; ks2 < 2; ++ks2) {
                    const s16x4_t lo_ = __builtin_amdgcn_ds_read_tr16_b64_v4i16((PG8_LAS s16x4_t*)(kb + (32 * ks2) * 256 + cho));
                    const s16x4_t hi_ = __builtin_amdgcn_ds_read_tr16_b64_v4i16((PG8_LAS s16x4_t*)(kb + (32 * ks2 + 16) * 256 + cho));
                    KTf[dt][ks2] = __builtin_shufflevector(lo_, hi_, 0, 1, 2, 3, 4, 5, 6, 7);
                } } }
#pragma unroll
            for (int mt = 0; mt < 4; ++mt) EK[mt] = *(PG8_LAS f32x4*)(L + SC_C + 512 + (16 * mt + 4 * q) * 4);
            const float gl = *(PG8_LAS float*)(L + SC_C + (dir ? 0 : 63) * 4);
            f32x4 X[4];
#pragma unroll
            for (int mt = 0; mt < 4; ++mt) X[mt] = BE[mt] * (V[mt] - EG[mt] * KS[mt]);
            bf16x8 Xb[2] = {pack8(X[0], X[1]), pack8(X[2], X[3])};
            f32x4 VN[4];
#pragma unroll
            for (int mt = 0; mt < 4; ++mt) VN[mt] = (f32x4){0.f, 0.f, 0.f, 0.f};
#pragma unroll
            for (int ks2 = 0; ks2 < 2; ++ks2)
#pragma unroll
                for (int mt = 0; mt < 4; ++mt) VN[mt] = MFMA16(Tf[mt][ks2], Xb[ks2], VN[mt]);
            *(PG8_LAS bf16x8*)(lds + SC_VB + (n & 1) * 2048 + lane * 16) = pack8(VN[0], VN[1]); *(PG8_LAS bf16x8*)(lds + SC_VB + (n & 1) * 2048 + (64 + lane) * 16) = pack8(VN[2], VN[3]);
            bf16x8 VNs[2] = {pack8(VN[0] * EK[0], VN[1] * EK[1]), pack8(VN[2] * EK[2], VN[3] * EK[3])};
#pragma unroll
            for (int dt = 0; dt < 8; ++dt) S[dt] = S[dt] * gl;
#pragma unroll
            for (int ks2 = 0; ks2 < 2; ++ks2)
#pragma unroll
                for (int dt = 0; dt < 8; ++dt) S[dt] = MFMA16(KTf[dt][ks2], VNs[ks2], S[dt]);
#pragma unroll
            for (int ks = 0; ks < 4; ++ks) { Sb[ks] = pack8(S[2 * ks], S[2 * ks + 1]); *(PG8_LAS bf16x8*)(lds + SC_SB + ((n + 1) & 1) * 4096 + (ks * 64 + lane) * 16) = Sb[ks]; }
            SC_BAR();
        }
    } else {
        bf16_t* O = (dir ? (bf16_t*)(p.out) + (size_t)M * D : (bf16_t*)(ws + 3 * UNIT));
        f32x4 Oa[4]; bf16x8 Af[4][2];
#pragma unroll
        for (int mt = 0; mt < 4; ++mt) { Oa[mt] = (f32x4){0.f, 0.f, 0.f, 0.f}; Af[mt][0] = (bf16x8){0, 0, 0, 0, 0, 0, 0, 0}; Af[mt][1] = Af[mt][0]; }
        SC_BAR();
        for (int n = 0; n <= 128; ++n) {
            if (n > 0) {
                const int c = dir ? 128 - n : n - 1; const size_t rowbase = (size_t)b * SEQ + c * 64;
                PG8_LAS unsigned char* vb = lds + SC_VB + ((n - 1) & 1) * 2048;
                bf16x8 VNb[2] = {*(PG8_LAS bf16x8*)(vb + lane * 16), *(PG8_LAS bf16x8*)(vb + (64 + lane) * 16)};
#pragma unroll
                for (int ks2 = 0; ks2 < 2; ++ks2)
#pragma unroll
                    for (int mt = 0; mt < 4; ++mt) Oa[mt] = MFMA16(Af[mt][ks2], VNb[ks2], Oa[mt]);
#pragma unroll
                for (int mt = 0; mt < 4; ++mt)
#pragma unroll
                    for (int r = 0; r < 4; ++r) __builtin_nontemporal_store((bf16_t)(cvt_pk_bf16(Oa[mt][r], 0.f) & 0xffffu), O + (rowbase + 16 * mt + 4 * q + r) * D + h * 128 + 16 * slice + il);
            }
            if (n < 128) {
                PG8_LAS unsigned char* L = lds + (n & 1) * SC_BUF;
                bf16x8 Qf[4][4], Sb[4]; f32x4 EG[4];
#pragma unroll
                for (int ks = 0; ks < 4; ++ks) Sb[ks] = *(PG8_LAS bf16x8*)(lds + SC_SB + (n & 1) * 4096 + (ks * 64 + lane) * 16);
#pragma unroll
                for (int mt = 0; mt < 4; ++mt) {
#pragma unroll
                    for (int ks = 0; ks < 4; ++ks) Qf[mt][ks] = *(PG8_LAS bf16x8*)(L + SC_Q + (16 * mt + il) * 256 + (((4 * ks + q) ^ il) << 4));
                    EG[mt] = *(PG8_LAS f32x4*)(L + SC_C + (16 * mt + 4 * q) * 4);
#pragma unroll
                    for (int ks2 = 0; ks2 < 2; ++ks2) Af[mt][ks2] = *(PG8_LAS bf16x8*)(L + SC_A + ((mt * 2 + ks2) * 64 + lane) * 16); }
                f32x4 QS[4];
#pragma unroll
                for (int mt = 0; mt < 4; ++mt) QS[mt] = (f32x4){0.f, 0.f, 0.f, 0.f};
#pragma unroll
                for (int ks = 0; ks < 4; ++ks)
#pragma unroll
                    for (int mt = 0; mt < 4; ++mt) QS[mt] = MFMA16(Qf[mt][ks], Sb[ks], QS[mt]);
#pragma unroll
                for (int mt = 0; mt < 4; ++mt) Oa[mt] = EG[mt] * QS[mt];
                SC_BAR();
            }
        }
    }
}


typedef const __attribute__((address_space(4))) Params* kparams_t;
#if defined(__HIP_DEVICE_COMPILE__)
DI Params load_params() { kparams_t pp = (kparams_t)__builtin_amdgcn_kernarg_segment_ptr(); asm volatile("" : "+s"(pp)); return *pp; }
#else
DI Params load_params() { return Params{}; }
#endif
#define PP() load_params()
#define XB_TMO      128
#define XB_XCNT(j)  (256  + 64 * (j))
#define XB_XSUB(j)  (1280 + 64 * (j))
#define XB_XGEN(j)  (2304 + 64 * (j))
#define XB_TOP      3328
#define XB_TOPGEN   3392
#define XCD_BAR_WORDS 3456
#define XB_SPIN_CAP (1u << 18)
#define LAS __attribute__((address_space(3)))

__device__ __forceinline__ unsigned xb_ld(unsigned* p)              { return __hip_atomic_load(p, __ATOMIC_RELAXED, __HIP_MEMORY_SCOPE_AGENT); }
__device__ __forceinline__ unsigned xb_add(unsigned* p, unsigned v) { return __hip_atomic_fetch_add(p, v, __ATOMIC_RELAXED, __HIP_MEMORY_SCOPE_AGENT); }
__device__ __forceinline__ unsigned xb_xcc_id() { return (unsigned)__builtin_amdgcn_s_getreg((3 << 11) | 20) & 0xFu; }
#define XB_SPIN(cond, bar) do { unsigned _sp = 0; while (cond) { __builtin_amdgcn_s_sleep(1); \
    if ((++_sp & 255u) == 0u) { if (xb_ld(&(bar)[XB_TMO])) break; if (_sp > XB_SPIN_CAP) { atomicAdd(&(bar)[XB_TMO], 1u); break; } } } } while (0)

struct XcdBarrier {
    unsigned* bar; unsigned x;
    volatile LAS unsigned* st;
};

__device__ __forceinline__ XcdBarrier xcd_barrier_post(unsigned* bar, volatile LAS unsigned* st) {
    XcdBarrier b; b.bar = bar; b.x = xb_xcc_id(); b.st = st;
    if (threadIdx.x == 0) (void)xb_add(&bar[XB_XCNT(b.x)], 1u);
    return b;
}
__device__ __forceinline__ void xcd_barrier_complete(unsigned* bar, unsigned x, unsigned& nloc, unsigned& nx) {
    const unsigned G = gridDim.x * gridDim.y * gridDim.z;
    unsigned sum, cnt, mine, sp = 0u;
    for (;;) {
        sum = 0u; cnt = 0u; mine = 0u;
#pragma unroll
        for (unsigned j = 0; j < 16; ++j) { const unsigned c = xb_ld(&bar[XB_XCNT(j)]); sum += c; cnt += (c > 0u) ? 1u : 0u; mine = (j == x) ? c : mine; }
        if (sum == G) break;
        __builtin_amdgcn_s_sleep(1);
        if ((++sp & 255u) == 0u) { if (xb_ld(&bar[XB_TMO])) break; if (sp > XB_SPIN_CAP) { atomicAdd(&bar[XB_TMO], 1u); break; } }
    }
    nloc = mine > 0u ? mine : 1u; nx = cnt > 0u ? cnt : 1u;
}

__device__ __forceinline__ void xcd_barrier(const XcdBarrier& b) {
    asm volatile("s_waitcnt vmcnt(0)" ::: "memory");
    __syncthreads();
    if (threadIdx.x == 0) {
        unsigned* bar = b.bar;
        __builtin_amdgcn_s_waitcnt(0);
        unsigned nloc = b.st[0], nx = b.st[1];
        if (nloc == 0u) { xcd_barrier_complete(bar, b.x, nloc, nx); b.st[0] = nloc; b.st[1] = nx; }
        const unsigned old = xb_add(&bar[XB_XSUB(b.x)], 1u);
        const unsigned gen = old / nloc;
        if (old + 1u == (gen + 1u) * nloc) {
            __builtin_amdgcn_fence(__ATOMIC_RELEASE, "agent");
            asm volatile("s_waitcnt vmcnt(0)" ::: "memory");
            const unsigned og = xb_add(&bar[XB_TOP], 1u);
            const unsigned tg = og / nx;
            if (og + 1u == (tg + 1u) * nx) xb_add(&bar[XB_TOPGEN], 1u);
            else XB_SPIN(xb_ld(&bar[XB_TOPGEN]) == tg, bar);
            __builtin_amdgcn_fence(__ATOMIC_ACQUIRE, "agent");
            xb_add(&bar[XB_XGEN(b.x)], 1u);
            asm volatile("s_waitcnt vmcnt(0)" ::: "memory");
        } else {
            XB_SPIN(xb_ld(&bar[XB_XGEN(b.x)]) == gen, bar);
            __builtin_amdgcn_fence(__ATOMIC_ACQUIRE, "agent");
            asm volatile("s_waitcnt vmcnt(0)" ::: "memory");
        }
    }
    __syncthreads();
}


constexpr size_t WS_BAR = 255 * MiB + 320 * 1024;
DI int fresh_tid() { int t = threadIdx.x; asm volatile("" : "+v"(t)); return t; }
#define IDS const int tid = fresh_tid(), lane = tid & 63, wave = __builtin_amdgcn_readfirstlane(tid >> 6); const int G = gridDim.x, bx = blockIdx.x; \
    const int gw = bx * NWAVES + wave, NGW = G * NWAVES, gtid = bx * NTHREADS + tid, NGT = G * NTHREADS; (void)lane; (void)gw; (void)NGW; (void)gtid; (void)NGT; (void)wave;
__global__ void __launch_bounds__(NTHREADS, 2) fwd_kernel(Params p) {
    extern __shared__ __attribute__((aligned(16))) unsigned char lds[];
    cg::grid_group grid = cg::this_grid();
    PG8_LAS unsigned char* ldsl = (PG8_LAS unsigned char*)lds;
    if (threadIdx.x < 4) ((PG8_LAS unsigned*)(ldsl + (LDS_BYTES - 256)))[threadIdx.x] = 0u;
    __syncthreads();
    const XcdBarrier bar = xcd_barrier_post((unsigned*)(PP().ws + WS_BAR), (volatile PG8_LAS unsigned*)(ldsl + (LDS_BYTES - 256)));

    { IDS phase0(PP(), gw, NGW, lane); }
    if (PP().ws == nullptr) grid.sync();
    xcd_barrier(bar);
    if (gridDim.x == 256) {
        IDS
        pg8::StaticOrder S1; S1.init(M, D, G, bx); pg8::Unit u1; (void)S1.next(0, u1);
        phase1(PP(), (float*)lds, gw, NGW, lane, tid, 256 * u1.pm + 64 * u1.pn);
        unsigned* cnt = (unsigned*)(PP().ws + WS_PCNT4) + 64 * u1.pm;
        asm volatile("s_waitcnt vmcnt(0)" ::: "memory");
        __syncthreads();
        if (threadIdx.x == 0) __hip_atomic_fetch_add(cnt, 1u, __ATOMIC_RELAXED, __HIP_MEMORY_SCOPE_AGENT);
        if (threadIdx.x < 64) {
            unsigned sp = 0;
            while ((unsigned)__builtin_amdgcn_readfirstlane(__hip_atomic_load(cnt, __ATOMIC_RELAXED, __HIP_MEMORY_SCOPE_AGENT)) < 4u) { __builtin_amdgcn_s_sleep(2); if (++sp > (1u << 22)) break; }
            __builtin_amdgcn_fence(__ATOMIC_ACQUIRE, "agent");
        }
        asm volatile("s_waitcnt vmcnt(0) lgkmcnt(0)" ::: "memory");
        __syncthreads();
    } else {
        { IDS phase1(PP(), (float*)lds, gw, NGW, lane, tid, -1); }
        xcd_barrier(bar);
    }
    {
        const Params q = PP(); unsigned char* ws = q.ws; bf16_t* WIN = (bf16_t*)(ws + WS_WIN); const int G = gridDim.x, bx = blockIdx.x;
        pg8::Gemm g{(const bf16_t*)(ws + 0 * UNIT), WIN + (size_t)ROWS_A * D, M, NB_TILES * 256, D}; pg8::StaticOrder S; S.init(M, NB_TILES * 256, G, bx);
        EpiB E{(bf16_t*)(ws + 1 * UNIT)};
        pg8::gemm_phase<EpiB, pg8::StaticOrder, true, true>(ldsl, g, S, E);
    }
    if (gridDim.x == 256) {
        IDS
        pg8::StaticOrder S1; S1.init(M, D, G, bx); pg8::Unit u1; (void)S1.next(0, u1);
        if (wave < 4) ab_item(PP(), 16 * u1.pm + 4 * u1.pn + wave, lane);
    } else { IDS for (int it = gw; it < M / 16; it += NGW) ab_item(PP(), it, lane); }
    if (gridDim.x == 256) {
        IDS
        pg8::StaticOrder S3; S3.init(M, D, G, bx); pg8::Unit u3; (void)S3.next(0, u3);
        unsigned* cnt = (unsigned*)(PP().ws + WS_PCNT5);
        asm volatile("s_waitcnt vmcnt(0)" ::: "memory");
        __syncthreads();
        if (threadIdx.x == 0) __hip_atomic_fetch_add(cnt + 16 * (u3.pm * 4 + u3.pn), 1u, __ATOMIC_RELAXED, __HIP_MEMORY_SCOPE_AGENT);
        if (threadIdx.x < 64) {
#pragma unroll 1
            for (int dlt = -1; dlt <= 1; dlt += 2) {
                const int pp = u3.pm + dlt;
                if (pp < 0 || pp > 63 || (pp >> 5) != (u3.pm >> 5)) continue;
                unsigned sp = 0;
                while ((unsigned)__builtin_amdgcn_readfirstlane(__hip_atomic_load(cnt + 16 * (pp * 4 + u3.pn), __ATOMIC_RELAXED, __HIP_MEMORY_SCOPE_AGENT)) < 1u) { __builtin_amdgcn_s_sleep(2); if (++sp > (1u << 22)) break; }
            }
#pragma unroll 1
            for (int jj = 0; jj < 4; ++jj) {
                unsigned sp = 0;
                while ((unsigned)__builtin_amdgcn_readfirstlane(__hip_atomic_load(cnt + 16 * (u3.pm * 4 + jj), __ATOMIC_RELAXED, __HIP_MEMORY_SCOPE_AGENT)) < 1u) { __builtin_amdgcn_s_sleep(2); if (++sp > (1u << 22)) break; }
            }
            __builtin_amdgcn_fence(__ATOMIC_ACQUIRE, "agent");
        }
        asm volatile("s_waitcnt vmcnt(0) lgkmcnt(0)" ::: "memory");
        __syncthreads();
        const int b3 = u3.pm >> 5, tg = (u3.pm & 31) * 8 + wave;
#pragma nounroll
        for (int hh = 0; hh < 2; ++hh) { const int l2 = fresh_tid() & 63; phase3_item(PP(), ((b3 * 8 + 2 * u3.pn + hh) << 8) + tg, l2); }
    } else {
        xcd_barrier(bar);
        { IDS for (int it = gw; it < 4096; it += NGW) phase3_item(PP(), it, lane); }
    }
    xcd_barrier(bar);
    { IDS for (int it = gw; it < 4096; it += NGW) chunk_prep_item(PP(), (float*)(lds + wave * 16384), it, lane); }
    xcd_barrier(bar);
    for (int tk = blockIdx.x; tk < 256; tk += gridDim.x) { const int t2 = fresh_tid(); scan_task(PP(), ldsl, (tk & 7) + 8 * (tk >> 6), (tk >> 3) & 7, t2, __builtin_amdgcn_readfirstlane(t2 >> 6), t2 & 63); __syncthreads(); }
    xcd_barrier(bar);
    {
        const Params q = PP(); unsigned char* ws = q.ws; bf16_t* WIN = (bf16_t*)(ws + WS_WIN); const int G = gridDim.x, bx = blockIdx.x;
        pg8::Gemm g{(const bf16_t*)(ws + 0 * UNIT), WIN, M, NA_TILES * 256, D}; pg8::StaticOrder S; S.init(M, NA_TILES * 256, G, bx);
        EpiA E{(bf16_t*)(ws + 1 * UNIT), (bf16_t*)(ws + 4 * UNIT)};
        pg8::gemm_phase<EpiA, pg8::StaticOrder, true, true>(ldsl, g, S, E);
    }
    if (gridDim.x == 256) {
        IDS
        pg8::StaticOrder S7; S7.init(M, D, G, bx); pg8::Unit u7; (void)S7.next(0, u7);
        unsigned* cntA = (unsigned*)(PP().ws + WS_PCNT3);
        asm volatile("s_waitcnt vmcnt(0)" ::: "memory");
        __syncthreads();
        if (threadIdx.x == 0) __hip_atomic_fetch_add(cntA + 64 * u7.pm, 1u, __ATOMIC_RELAXED, __HIP_MEMORY_SCOPE_AGENT);
        if (threadIdx.x < 64) {
            const int plo = u7.pm > 0 ? u7.pm - 1 : 0, phi = u7.pm < 63 ? u7.pm + 1 : 63;
            for (int pp = plo; pp <= phi; ++pp) { unsigned sp = 0;
                while ((unsigned)__builtin_amdgcn_readfirstlane(__hip_atomic_load(cntA + 64 * pp, __ATOMIC_RELAXED, __HIP_MEMORY_SCOPE_AGENT)) < 4u) { __builtin_amdgcn_s_sleep(2); if (++sp > (1u << 22)) break; } }
            __builtin_amdgcn_fence(__ATOMIC_ACQUIRE, "agent");
        }
        asm volatile("s_waitcnt vmcnt(0) lgkmcnt(0)" ::: "memory");
        __syncthreads();
        phase7_panel(PP(), u7.pm, u7.pn, tid, lane, wave);
    } else {
        xcd_barrier(bar);
        { IDS phase7(PP(), gw, NGW, lane, gtid, NGT); }
    }
    xcd_barrier(bar);
    if (gridDim.x == 256) {
        const Params q = PP(); unsigned char* ws = q.ws; const int G = gridDim.x, bx = blockIdx.x;
        static_assert(6 * UNIT - 2 * UNIT == (size_t)256 * 256 * D * 2 && WS_WPB - WS_WPA == (size_t)4 * 256 * D * 2, "TwoGemmOrder address arithmetic");
        TwoGemmOrder S; S.so.init(M, D, G, bx);
        pg8::Gemm g{(const bf16_t*)(ws + 2 * UNIT), (const bf16_t*)(ws + WS_WPA), M, D, D}; EpiYaYb E{(bf16_t*)(ws + 4 * UNIT), (const bf16_t*)(ws + 5 * UNIT)};
        pg8::gemm_phase<EpiYaYb, TwoGemmOrder, true, true>(ldsl, g, S, E);
    } else {
        const Params q = PP(); unsigned char* ws = q.ws; const int G = gridDim.x, bx = blockIdx.x;
        pg8::StaticOrder S; S.init(M, D, G, bx);
        { pg8::Gemm g{(const bf16_t*)(ws + 2 * UNIT), (const bf16_t*)(ws + WS_WPA), M, D, D}; EpiYa E{(bf16_t*)(ws + 4 * UNIT)};
          pg8::gemm_phase<EpiYa, pg8::StaticOrder, true, true>(ldsl, g, S, E); }
        { pg8::Gemm g{(const bf16_t*)(ws + 6 * UNIT), (const bf16_t*)(ws + WS_WPB), M, D, D}; EpiYb E{(bf16_t*)(ws + 4 * UNIT), (const bf16_t*)(ws + 5 * UNIT)};
          pg8::gemm_phase<EpiYb, pg8::StaticOrder, true, true>(ldsl, g, S, E); }
    }
    if (gridDim.x == 256) {
        pg8::StaticOrder S; S.init(M, D, (int)gridDim.x, (int)blockIdx.x); pg8::Unit u; (void)S.next(0, u);
        unsigned* cnt = (unsigned*)(PP().ws + WS_PCNT2) + 64 * u.pm;
        asm volatile("s_waitcnt vmcnt(0)" ::: "memory");
        __syncthreads();
        if (threadIdx.x == 0) __hip_atomic_fetch_add(cnt, 1u, __ATOMIC_RELAXED, __HIP_MEMORY_SCOPE_AGENT);
        if (threadIdx.x < 64) {
            unsigned sp = 0;
            while ((unsigned)__builtin_amdgcn_readfirstlane(__hip_atomic_load(cnt, __ATOMIC_RELAXED, __HIP_MEMORY_SCOPE_AGENT)) < 4u) { __builtin_amdgcn_s_sleep(2); if (++sp > (1u << 22)) break; }
            __builtin_amdgcn_fence(__ATOMIC_ACQUIRE, "agent");
        }
        asm volatile("s_waitcnt vmcnt(0) lgkmcnt(0)" ::: "memory");
        __syncthreads();
    } else {
        xcd_barrier(bar);
    }
    if (gridDim.x == 256) {
        const Params q = PP(); unsigned char* ws = q.ws; const int G = gridDim.x, bx = blockIdx.x;
        pg8::Gemm g{(const bf16_t*)(ws + 4 * UNIT), (const bf16_t*)(ws + WS_WO), M, D, D}; pg8::StaticOrder S; S.init(M, D, G, bx);
        EpiOutFused E{q.in[0], (const float*)(ws + WS_MODF), q.in[14], q.out, (float*)(ws + WS_PSS), (unsigned*)(ws + WS_PCNT)};
        pg8::gemm_phase<EpiOutFused, pg8::StaticOrder, true, true>(ldsl, g, S, E);
    } else {
        {
            const Params q = PP(); unsigned char* ws = q.ws; const int G = gridDim.x, bx = blockIdx.x;
            pg8::Gemm g{(const bf16_t*)(ws + 4 * UNIT), (const bf16_t*)(ws + WS_WO), M, D, D}; pg8::StaticOrder S; S.init(M, D, G, bx);
            EpiOut E{q.in[0], (const float*)(ws + WS_MODF), (float*)(ws + 0 * UNIT)};
            pg8::gemm_phase<EpiOut, pg8::StaticOrder, true, true>(ldsl, g, S, E);
        }
        xcd_barrier(bar);
        { IDS phase10(PP(), gw, NGW, lane); }
    }
}

extern "C" void kernel_launch(void* const* d_in, const int* in_sizes, int n_in, void* d_out, int out_size, void* d_ws, size_t ws_size, hipStream_t stream) {
    static int grid = 0;
    if (grid == 0) {
        int dev = 0, cus = 0, per_cu = 0;
        if (n_in != 15 || out_size != M * D || ws_size < 256 * MiB) { fprintf(stderr, "kernel_launch: unexpected shapes (n_in %d out %d ws %zu)\n", n_in, out_size, ws_size); grid = -1; return; }
        hipGetDevice(&dev); hipDeviceGetAttribute(&cus, hipDeviceAttributeMultiprocessorCount, dev);
        if (hipFuncSetAttribute((const void*)fwd_kernel, hipFuncAttributeMaxDynamicSharedMemorySize, LDS_BYTES) != hipSuccess) { fprintf(stderr, "kernel_launch: hipFuncSetAttribute failed\n"); grid = -1; return; }
        hipOccupancyMaxActiveBlocksPerMultiprocessor(&per_cu, (const void*)fwd_kernel, NTHREADS, LDS_BYTES);
        if (per_cu < 1) { fprintf(stderr, "kernel_launch: occupancy query says %d blocks/CU\n", per_cu); per_cu = 1; }
        (void)hipGetLastError();
        grid = cus;
    }
    if (grid < 0) return;
    if (hipMemsetAsync((char*)d_ws + WS_BAR, 0, 98304, stream) != hipSuccess) { fprintf(stderr, "kernel_launch: memset of barrier words failed\n"); return; }
    Params p{};
    for (int i = 0; i < 15; ++i) p.in[i] = (const float*)d_in[i];
    p.out = (float*)d_out; p.ws = (unsigned char*)d_ws;
    void* args[] = {&p};
    hipError_t e = hipLaunchCooperativeKernel((const void*)fwd_kernel, dim3(grid), dim3(NTHREADS), args, LDS_BYTES, stream);
    if (e != hipSuccess) fprintf(stderr, "cooperative launch failed: %s (grid %d)\n", hipGetErrorString(e), grid);
}
```

```cpp
#include <hip/hip_runtime.h>
#include <hip/hip_cooperative_groups.h>
#include <cstdio>
#include <cstdint>
namespace cg = cooperative_groups;

#define DI __device__ __forceinline__
#define PG8_LAS __attribute__((address_space(3)))
typedef unsigned short bf16_t;
typedef short bf16x8 __attribute__((ext_vector_type(8)));
typedef float f32x4 __attribute__((ext_vector_type(4)));
typedef float f32x2 __attribute__((ext_vector_type(2)));
typedef unsigned u32x4 __attribute__((ext_vector_type(4)));
typedef unsigned u32x2 __attribute__((ext_vector_type(2)));

namespace pg8 {
constexpr int BM = 256, BK = 64, HALF = 128, HTB = HALF * BK * 2, STAGE_BYTES = 8 * HTB, NXCD = 8, WGM = 8;
__host__ __device__ __forceinline__ int lds_byte(int r, int c) { const int st = (r >> 4) * 2 + (c >> 5), rr = r & 15, cc = c & 31, ob = rr * 64 + cc * 2; return st * 1024 + (ob ^ (((ob >> 9) & 1) << 5)); }
__host__ __device__ __forceinline__ void stage_rc(int b, int& R, int& C) { const int st = b / 1024, sb = b % 1024, swz = sb ^ (((sb >> 9) & 1) << 5); R = (st >> 1) * 16 + swz / 64; C = (st & 1) * 32 + (swz % 64) / 2; }
__host__ __device__ __forceinline__ int perm32(int rho) { const int n = rho >> 4, i = rho & 15; return 8 * (i >> 2) + 4 * n + (i & 3); }
struct Unit { int pm, pn; };
struct Gemm { const bf16_t* A; const bf16_t* Bt; int M, N, K; };
struct StaticOrder {
    int nM, nN, nwg, G, c;
    __host__ __device__ void init(int M, int N, int G_, int c_) { nM = M / BM; nN = N / BM; nwg = nM * nN; G = G_; c = c_; }
    __host__ __device__ bool next(int i, Unit& u) const {
        const long L = (long)i * G + c; if (L >= nwg) return false;
        int wgid = (int)L; { const int q = nwg / NXCD, r = nwg % NXCD, xcd = wgid % NXCD, off = wgid / NXCD; wgid = (xcd < r ? xcd * (q + 1) : r * (q + 1) + (xcd - r) * q) + off; }
        const int nig = WGM * nN, gid = wgid / nig, fm = gid * WGM, gsz = (nM - fm) < WGM ? (nM - fm) : WGM;
        u.pm = fm + ((wgid % nig) % gsz); u.pn = (wgid % nig) / gsz; return true;
    }
    __device__ __forceinline__ void a_ready(const Unit&) const {}
    __device__ __forceinline__ void done(const Unit&) const {}
};
template <class Epi, class Sched, bool ALIGN_EPI = false, bool SP2 = false>
__device__ __forceinline__ void gemm_phase(PG8_LAS unsigned char* lds, const Gemm g, const Sched& S, const Epi& E) {
    int tid = threadIdx.x; asm volatile("" : "+v"(tid)); const int wid = __builtin_amdgcn_readfirstlane(tid >> 6), lane = tid & 63, wr = wid >> 2, wc = wid & 3, fr = lane & 15, fq = lane >> 4;
    const int K = g.K, nt = K / BK;
    unsigned voffA[2], voffB[2];
#pragma unroll
    for (int i = 0; i < 2; ++i) { int R, C; stage_rc(tid * 16 + i * 8192, R, C); const int Rb = Epi::PERM ? ((R & ~31) + perm32(R & 31)) : R;
        voffA[i] = (unsigned)(R * K + C) * 2u; voffB[i] = (unsigned)(Rb * K + C) * 2u; }
    const size_t kstep = (size_t)(BK * 2);
    const size_t hstep = (size_t)HALF * K * 2;
    const size_t tstep = 2 * hstep;
    const unsigned ldsw = (unsigned)wid * 1024u;
    const int aoff = lds_byte(wr * 64 + fr, fq * 8), boff = lds_byte(wc * 32 + fr, fq * 8);
#define PG8_SA(b, h) (((b) * 2 + (h)) * HTB)
#define PG8_SB(b, h) ((4 + (b) * 2 + (h)) * HTB)
#define PG8_STAGE(bufoff, gbase, voff) do { _Pragma("unroll") for (int _i = 0; _i < 2; ++_i) \
        __builtin_amdgcn_global_load_lds((const unsigned*)((const char*)(gbase) + (voff)[_i]), (PG8_LAS unsigned*)(lds + (bufoff) + ldsw + _i * 8192), 16, 0, 0); } while (0)
#define PG8_LDA(dst, b, h) do { _Pragma("unroll") for (int m = 0; m < 4; ++m) _Pragma("unroll") for (int k = 0; k < 2; ++k) dst[m][k] = *(const PG8_LAS bf16x8*)(lds + PG8_SA(b, h) + aoff + m * 2048 + k * 1024); } while (0)
#define PG8_LDB(dst, b, h) do { _Pragma("unroll") for (int n = 0; n < 2; ++n) _Pragma("unroll") for (int k = 0; k < 2; ++k) dst[n][k] = *(const PG8_LAS bf16x8*)(lds + PG8_SB(b, h) + boff + n * 2048 + k * 1024); } while (0)
#define PG8_MMA(ai, bj, At, Bt) do { __builtin_amdgcn_s_setprio(1); _Pragma("unroll") for (int m = 0; m < 4; ++m) _Pragma("unroll") for (int n = 0; n < 2; ++n) _Pragma("unroll") for (int k = 0; k < 2; ++k) \
        acc[ai][bj][m][n] = __builtin_amdgcn_mfma_f32_16x16x32_bf16(Bt[n][k], At[m][k], acc[ai][bj][m][n], 0, 0, 0); __builtin_amdgcn_s_setprio(0); } while (0)
#define PG8_WAIT_V(n) asm volatile("s_waitcnt vmcnt(" #n ")" ::: "memory")
#define PG8_WAIT_L(n) asm volatile("s_waitcnt lgkmcnt(" #n ")" ::: "memory")
#define PG8_BAR __builtin_amdgcn_s_barrier()
#define PG8_SCHED __builtin_amdgcn_sched_barrier(0)
    Unit cur, nxt; int ui = 0;
    if (!S.next(0, cur)) return;
    f32x4 acc[2][2][4][2];
#pragma unroll
    for (int a = 0; a < 2; ++a)
#pragma unroll
        for (int b = 0; b < 2; ++b)
#pragma unroll
            for (int m = 0; m < 4; ++m)
#pragma unroll
                for (int n = 0; n < 2; ++n) acc[a][b][m][n] = (f32x4){0.f, 0.f, 0.f, 0.f};
    bf16x8 At[4][2], B0[2][2], B1[2][2];
    const char* cA = (const char*)g.A + (size_t)cur.pm * tstep; const char* cB = (const char*)g.Bt + (size_t)cur.pn * tstep;
    S.a_ready(cur);
    if constexpr (SP2) {
        PG8_STAGE(PG8_SB(0, 0), cB, voffB); PG8_STAGE(PG8_SB(0, 1), cB + hstep, voffB); PG8_STAGE(PG8_SA(0, 0), cA, voffA); PG8_STAGE(PG8_SA(0, 1), cA + hstep, voffA);
        if (wr == 1) PG8_BAR;
        PG8_WAIT_V(2); PG8_BAR;
        PG8_STAGE(PG8_SB(1, 0), cB + kstep, voffB); PG8_STAGE(PG8_SA(1, 0), cA + kstep, voffA); PG8_STAGE(PG8_SB(1, 1), cB + hstep + kstep, voffB);
        PG8_WAIT_V(6); PG8_BAR;
    } else {
        PG8_STAGE(PG8_SB(0, 0), cB, voffB); PG8_STAGE(PG8_SA(0, 0), cA, voffA); PG8_STAGE(PG8_SB(0, 1), cB + hstep, voffB); PG8_STAGE(PG8_SA(0, 1), cA + hstep, voffA);
        if (wr == 1) PG8_BAR;
        PG8_WAIT_V(4); PG8_BAR;
        PG8_STAGE(PG8_SB(1, 0), cB + kstep, voffB); PG8_STAGE(PG8_SA(1, 0), cA + kstep, voffA); PG8_STAGE(PG8_SB(1, 1), cB + hstep + kstep, voffB);
        PG8_WAIT_V(6); PG8_BAR;
    }
    for (;;) {
        const bool has_next = S.next(ui + 1, nxt);
        const char* nA = has_next ? (const char*)g.A + (size_t)nxt.pm * tstep : cA; const char* nB = has_next ? (const char*)g.Bt + (size_t)nxt.pn * tstep : cB;
        for (int t = 0; t < nt; t += 2) {
            const bool last = (t == nt - 2);
            const char* a1 = cA + (size_t)(t + 1) * kstep;
            const char* a2 = last ? nA : cA + (size_t)(t + 2) * kstep; const char* b2 = last ? nB : cB + (size_t)(t + 2) * kstep;
            const char* a3 = a2 + kstep; const char* b3 = b2 + kstep;
            if (last && has_next) S.a_ready(nxt);
            if constexpr (SP2) {
            PG8_LDB(B0, 0, 0); PG8_LDB(B1, 0, 1); PG8_SCHED; PG8_LDA(At, 0, 0); PG8_STAGE(PG8_SA(1, 1), a1 + hstep, voffA);
            PG8_WAIT_V(8); PG8_WAIT_L(0); PG8_BAR; PG8_MMA(0, 0, At, B0); PG8_MMA(0, 1, At, B1); PG8_BAR; PG8_SCHED;
            PG8_LDA(At, 0, 1); PG8_STAGE(PG8_SB(0, 0), b2, voffB); PG8_STAGE(PG8_SB(0, 1), b2 + hstep, voffB); PG8_STAGE(PG8_SA(0, 0), a2, voffA);
            PG8_WAIT_V(8); PG8_WAIT_L(0); PG8_BAR; PG8_MMA(1, 0, At, B0); PG8_MMA(1, 1, At, B1); PG8_BAR; PG8_SCHED;
            PG8_LDB(B0, 1, 0); PG8_LDB(B1, 1, 1); PG8_SCHED; PG8_LDA(At, 1, 0); PG8_STAGE(PG8_SA(0, 1), a2 + hstep, voffA);
            PG8_WAIT_V(8); PG8_WAIT_L(0); PG8_BAR; PG8_MMA(0, 0, At, B0); PG8_MMA(0, 1, At, B1); PG8_BAR; PG8_SCHED;
            PG8_LDA(At, 1, 1); PG8_STAGE(PG8_SB(1, 0), b3, voffB); PG8_STAGE(PG8_SB(1, 1), b3 + hstep, voffB); PG8_STAGE(PG8_SA(1, 0), a3, voffA);
            PG8_WAIT_V(8); PG8_WAIT_L(0); PG8_BAR; PG8_MMA(1, 0, At, B0); PG8_MMA(1, 1, At, B1); PG8_BAR; PG8_SCHED;
            } else {
            PG8_LDB(B0, 0, 0); PG8_SCHED; PG8_LDA(At, 0, 0); PG8_STAGE(PG8_SA(1, 1), a1 + hstep, voffA);
            PG8_WAIT_L(8); PG8_BAR; PG8_WAIT_L(0); PG8_MMA(0, 0, At, B0); PG8_BAR; PG8_SCHED;
            PG8_LDB(B1, 0, 1); PG8_STAGE(PG8_SB(0, 0), b2, voffB);
            PG8_BAR; PG8_WAIT_L(0); PG8_MMA(0, 1, At, B1); PG8_BAR;
            PG8_LDA(At, 0, 1); PG8_STAGE(PG8_SA(0, 0), a2, voffA);
            PG8_BAR; PG8_WAIT_L(0); PG8_MMA(1, 0, At, B0); PG8_BAR; PG8_SCHED;
            PG8_STAGE(PG8_SB(0, 1), b2 + hstep, voffB);
            PG8_WAIT_V(6); PG8_BAR; PG8_MMA(1, 1, At, B1); PG8_BAR;
            PG8_LDB(B0, 1, 0); PG8_SCHED; PG8_LDA(At, 1, 0); PG8_STAGE(PG8_SA(0, 1), a2 + hstep, voffA);
            PG8_WAIT_L(8); PG8_BAR; PG8_WAIT_L(0); PG8_MMA(0, 0, At, B0); PG8_BAR; PG8_SCHED;
            PG8_LDB(B1, 1, 1); PG8_STAGE(PG8_SB(1, 0), b3, voffB);
            PG8_BAR; PG8_WAIT_L(0); PG8_MMA(0, 1, At, B1); PG8_BAR;
            PG8_LDA(At, 1, 1); PG8_STAGE(PG8_SA(1, 0), a3, voffA);
            PG8_BAR; PG8_WAIT_L(0); PG8_MMA(1, 0, At, B0); PG8_BAR; PG8_SCHED;
            PG8_STAGE(PG8_SB(1, 1), b3 + hstep, voffB);
            PG8_WAIT_V(6); PG8_BAR; PG8_MMA(1, 1, At, B1); PG8_BAR;
            }
        }
        if constexpr (ALIGN_EPI) { if (wr == 0) PG8_BAR; }
        if constexpr (!Epi::AFTER_DRAIN) { E(acc, cur, wr, wc, fr, fq); S.done(cur); }
        if (!has_next) break;
#pragma unroll
        for (int a = 0; a < 2; ++a)
#pragma unroll
            for (int b = 0; b < 2; ++b)
#pragma unroll
                for (int m = 0; m < 4; ++m)
#pragma unroll
                    for (int n = 0; n < 2; ++n) acc[a][b][m][n] = (f32x4){0.f, 0.f, 0.f, 0.f};
        cur = nxt; cA = nA; cB = nB; ++ui;
        if constexpr (ALIGN_EPI) { if (wr == 1) PG8_BAR; }
    }
    PG8_WAIT_V(0);
    if constexpr (!ALIGN_EPI) { if (wr == 0) PG8_BAR; }
    PG8_BAR;
    if constexpr (Epi::AFTER_DRAIN) { E.fused(acc, cur, wr, wc, fr, fq, lds, wid, lane); S.done(cur); }
#undef PG8_SA
#undef PG8_SB
#undef PG8_STAGE
#undef PG8_LDA
#undef PG8_LDB
#undef PG8_MMA
#undef PG8_WAIT_V
#undef PG8_WAIT_L
#undef PG8_BAR
#undef PG8_SCHED
}}

constexpr int SEQ = 8192, NB = 2, M = NB * SEQ, D = 1024, NIN = 10272, NPAD = 10496;
constexpr int NA_TILES = 28, NB_TILES = 12, ROWS_A = NA_TILES * 256;
constexpr size_t MiB = 1u << 20;
constexpr size_t UNIT = 32 * MiB;
constexpr size_t WS_WIN = 224 * MiB, WS_WPA = 245 * MiB, WS_WPB = 247 * MiB, WS_WO = 249 * MiB, WS_AB = 251 * MiB, WS_G = 253 * MiB, WS_BETA = 254 * MiB;
constexpr size_t WS_MODP = 255 * MiB, WS_MODF = 255 * MiB + 256 * 1024;
constexpr size_t WS_CSC = 239 * MiB;
constexpr int LDS_BYTES = 155648;
constexpr int NWAVES = 8, NTHREADS = 512;
constexpr float NORM_EPS = 1e-6f, L2_EPS = 1e-6f;

struct Params { const float* in[15]; float* out; unsigned char* ws; };

typedef __bf16 bf16v2_t __attribute__((ext_vector_type(2)));
DI unsigned cvt_pk_bf16(float lo, float hi) { const f32x2 v = {lo, hi}; const bf16v2_t r = __builtin_convertvector(v, bf16v2_t); return __builtin_bit_cast(unsigned, r); }
DI void store_wt16(void* p, const u32x4& v) { asm volatile("global_store_dwordx4 %0, %1, off sc1\n\ts_nop 1" :: "v"(p), "v"(v) : "memory"); }
DI float bf_lo(unsigned u) { return __uint_as_float(u << 16); }
DI float bf_hi(unsigned u) { return __uint_as_float(u & 0xffff0000u); }
DI float bf1(bf16_t u) { return __uint_as_float(((unsigned)u) << 16); }
DI float sigmoidf_(float x) { return __builtin_amdgcn_rcpf(1.0f + __expf(-x)); }
DI float siluf_(float x) { return x * __builtin_amdgcn_rcpf(1.0f + __expf(-x)); }
DI float softplusf_(float x) { return fmaxf(x, 0.f) + log1pf(__expf(-fabsf(x))); }
#define DPP_F(v, ctrl) __builtin_bit_cast(float, __builtin_amdgcn_mov_dpp(__builtin_bit_cast(int, (v)), (ctrl), 0xF, 0xF, true))
DI float row16_sum(float v) {
    v += DPP_F(v, 0xB1);
    v += DPP_F(v, 0x4E);
    v += DPP_F(v, 0x141);
    v += DPP_F(v, 0x140);
    return v;
}
DI float wave_sum(float v) {
    v = row16_sum(v);
    return __builtin_bit_cast(float, __builtin_amdgcn_readlane(__builtin_bit_cast(int, v), 0)) + __builtin_bit_cast(float, __builtin_amdgcn_readlane(__builtin_bit_cast(int, v), 16))
         + __builtin_bit_cast(float, __builtin_amdgcn_readlane(__builtin_bit_cast(int, v), 32)) + __builtin_bit_cast(float, __builtin_amdgcn_readlane(__builtin_bit_cast(int, v), 48));
}
DI int permpos(int dk) { const int loc = dk & 31; return (dk & ~31) + 8 * ((loc >> 2) & 3) + 4 * (loc >> 4) + (loc & 3); }
DI int win_src_col(int d) {
    if (d < 2048) { const int i = d >> 8, w = d & 255; return w < 128 ? (128 * i + w) : (2048 + 128 * i + (w - 128)); }
    if (d < 4096) { const int i = (d - 2048) >> 8, w = d & 255; return w < 128 ? (1024 + 128 * i + w) : (3072 + 128 * i + (w - 128)); }
    if (d < 5120) return 8224 + (d - 4096);
    if (d < 6144) return 9248 + (d - 5120);
    if (d < 7168) return 7168 + (d - 6144);
    if (d < 10240) return 4096 + (d - 7168);
    if (d < 10272) return 8192 + (d - 10240);
    return -1;
}

struct EpiA {
    static constexpr bool PERM = true, AFTER_DRAIN = false;
    bf16_t *PR, *SG;
    DI void operator()(const f32x4 (&acc)[2][2][4][2], const pg8::Unit& u, int wr, int wc, int fr, int fq) const {
        const int row0 = u.pm * 256 + wr * 64 + fr, pn = u.pn;
        if (pn < 16) {
            bf16_t* O = PR + (size_t)(pn >> 3) * (UNIT / 2) + (size_t)(128 * (pn & 7) + 32 * wc + 8 * fq);
#pragma unroll
            for (int ai = 0; ai < 2; ++ai)
#pragma unroll
                for (int m = 0; m < 4; ++m) {
                    float o[8];
#pragma unroll
                    for (int n = 0; n < 2; ++n)
#pragma unroll
                        for (int j = 0; j < 4; ++j) { const float a = acc[ai][0][m][n][j], b = acc[ai][1][m][n][j]; o[4 * n + j] = pn < 8 ? a * b : a * siluf_(b); }
                    u32x4 w; w.x = cvt_pk_bf16(o[0], o[1]); w.y = cvt_pk_bf16(o[2], o[3]); w.z = cvt_pk_bf16(o[4], o[5]); w.w = cvt_pk_bf16(o[6], o[7]);
                    store_wt16(O + (size_t)(row0 + ai * 128 + m * 16) * D, w);
                }
        } else {
            const int g = (pn - 16) >> 2;
            bf16_t* O = SG + (size_t)g * (UNIT / 2) + (size_t)(256 * ((pn - 16) & 3) + 32 * wc + 8 * fq);
#pragma unroll
            for (int ai = 0; ai < 2; ++ai)
#pragma unroll
                for (int m = 0; m < 4; ++m)
#pragma unroll
                    for (int bj = 0; bj < 2; ++bj) {
                        float o[8];
#pragma unroll
                        for (int n = 0; n < 2; ++n)
#pragma unroll
                            for (int j = 0; j < 4; ++j) { const float a = acc[ai][bj][m][n][j]; o[4 * n + j] = g == 2 ? siluf_(a) : sigmoidf_(a); }
                        u32x4 w; w.x = cvt_pk_bf16(o[0], o[1]); w.y = cvt_pk_bf16(o[2], o[3]); w.z = cvt_pk_bf16(o[4], o[5]); w.w = cvt_pk_bf16(o[6], o[7]);
                        store_wt16(O + (size_t)(row0 + ai * 128 + m * 16) * D + bj * 128, w);
                    }
        }
    }
};
struct EpiB {
    static constexpr bool PERM = true, AFTER_DRAIN = false;
    bf16_t* QKV;
    DI void operator()(const f32x4 (&acc)[2][2][4][2], const pg8::Unit& u, int wr, int wc, int fr, int fq) const {
        const int row0 = u.pm * 256 + wr * 64 + fr, pn = u.pn;
        bf16_t* O = QKV + (size_t)(pn >> 2) * (UNIT / 2) + (size_t)(256 * (pn & 3) + 32 * wc + 8 * fq);
#pragma unroll
        for (int ai = 0; ai < 2; ++ai)
#pragma unroll
            for (int m = 0; m < 4; ++m)
#pragma unroll
                for (int bj = 0; bj < 2; ++bj) {
                    const f32x4 v0 = acc[ai][bj][m][0], v1 = acc[ai][bj][m][1];
                    u32x4 w; w.x = cvt_pk_bf16(v0[0], v0[1]); w.y = cvt_pk_bf16(v0[2], v0[3]); w.z = cvt_pk_bf16(v1[0], v1[1]); w.w = cvt_pk_bf16(v1[2], v1[3]);
                    store_wt16(O + (size_t)(row0 + ai * 128 + m * 16) * D + bj * 128, w);
                }
    }
};
struct EpiYa {
    static constexpr bool PERM = true, AFTER_DRAIN = false;
    bf16_t* SGA;
    DI void operator()(const f32x4 (&acc)[2][2][4][2], const pg8::Unit& u, int wr, int wc, int fr, int fq) const {
        const int row0 = u.pm * 256 + wr * 64 + fr; bf16_t* O = SGA + (size_t)(256 * u.pn + 32 * wc + 8 * fq);
#pragma unroll
        for (int ai = 0; ai < 2; ++ai)
#pragma unroll
            for (int m = 0; m < 4; ++m)
#pragma unroll
                for (int bj = 0; bj < 2; ++bj) {
                    u32x4* p = (u32x4*)(O + (size_t)(row0 + ai * 128 + m * 16) * D + bj * 128);
                    const u32x4 s = *p; const f32x4 v0 = acc[ai][bj][m][0], v1 = acc[ai][bj][m][1];
                    u32x4 w; w.x = cvt_pk_bf16(bf_lo(s.x) * v0[0], bf_hi(s.x) * v0[1]); w.y = cvt_pk_bf16(bf_lo(s.y) * v0[2], bf_hi(s.y) * v0[3]);
                    w.z = cvt_pk_bf16(bf_lo(s.z) * v1[0], bf_hi(s.z) * v1[1]); w.w = cvt_pk_bf16(bf_lo(s.w) * v1[2], bf_hi(s.w) * v1[3]);
                    *p = w;
                }
    }
};
struct EpiYb {
    static constexpr bool PERM = true, AFTER_DRAIN = false;
    bf16_t* MA; const bf16_t* SGB;
    DI void operator()(const f32x4 (&acc)[2][2][4][2], const pg8::Unit& u, int wr, int wc, int fr, int fq) const {
        const int row0 = u.pm * 256 + wr * 64 + fr; const size_t c0 = (size_t)(256 * u.pn + 32 * wc + 8 * fq);
#pragma unroll
        for (int ai = 0; ai < 2; ++ai)
#pragma unroll
            for (int m = 0; m < 4; ++m)
#pragma unroll
                for (int bj = 0; bj < 2; ++bj) {
                    const size_t off = (size_t)(row0 + ai * 128 + m * 16) * D + bj * 128 + c0;
                    u32x4* p = (u32x4*)(MA + off); const u32x4 a = *p; const u32x4 s = *(const u32x4*)(SGB + off);
                    const f32x4 v0 = acc[ai][bj][m][0], v1 = acc[ai][bj][m][1];
                    u32x4 w; w.x = cvt_pk_bf16(bf_lo(a.x) + bf_lo(s.x) * v0[0], bf_hi(a.x) + bf_hi(s.x) * v0[1]); w.y = cvt_pk_bf16(bf_lo(a.y) + bf_lo(s.y) * v0[2], bf_hi(a.y) + bf_hi(s.y) * v0[3]);
                    w.z = cvt_pk_bf16(bf_lo(a.z) + bf_lo(s.z) * v1[0], bf_hi(a.z) + bf_hi(s.z) * v1[1]); w.w = cvt_pk_bf16(bf_lo(a.w) + bf_lo(s.w) * v1[2], bf_hi(a.w) + bf_hi(s.w) * v1[3]);
                    store_wt16(p, w);
                }
    }
};
struct EpiOut {
    static constexpr bool PERM = true, AFTER_DRAIN = false;
    const float* X; const float* GATE; float* XN;
    DI void operator()(const f32x4 (&acc)[2][2][4][2], const pg8::Unit& u, int wr, int wc, int fr, int fq) const {
        const int row0 = u.pm * 256 + wr * 64 + fr; const int c0 = 256 * u.pn + 32 * wc + 8 * fq;
        const float* gp = GATE + (size_t)((u.pm * 256) / SEQ) * D + c0;
        f32x4 gt[2][2];
#pragma unroll
        for (int bj = 0; bj < 2; ++bj) { gt[bj][0] = *(const f32x4*)(gp + bj * 128); gt[bj][1] = *(const f32x4*)(gp + bj * 128 + 4); }
#pragma unroll
        for (int ai = 0; ai < 2; ++ai)
#pragma unroll
            for (int m = 0; m < 4; ++m)
#pragma unroll
                for (int bj = 0; bj < 2; ++bj) {
                    const size_t off = (size_t)(row0 + ai * 128 + m * 16) * D + bj * 128 + c0;
                    const f32x4 x0 = *(const f32x4*)(X + off), x1 = *(const f32x4*)(X + off + 4);
                    *(f32x4*)(XN + off) = x0 + gt[bj][0] * acc[ai][bj][m][0]; *(f32x4*)(XN + off + 4) = x1 + gt[bj][1] * acc[ai][bj][m][1];
                }
    }
};

constexpr size_t WS_PCNT = 255 * MiB + 336 * 1024;
constexpr size_t WS_PSS = 255 * MiB + 512 * 1024;
constexpr size_t WS_PCNT3 = 255 * MiB + 368 * 1024;
constexpr size_t WS_PCNT4 = 255 * MiB + 384 * 1024;
constexpr size_t WS_PCNT5 = 255 * MiB + 400 * 1024;
constexpr size_t WS_PCNT6 = 255 * MiB + 416 * 1024;
constexpr size_t WS_PCNT2 = 255 * MiB + 352 * 1024;
struct EpiOutFused {
    static constexpr bool PERM = true, AFTER_DRAIN = true;
    const float* X; const float* GATE; const float* FW; float* OUT; float* PSS; unsigned* PCNT;
    DI void operator()(const f32x4 (&)[2][2][4][2], const pg8::Unit&, int, int, int, int) const {}
    DI void fused(f32x4 (&acc)[2][2][4][2], const pg8::Unit& u, int wr, int wc, int fr, int fq, PG8_LAS unsigned char* lds, int wid, int lane) const {
        PG8_LAS float* P = (PG8_LAS float*)lds;
        PG8_LAS float* S = (PG8_LAS float*)(lds + 4096);
        const int row0 = u.pm * 256 + wr * 64 + fr; const int c0 = 256 * u.pn + 32 * wc + 8 * fq;
        const float* gp = GATE + (size_t)((u.pm * 256) / SEQ) * D + c0;
        f32x4 gt[2][2];
#pragma unroll
        for (int bj = 0; bj < 2; ++bj) { gt[bj][0] = *(const f32x4*)(gp + bj * 128); gt[bj][1] = *(const f32x4*)(gp + bj * 128 + 4); }
#pragma unroll
        for (int ai = 0; ai < 2; ++ai)
#pragma unroll
            for (int m = 0; m < 4; ++m) {
                float s = 0.f;
#pragma unroll
                for (int bj = 0; bj < 2; ++bj) {
                    const size_t off = (size_t)(row0 + ai * 128 + m * 16) * D + bj * 128 + c0;
                    const f32x4 v0 = __builtin_nontemporal_load((const f32x4*)(X + off)) + gt[bj][0] * acc[ai][bj][m][0], v1 = __builtin_nontemporal_load((const f32x4*)(X + off + 4)) + gt[bj][1] * acc[ai][bj][m][1];
                    acc[ai][bj][m][0] = v0; acc[ai][bj][m][1] = v1;
                    s += (v0[0] * v0[0] + v0[1] * v0[1]) + (v0[2] * v0[2] + v0[3] * v0[3]) + (v1[0] * v1[0] + v1[1] * v1[1]) + (v1[2] * v1[2] + v1[3] * v1[3]);
                }
                s += __shfl_xor(s, 16); s += __shfl_xor(s, 32);
                if (fq == 0) P[(ai * 128 + wr * 64 + m * 16 + fr) * 4 + wc] = s;
                if (m & 1) __builtin_amdgcn_sched_barrier(0);
            }
        asm volatile("s_waitcnt lgkmcnt(0)" ::: "memory"); __builtin_amdgcn_s_barrier(); asm volatile("" ::: "memory");
        const int row = wid * 32 + (lane & 31);
        if (lane < 32) {
            const float t = (P[row * 4 + 0] + P[row * 4 + 1]) + (P[row * 4 + 2] + P[row * 4 + 3]);
            __hip_atomic_store(PSS + (size_t)(u.pm * 256 + row) * 4 + u.pn, t, __ATOMIC_RELAXED, __HIP_MEMORY_SCOPE_AGENT);
        }
        asm volatile("s_waitcnt vmcnt(0)" ::: "memory");
        if (lane == 0) __hip_atomic_fetch_add(PCNT + 64 * u.pm, 1u, __ATOMIC_RELAXED, __HIP_MEMORY_SCOPE_AGENT);
        if (wid == 0) {
            unsigned sp = 0;
            while ((unsigned)__builtin_amdgcn_readfirstlane(__hip_atomic_load(PCNT + 64 * u.pm, __ATOMIC_RELAXED, __HIP_MEMORY_SCOPE_AGENT)) < 32u) { __builtin_amdgcn_s_sleep(2); if (++sp > (1u << 22)) break; }
            __builtin_amdgcn_fence(__ATOMIC_ACQUIRE, "agent");
        }
        asm volatile("s_waitcnt vmcnt(0) lgkmcnt(0)" ::: "memory"); __builtin_amdgcn_s_barrier(); asm volatile("" ::: "memory");
        if (lane < 32) {
            const float* ps = PSS + (size_t)(u.pm * 256 + row) * 4; float t = 0.f;
#pragma unroll
            for (int k = 0; k < 4; ++k) t += __hip_atomic_load(ps + k, __ATOMIC_RELAXED, __HIP_MEMORY_SCOPE_AGENT);
            S[row] = rsqrtf(t * (1.f / D) + NORM_EPS);
        }
        asm volatile("s_waitcnt vmcnt(0) lgkmcnt(0)" ::: "memory"); __builtin_amdgcn_s_barrier(); asm volatile("" ::: "memory");
        f32x4 fw[2][2];
#pragma unroll
        for (int bj = 0; bj < 2; ++bj) { fw[bj][0] = *(const f32x4*)(FW + c0 + bj * 128); fw[bj][1] = *(const f32x4*)(FW + c0 + bj * 128 + 4); }
#pragma unroll
        for (int ai = 0; ai < 2; ++ai)
#pragma unroll
            for (int m = 0; m < 4; ++m) {
                const float rs = S[ai * 128 + wr * 64 + m * 16 + fr];
#pragma unroll
                for (int bj = 0; bj < 2; ++bj) {
                    const size_t off = (size_t)(row0 + ai * 128 + m * 16) * D + bj * 128 + c0;
                    __builtin_nontemporal_store(acc[ai][bj][m][0] * rs * fw[bj][0], (f32x4*)(OUT + off)); __builtin_nontemporal_store(acc[ai][bj][m][1] * rs * fw[bj][1], (f32x4*)(OUT + off + 4));
                }
            }
    }
};

struct TwoGemmOrder {
    pg8::StaticOrder so;
    DI bool next(int i, pg8::Unit& u) const { if (i >= 2) return false; if (!so.next(0, u)) return false; if (i == 1) { u.pm += 256; u.pn += 4; } return true; }
    DI void a_ready(const pg8::Unit&) const {}
    DI void done(const pg8::Unit&) const {}
};
struct EpiYaYb {
    static constexpr bool PERM = true, AFTER_DRAIN = false;
    bf16_t* MA; const bf16_t* SGB;
    DI void operator()(const f32x4 (&acc)[2][2][4][2], const pg8::Unit& u, int wr, int wc, int fr, int fq) const {
        if (u.pn < 4) { EpiYa e{MA}; e(acc, u, wr, wc, fr, fq); }
        else { EpiYb e{MA, SGB}; pg8::Unit v; v.pm = u.pm - 256; v.pn = u.pn - 4; e(acc, v, wr, wc, fr, fq); }
    }
};

DI void p0_transpose_item(const float* W, int N, bf16_t* WT, int rg, int kg, int lane, bool is_win) {
    const int d = rg * 64 + lane; const int s = is_win ? win_src_col(d) : d; const int k0 = kg * 64;
    bf16_t* o = WT + (size_t)d * D + k0;
    if (s < 0) {
#pragma unroll
        for (int kk = 0; kk < 8; ++kk) *(u32x4*)(o + 8 * kk) = (u32x4){0u, 0u, 0u, 0u};
        return;
    }
    const float* w = W + (size_t)k0 * N + s;
    float v[64];
#pragma unroll
    for (int j = 0; j < 64; ++j) v[j] = __builtin_nontemporal_load(w + (size_t)j * N);
#pragma unroll
    for (int kk = 0; kk < 8; ++kk) {
        u32x4 p; p.x = cvt_pk_bf16(v[8 * kk], v[8 * kk + 1]); p.y = cvt_pk_bf16(v[8 * kk + 2], v[8 * kk + 3]); p.z = cvt_pk_bf16(v[8 * kk + 4], v[8 * kk + 5]); p.w = cvt_pk_bf16(v[8 * kk + 6], v[8 * kk + 7]);
        *(u32x4*)(o + 8 * kk) = p;
    }
}
DI void phase0(const Params& p, int gw, int NGW, int lane) {
    unsigned char* ws = p.ws;
    constexpr int I_WIN = (NPAD / 64) * 16, I_SQ = 16 * 16, I_MOD = 48 * 8, NITEMS = I_WIN + 3 * I_SQ + I_MOD;
    for (int it = gw; it < NITEMS; it += NGW) {
        int r = it;
        if (r < I_WIN) { p0_transpose_item(p.in[5], NIN, (bf16_t*)(ws + WS_WIN), r >> 4, r & 15, lane, true); continue; } r -= I_WIN;
        if (r < I_SQ) { p0_transpose_item(p.in[11], D, (bf16_t*)(ws + WS_WPA), r >> 4, r & 15, lane, false); continue; } r -= I_SQ;
        if (r < I_SQ) { p0_transpose_item(p.in[12], D, (bf16_t*)(ws + WS_WPB), r >> 4, r & 15, lane, false); continue; } r -= I_SQ;
        if (r < I_SQ) { p0_transpose_item(p.in[13], D, (bf16_t*)(ws + WS_WO), r >> 4, r & 15, lane, false); continue; } r -= I_SQ;
        const int cgp = r >> 3, ks = r & 7; const float* c = p.in[1]; const float* wa = p.in[2] + (size_t)(ks * 128) * 3072 + cgp * 64 + lane;
        float a0 = 0.f, a1 = 0.f;
#pragma unroll
        for (int k0 = 0; k0 < 128; k0 += 32) {
            float wv[32];
#pragma unroll
            for (int k = 0; k < 32; ++k) wv[k] = __builtin_nontemporal_load(wa + (size_t)(k0 + k) * 3072);
#pragma unroll
            for (int k = 0; k < 32; ++k) { a0 += siluf_(c[ks * 128 + k0 + k]) * wv[k]; a1 += siluf_(c[D + ks * 128 + k0 + k]) * wv[k]; }
        }
        float* mp = (float*)(ws + WS_MODP) + (size_t)ks * 2 * 3072 + cgp * 64 + lane;
        mp[0] = a0; mp[3072] = a1;
    }
}
DI void phase1(const Params& p, float* ldsf, int gw, int NGW, int lane, int tid, int row_base) {
    const float* modp = (const float*)(p.ws + WS_MODP); const float* b_ada = p.in[3]; const float* nw = p.in[4];
    float* s_tab = ldsf;
    float* a_tab = ldsf + 2048;
    for (int idx = tid; idx < 2 * 2048; idx += NTHREADS) {
        const int b = idx >> 11, j = idx & 2047; float s = b_ada[j];
#pragma unroll
        for (int q = 0; q < 8; ++q) s += modp[(size_t)q * 2 * 3072 + b * 3072 + j];
        if (j < 1024) s_tab[b * 1024 + j] = s; else a_tab[b * 1024 + j - 1024] = nw[j - 1024] * (1.f + s);
    }
    if (blockIdx.x == 0) {
        float* modf = (float*)(p.ws + WS_MODF);
        for (int idx = tid; idx < 2 * 1024; idx += NTHREADS) {
            const int b = idx >> 10, j = idx & 1023; float s = b_ada[2048 + j];
#pragma unroll
            for (int q = 0; q < 8; ++q) s += modp[(size_t)q * 2 * 3072 + b * 3072 + 2048 + j];
            modf[b * 1024 + j] = s;
        }
    }
    __syncthreads();
    bf16_t* H = (bf16_t*)(p.ws + 0 * UNIT);
    const bool pmode = row_base >= 0; const int pw = (tid >> 6) * 8;
    for (int m0 = pmode ? row_base + pw : gw; pmode ? (m0 < row_base + pw + 8) : (m0 < M); m0 += pmode ? 2 : 2 * NGW) {
        const int m1 = pmode ? m0 + 1 : (m0 + NGW < M ? m0 + NGW : m0);
        f32x4 v[2][4]; float s[2] = {0.f, 0.f};
#pragma unroll
        for (int u = 0; u < 2; ++u) { const f32x4* xr = (const f32x4*)(p.in[0] + (size_t)(u ? m1 : m0) * D) + lane;
#pragma unroll
            for (int j = 0; j < 4; ++j) v[u][j] = __builtin_nontemporal_load(xr + 64 * j); }
#pragma unroll
        for (int u = 0; u < 2; ++u) {
#pragma unroll
            for (int j = 0; j < 4; ++j) s[u] += (v[u][j].x * v[u][j].x + v[u][j].y * v[u][j].y) + (v[u][j].z * v[u][j].z + v[u][j].w * v[u][j].w);
            const int m = u ? m1 : m0; const int b = m / SEQ;
            const float rstd = rsqrtf(wave_sum(s[u]) * (1.f / D) + NORM_EPS);
            u32x2* o = (u32x2*)(H + (size_t)m * D) + lane;
#pragma unroll
            for (int j = 0; j < 4; ++j) {
                const f32x4 a = *(const f32x4*)(a_tab + b * 1024 + 4 * lane + 256 * j), sh = *(const f32x4*)(s_tab + b * 1024 + 4 * lane + 256 * j);
                const f32x4 hh = v[u][j] * rstd * a + sh;
                u32x2 w; w.x = cvt_pk_bf16(hh.x, hh.y); w.y = cvt_pk_bf16(hh.z, hh.w);
                __hip_atomic_store((unsigned long long*)(o + 64 * j), ((unsigned long long)w.y << 32) | w.x, __ATOMIC_RELAXED, __HIP_MEMORY_SCOPE_AGENT);
            }
        }
    }
    __syncthreads();
}
DI void ab_item(const Params& p, int item, int lane) {
    unsigned char* ws = p.ws; const int il = lane & 15, q = lane >> 4;
    const bf16_t* Hr = (const bf16_t*)(ws + 0 * UNIT) + (size_t)(item * 16 + il) * D + 8 * q;
    const bf16_t* W0 = (const bf16_t*)(ws + WS_WIN) + (size_t)(10240 + il) * D + 8 * q; const bf16_t* W1 = W0 + (size_t)16 * D;
    f32x4 a0 = {0.f, 0.f, 0.f, 0.f}, a1 = {0.f, 0.f, 0.f, 0.f};
#pragma unroll 8
    for (int ks = 0; ks < 32; ++ks) { const bf16x8 hf = *(const bf16x8*)(Hr + 32 * ks);
        a0 = __builtin_amdgcn_mfma_f32_16x16x32_bf16(hf, *(const bf16x8*)(W0 + 32 * ks), a0, 0, 0, 0); a1 = __builtin_amdgcn_mfma_f32_16x16x32_bf16(hf, *(const bf16x8*)(W1 + 32 * ks), a1, 0, 0, 0); }
    float* AB = (float*)(ws + WS_AB) + (size_t)(item * 16 + 4 * q) * 32 + il;
#pragma unroll
    for (int r = 0; r < 4; ++r) { AB[r * 32] = a0[r]; AB[r * 32 + 16] = a1[r]; }
}
DI void phase3_item(const Params& p, int item, int lane) {
    unsigned char* ws = p.ws;
    const bf16_t* Qr = (const bf16_t*)(ws + 1 * UNIT); const bf16_t* Kr = (const bf16_t*)(ws + 2 * UNIT); const bf16_t* Vr = (const bf16_t*)(ws + 3 * UNIT);
    bf16_t* Qn = (bf16_t*)(ws + 4 * UNIT); bf16_t* Kn = (bf16_t*)(ws + 5 * UNIT); bf16_t* Vc = (bf16_t*)p.out;
    const int tg = item & 255, h = (item >> 8) & 7, b = item >> 11; const int t_base = tg * 32; const size_t rb = (size_t)b * SEQ;
    const int col = h * 128 + 2 * lane; const int pcol = h * 128 + permpos(2 * lane);
    const float* cw = p.in[7];
    f32x2 wq[5], wk[5], wv[5];
#pragma unroll
    for (int j = 0; j < 5; ++j) { wq[j] = *(const f32x2*)(cw + j * 3072 + col); wk[j] = *(const f32x2*)(cw + j * 3072 + 1024 + col); wv[j] = *(const f32x2*)(cw + j * 3072 + 2048 + col); }
#pragma unroll
    for (int hf = 0; hf < 2; ++hf) {
        unsigned rq[20], rk[20], rv[20];
#pragma unroll
        for (int j = 0; j < 20; ++j) {
            const int t = t_base + 16 * hf - 2 + j; const bool ok = (t >= 0) && (t < SEQ); const int tc = t < 0 ? 0 : (t >= SEQ ? SEQ - 1 : t);
            const size_t off = (rb + tc) * D + col;
            const unsigned a0 = *(const unsigned*)(Qr + off), a1 = *(const unsigned*)(Kr + off), a2 = *(const unsigned*)(Vr + off);
            rq[j] = ok ? a0 : 0u; rk[j] = ok ? a1 : 0u; rv[j] = ok ? a2 : 0u;
        }
#pragma unroll
        for (int t16 = 0; t16 < 16; ++t16) {
            const int tt = 16 * hf + t16, t = t_base + tt;
            float q0 = 0.f, q1 = 0.f, k0 = 0.f, k1 = 0.f, v0 = 0.f, v1 = 0.f;
#pragma unroll
            for (int j = 0; j < 5; ++j) { q0 += wq[j].x * bf_lo(rq[t16 + j]); q1 += wq[j].y * bf_hi(rq[t16 + j]); k0 += wk[j].x * bf_lo(rk[t16 + j]); k1 += wk[j].y * bf_hi(rk[t16 + j]); v0 += wv[j].x * bf_lo(rv[t16 + j]); v1 += wv[j].y * bf_hi(rv[t16 + j]); }
            q0 = siluf_(q0); q1 = siluf_(q1); k0 = siluf_(k0); k1 = siluf_(k1); v0 = siluf_(v0); v1 = siluf_(v1);
            const float rq_ = rsqrtf(wave_sum(q0 * q0 + q1 * q1) + L2_EPS) * 0.08838834764831845f, rk_ = rsqrtf(wave_sum(k0 * k0 + k1 * k1) + L2_EPS);
            q0 *= rq_; q1 *= rq_; k0 *= rk_; k1 *= rk_;
            const size_t ro = (rb + t) * D;
            *(unsigned*)(Qn + ro + pcol) = cvt_pk_bf16(q0, q1); *(unsigned*)(Kn + ro + pcol) = cvt_pk_bf16(k0, k1); *(unsigned*)(Vc + ro + col) = cvt_pk_bf16(v0, v1);
        }
    }
    { const int i = lane & 31, dir = lane >> 5; const size_t row = rb + t_base + i; const float* AB = (const float*)(ws + WS_AB);
      const float a_raw = AB[row * 32 + dir * 8 + h], b_raw = AB[row * 32 + 16 + dir * 8 + h];
      const float g = -__expf(p.in[8][dir * 8 + h]) * softplusf_(a_raw + p.in[9][dir * 8 + h]);
      ((float*)(ws + WS_G))[row * 16 + dir * 8 + h] = g; ((float*)(ws + WS_BETA))[row * 16 + dir * 8 + h] = sigmoidf_(b_raw); }
}
DI void naive_scan(const Params& p, float* ldsw, int task, int lane) {
    unsigned char* ws = p.ws;
    const bf16_t* Qn = (const bf16_t*)(ws + 4 * UNIT); const bf16_t* Kn = (const bf16_t*)(ws + 5 * UNIT); const bf16_t* Vc = (const bf16_t*)p.out;
    const float* G = (const float*)(ws + WS_G); const float* BE = (const float*)(ws + WS_BETA);
    const int chain = task >> 1, b = chain >> 4, dir = (chain >> 3) & 1, h = chain & 7, e = (task & 1) * 64 + lane;
    bf16_t* O = (dir ? (bf16_t*)(p.out) + (size_t)M * D : (bf16_t*)(ws + 3 * UNIT));
    float* kb = ldsw; float* qb = ldsw + 128;
    float P[128];
#pragma unroll
    for (int d = 0; d < 128; ++d) P[d] = 0.f;
    for (int n = 0; n < SEQ; ++n) {
        const int t = dir ? SEQ - 1 - n : n; const size_t row = (size_t)b * SEQ + t;
        const unsigned ku = *(const unsigned*)(Kn + row * D + h * 128 + 2 * lane), qu = *(const unsigned*)(Qn + row * D + h * 128 + 2 * lane);
        const float v = bf1(Vc[row * D + h * 128 + e]); const float al = __expf(G[row * 16 + dir * 8 + h]), be = BE[row * 16 + dir * 8 + h];
        kb[2 * lane] = bf_lo(ku); kb[2 * lane + 1] = bf_hi(ku); qb[2 * lane] = bf_lo(qu); qb[2 * lane + 1] = bf_hi(qu);
        asm volatile("s_waitcnt lgkmcnt(0)" ::: "memory");
        float sk = 0.f;
#pragma unroll
        for (int d4 = 0; d4 < 32; ++d4) { if ((d4 & 3) == 0) __builtin_amdgcn_sched_barrier(0); const f32x4 k4 = *(const f32x4*)(kb + 4 * d4); sk += P[4 * d4] * k4.x + P[4 * d4 + 1] * k4.y + P[4 * d4 + 2] * k4.z + P[4 * d4 + 3] * k4.w; }
        const float vn = be * (v - al * sk); float o = 0.f;
#pragma unroll
        for (int d4 = 0; d4 < 32; ++d4) { if ((d4 & 3) == 0) __builtin_amdgcn_sched_barrier(0); const f32x4 k4 = *(const f32x4*)(kb + 4 * d4), q4 = *(const f32x4*)(qb + 4 * d4);
            P[4 * d4] = al * P[4 * d4] + k4.x * vn; P[4 * d4 + 1] = al * P[4 * d4 + 1] + k4.y * vn; P[4 * d4 + 2] = al * P[4 * d4 + 2] + k4.z * vn; P[4 * d4 + 3] = al * P[4 * d4 + 3] + k4.w * vn;
            o += P[4 * d4] * q4.x + P[4 * d4 + 1] * q4.y + P[4 * d4 + 2] * q4.z + P[4 * d4 + 3] * q4.w; }
        O[row * D + h * 128 + e] = (bf16_t)(cvt_pk_bf16(o, 0.f) & 0xffffu);
        asm volatile("s_waitcnt lgkmcnt(0)" ::: "memory");
    }
}
DI void ya_acc(float (&acc)[8], const u32x4& pv, const f32x4& wa, const f32x4& wb) {
    acc[0] += wa.x * bf_lo(pv.x); acc[1] += wa.y * bf_hi(pv.x); acc[2] += wa.z * bf_lo(pv.y); acc[3] += wa.w * bf_hi(pv.y);
    acc[4] += wb.x * bf_lo(pv.z); acc[5] += wb.y * bf_hi(pv.z); acc[6] += wb.z * bf_lo(pv.w); acc[7] += wb.w * bf_hi(pv.w);
}
DI void phase7(const Params& p, int gw, int NGW, int lane, int gtid, int NGT) {
    unsigned char* ws = p.ws;
    const bf16_t* Pb = (const bf16_t*)(ws + 1 * UNIT); bf16_t* R = (bf16_t*)(ws + 2 * UNIT); const float* cw = p.in[6];
    for (int it = gtid; it < (M / 4) * 128; it += NGT) {
        const int row0 = (it >> 7) * 4, c8 = (it & 127) * 8, t0 = row0 & (SEQ - 1);
        const u32x4 z = (u32x4){0u, 0u, 0u, 0u};
        u32x4 pv[6], rv[4];
        { const u32x4 t_ = *(const u32x4*)(Pb + (size_t)(t0 > 0 ? row0 - 1 : row0) * D + c8); pv[0] = t0 > 0 ? t_ : z; }
#pragma unroll
        for (int j = 0; j < 4; ++j) { pv[j + 1] = *(const u32x4*)(Pb + (size_t)(row0 + j) * D + c8); rv[j] = *(const u32x4*)(R + (size_t)(row0 + j) * D + c8); }
        { const u32x4 t_ = *(const u32x4*)(Pb + (size_t)(t0 + 4 < SEQ ? row0 + 4 : row0) * D + c8); pv[5] = t0 + 4 < SEQ ? t_ : z; }
        f32x4 wa[3], wb[3];
#pragma unroll
        for (int j = 0; j < 3; ++j) { wa[j] = *(const f32x4*)(cw + j * D + c8); wb[j] = *(const f32x4*)(cw + j * D + c8 + 4); }
#pragma unroll
        for (int j = 0; j < 4; ++j) {
            float acc[8] = {0.f, 0.f, 0.f, 0.f, 0.f, 0.f, 0.f, 0.f};
            ya_acc(acc, pv[j], wa[0], wb[0]); ya_acc(acc, pv[j + 1], wa[1], wb[1]); ya_acc(acc, pv[j + 2], wa[2], wb[2]);
            u32x4 o; const u32x4 r = rv[j];
            o.x = cvt_pk_bf16(bf_lo(r.x) * acc[0], bf_hi(r.x) * acc[1]); o.y = cvt_pk_bf16(bf_lo(r.y) * acc[2], bf_hi(r.y) * acc[3]);
            o.z = cvt_pk_bf16(bf_lo(r.z) * acc[4], bf_hi(r.z) * acc[5]); o.w = cvt_pk_bf16(bf_lo(r.w) * acc[6], bf_hi(r.w) * acc[7]);
            *(u32x4*)(R + (size_t)(row0 + j) * D + c8) = o;
        }
    }
    const bf16_t* Of = (const bf16_t*)(ws + 3 * UNIT); const bf16_t* Ob = (const bf16_t*)p.out + (size_t)M * D; bf16_t* SZ = (bf16_t*)(ws + 6 * UNIT);
    const f32x4 g0 = *(const f32x4*)(p.in[10] + (lane & 15) * 8), g1 = *(const f32x4*)(p.in[10] + (lane & 15) * 8 + 4);
    for (int rp = gw; rp < M / 2; rp += NGW) {
        u32x4 a[4], bb[4], zz[4];
#pragma unroll
        for (int u = 0; u < 4; ++u) { const size_t off = (size_t)(rp * 2 + (u >> 1)) * D + (u & 1) * 512 + lane * 8;
            a[u] = __builtin_nontemporal_load((const u32x4*)(Of + off)); bb[u] = __builtin_nontemporal_load((const u32x4*)(Ob + off)); zz[u] = __builtin_nontemporal_load((const u32x4*)(SZ + off)); }
#pragma unroll
        for (int u = 0; u < 4; ++u) { const size_t off = (size_t)(rp * 2 + (u >> 1)) * D + (u & 1) * 512 + lane * 8;
            float o[8];
            o[0] = bf_lo(a[u].x) + bf_lo(bb[u].x); o[1] = bf_hi(a[u].x) + bf_hi(bb[u].x); o[2] = bf_lo(a[u].y) + bf_lo(bb[u].y); o[3] = bf_hi(a[u].y) + bf_hi(bb[u].y);
            o[4] = bf_lo(a[u].z) + bf_lo(bb[u].z); o[5] = bf_hi(a[u].z) + bf_hi(bb[u].z); o[6] = bf_lo(a[u].w) + bf_lo(bb[u].w); o[7] = bf_hi(a[u].w) + bf_hi(bb[u].w);
            float ss = 0.f;
#pragma unroll
            for (int j = 0; j < 8; ++j) ss += o[j] * o[j];
            ss = row16_sum(ss);
            const float rs = rsqrtf(ss * (1.f / 128.f) + NORM_EPS);
            u32x4 w;
            w.x = cvt_pk_bf16(o[0] * rs * g0.x * bf_lo(zz[u].x), o[1] * rs * g0.y * bf_hi(zz[u].x)); w.y = cvt_pk_bf16(o[2] * rs * g0.z * bf_lo(zz[u].y), o[3] * rs * g0.w * bf_hi(zz[u].y));
            w.z = cvt_pk_bf16(o[4] * rs * g1.x * bf_lo(zz[u].z), o[5] * rs * g1.y * bf_hi(zz[u].z)); w.w = cvt_pk_bf16(o[6] * rs * g1.z * bf_lo(zz[u].w), o[7] * rs * g1.w * bf_hi(zz[u].w));
            *(u32x4*)(SZ + off) = w;
        }
    }
}
DI void phase7_panel(const Params& p, int pm, int pn, int tid, int lane, int wave) {
    unsigned char* ws = p.ws;
    const bf16_t* Pb = (const bf16_t*)(ws + 1 * UNIT); bf16_t* R = (bf16_t*)(ws + 2 * UNIT); const float* cw = p.in[6];
#pragma unroll 1
    for (int i = 0; i < 4; ++i) {
        const int it = tid + NTHREADS * i; const int row0 = 256 * pm + 4 * (it >> 5), c8 = 256 * pn + 8 * (it & 31), t0 = row0 & (SEQ - 1);
        const u32x4 z = (u32x4){0u, 0u, 0u, 0u};
        u32x4 pv[6], rv[4];
        { const u32x4 t_ = *(const u32x4*)(Pb + (size_t)(t0 > 0 ? row0 - 1 : row0) * D + c8); pv[0] = t0 > 0 ? t_ : z; }
#pragma unroll
        for (int j = 0; j < 4; ++j) { pv[j + 1] = *(const u32x4*)(Pb + (size_t)(row0 + j) * D + c8); rv[j] = *(const u32x4*)(R + (size_t)(row0 + j) * D + c8); }
        { const u32x4 t_ = *(const u32x4*)(Pb + (size_t)(t0 + 4 < SEQ ? row0 + 4 : row0) * D + c8); pv[5] = t0 + 4 < SEQ ? t_ : z; }
        f32x4 wa[3], wb[3];
#pragma unroll
        for (int j = 0; j < 3; ++j) { wa[j] = *(const f32x4*)(cw + j * D + c8); wb[j] = *(const f32x4*)(cw + j * D + c8 + 4); }
#pragma unroll
        for (int j = 0; j < 4; ++j) {
            float acc[8] = {0.f, 0.f, 0.f, 0.f, 0.f, 0.f, 0.f, 0.f};
            ya_acc(acc, pv[j], wa[0], wb[0]); ya_acc(acc, pv[j + 1], wa[1], wb[1]); ya_acc(acc, pv[j + 2], wa[2], wb[2]);
            u32x4 o; const u32x4 r = rv[j];
            o.x = cvt_pk_bf16(bf_lo(r.x) * acc[0], bf_hi(r.x) * acc[1]); o.y = cvt_pk_bf16(bf_lo(r.y) * acc[2], bf_hi(r.y) * acc[3]);
            o.z = cvt_pk_bf16(bf_lo(r.z) * acc[4], bf_hi(r.z) * acc[5]); o.w = cvt_pk_bf16(bf_lo(r.w) * acc[6], bf_hi(r.w) * acc[7]);
            store_wt16(R + (size_t)(row0 + j) * D + c8, o);
        }
    }
    const bf16_t* Of = (const bf16_t*)(ws + 3 * UNIT); const bf16_t* Ob = (const bf16_t*)p.out + (size_t)M * D; bf16_t* SZ = (bf16_t*)(ws + 6 * UNIT);
    const f32x4 g0 = *(const f32x4*)(p.in[10] + (lane & 15) * 8), g1 = *(const f32x4*)(p.in[10] + (lane & 15) * 8 + 4);
#pragma unroll 1
    for (int i = 0; i < 4; ++i) {
        u32x4 a[4], bb[4], zz[4];
#pragma unroll
        for (int u = 0; u < 4; ++u) { const size_t off = (size_t)(256 * pm + 32 * wave + 8 * i + 2 * u + (lane >> 5)) * D + 256 * pn + (lane & 31) * 8;
            a[u] = __builtin_nontemporal_load((const u32x4*)(Of + off)); bb[u] = __builtin_nontemporal_load((const u32x4*)(Ob + off)); zz[u] = __builtin_nontemporal_load((const u32x4*)(SZ + off)); }
#pragma unroll
        for (int u = 0; u < 4; ++u) { const size_t off = (size_t)(256 * pm + 32 * wave + 8 * i + 2 * u + (lane >> 5)) * D + 256 * pn + (lane & 31) * 8;
            float o[8];
            o[0] = bf_lo(a[u].x) + bf_lo(bb[u].x); o[1] = bf_hi(a[u].x) + bf_hi(bb[u].x); o[2] = bf_lo(a[u].y) + bf_lo(bb[u].y); o[3] = bf_hi(a[u].y) + bf_hi(bb[u].y);
            o[4] = bf_lo(a[u].z) + bf_lo(bb[u].z); o[5] = bf_hi(a[u].z) + bf_hi(bb[u].z); o[6] = bf_lo(a[u].w) + bf_lo(bb[u].w); o[7] = bf_hi(a[u].w) + bf_hi(bb[u].w);
            float ss = 0.f;
#pragma unroll
            for (int j = 0; j < 8; ++j) ss += o[j] * o[j];
            ss = row16_sum(ss);
            const float rs = rsqrtf(ss * (1.f / 128.f) + NORM_EPS);
            u32x4 w;
            w.x = cvt_pk_bf16(o[0] * rs * g0.x * bf_lo(zz[u].x), o[1] * rs * g0.y * bf_hi(zz[u].x)); w.y = cvt_pk_bf16(o[2] * rs * g0.z * bf_lo(zz[u].y), o[3] * rs * g0.w * bf_hi(zz[u].y));
            w.z = cvt_pk_bf16(o[4] * rs * g1.x * bf_lo(zz[u].z), o[5] * rs * g1.y * bf_hi(zz[u].z)); w.w = cvt_pk_bf16(o[6] * rs * g1.z * bf_lo(zz[u].w), o[7] * rs * g1.w * bf_hi(zz[u].w));
            store_wt16(SZ + off, w);
        }
    }
}
DI void phase10(const Params& p, int gw, int NGW, int lane) {
    const float* XN = (const float*)(p.ws + 0 * UNIT); const float* fw = p.in[14];
    f32x4 w[4];
#pragma unroll
    for (int j = 0; j < 4; ++j) w[j] = *((const f32x4*)fw + lane + 64 * j);
    for (int m = gw; m < M; m += NGW) {
        const f32x4* xr = (const f32x4*)(XN + (size_t)m * D) + lane; f32x4 v[4]; float s = 0.f;
#pragma unroll
        for (int j = 0; j < 4; ++j) { v[j] = xr[64 * j]; s += (v[j].x * v[j].x + v[j].y * v[j].y) + (v[j].z * v[j].z + v[j].w * v[j].w); }
        const float rstd = rsqrtf(wave_sum(s) * (1.f / D) + NORM_EPS);
        f32x4* o = (f32x4*)(p.out + (size_t)m * D) + lane;
#pragma unroll
        for (int j = 0; j < 4; ++j) o[64 * j] = v[j] * rstd * w[j];
    }
}
#define MFMA16(a, b, c) __builtin_amdgcn_mfma_f32_16x16x32_bf16((a), (b), (c), 0, 0, 0)
DI void chunk_prep_item(const Params& p, float* Lm, int item, int lane) {
    unsigned char* ws = p.ws;
    const bf16_t* Qn = (const bf16_t*)(ws + 4 * UNIT); const bf16_t* Kn = (const bf16_t*)(ws + 5 * UNIT);
    bf16_t* TF = (bf16_t*)(ws + 1 * UNIT) + (size_t)item * 4096; bf16_t* AF = (bf16_t*)(ws + 2 * UNIT) + (size_t)item * 4096;
    float* csc = (float*)(ws + WS_CSC) + (size_t)item * 192;
    const int c = item & 127, h = (item >> 7) & 7, dir = (item >> 10) & 1, b = item >> 11;
    const size_t rb = (size_t)b * SEQ + c * 64; const int il = lane & 15, q = lane >> 4;
    const int tl = dir ? 63 - lane : lane;
    const float g = ((const float*)(ws + WS_G))[(rb + tl) * 16 + dir * 8 + h], be = ((const float*)(ws + WS_BETA))[(rb + tl) * 16 + dir * 8 + h];
    float gc = g;
#pragma unroll
    for (int o = 1; o < 64; o <<= 1) { const float v = __shfl_up(gc, o); if (lane >= o) gc += v; }
    const float gl = __shfl(gc, 63);
    csc[tl] = __expf(gc); csc[64 + tl] = be; csc[128 + tl] = __expf(gl - gc);
    float gcr[4][4], ber[4][4], gcc[4];
#pragma unroll
    for (int t = 0; t < 4; ++t) { gcc[t] = __shfl(gc, 16 * t + il);
#pragma unroll
        for (int r = 0; r < 4; ++r) { gcr[t][r] = __shfl(gc, 16 * t + 4 * q + r); ber[t][r] = __shfl(be, 16 * t + 4 * q + r); } }
    bf16x8 Kf[4][4];
#pragma unroll
    for (int rt = 0; rt < 4; ++rt) { const int ip = 16 * rt + il; const size_t ro = (rb + (dir ? 63 - ip : ip)) * D + h * 128 + 8 * q;
#pragma unroll
        for (int ks = 0; ks < 4; ++ks) Kf[rt][ks] = *(const bf16x8*)(Kn + ro + 32 * ks); }
#pragma unroll
    for (int it = 0; it < 4; ++it)
#pragma unroll
        for (int jt = 0; jt <= it; ++jt) {
            f32x4 acc = {0.f, 0.f, 0.f, 0.f};
#pragma unroll
            for (int ks = 0; ks < 4; ++ks) acc = MFMA16(Kf[it][ks], Kf[jt][ks], acc);
#pragma unroll
            for (int r = 0; r < 4; ++r) { const int ip = 16 * it + 4 * q + r, jp = 16 * jt + il;
                Lm[ip * 64 + jp] = ip > jp ? ber[it][r] * acc[r] * __expf(gcr[it][r] - gcc[jt]) : 0.f; }
        }
    __builtin_amdgcn_sched_barrier(0);
    bf16x8 Qnext[4];
    { const int ip = il; const size_t ro = (rb + (dir ? 63 - ip : ip)) * D + h * 128 + 8 * q;
#pragma unroll
      for (int ks = 0; ks < 4; ++ks) Qnext[ks] = *(const bf16x8*)(Qn + ro + 32 * ks); }
#pragma unroll
    for (int mt = 0; mt < 4; ++mt) {
        bf16x8 Qf[4];
#pragma unroll
        for (int ks = 0; ks < 4; ++ks) Qf[ks] = Qnext[ks];
        if (mt < 3) { const int ip = 16 * (mt + 1) + il; const size_t ro = (rb + (dir ? 63 - ip : ip)) * D + h * 128 + 8 * q;
#pragma unroll
          for (int ks = 0; ks < 4; ++ks) Qnext[ks] = *(const bf16x8*)(Qn + ro + 32 * ks); }
#pragma unroll
        for (int ks2 = 0; ks2 < 2; ++ks2) {
            float vals[8];
#pragma unroll
            for (int a = 0; a < 2; ++a) { const int jt = 2 * ks2 + a; f32x4 acc = {0.f, 0.f, 0.f, 0.f};
#pragma unroll
                for (int ks = 0; ks < 4; ++ks) acc = MFMA16(Kf[jt][ks], Qf[ks], acc);
#pragma unroll
                for (int r = 0; r < 4; ++r) { const int jp = 16 * jt + 4 * q + r, ip = 16 * mt + il; vals[4 * a + r] = ip >= jp ? acc[r] * __expf(gcc[mt] - gcr[jt][r]) : 0.f; } }
            u32x4 w;
            if (dir) { w.x = cvt_pk_bf16(vals[7], vals[6]); w.y = cvt_pk_bf16(vals[5], vals[4]); w.z = cvt_pk_bf16(vals[3], vals[2]); w.w = cvt_pk_bf16(vals[1], vals[0]); }
            else { w.x = cvt_pk_bf16(vals[0], vals[1]); w.y = cvt_pk_bf16(vals[2], vals[3]); w.z = cvt_pk_bf16(vals[4], vals[5]); w.w = cvt_pk_bf16(vals[6], vals[7]); }
            const int fi = dir ? ((3 - mt) * 2 + (1 - ks2)) : (mt * 2 + ks2), ln = dir ? ((3 - q) * 16 + (15 - il)) : lane;
            *(u32x4*)(AF + (size_t)(fi * 64 + ln) * 8) = w;
        }
        __builtin_amdgcn_sched_barrier(0);
    }
    asm volatile("s_waitcnt lgkmcnt(0)" ::: "memory");
    __builtin_amdgcn_sched_barrier(0);
    float T[64];
#pragma unroll
    for (int i = 0; i < 64; ++i) {
        float s0 = (lane == i) ? 1.f : 0.f, s1 = 0.f;
#pragma unroll
        for (int m4 = 0; m4 < (i + 3) / 4; ++m4) {
            const f32x4 l4 = *(const f32x4*)(Lm + i * 64 + 4 * m4);
            if (4 * m4 + 0 < i) s0 -= l4.x * T[4 * m4 + 0];
            if (4 * m4 + 1 < i) s1 -= l4.y * T[4 * m4 + 1];
            if (4 * m4 + 2 < i) s0 -= l4.z * T[4 * m4 + 2];
            if (4 * m4 + 3 < i) s1 -= l4.w * T[4 * m4 + 3];
        }
        T[i] = s0 + s1;
        if ((i & 3) == 3) __builtin_amdgcn_sched_barrier(0);
    }
    asm volatile("s_waitcnt lgkmcnt(0)" ::: "memory");
    bf16_t* TL = (bf16_t*)Lm;
#pragma unroll
    for (int i = 0; i < 64; ++i) TL[i * 72 + lane] = (bf16_t)(cvt_pk_bf16(T[i], 0.f) & 0xffffu);
    asm volatile("s_waitcnt lgkmcnt(0)" ::: "memory");
#pragma unroll
    for (int mt = 0; mt < 4; ++mt)
#pragma unroll
        for (int ks2 = 0; ks2 < 2; ++ks2) {
            u32x4 w;
            if (dir) {
                const int row = 63 - 16 * mt - il;
                const u32x2 lo = *(const u32x2*)(TL + row * 72 + (60 - 32 * ks2 - 4 * q)), hi = *(const u32x2*)(TL + row * 72 + (44 - 32 * ks2 - 4 * q));
                w.x = (lo.y >> 16) | (lo.y << 16); w.y = (lo.x >> 16) | (lo.x << 16); w.z = (hi.y >> 16) | (hi.y << 16); w.w = (hi.x >> 16) | (hi.x << 16);
            } else {
                const int row = 16 * mt + il;
                const u32x2 lo = *(const u32x2*)(TL + row * 72 + (32 * ks2 + 4 * q)), hi = *(const u32x2*)(TL + row * 72 + (32 * ks2 + 16 + 4 * q));
                w.x = lo.x; w.y = lo.y; w.z = hi.x; w.w = hi.y;
            }
            *(u32x4*)(TF + (size_t)((mt * 2 + ks2) * 64 + lane) * 8) = w;
        }
    asm volatile("s_waitcnt lgkmcnt(0)" ::: "memory");
}
DI bf16x8 pack8(const f32x4& a, const f32x4& b) {
    u32x4 w; w.x = cvt_pk_bf16(a[0], a[1]); w.y = cvt_pk_bf16(a[2], a[3]); w.z = cvt_pk_bf16(b[0], b[1]); w.w = cvt_pk_bf16(b[2], b[3]);
    return __builtin_bit_cast(bf16x8, w);
}
DI void mfma_scan(const Params& p, int chain, int slice, int lane) {
    unsigned char* ws = p.ws;
    const bf16_t* Qn = (const bf16_t*)(ws + 4 * UNIT); const bf16_t* Kn = (const bf16_t*)(ws + 5 * UNIT); const bf16_t* KT = (const bf16_t*)(ws + 6 * UNIT); const bf16_t* Vc = (const bf16_t*)p.out;
    const bf16_t* TFb = (const bf16_t*)(ws + 1 * UNIT); const bf16_t* AFb = (const bf16_t*)(ws + 2 * UNIT); const float* cscb = (const float*)(ws + WS_CSC);
    const int b = chain >> 4, dir = (chain >> 3) & 1, h = chain & 7, il = lane & 15, q = lane >> 4;
    bf16_t* O = (dir ? (bf16_t*)(p.out) + (size_t)M * D : (bf16_t*)(ws + 3 * UNIT));
    f32x4 S[8];
#pragma unroll
    for (int dt = 0; dt < 8; ++dt) S[dt] = (f32x4){0.f, 0.f, 0.f, 0.f};
    for (int n = 0; n < 128; ++n) {
        const int c = dir ? 127 - n : n; const int item = chain * 128 + c; const size_t rowbase = (size_t)b * SEQ + c * 64;
        const bf16_t* TF = TFb + (size_t)item * 4096 + lane * 8; const bf16_t* AF = AFb + (size_t)item * 4096 + lane * 8; const float* csc = cscb + (size_t)item * 192;
        const float gl = csc[dir ? 0 : 63];
        f32x4 EG[4], BE[4], EK[4], V[4];
#pragma unroll
        for (int mt = 0; mt < 4; ++mt) { EG[mt] = *(const f32x4*)(csc + 16 * mt + 4 * q); BE[mt] = *(const f32x4*)(csc + 64 + 16 * mt + 4 * q); EK[mt] = *(const f32x4*)(csc + 128 + 16 * mt + 4 * q);
#pragma unroll
            for (int r = 0; r < 4; ++r) V[mt][r] = bf1(Vc[(rowbase + 16 * mt + 4 * q + r) * D + h * 128 + 16 * slice + il]); }
        bf16x8 Sb[4];
#pragma unroll
        for (int ks = 0; ks < 4; ++ks) Sb[ks] = pack8(S[2 * ks], S[2 * ks + 1]);
        f32x4 KS[4], QS[4];
#pragma unroll
        for (int mt = 0; mt < 4; ++mt) { const size_t ro = (rowbase + 16 * mt + il) * D + h * 128 + 8 * q;
            KS[mt] = (f32x4){0.f, 0.f, 0.f, 0.f}; QS[mt] = (f32x4){0.f, 0.f, 0.f, 0.f};
#pragma unroll
            for (int ks = 0; ks < 4; ++ks) { KS[mt] = MFMA16(*(const bf16x8*)(Kn + ro + 32 * ks), Sb[ks], KS[mt]); QS[mt] = MFMA16(*(const bf16x8*)(Qn + ro + 32 * ks), Sb[ks], QS[mt]); } }
        f32x4 X[4];
#pragma unroll
        for (int mt = 0; mt < 4; ++mt) X[mt] = BE[mt] * (V[mt] - EG[mt] * KS[mt]);
        bf16x8 Xb[2] = {pack8(X[0], X[1]), pack8(X[2], X[3])};
        f32x4 VN[4];
#pragma unroll
        for (int mt = 0; mt < 4; ++mt) { VN[mt] = (f32x4){0.f, 0.f, 0.f, 0.f};
#pragma unroll
            for (int ks2 = 0; ks2 < 2; ++ks2) VN[mt] = MFMA16(*(const bf16x8*)(TF + (size_t)((mt * 2 + ks2) * 64) * 8), Xb[ks2], VN[mt]); }
        bf16x8 VNb[2] = {pack8(VN[0], VN[1]), pack8(VN[2], VN[3])};
        bf16x8 VNs[2] = {pack8(VN[0] * EK[0], VN[1] * EK[1]), pack8(VN[2] * EK[2], VN[3] * EK[3])};
#pragma unroll
        for (int mt = 0; mt < 4; ++mt) { f32x4 o = EG[mt] * QS[mt];
#pragma unroll
            for (int ks2 = 0; ks2 < 2; ++ks2) o = MFMA16(*(const bf16x8*)(AF + (size_t)((mt * 2 + ks2) * 64) * 8), VNb[ks2], o);
#pragma unroll
            for (int r = 0; r < 4; ++r) O[(rowbase + 16 * mt + 4 * q + r) * D + h * 128 + 16 * slice + il] = (bf16_t)(cvt_pk_bf16(o[r], 0.f) & 0xffffu); }
#pragma unroll
        for (int dt = 0; dt < 8; ++dt) { const bf16_t* kt = KT + ((size_t)((b * 8 + h) * 128 + 16 * dt + il)) * SEQ + c * 64 + 8 * q; f32x4 s = S[dt] * gl;
#pragma unroll
            for (int ks2 = 0; ks2 < 2; ++ks2) s = MFMA16(*(const bf16x8*)(kt + 32 * ks2), VNs[ks2], s);
            S[dt] = s; }
    }
}
constexpr int SC_K = 0, SC_Q = 16384, SC_T = 32768, SC_A = 40960, SC_V = 49152, SC_C = 51200, SC_BUF = 52224, SC_NPIECE = 3248, SC_NLD = 384, SC_PPL = 9;
constexpr int SC_SB = 2 * SC_BUF, SC_VB = SC_SB + 2 * 4096, SC_END = SC_VB + 2 * 2048;
static_assert(SC_END <= LDS_BYTES - 256, "scan LDS");
typedef short s16x4_t __attribute__((ext_vector_type(4)));
#define SC_BAR() do { asm volatile("s_waitcnt lgkmcnt(0)" ::: "memory"); __builtin_amdgcn_s_barrier(); asm volatile("" ::: "memory"); } while (0)
DI void scan_task(const Params& p, PG8_LAS unsigned char* lds, int chain, int slice, int tid, int wave, int lane) {
    unsigned char* ws = p.ws;
    const int b = chain >> 4, dir = (chain >> 3) & 1, h = chain & 7, il = lane & 15, q = lane >> 4;
    const int c0 = dir ? 127 : 0; const long sgn = dir ? -1 : 1;
    if (wave >= 2) {
        const int lt = tid - 128; const int wbase = 64 * (wave - 2);
        const unsigned char* gp[SC_PPL]; int gstride[SC_PPL];
        const size_t rowbase0 = (size_t)b * SEQ + c0 * 64; const size_t item0 = (size_t)chain * 128 + c0;
#pragma unroll
        for (int k = 0; k < SC_PPL; ++k) {
            int pid = lt + SC_NLD * k; if (pid >= SC_NPIECE) pid -= 64;
            const unsigned char* g = ws; int st = 0;
            if (pid < 2048) { const int pp = pid & 1023, row = pp >> 4, ch = (pp & 15) ^ (row & 15);
                g = ws + (pid < 1024 ? 5 : 4) * UNIT + ((rowbase0 + row) * D + h * 128) * 2 + ch * 16; st = 64 * D * 2; }
            else if (pid < 3072) { const int pp = pid & 511; const bool isT = pid < 2560;
                g = ws + (isT ? 1 : 2) * UNIT + item0 * 8192 + pp * 16; st = 8192; }
            else if (pid < 3200) { const int pp = pid - 3072, row = pp >> 1, hf = pp & 1;
                g = (const unsigned char*)p.out + ((rowbase0 + row) * D + h * 128 + slice * 16) * 2 + hf * 16; st = 64 * D * 2; }
            else { const int pp = pid - 3200; g = ws + WS_CSC + item0 * 768 + pp * 16; st = 768; }
            gp[k] = g; gstride[k] = st;
        }
#define SC_DMA(bo) do { _Pragma("unroll") for (int k = 0; k < SC_PPL; ++k) { if (wbase + SC_NLD * k < SC_NPIECE) \
            __builtin_amdgcn_global_load_lds((const unsigned*)gp[k], (PG8_LAS unsigned*)(lds + (bo) + (wbase + SC_NLD * k) * 16), 16, 0, 0); gp[k] += sgn * gstride[k]; } } while (0)
        SC_DMA(0u);
        asm volatile("s_waitcnt vmcnt(0)" ::: "memory");
        SC_BAR();
        for (int n = 0; n < 128; ++n) {
            if (n + 1 < 128) SC_DMA((unsigned)(((n + 1) & 1) * SC_BUF));
            asm volatile("s_waitcnt vmcnt(0)" ::: "memory");
            SC_BAR();
        }
#undef SC_DMA
    } else if (wave == 0) {
        f32x4 S[8];
#pragma unroll
        for (int dt = 0; dt < 8; ++dt) S[dt] = (f32x4){0.f, 0.f, 0.f, 0.f};
        bf16x8 Sb[4];
#pragma unroll
        for (int ks = 0; ks < 4; ++ks) { Sb[ks] = pack8(S[2 * ks], S[2 * ks + 1]); *(PG8_LAS bf16x8*)(lds + SC_SB + (ks * 64 + lane) * 16) = Sb[ks]; }
        SC_BAR();
        for (int n = 0; n < 128; ++n) {
            PG8_LAS unsigned char* L = lds + (n & 1) * SC_BUF;
            bf16x8 Kf[4][4];
#pragma unroll
            for (int mt = 0; mt < 4; ++mt)
#pragma unroll
                for (int ks = 0; ks < 4; ++ks) Kf[mt][ks] = *(PG8_LAS bf16x8*)(L + SC_K + (16 * mt + il) * 256 + (((4 * ks + q) ^ il) << 4));
            f32x4 EG[4], BE[4], V[4]; bf16x8 Tf[4][2];
#pragma unroll
            for (int mt = 0; mt < 4; ++mt) { EG[mt] = *(PG8_LAS f32x4*)(L + SC_C + (16 * mt + 4 * q) * 4); BE[mt] = *(PG8_LAS f32x4*)(L + SC_C + 256 + (16 * mt + 4 * q) * 4);
#pragma unroll
                for (int r = 0; r < 4; ++r) V[mt][r] = bf1(*(PG8_LAS bf16_t*)(L + SC_V + (16 * mt + 4 * q + r) * 32 + il * 2));
#pragma unroll
                for (int ks2 = 0; ks2 < 2; ++ks2) Tf[mt][ks2] = *(PG8_LAS bf16x8*)(L + SC_T + ((mt * 2 + ks2) * 64 + lane) * 16); }
            f32x4 KS[4];
#pragma unroll
            for (int mt = 0; mt < 4; ++mt) KS[mt] = (f32x4){0.f, 0.f, 0.f, 0.f};
#pragma unroll
            for (int ks = 0; ks < 4; ++ks)
#pragma unroll
                for (int mt = 0; mt < 4; ++mt) KS[mt] = MFMA16(Kf[mt][ks], Sb[ks], KS[mt]);
            __builtin_amdgcn_sched_barrier(0);
            bf16x8 KTf[8][2]; f32x4 EK[4];
            { const int rr = il >> 2, pc = il & 3;
              PG8_LAS unsigned char* kb = L + SC_K + (4 * q + rr) * 256;
#pragma unroll
              for (int dt = 0; dt < 8; ++dt) {
                const int cho = (((4 * (dt >> 1) + pc) ^ (4 * q + rr)) << 4) + 8 * (dt & 1);
#pragma unroll
                for (int ks2 = 0; ks2 < 2; ++ks2) {
                    const s16x4_t lo_ = __builtin_amdgcn_ds_read_tr16_b64_v4i16((PG8_LAS s16x4_t*)(kb + (32 * ks2) * 256 + cho));
                    const s16x4_t hi_ = __builtin_amdgcn_ds_read_tr16_b64_v4i16((PG8_LAS s16x4_t*)(kb + (32 * ks2 + 16) * 256 + cho));
                    KTf[dt][ks2] = __builtin_shufflevector(lo_, hi_, 0, 1, 2, 3, 4, 5, 6, 7);
                } } }
#pragma unroll
            for (int mt = 0; mt < 4; ++mt) EK[mt] = *(PG8_LAS f32x4*)(L + SC_C + 512 + (16 * mt + 4 * q) * 4);
            const float gl = *(PG8_LAS float*)(L + SC_C + (dir ? 0 : 63) * 4);
            f32x4 X[4];
#pragma unroll
            for (int mt = 0; mt < 4; ++mt) X[mt] = BE[mt] * (V[mt] - EG[mt] * KS[mt]);
            bf16x8 Xb[2] = {pack8(X[0], X[1]), pack8(X[2], X[3])};
            f32x4 VN[4];
#pragma unroll
            for (int mt = 0; mt < 4; ++mt) VN[mt] = (f32x4){0.f, 0.f, 0.f, 0.f};
#pragma unroll
            for (int ks2 = 0; ks2 < 2; ++ks2)
#pragma unroll
                for (int mt = 0; mt < 4; ++mt) VN[mt] = MFMA16(Tf[mt][ks2], Xb[ks2], VN[mt]);
            *(PG8_LAS bf16x8*)(lds + SC_VB + (n & 1) * 2048 + lane * 16) = pack8(VN[0], VN[1]); *(PG8_LAS bf16x8*)(lds + SC_VB + (n & 1) * 2048 + (64 + lane) * 16) = pack8(VN[2], VN[3]);
            bf16x8 VNs[2] = {pack8(VN[0] * EK[0], VN[1] * EK[1]), pack8(VN[2] * EK[2], VN[3] * EK[3])};
#pragma unroll
            for (int dt = 0; dt < 8; ++dt) S[dt] = S[dt] * gl;
#pragma unroll
            for (int ks2 = 0; ks2 < 2; ++ks2)
#pragma unroll
                for (int dt = 0; dt < 8; ++dt) S[dt] = MFMA16(KTf[dt][ks2], VNs[ks2], S[dt]);
#pragma unroll
            for (int ks = 0; ks < 4; ++ks) { Sb[ks] = pack8(S[2 * ks], S[2 * ks + 1]); *(PG8_LAS bf16x8*)(lds + SC_SB + ((n + 1) & 1) * 4096 + (ks * 64 + lane) * 16) = Sb[ks]; }
            SC_BAR();
        }
    } else {
        bf16_t* O = (dir ? (bf16_t*)(p.out) + (size_t)M * D : (bf16_t*)(ws + 3 * UNIT));
        f32x4 Oa[4]; bf16x8 Af[4][2];
#pragma unroll
        for (int mt = 0; mt < 4; ++mt) { Oa[mt] = (f32x4){0.f, 0.f, 0.f, 0.f}; Af[mt][0] = (bf16x8){0, 0, 0, 0, 0, 0, 0, 0}; Af[mt][1] = Af[mt][0]; }
        SC_BAR();
        for (int n = 0; n <= 128; ++n) {
            if (n > 0) {
                const int c = dir ? 128 - n : n - 1; const size_t rowbase = (size_t)b * SEQ + c * 64;
                PG8_LAS unsigned char* vb = lds + SC_VB + ((n - 1) & 1) * 2048;
                bf16x8 VNb[2] = {*(PG8_LAS bf16x8*)(vb + lane * 16), *(PG8_LAS bf16x8*)(vb + (64 + lane) * 16)};
#pragma unroll
                for (int ks2 = 0; ks2 < 2; ++ks2)
#pragma unroll
                    for (int mt = 0; mt < 4; ++mt) Oa[mt] = MFMA16(Af[mt][ks2], VNb[ks2], Oa[mt]);
#pragma unroll
                for (int mt = 0; mt < 4; ++mt)
#pragma unroll
                    for (int r = 0; r < 4; ++r) __builtin_nontemporal_store((bf16_t)(cvt_pk_bf16(Oa[mt][r], 0.f) & 0xffffu), O + (rowbase + 16 * mt + 4 * q + r) * D + h * 128 + 16 * slice + il);
            }
            if (n < 128) {
                PG8_LAS unsigned char* L = lds + (n & 1) * SC_BUF;
                bf16x8 Qf[4][4], Sb[4]; f32x4 EG[4];
#pragma unroll
                for (int ks = 0; ks < 4; ++ks) Sb[ks] = *(PG8_LAS bf16x8*)(lds + SC_SB + (n & 1) * 4096 + (ks * 64 + lane) * 16);
#pragma unroll
                for (int mt = 0; mt < 4; ++mt) {
#pragma unroll
                    for (int ks = 0; ks < 4; ++ks) Qf[mt][ks] = *(PG8_LAS bf16x8*)(L + SC_Q + (16 * mt + il) * 256 + (((4 * ks + q) ^ il) << 4));
                    EG[mt] = *(PG8_LAS f32x4*)(L + SC_C + (16 * mt + 4 * q) * 4);
#pragma unroll
                    for (int ks2 = 0; ks2 < 2; ++ks2) Af[mt][ks2] = *(PG8_LAS bf16x8*)(L + SC_A + ((mt * 2 + ks2) * 64 + lane) * 16); }
                f32x4 QS[4];
#pragma unroll
                for (int mt = 0; mt < 4; ++mt) QS[mt] = (f32x4){0.f, 0.f, 0.f, 0.f};
#pragma unroll
                for (int ks = 0; ks < 4; ++ks)
#pragma unroll
                    for (int mt = 0; mt < 4; ++mt) QS[mt] = MFMA16(Qf[mt][ks], Sb[ks], QS[mt]);
#pragma unroll
                for (int mt = 0; mt < 4; ++mt) Oa[mt] = EG[mt] * QS[mt];
                SC_BAR();
            }
        }
    }
}


typedef const __attribute__((address_space(4))) Params* kparams_t;
#if defined(__HIP_DEVICE_COMPILE__)
DI Params load_params() { kparams_t pp = (kparams_t)__builtin_amdgcn_kernarg_segment_ptr(); asm volatile("" : "+s"(pp)); return *pp; }
#else
DI Params load_params() { return Params{}; }
#endif
#define PP() load_params()
#define XB_TMO      128
#define XB_XCNT(j)  (256  + 64 * (j))
#define XB_XSUB(j)  (1280 + 64 * (j))
#define XB_XGEN(j)  (2304 + 64 * (j))
#define XB_TOP      3328
#define XB_TOPGEN   3392
#define XCD_BAR_WORDS 3456
#define XB_SPIN_CAP (1u << 18)
#define LAS __attribute__((address_space(3)))

__device__ __forceinline__ unsigned xb_ld(unsigned* p)              { return __hip_atomic_load(p, __ATOMIC_RELAXED, __HIP_MEMORY_SCOPE_AGENT); }
__device__ __forceinline__ unsigned xb_add(unsigned* p, unsigned v) { return __hip_atomic_fetch_add(p, v, __ATOMIC_RELAXED, __HIP_MEMORY_SCOPE_AGENT); }
__device__ __forceinline__ unsigned xb_xcc_id() { return (unsigned)__builtin_amdgcn_s_getreg((3 << 11) | 20) & 0xFu; }
#define XB_SPIN(cond, bar) do { unsigned _sp = 0; while (cond) { __builtin_amdgcn_s_sleep(1); \
    if ((++_sp & 255u) == 0u) { if (xb_ld(&(bar)[XB_TMO])) break; if (_sp > XB_SPIN_CAP) { atomicAdd(&(bar)[XB_TMO], 1u); break; } } } } while (0)

struct XcdBarrier {
    unsigned* bar; unsigned x;
    volatile LAS unsigned* st;
};

__device__ __forceinline__ XcdBarrier xcd_barrier_post(unsigned* bar, volatile LAS unsigned* st) {
    XcdBarrier b; b.bar = bar; b.x = xb_xcc_id(); b.st = st;
    if (threadIdx.x == 0) (void)xb_add(&bar[XB_XCNT(b.x)], 1u);
    return b;
}
__device__ __forceinline__ void xcd_barrier_complete(unsigned* bar, unsigned x, unsigned& nloc, unsigned& nx) {
    const unsigned G = gridDim.x * gridDim.y * gridDim.z;
    unsigned sum, cnt, mine, sp = 0u;
    for (;;) {
        sum = 0u; cnt = 0u; mine = 0u;
#pragma unroll
        for (unsigned j = 0; j < 16; ++j) { const unsigned c = xb_ld(&bar[XB_XCNT(j)]); sum += c; cnt += (c > 0u) ? 1u : 0u; mine = (j == x) ? c : mine; }
        if (sum == G) break;
        __builtin_amdgcn_s_sleep(1);
        if ((++sp & 255u) == 0u) { if (xb_ld(&bar[XB_TMO])) break; if (sp > XB_SPIN_CAP) { atomicAdd(&bar[XB_TMO], 1u); break; } }
    }
    nloc = mine > 0u ? mine : 1u; nx = cnt > 0u ? cnt : 1u;
}

__device__ __forceinline__ void xcd_barrier(const XcdBarrier& b) {
    asm volatile("s_waitcnt vmcnt(0)" ::: "memory");
    __syncthreads();
    if (threadIdx.x == 0) {
        unsigned* bar = b.bar;
        __builtin_amdgcn_s_waitcnt(0);
        unsigned nloc = b.st[0], nx = b.st[1];
        if (nloc == 0u) { xcd_barrier_complete(bar, b.x, nloc, nx); b.st[0] = nloc; b.st[1] = nx; }
        const unsigned old = xb_add(&bar[XB_XSUB(b.x)], 1u);
        const unsigned gen = old / nloc;
        if (old + 1u == (gen + 1u) * nloc) {
            __builtin_amdgcn_fence(__ATOMIC_RELEASE, "agent");
            asm volatile("s_waitcnt vmcnt(0)" ::: "memory");
            const unsigned og = xb_add(&bar[XB_TOP], 1u);
            const unsigned tg = og / nx;
            if (og + 1u == (tg + 1u) * nx) xb_add(&bar[XB_TOPGEN], 1u);
            else XB_SPIN(xb_ld(&bar[XB_TOPGEN]) == tg, bar);
            __builtin_amdgcn_fence(__ATOMIC_ACQUIRE, "agent");
            xb_add(&bar[XB_XGEN(b.x)], 1u);
            asm volatile("s_waitcnt vmcnt(0)" ::: "memory");
        } else {
            XB_SPIN(xb_ld(&bar[XB_XGEN(b.x)]) == gen, bar);
            __builtin_amdgcn_fence(__ATOMIC_ACQUIRE, "agent");
            asm volatile("s_waitcnt vmcnt(0)" ::: "memory");
        }
    }
    __syncthreads();
}


constexpr size_t WS_BAR = 255 * MiB + 320 * 1024;
DI int fresh_tid() { int t = threadIdx.x; asm volatile("" : "+v"(t)); return t; }
#define IDS const int tid = fresh_tid(), lane = tid & 63, wave = __builtin_amdgcn_readfirstlane(tid >> 6); const int G = gridDim.x, bx = blockIdx.x; \
    const int gw = bx * NWAVES + wave, NGW = G * NWAVES, gtid = bx * NTHREADS + tid, NGT = G * NTHREADS; (void)lane; (void)gw; (void)NGW; (void)gtid; (void)NGT; (void)wave;
__global__ void __launch_bounds__(NTHREADS, 2) fwd_kernel(Params p) {
    extern __shared__ __attribute__((aligned(16))) unsigned char lds[];
    cg::grid_group grid = cg::this_grid();
    PG8_LAS unsigned char* ldsl = (PG8_LAS unsigned char*)lds;
    if (threadIdx.x < 4) ((PG8_LAS unsigned*)(ldsl + (LDS_BYTES - 256)))[threadIdx.x] = 0u;
    __syncthreads();
    const XcdBarrier bar = xcd_barrier_post((unsigned*)(PP().ws + WS_BAR), (volatile PG8_LAS unsigned*)(ldsl + (LDS_BYTES - 256)));

    { IDS phase0(PP(), gw, NGW, lane); }
    if (PP().ws == nullptr) grid.sync();
    xcd_barrier(bar);
    if (gridDim.x == 256) {
        IDS
        pg8::StaticOrder S1; S1.init(M, D, G, bx); pg8::Unit u1; (void)S1.next(0, u1);
        phase1(PP(), (float*)lds, gw, NGW, lane, tid, 256 * u1.pm + 64 * u1.pn);
        unsigned* cnt = (unsigned*)(PP().ws + WS_PCNT4) + 64 * u1.pm;
        asm volatile("s_waitcnt vmcnt(0)" ::: "memory");
        __syncthreads();
        if (threadIdx.x == 0) __hip_atomic_fetch_add(cnt, 1u, __ATOMIC_RELAXED, __HIP_MEMORY_SCOPE_AGENT);
        if (threadIdx.x < 64) {
            unsigned sp = 0;
            while ((unsigned)__builtin_amdgcn_readfirstlane(__hip_atomic_load(cnt, __ATOMIC_RELAXED, __HIP_MEMORY_SCOPE_AGENT)) < 4u) { __builtin_amdgcn_s_sleep(2); if (++sp > (1u << 22)) break; }
            __builtin_amdgcn_fence(__ATOMIC_ACQUIRE, "agent");
        }
        asm volatile("s_waitcnt vmcnt(0) lgkmcnt(0)" ::: "memory");
        __syncthreads();
    } else {
        { IDS phase1(PP(), (float*)lds, gw, NGW, lane, tid, -1); }
        xcd_barrier(bar);
    }
    {
        const Params q = PP(); unsigned char* ws = q.ws; bf16_t* WIN = (bf16_t*)(ws + WS_WIN); const int G = gridDim.x, bx = blockIdx.x;
        pg8::Gemm g{(const bf16_t*)(ws + 0 * UNIT), WIN + (size_t)ROWS_A * D, M, NB_TILES * 256, D}; pg8::StaticOrder S; S.init(M, NB_TILES * 256, G, bx);
        EpiB E{(bf16_t*)(ws + 1 * UNIT)};
        pg8::gemm_phase<EpiB, pg8::StaticOrder, true, true>(ldsl, g, S, E);
    }
    if (gridDim.x == 256) {
        IDS
        pg8::StaticOrder S1; S1.init(M, D, G, bx); pg8::Unit u1; (void)S1.next(0, u1);
        if (wave < 4) ab_item(PP(), 16 * u1.pm + 4 * u1.pn + wave, lane);
    } else { IDS for (int it = gw; it < M / 16; it += NGW) ab_item(PP(), it, lane); }
    if (gridDim.x == 256) {
        IDS
        pg8::StaticOrder S3; S3.init(M, D, G, bx); pg8::Unit u3; (void)S3.next(0, u3);
        unsigned* cnt = (unsigned*)(PP().ws + WS_PCNT5);
        asm volatile("s_waitcnt vmcnt(0)" ::: "memory");
        __syncthreads();
        if (threadIdx.x == 0) __hip_atomic_fetch_add(cnt + 16 * (u3.pm * 4 + u3.pn), 1u, __ATOMIC_RELAXED, __HIP_MEMORY_SCOPE_AGENT);
        if (threadIdx.x < 64) {
#pragma unroll 1
            for (int dlt = -1; dlt <= 1; dlt += 2) {
                const int pp = u3.pm + dlt;
                if (pp < 0 || pp > 63 || (pp >> 5) != (u3.pm >> 5)) continue;
                unsigned sp = 0;
                while ((unsigned)__builtin_amdgcn_readfirstlane(__hip_atomic_load(cnt + 16 * (pp * 4 + u3.pn), __ATOMIC_RELAXED, __HIP_MEMORY_SCOPE_AGENT)) < 1u) { __builtin_amdgcn_s_sleep(2); if (++sp > (1u << 22)) break; }
            }
#pragma unroll 1
            for (int jj = 0; jj < 4; ++jj) {
                unsigned sp = 0;
                while ((unsigned)__builtin_amdgcn_readfirstlane(__hip_atomic_load(cnt + 16 * (u3.pm * 4 + jj), __ATOMIC_RELAXED, __HIP_MEMORY_SCOPE_AGENT)) < 1u) { __builtin_amdgcn_s_sleep(2); if (++sp > (1u << 22)) break; }
            }
            __builtin_amdgcn_fence(__ATOMIC_ACQUIRE, "agent");
        }
        asm volatile("s_waitcnt vmcnt(0) lgkmcnt(0)" ::: "memory");
        __syncthreads();
        const int b3 = u3.pm >> 5, tg = (u3.pm & 31) * 8 + wave;
#pragma nounroll
        for (int hh = 0; hh < 2; ++hh) { const int l2 = fresh_tid() & 63; phase3_item(PP(), ((b3 * 8 + 2 * u3.pn + hh) << 8) + tg, l2); }
    } else {
        xcd_barrier(bar);
        { IDS for (int it = gw; it < 4096; it += NGW) phase3_item(PP(), it, lane); }
    }
    xcd_barrier(bar);
    { IDS for (int it = gw; it < 4096; it += NGW) chunk_prep_item(PP(), (float*)(lds + wave * 16384), it, lane); }
    xcd_barrier(bar);
    for (int tk = blockIdx.x; tk < 256; tk += gridDim.x) { const int t2 = fresh_tid(); scan_task(PP(), ldsl, (tk & 7) + 8 * (tk >> 6), (tk >> 3) & 7, t2, __builtin_amdgcn_readfirstlane(t2 >> 6), t2 & 63); __syncthreads(); }
    xcd_barrier(bar);
    {
        const Params q = PP(); unsigned char* ws = q.ws; bf16_t* WIN = (bf16_t*)(ws + WS_WIN); const int G = gridDim.x, bx = blockIdx.x;
        pg8::Gemm g{(const bf16_t*)(ws + 0 * UNIT), WIN, M, NA_TILES * 256, D}; pg8::StaticOrder S; S.init(M, NA_TILES * 256, G, bx);
        EpiA E{(bf16_t*)(ws + 1 * UNIT), (bf16_t*)(ws + 4 * UNIT)};
        pg8::gemm_phase<EpiA, pg8::StaticOrder, true, true>(ldsl, g, S, E);
    }
    if (gridDim.x == 256) {
        IDS
        pg8::StaticOrder S7; S7.init(M, D, G, bx); pg8::Unit u7; (void)S7.next(0, u7);
        unsigned* cntA = (unsigned*)(PP().ws + WS_PCNT3);
        asm volatile("s_waitcnt vmcnt(0)" ::: "memory");
        __syncthreads();
        if (threadIdx.x == 0) __hip_atomic_fetch_add(cntA + 64 * u7.pm, 1u, __ATOMIC_RELAXED, __HIP_MEMORY_SCOPE_AGENT);
        if (threadIdx.x < 64) {
            const int plo = u7.pm > 0 ? u7.pm - 1 : 0, phi = u7.pm < 63 ? u7.pm + 1 : 63;
            for (int pp = plo; pp <= phi; ++pp) { unsigned sp = 0;
                while ((unsigned)__builtin_amdgcn_readfirstlane(__hip_atomic_load(cntA + 64 * pp, __ATOMIC_RELAXED, __HIP_MEMORY_SCOPE_AGENT)) < 4u) { __builtin_amdgcn_s_sleep(2); if (++sp > (1u << 22)) break; } }
            __builtin_amdgcn_fence(__ATOMIC_ACQUIRE, "agent");
        }
        asm volatile("s_waitcnt vmcnt(0) lgkmcnt(0)" ::: "memory");
        __syncthreads();
        phase7_panel(PP(), u7.pm, u7.pn, tid, lane, wave);
        unsigned* cnt6 = (unsigned*)(PP().ws + WS_PCNT6) + 64 * u7.pm;
        asm volatile("s_waitcnt vmcnt(0)" ::: "memory");
        __syncthreads();
        if (threadIdx.x == 0) __hip_atomic_fetch_add(cnt6, 1u, __ATOMIC_RELAXED, __HIP_MEMORY_SCOPE_AGENT);
        if (threadIdx.x < 64) {
            unsigned sp = 0;
            while ((unsigned)__builtin_amdgcn_readfirstlane(__hip_atomic_load(cnt6, __ATOMIC_RELAXED, __HIP_MEMORY_SCOPE_AGENT)) < 4u) { __builtin_amdgcn_s_sleep(2); if (++sp > (1u << 22)) break; }
            __builtin_amdgcn_fence(__ATOMIC_ACQUIRE, "agent");
        }
        asm volatile("s_waitcnt vmcnt(0) lgkmcnt(0)" ::: "memory");
        __syncthreads();
    } else {
        xcd_barrier(bar);
        { IDS phase7(PP(), gw, NGW, lane, gtid, NGT); }
        xcd_barrier(bar);
    }
    if (gridDim.x == 256) {
        const Params q = PP(); unsigned char* ws = q.ws; const int G = gridDim.x, bx = blockIdx.x;
        static_assert(6 * UNIT - 2 * UNIT == (size_t)256 * 256 * D * 2 && WS_WPB - WS_WPA == (size_t)4 * 256 * D * 2, "TwoGemmOrder address arithmetic");
        TwoGemmOrder S; S.so.init(M, D, G, bx);
        pg8::Gemm g{(const bf16_t*)(ws + 2 * UNIT), (const bf16_t*)(ws + WS_WPA), M, D, D}; EpiYaYb E{(bf16_t*)(ws + 4 * UNIT), (const bf16_t*)(ws + 5 * UNIT)};
        pg8::gemm_phase<EpiYaYb, TwoGemmOrder, true, true>(ldsl, g, S, E);
    } else {
        const Params q = PP(); unsigned char* ws = q.ws; const int G = gridDim.x, bx = blockIdx.x;
        pg8::StaticOrder S; S.init(M, D, G, bx);
        { pg8::Gemm g{(const bf16_t*)(ws + 2 * UNIT), (const bf16_t*)(ws + WS_WPA), M, D, D}; EpiYa E{(bf16_t*)(ws + 4 * UNIT)};
          pg8::gemm_phase<EpiYa, pg8::StaticOrder, true, true>(ldsl, g, S, E); }
        { pg8::Gemm g{(const bf16_t*)(ws + 6 * UNIT), (const bf16_t*)(ws + WS_WPB), M, D, D}; EpiYb E{(bf16_t*)(ws + 4 * UNIT), (const bf16_t*)(ws + 5 * UNIT)};
          pg8::gemm_phase<EpiYb, pg8::StaticOrder, true, true>(ldsl, g, S, E); }
    }
    if (gridDim.x == 256) {
        pg8::StaticOrder S; S.init(M, D, (int)gridDim.x, (int)blockIdx.x); pg8::Unit u; (void)S.next(0, u);
        unsigned* cnt = (unsigned*)(PP().ws + WS_PCNT2) + 64 * u.pm;
        asm volatile("s_waitcnt vmcnt(0)" ::: "memory");
        __syncthreads();
        if (threadIdx.x == 0) __hip_atomic_fetch_add(cnt, 1u, __ATOMIC_RELAXED, __HIP_MEMORY_SCOPE_AGENT);
        if (threadIdx.x < 64) {
            unsigned sp = 0;
            while ((unsigned)__builtin_amdgcn_readfirstlane(__hip_atomic_load(cnt, __ATOMIC_RELAXED, __HIP_MEMORY_SCOPE_AGENT)) < 4u) { __builtin_amdgcn_s_sleep(2); if (++sp > (1u << 22)) break; }
            if (u.pm >= 32) {
                unsigned* c6 = (unsigned*)(PP().ws + WS_PCNT6);
#pragma unroll 1
                for (int e = 0; e < 2; ++e) { unsigned sq = 0;
                    while ((unsigned)__builtin_amdgcn_readfirstlane(__hip_atomic_load(c6 + 64 * (2 * (u.pm - 32) + e), __ATOMIC_RELAXED, __HIP_MEMORY_SCOPE_AGENT)) < 4u) { __builtin_amdgcn_s_sleep(2); if (++sq > (1u << 22)) break; } }
            }
            __builtin_amdgcn_fence(__ATOMIC_ACQUIRE, "agent");
        }
        asm volatile("s_waitcnt vmcnt(0) lgkmcnt(0)" ::: "memory");
        __syncthreads();
    } else {
        xcd_barrier(bar);
    }
    if (gridDim.x == 256) {
        const Params q = PP(); unsigned char* ws = q.ws; const int G = gridDim.x, bx = blockIdx.x;
        pg8::Gemm g{(const bf16_t*)(ws + 4 * UNIT), (const bf16_t*)(ws + WS_WO), M, D, D}; pg8::StaticOrder S; S.init(M, D, G, bx);
        EpiOutFused E{q.in[0], (const float*)(ws + WS_MODF), q.in[14], q.out, (float*)(ws + WS_PSS), (unsigned*)(ws + WS_PCNT)};
        pg8::gemm_phase<EpiOutFused, pg8::StaticOrder, true, true>(ldsl, g, S, E);
    } else {
        {
            const Params q = PP(); unsigned char* ws = q.ws; const int G = gridDim.x, bx = blockIdx.x;
            pg8::Gemm g{(const bf16_t*)(ws + 4 * UNIT), (const bf16_t*)(ws + WS_WO), M, D, D}; pg8::StaticOrder S; S.init(M, D, G, bx);
            EpiOut E{q.in[0], (const float*)(ws + WS_MODF), (float*)(ws + 0 * UNIT)};
            pg8::gemm_phase<EpiOut, pg8::StaticOrder, true, true>(ldsl, g, S, E);
        }
        xcd_barrier(bar);
        { IDS phase10(PP(), gw, NGW, lane); }
    }
}

extern "C" void kernel_launch(void* const* d_in, const int* in_sizes, int n_in, void* d_out, int out_size, void* d_ws, size_t ws_size, hipStream_t stream) {
    static int grid = 0;
    if (grid == 0) {
        int dev = 0, cus = 0, per_cu = 0;
        if (n_in != 15 || out_size != M * D || ws_size < 256 * MiB) { fprintf(stderr, "kernel_launch: unexpected shapes (n_in %d out %d ws %zu)\n", n_in, out_size, ws_size); grid = -1; return; }
        hipGetDevice(&dev); hipDeviceGetAttribute(&cus, hipDeviceAttributeMultiprocessorCount, dev);
        if (hipFuncSetAttribute((const void*)fwd_kernel, hipFuncAttributeMaxDynamicSharedMemorySize, LDS_BYTES) != hipSuccess) { fprintf(stderr, "kernel_launch: hipFuncSetAttribute failed\n"); grid = -1; return; }
        hipOccupancyMaxActiveBlocksPerMultiprocessor(&per_cu, (const void*)fwd_kernel, NTHREADS, LDS_BYTES);
        if (per_cu < 1) { fprintf(stderr, "kernel_launch: occupancy query says %d blocks/CU\n", per_cu); per_cu = 1; }
        (void)hipGetLastError();
        grid = cus;
    }
    if (grid < 0) return;
    if (hipMemsetAsync((char*)d_ws + WS_BAR, 0, 114688, stream) != hipSuccess) { fprintf(stderr, "kernel_launch: memset of barrier words failed\n"); return; }
    Params p{};
    for (int i = 0; i < 15; ++i) p.in[i] = (const float*)d_in[i];
    p.out = (float*)d_out; p.ws = (unsigned char*)d_ws;
    void* args[] = {&p};
    hipError_t e = hipLaunchCooperativeKernel((const void*)fwd_kernel, dim3(grid), dim3(NTHREADS), args, LDS_BYTES, stream);
    if (e != hipSuccess) fprintf(stderr, "cooperative launch failed: %s (grid %d)\n", hipGetErrorString(e), grid);
}
```

```cpp
#include <hip/hip_runtime.h>
#include <hip/hip_cooperative_groups.h>
#include <cstdio>
#include <cstdint>
namespace cg = cooperative_groups;

#define DI __device__ __forceinline__
#define PG8_LAS __attribute__((address_space(3)))
typedef unsigned short bf16_t;
typedef short bf16x8 __attribute__((ext_vector_type(8)));
typedef float f32x4 __attribute__((ext_vector_type(4)));
typedef float f32x2 __attribute__((ext_vector_type(2)));
typedef unsigned u32x4 __attribute__((ext_vector_type(4)));
typedef unsigned u32x2 __attribute__((ext_vector_type(2)));

namespace pg8 {
constexpr int BM = 256, BK = 64, HALF = 128, HTB = HALF * BK * 2, STAGE_BYTES = 8 * HTB, NXCD = 8, WGM = 8;
__host__ __device__ __forceinline__ int lds_byte(int r, int c) { const int st = (r >> 4) * 2 + (c >> 5), rr = r & 15, cc = c & 31, ob = rr * 64 + cc * 2; return st * 1024 + (ob ^ (((ob >> 9) & 1) << 5)); }
__host__ __device__ __forceinline__ void stage_rc(int b, int& R, int& C) { const int st = b / 1024, sb = b % 1024, swz = sb ^ (((sb >> 9) & 1) << 5); R = (st >> 1) * 16 + swz / 64; C = (st & 1) * 32 + (swz % 64) / 2; }
__host__ __device__ __forceinline__ int perm32(int rho) { const int n = rho >> 4, i = rho & 15; return 8 * (i >> 2) + 4 * n + (i & 3); }
struct Unit { int pm, pn; };
struct Gemm { const bf16_t* A; const bf16_t* Bt; int M, N, K; };
struct StaticOrder {
    int nM, nN, nwg, G, c;
    __host__ __device__ void init(int M, int N, int G_, int c_) { nM = M / BM; nN = N / BM; nwg = nM * nN; G = G_; c = c_; }
    __host__ __device__ bool next(int i, Unit& u) const {
        const long L = (long)i * G + c; if (L >= nwg) return false;
        int wgid = (int)L; { const int q = nwg / NXCD, r = nwg % NXCD, xcd = wgid % NXCD, off = wgid / NXCD; wgid = (xcd < r ? xcd * (q + 1) : r * (q + 1) + (xcd - r) * q) + off; }
        const int nig = WGM * nN, gid = wgid / nig, fm = gid * WGM, gsz = (nM - fm) < WGM ? (nM - fm) : WGM;
        u.pm = fm + ((wgid % nig) % gsz); u.pn = (wgid % nig) / gsz; return true;
    }
    __device__ __forceinline__ void a_ready(const Unit&) const {}
    __device__ __forceinline__ void done(const Unit&) const {}
};
template <class Epi, class Sched, bool ALIGN_EPI = false, bool SP2 = false>
__device__ __forceinline__ void gemm_phase(PG8_LAS unsigned char* lds, const Gemm g, const Sched& S, const Epi& E) {
    int tid = threadIdx.x; asm volatile("" : "+v"(tid)); const int wid = __builtin_amdgcn_readfirstlane(tid >> 6), lane = tid & 63, wr = wid >> 2, wc = wid & 3, fr = lane & 15, fq = lane >> 4;
    const int K = g.K, nt = K / BK;
    unsigned voffA[2], voffB[2];
#pragma unroll
    for (int i = 0; i < 2; ++i) { int R, C; stage_rc(tid * 16 + i * 8192, R, C); const int Rb = Epi::PERM ? ((R & ~31) + perm32(R & 31)) : R;
        voffA[i] = (unsigned)(R * K + C) * 2u; voffB[i] = (unsigned)(Rb * K + C) * 2u; }
    const size_t kstep = (size_t)(BK * 2);
    const size_t hstep = (size_t)HALF * K * 2;
    const size_t tstep = 2 * hstep;
    const unsigned ldsw = (unsigned)wid * 1024u;
    const int aoff = lds_byte(wr * 64 + fr, fq * 8), boff = lds_byte(wc * 32 + fr, fq * 8);
#define PG8_SA(b, h) (((b) * 2 + (h)) * HTB)
#define PG8_SB(b, h) ((4 + (b) * 2 + (h)) * HTB)
#define PG8_STAGE(bufoff, gbase, voff) do { _Pragma("unroll") for (int _i = 0; _i < 2; ++_i) \
        __builtin_amdgcn_global_load_lds((const unsigned*)((const char*)(gbase) + (voff)[_i]), (PG8_LAS unsigned*)(lds + (bufoff) + ldsw + _i * 8192), 16, 0, 0); } while (0)
#define PG8_LDA(dst, b, h) do { _Pragma("unroll") for (int m = 0; m < 4; ++m) _Pragma("unroll") for (int k = 0; k < 2; ++k) dst[m][k] = *(const PG8_LAS bf16x8*)(lds + PG8_SA(b, h) + aoff + m * 2048 + k * 1024); } while (0)
#define PG8_LDB(dst, b, h) do { _Pragma("unroll") for (int n = 0; n < 2; ++n) _Pragma("unroll") for (int k = 0; k < 2; ++k) dst[n][k] = *(const PG8_LAS bf16x8*)(lds + PG8_SB(b, h) + boff + n * 2048 + k * 1024); } while (0)
#define PG8_MMA(ai, bj, At, Bt) do { __builtin_amdgcn_s_setprio(1); _Pragma("unroll") for (int m = 0; m < 4; ++m) _Pragma("unroll") for (int n = 0; n < 2; ++n) _Pragma("unroll") for (int k = 0; k < 2; ++k) \
        acc[ai][bj][m][n] = __builtin_amdgcn_mfma_f32_16x16x32_bf16(Bt[n][k], At[m][k], acc[ai][bj][m][n], 0, 0, 0); __builtin_amdgcn_s_setprio(0); } while (0)
#define PG8_WAIT_V(n) asm volatile("s_waitcnt vmcnt(" #n ")" ::: "memory")
#define PG8_WAIT_L(n) asm volatile("s_waitcnt lgkmcnt(" #n ")" ::: "memory")
#define PG8_BAR __builtin_amdgcn_s_barrier()
#define PG8_SCHED __builtin_amdgcn_sched_barrier(0)
    Unit cur, nxt; int ui = 0;
    if (!S.next(0, cur)) return;
    f32x4 acc[2][2][4][2];
#pragma unroll
    for (int a = 0; a < 2; ++a)
#pragma unroll
        for (int b = 0; b < 2; ++b)
#pragma unroll
            for (int m = 0; m < 4; ++m)
#pragma unroll
                for (int n = 0; n < 2; ++n) acc[a][b][m][n] = (f32x4){0.f, 0.f, 0.f, 0.f};
    bf16x8 At[4][2], B0[2][2], B1[2][2];
    const char* cA = (const char*)g.A + (size_t)cur.pm * tstep; const char* cB = (const char*)g.Bt + (size_t)cur.pn * tstep;
    S.a_ready(cur);
    if constexpr (SP2) {
        PG8_STAGE(PG8_SB(0, 0), cB, voffB); PG8_STAGE(PG8_SB(0, 1), cB + hstep, voffB); PG8_STAGE(PG8_SA(0, 0), cA, voffA); PG8_STAGE(PG8_SA(0, 1), cA + hstep, voffA);
        if (wr == 1) PG8_BAR;
        PG8_WAIT_V(2); PG8_BAR;
        PG8_STAGE(PG8_SB(1, 0), cB + kstep, voffB); PG8_STAGE(PG8_SA(1, 0), cA + kstep, voffA); PG8_STAGE(PG8_SB(1, 1), cB + hstep + kstep, voffB);
        PG8_WAIT_V(6); PG8_BAR;
    } else {
        PG8_STAGE(PG8_SB(0, 0), cB, voffB); PG8_STAGE(PG8_SA(0, 0), cA, voffA); PG8_STAGE(PG8_SB(0, 1), cB + hstep, voffB); PG8_STAGE(PG8_SA(0, 1), cA + hstep, voffA);
        if (wr == 1) PG8_BAR;
        PG8_WAIT_V(4); PG8_BAR;
        PG8_STAGE(PG8_SB(1, 0), cB + kstep, voffB); PG8_STAGE(PG8_SA(1, 0), cA + kstep, voffA); PG8_STAGE(PG8_SB(1, 1), cB + hstep + kstep, voffB);
        PG8_WAIT_V(6); PG8_BAR;
    }
    for (;;) {
        const bool has_next = S.next(ui + 1, nxt);
        const char* nA = has_next ? (const char*)g.A + (size_t)nxt.pm * tstep : cA; const char* nB = has_next ? (const char*)g.Bt + (size_t)nxt.pn * tstep : cB;
        for (int t = 0; t < nt; t += 2) {
            const bool last = (t == nt - 2);
            const char* a1 = cA + (size_t)(t + 1) * kstep;
            const char* a2 = last ? nA : cA + (size_t)(t + 2) * kstep; const char* b2 = last ? nB : cB + (size_t)(t + 2) * kstep;
            const char* a3 = a2 + kstep; const char* b3 = b2 + kstep;
            if (last && has_next) S.a_ready(nxt);
            if constexpr (SP2) {
            PG8_LDB(B0, 0, 0); PG8_LDB(B1, 0, 1); PG8_SCHED; PG8_LDA(At, 0, 0); PG8_STAGE(PG8_SA(1, 1), a1 + hstep, voffA);
            PG8_WAIT_V(8); PG8_WAIT_L(0); PG8_BAR; PG8_MMA(0, 0, At, B0); PG8_MMA(0, 1, At, B1); PG8_BAR; PG8_SCHED;
            PG8_LDA(At, 0, 1); PG8_STAGE(PG8_SB(0, 0), b2, voffB); PG8_STAGE(PG8_SB(0, 1), b2 + hstep, voffB); PG8_STAGE(PG8_SA(0, 0), a2, voffA);
            PG8_WAIT_V(8); PG8_WAIT_L(0); PG8_BAR; PG8_MMA(1, 0, At, B0); PG8_MMA(1, 1, At, B1); PG8_BAR; PG8_SCHED;
            PG8_LDB(B0, 1, 0); PG8_LDB(B1, 1, 1); PG8_SCHED; PG8_LDA(At, 1, 0); PG8_STAGE(PG8_SA(0, 1), a2 + hstep, voffA);
            PG8_WAIT_V(8); PG8_WAIT_L(0); PG8_BAR; PG8_MMA(0, 0, At, B0); PG8_MMA(0, 1, At, B1); PG8_BAR; PG8_SCHED;
            PG8_LDA(At, 1, 1); PG8_STAGE(PG8_SB(1, 0), b3, voffB); PG8_STAGE(PG8_SB(1, 1), b3 + hstep, voffB); PG8_STAGE(PG8_SA(1, 0), a3, voffA);
            PG8_WAIT_V(8); PG8_WAIT_L(0); PG8_BAR; PG8_MMA(1, 0, At, B0); PG8_MMA(1, 1, At, B1); PG8_BAR; PG8_SCHED;
            } else {
            PG8_LDB(B0, 0, 0); PG8_SCHED; PG8_LDA(At, 0, 0); PG8_STAGE(PG8_SA(1, 1), a1 + hstep, voffA);
            PG8_WAIT_L(8); PG8_BAR; PG8_WAIT_L(0); PG8_MMA(0, 0, At, B0); PG8_BAR; PG8_SCHED;
            PG8_LDB(B1, 0, 1); PG8_STAGE(PG8_SB(0, 0), b2, voffB);
            PG8_BAR; PG8_WAIT_L(0); PG8_MMA(0, 1, At, B1); PG8_BAR;
            PG8_LDA(At, 0, 1); PG8_STAGE(PG8_SA(0, 0), a2, voffA);
            PG8_BAR; PG8_WAIT_L(0); PG8_MMA(1, 0, At, B0); PG8_BAR; PG8_SCHED;
            PG8_STAGE(PG8_SB(0, 1), b2 + hstep, voffB);
            PG8_WAIT_V(6); PG8_BAR; PG8_MMA(1, 1, At, B1); PG8_BAR;
            PG8_LDB(B0, 1, 0); PG8_SCHED; PG8_LDA(At, 1, 0); PG8_STAGE(PG8_SA(0, 1), a2 + hstep, voffA);
            PG8_WAIT_L(8); PG8_BAR; PG8_WAIT_L(0); PG8_MMA(0, 0, At, B0); PG8_BAR; PG8_SCHED;
            PG8_LDB(B1, 1, 1); PG8_STAGE(PG8_SB(1, 0), b3, voffB);
            PG8_BAR; PG8_WAIT_L(0); PG8_MMA(0, 1, At, B1); PG8_BAR;
            PG8_LDA(At, 1, 1); PG8_STAGE(PG8_SA(1, 0), a3, voffA);
            PG8_BAR; PG8_WAIT_L(0); PG8_MMA(1, 0, At, B0); PG8_BAR; PG8_SCHED;
            PG8_STAGE(PG8_SB(1, 1), b3 + hstep, voffB);
            PG8_WAIT_V(6); PG8_BAR; PG8_MMA(1, 1, At, B1); PG8_BAR;
            }
        }
        if constexpr (ALIGN_EPI) { if (wr == 0) PG8_BAR; }
        if constexpr (!Epi::AFTER_DRAIN) { E(acc, cur, wr, wc, fr, fq); S.done(cur); }
        if (!has_next) break;
#pragma unroll
        for (int a = 0; a < 2; ++a)
#pragma unroll
            for (int b = 0; b < 2; ++b)
#pragma unroll
                for (int m = 0; m < 4; ++m)
#pragma unroll
                    for (int n = 0; n < 2; ++n) acc[a][b][m][n] = (f32x4){0.f, 0.f, 0.f, 0.f};
        cur = nxt; cA = nA; cB = nB; ++ui;
        if constexpr (ALIGN_EPI) { if (wr == 1) PG8_BAR; }
    }
    PG8_WAIT_V(0);
    if constexpr (!ALIGN_EPI) { if (wr == 0) PG8_BAR; }
    PG8_BAR;
    if constexpr (Epi::AFTER_DRAIN) { E.fused(acc, cur, wr, wc, fr, fq, lds, wid, lane); S.done(cur); }
#undef PG8_SA
#undef PG8_SB
#undef PG8_STAGE
#undef PG8_LDA
#undef PG8_LDB
#undef PG8_MMA
#undef PG8_WAIT_V
#undef PG8_WAIT_L
#undef PG8_BAR
#undef PG8_SCHED
}}

constexpr int SEQ = 8192, NB = 2, M = NB * SEQ, D = 1024, NIN = 10272, NPAD = 10496;
constexpr int NA_TILES = 28, NB_TILES = 12, ROWS_A = NA_TILES * 256;
constexpr size_t MiB = 1u << 20;
constexpr size_t UNIT = 32 * MiB;
constexpr size_t WS_WIN = 224 * MiB, WS_WPA = 245 * MiB, WS_WPB = 247 * MiB, WS_WO = 249 * MiB, WS_AB = 251 * MiB, WS_G = 253 * MiB, WS_BETA = 254 * MiB;
constexpr size_t WS_MODP = 255 * MiB, WS_MODF = 255 * MiB + 256 * 1024;
constexpr size_t WS_CSC = 239 * MiB;
constexpr int LDS_BYTES = 155648;
constexpr int NWAVES = 8, NTHREADS = 512;
constexpr float NORM_EPS = 1e-6f, L2_EPS = 1e-6f;

struct Params { const float* in[15]; float* out; unsigned char* ws; };

typedef __bf16 bf16v2_t __attribute__((ext_vector_type(2)));
DI unsigned cvt_pk_bf16(float lo, float hi) { const f32x2 v = {lo, hi}; const bf16v2_t r = __builtin_convertvector(v, bf16v2_t); return __builtin_bit_cast(unsigned, r); }
DI void store_wt16(void* p, const u32x4& v) { asm volatile("global_store_dwordx4 %0, %1, off sc1\n\ts_nop 1" :: "v"(p), "v"(v) : "memory"); }
DI float bf_lo(unsigned u) { return __uint_as_float(u << 16); }
DI float bf_hi(unsigned u) { return __uint_as_float(u & 0xffff0000u); }
DI float bf1(bf16_t u) { return __uint_as_float(((unsigned)u) << 16); }
DI float sigmoidf_(float x) { return __builtin_amdgcn_rcpf(1.0f + __expf(-x)); }
DI float siluf_(float x) { return x * __builtin_amdgcn_rcpf(1.0f + __expf(-x)); }
DI float softplusf_(float x) { return fmaxf(x, 0.f) + log1pf(__expf(-fabsf(x))); }
#define DPP_F(v, ctrl) __builtin_bit_cast(float, __builtin_amdgcn_mov_dpp(__builtin_bit_cast(int, (v)), (ctrl), 0xF, 0xF, true))
DI float row16_sum(float v) {
    v += DPP_F(v, 0xB1);
    v += DPP_F(v, 0x4E);
    v += DPP_F(v, 0x141);
    v += DPP_F(v, 0x140);
    return v;
}
DI float wave_sum(float v) {
    v = row16_sum(v);
    return __builtin_bit_cast(float, __builtin_amdgcn_readlane(__builtin_bit_cast(int, v), 0)) + __builtin_bit_cast(float, __builtin_amdgcn_readlane(__builtin_bit_cast(int, v), 16))
         + __builtin_bit_cast(float, __builtin_amdgcn_readlane(__builtin_bit_cast(int, v), 32)) + __builtin_bit_cast(float, __builtin_amdgcn_readlane(__builtin_bit_cast(int, v), 48));
}
DI int permpos(int dk) { const int loc = dk & 31; return (dk & ~31) + 8 * ((loc >> 2) & 3) + 4 * (loc >> 4) + (loc & 3); }
DI int win_src_col(int d) {
    if (d < 2048) { const int i = d >> 8, w = d & 255; return w < 128 ? (128 * i + w) : (2048 + 128 * i + (w - 128)); }
    if (d < 4096) { const int i = (d - 2048) >> 8, w = d & 255; return w < 128 ? (1024 + 128 * i + w) : (3072 + 128 * i + (w - 128)); }
    if (d < 5120) return 8224 + (d - 4096);
    if (d < 6144) return 9248 + (d - 5120);
    if (d < 7168) return 7168 + (d - 6144);
    if (d < 10240) return 4096 + (d - 7168);
    if (d < 10272) return 8192 + (d - 10240);
    return -1;
}

struct EpiA {
    static constexpr bool PERM = true, AFTER_DRAIN = false;
    bf16_t *PR, *SG;
    DI void operator()(const f32x4 (&acc)[2][2][4][2], const pg8::Unit& u, int wr, int wc, int fr, int fq) const {
        const int row0 = u.pm * 256 + wr * 64 + fr, pn = u.pn;
        if (pn < 16) {
            bf16_t* O = PR + (size_t)(pn >> 3) * (UNIT / 2) + (size_t)(128 * (pn & 7) + 32 * wc + 8 * fq);
#pragma unroll
            for (int ai = 0; ai < 2; ++ai)
#pragma unroll
                for (int m = 0; m < 4; ++m) {
                    float o[8];
#pragma unroll
                    for (int n = 0; n < 2; ++n)
#pragma unroll
                        for (int j = 0; j < 4; ++j) { const float a = acc[ai][0][m][n][j], b = acc[ai][1][m][n][j]; o[4 * n + j] = pn < 8 ? a * b : a * siluf_(b); }
                    u32x4 w; w.x = cvt_pk_bf16(o[0], o[1]); w.y = cvt_pk_bf16(o[2], o[3]); w.z = cvt_pk_bf16(o[4], o[5]); w.w = cvt_pk_bf16(o[6], o[7]);
                    store_wt16(O + (size_t)(row0 + ai * 128 + m * 16) * D, w);
                }
        } else {
            const int g = (pn - 16) >> 2;
            bf16_t* O = SG + (size_t)g * (UNIT / 2) + (size_t)(256 * ((pn - 16) & 3) + 32 * wc + 8 * fq);
#pragma unroll
            for (int ai = 0; ai < 2; ++ai)
#pragma unroll
                for (int m = 0; m < 4; ++m)
#pragma unroll
                    for (int bj = 0; bj < 2; ++bj) {
                        float o[8];
#pragma unroll
                        for (int n = 0; n < 2; ++n)
#pragma unroll
                            for (int j = 0; j < 4; ++j) { const float a = acc[ai][bj][m][n][j]; o[4 * n + j] = g == 2 ? siluf_(a) : sigmoidf_(a); }
                        u32x4 w; w.x = cvt_pk_bf16(o[0], o[1]); w.y = cvt_pk_bf16(o[2], o[3]); w.z = cvt_pk_bf16(o[4], o[5]); w.w = cvt_pk_bf16(o[6], o[7]);
                        store_wt16(O + (size_t)(row0 + ai * 128 + m * 16) * D + bj * 128, w);
                    }
        }
    }
};
struct EpiB {
    static constexpr bool PERM = true, AFTER_DRAIN = false;
    bf16_t* QKV;
    DI void operator()(const f32x4 (&acc)[2][2][4][2], const pg8::Unit& u, int wr, int wc, int fr, int fq) const {
        const int row0 = u.pm * 256 + wr * 64 + fr, pn = u.pn;
        bf16_t* O = QKV + (size_t)(pn >> 2) * (UNIT / 2) + (size_t)(256 * (pn & 3) + 32 * wc + 8 * fq);
#pragma unroll
        for (int ai = 0; ai < 2; ++ai)
#pragma unroll
            for (int m = 0; m < 4; ++m)
#pragma unroll
                for (int bj = 0; bj < 2; ++bj) {
                    const f32x4 v0 = acc[ai][bj][m][0], v1 = acc[ai][bj][m][1];
                    u32x4 w; w.x = cvt_pk_bf16(v0[0], v0[1]); w.y = cvt_pk_bf16(v0[2], v0[3]); w.z = cvt_pk_bf16(v1[0], v1[1]); w.w = cvt_pk_bf16(v1[2], v1[3]);
                    store_wt16(O + (size_t)(row0 + ai * 128 + m * 16) * D + bj * 128, w);
                }
    }
};
struct EpiYa {
    static constexpr bool PERM = true, AFTER_DRAIN = false;
    bf16_t* SGA;
    DI void operator()(const f32x4 (&acc)[2][2][4][2], const pg8::Unit& u, int wr, int wc, int fr, int fq) const {
        const int row0 = u.pm * 256 + wr * 64 + fr; bf16_t* O = SGA + (size_t)(256 * u.pn + 32 * wc + 8 * fq);
#pragma unroll
        for (int ai = 0; ai < 2; ++ai)
#pragma unroll
            for (int m = 0; m < 4; ++m)
#pragma unroll
                for (int bj = 0; bj < 2; ++bj) {
                    u32x4* p = (u32x4*)(O + (size_t)(row0 + ai * 128 + m * 16) * D + bj * 128);
                    const u32x4 s = *p; const f32x4 v0 = acc[ai][bj][m][0], v1 = acc[ai][bj][m][1];
                    u32x4 w; w.x = cvt_pk_bf16(bf_lo(s.x) * v0[0], bf_hi(s.x) * v0[1]); w.y = cvt_pk_bf16(bf_lo(s.y) * v0[2], bf_hi(s.y) * v0[3]);
                    w.z = cvt_pk_bf16(bf_lo(s.z) * v1[0], bf_hi(s.z) * v1[1]); w.w = cvt_pk_bf16(bf_lo(s.w) * v1[2], bf_hi(s.w) * v1[3]);
                    *p = w;
                }
    }
};
struct EpiYb {
    static constexpr bool PERM = true, AFTER_DRAIN = false;
    bf16_t* MA; const bf16_t* SGB;
    DI void operator()(const f32x4 (&acc)[2][2][4][2], const pg8::Unit& u, int wr, int wc, int fr, int fq) const {
        const int row0 = u.pm * 256 + wr * 64 + fr; const size_t c0 = (size_t)(256 * u.pn + 32 * wc + 8 * fq);
#pragma unroll
        for (int ai = 0; ai < 2; ++ai)
#pragma unroll
            for (int m = 0; m < 4; ++m)
#pragma unroll
                for (int bj = 0; bj < 2; ++bj) {
                    const size_t off = (size_t)(row0 + ai * 128 + m * 16) * D + bj * 128 + c0;
                    u32x4* p = (u32x4*)(MA + off); const u32x4 a = *p; const u32x4 s = *(const u32x4*)(SGB + off);
                    const f32x4 v0 = acc[ai][bj][m][0], v1 = acc[ai][bj][m][1];
                    u32x4 w; w.x = cvt_pk_bf16(bf_lo(a.x) + bf_lo(s.x) * v0[0], bf_hi(a.x) + bf_hi(s.x) * v0[1]); w.y = cvt_pk_bf16(bf_lo(a.y) + bf_lo(s.y) * v0[2], bf_hi(a.y) + bf_hi(s.y) * v0[3]);
                    w.z = cvt_pk_bf16(bf_lo(a.z) + bf_lo(s.z) * v1[0], bf_hi(a.z) + bf_hi(s.z) * v1[1]); w.w = cvt_pk_bf16(bf_lo(a.w) + bf_lo(s.w) * v1[2], bf_hi(a.w) + bf_hi(s.w) * v1[3]);
                    store_wt16(p, w);
                }
    }
};
struct EpiOut {
    static constexpr bool PERM = true, AFTER_DRAIN = false;
    const float* X; const float* GATE; float* XN;
    DI void operator()(const f32x4 (&acc)[2][2][4][2], const pg8::Unit& u, int wr, int wc, int fr, int fq) const {
        const int row0 = u.pm * 256 + wr * 64 + fr; const int c0 = 256 * u.pn + 32 * wc + 8 * fq;
        const float* gp = GATE + (size_t)((u.pm * 256) / SEQ) * D + c0;
        f32x4 gt[2][2];
#pragma unroll
        for (int bj = 0; bj < 2; ++bj) { gt[bj][0] = *(const f32x4*)(gp + bj * 128); gt[bj][1] = *(const f32x4*)(gp + bj * 128 + 4); }
#pragma unroll
        for (int ai = 0; ai < 2; ++ai)
#pragma unroll
            for (int m = 0; m < 4; ++m)
#pragma unroll
                for (int bj = 0; bj < 2; ++bj) {
                    const size_t off = (size_t)(row0 + ai * 128 + m * 16) * D + bj * 128 + c0;
                    const f32x4 x0 = *(const f32x4*)(X + off), x1 = *(const f32x4*)(X + off + 4);
                    *(f32x4*)(XN + off) = x0 + gt[bj][0] * acc[ai][bj][m][0]; *(f32x4*)(XN + off + 4) = x1 + gt[bj][1] * acc[ai][bj][m][1];
                }
    }
};

constexpr size_t WS_PCNT = 255 * MiB + 336 * 1024;
constexpr size_t WS_PSS = 255 * MiB + 512 * 1024;
constexpr size_t WS_PCNT3 = 255 * MiB + 368 * 1024;
constexpr size_t WS_PCNT4 = 255 * MiB + 384 * 1024;
constexpr size_t WS_PCNT5 = 255 * MiB + 400 * 1024;
constexpr size_t WS_PCNT6 = 255 * MiB + 416 * 1024;
constexpr size_t WS_PCNT2 = 255 * MiB + 352 * 1024;
struct EpiOutFused {
    static constexpr bool PERM = true, AFTER_DRAIN = true;
    const float* X; const float* GATE; const float* FW; float* OUT; float* PSS; unsigned* PCNT;
    DI void operator()(const f32x4 (&)[2][2][4][2], const pg8::Unit&, int, int, int, int) const {}
    DI void fused(f32x4 (&acc)[2][2][4][2], const pg8::Unit& u, int wr, int wc, int fr, int fq, PG8_LAS unsigned char* lds, int wid, int lane) const {
        PG8_LAS float* P = (PG8_LAS float*)lds;
        PG8_LAS float* S = (PG8_LAS float*)(lds + 4096);
        const int row0 = u.pm * 256 + wr * 64 + fr; const int c0 = 256 * u.pn + 32 * wc + 8 * fq;
        const float* gp = GATE + (size_t)((u.pm * 256) / SEQ) * D + c0;
        f32x4 gt[2][2];
#pragma unroll
        for (int bj = 0; bj < 2; ++bj) { gt[bj][0] = *(const f32x4*)(gp + bj * 128); gt[bj][1] = *(const f32x4*)(gp + bj * 128 + 4); }
#pragma unroll
        for (int ai = 0; ai < 2; ++ai)
#pragma unroll
            for (int m = 0; m < 4; ++m) {
                float s = 0.f;
#pragma unroll
                for (int bj = 0; bj < 2; ++bj) {
                    const size_t off = (size_t)(row0 + ai * 128 + m * 16) * D + bj * 128 + c0;
                    const f32x4 v0 = __builtin_nontemporal_load((const f32x4*)(X + off)) + gt[bj][0] * acc[ai][bj][m][0], v1 = __builtin_nontemporal_load((const f32x4*)(X + off + 4)) + gt[bj][1] * acc[ai][bj][m][1];
                    acc[ai][bj][m][0] = v0; acc[ai][bj][m][1] = v1;
                    s += (v0[0] * v0[0] + v0[1] * v0[1]) + (v0[2] * v0[2] + v0[3] * v0[3]) + (v1[0] * v1[0] + v1[1] * v1[1]) + (v1[2] * v1[2] + v1[3] * v1[3]);
                }
                s += __shfl_xor(s, 16); s += __shfl_xor(s, 32);
                if (fq == 0) P[(ai * 128 + wr * 64 + m * 16 + fr) * 4 + wc] = s;
                if (m & 1) __builtin_amdgcn_sched_barrier(0);
            }
        asm volatile("s_waitcnt lgkmcnt(0)" ::: "memory"); __builtin_amdgcn_s_barrier(); asm volatile("" ::: "memory");
        const int row = wid * 32 + (lane & 31);
        if (lane < 32) {
            const float t = (P[row * 4 + 0] + P[row * 4 + 1]) + (P[row * 4 + 2] + P[row * 4 + 3]);
            __hip_atomic_store(PSS + (size_t)(u.pm * 256 + row) * 4 + u.pn, t, __ATOMIC_RELAXED, __HIP_MEMORY_SCOPE_AGENT);
        }
        asm volatile("s_waitcnt vmcnt(0)" ::: "memory");
        if (lane == 0) __hip_atomic_fetch_add(PCNT + 64 * u.pm, 1u, __ATOMIC_RELAXED, __HIP_MEMORY_SCOPE_AGENT);
        if (wid == 0) {
            unsigned sp = 0;
            while ((unsigned)__builtin_amdgcn_readfirstlane(__hip_atomic_load(PCNT + 64 * u.pm, __ATOMIC_RELAXED, __HIP_MEMORY_SCOPE_AGENT)) < 32u) { __builtin_amdgcn_s_sleep(2); if (++sp > (1u << 22)) break; }
            __builtin_amdgcn_fence(__ATOMIC_ACQUIRE, "agent");
        }
        asm volatile("s_waitcnt vmcnt(0) lgkmcnt(0)" ::: "memory"); __builtin_amdgcn_s_barrier(); asm volatile("" ::: "memory");
        if (lane < 32) {
            const float* ps = PSS + (size_t)(u.pm * 256 + row) * 4; float t = 0.f;
#pragma unroll
            for (int k = 0; k < 4; ++k) t += __hip_atomic_load(ps + k, __ATOMIC_RELAXED, __HIP_MEMORY_SCOPE_AGENT);
            S[row] = rsqrtf(t * (1.f / D) + NORM_EPS);
        }
        asm volatile("s_waitcnt vmcnt(0) lgkmcnt(0)" ::: "memory"); __builtin_amdgcn_s_barrier(); asm volatile("" ::: "memory");
        f32x4 fw[2][2];
#pragma unroll
        for (int bj = 0; bj < 2; ++bj) { fw[bj][0] = *(const f32x4*)(FW + c0 + bj * 128); fw[bj][1] = *(const f32x4*)(FW + c0 + bj * 128 + 4); }
#pragma unroll
        for (int ai = 0; ai < 2; ++ai)
#pragma unroll
            for (int m = 0; m < 4; ++m) {
                const float rs = S[ai * 128 + wr * 64 + m * 16 + fr];
#pragma unroll
                for (int bj = 0; bj < 2; ++bj) {
                    const size_t off = (size_t)(row0 + ai * 128 + m * 16) * D + bj * 128 + c0;
                    __builtin_nontemporal_store(acc[ai][bj][m][0] * rs * fw[bj][0], (f32x4*)(OUT + off)); __builtin_nontemporal_store(acc[ai][bj][m][1] * rs * fw[bj][1], (f32x4*)(OUT + off + 4));
                }
            }
    }
};

struct TwoGemmOrder {
    pg8::StaticOrder so;
    DI bool next(int i, pg8::Unit& u) const { if (i >= 2) return false; if (!so.next(0, u)) return false; if (i == 1) { u.pm += 256; u.pn += 4; } return true; }
    DI void a_ready(const pg8::Unit&) const {}
    DI void done(const pg8::Unit&) const {}
};
struct EpiYaYb {
    static constexpr bool PERM = true, AFTER_DRAIN = false;
    bf16_t* MA; const bf16_t* SGB;
    DI void operator()(const f32x4 (&acc)[2][2][4][2], const pg8::Unit& u, int wr, int wc, int fr, int fq) const {
        if (u.pn < 4) { EpiYa e{MA}; e(acc, u, wr, wc, fr, fq); }
        else { EpiYb e{MA, SGB}; pg8::Unit v; v.pm = u.pm - 256; v.pn = u.pn - 4; e(acc, v, wr, wc, fr, fq); }
    }
};

DI void p0_transpose_item(const float* W, int N, bf16_t* WT, int rg, int kg, int lane, bool is_win) {
    const int d = rg * 64 + lane; const int s = is_win ? win_src_col(d) : d; const int k0 = kg * 64;
    bf16_t* o = WT + (size_t)d * D + k0;
    if (s < 0) {
#pragma unroll
        for (int kk = 0; kk < 8; ++kk) *(u32x4*)(o + 8 * kk) = (u32x4){0u, 0u, 0u, 0u};
        return;
    }
    const float* w = W + (size_t)k0 * N + s;
    float v[64];
#pragma unroll
    for (int j = 0; j < 64; ++j) v[j] = __builtin_nontemporal_load(w + (size_t)j * N);
#pragma unroll
    for (int kk = 0; kk < 8; ++kk) {
        u32x4 p; p.x = cvt_pk_bf16(v[8 * kk], v[8 * kk + 1]); p.y = cvt_pk_bf16(v[8 * kk + 2], v[8 * kk + 3]); p.z = cvt_pk_bf16(v[8 * kk + 4], v[8 * kk + 5]); p.w = cvt_pk_bf16(v[8 * kk + 6], v[8 * kk + 7]);
        *(u32x4*)(o + 8 * kk) = p;
    }
}
DI void phase0(const Params& p, int gw, int NGW, int lane) {
    unsigned char* ws = p.ws;
    constexpr int I_WIN = (NPAD / 64) * 16, I_SQ = 16 * 16, I_MOD = 48 * 8, NITEMS = I_WIN + 3 * I_SQ + I_MOD;
    for (int it = gw; it < NITEMS; it += NGW) {
        int r = it;
        if (r < I_WIN) { p0_transpose_item(p.in[5], NIN, (bf16_t*)(ws + WS_WIN), r >> 4, r & 15, lane, true); continue; } r -= I_WIN;
        if (r < I_SQ) { p0_transpose_item(p.in[11], D, (bf16_t*)(ws + WS_WPA), r >> 4, r & 15, lane, false); continue; } r -= I_SQ;
        if (r < I_SQ) { p0_transpose_item(p.in[12], D, (bf16_t*)(ws + WS_WPB), r >> 4, r & 15, lane, false); continue; } r -= I_SQ;
        if (r < I_SQ) { p0_transpose_item(p.in[13], D, (bf16_t*)(ws + WS_WO), r >> 4, r & 15, lane, false); continue; } r -= I_SQ;
        const int cgp = r >> 3, ks = r & 7; const float* c = p.in[1]; const float* wa = p.in[2] + (size_t)(ks * 128) * 3072 + cgp * 64 + lane;
        float a0 = 0.f, a1 = 0.f;
#pragma unroll
        for (int k0 = 0; k0 < 128; k0 += 32) {
            float wv[32];
#pragma unroll
            for (int k = 0; k < 32; ++k) wv[k] = __builtin_nontemporal_load(wa + (size_t)(k0 + k) * 3072);
#pragma unroll
            for (int k = 0; k < 32; ++k) { a0 += siluf_(c[ks * 128 + k0 + k]) * wv[k]; a1 += siluf_(c[D + ks * 128 + k0 + k]) * wv[k]; }
        }
        float* mp = (float*)(ws + WS_MODP) + (size_t)ks * 2 * 3072 + cgp * 64 + lane;
        mp[0] = a0; mp[3072] = a1;
    }
}
DI void phase1(const Params& p, float* ldsf, int gw, int NGW, int lane, int tid, int row_base) {
    const float* modp = (const float*)(p.ws + WS_MODP); const float* b_ada = p.in[3]; const float* nw = p.in[4];
    float* s_tab = ldsf;
    float* a_tab = ldsf + 2048;
    const int tb_lo = row_base >= 0 ? (row_base / SEQ) * 2048 : 0, tb_hi = row_base >= 0 ? tb_lo + 2048 : 2 * 2048;
    for (int idx = tb_lo + tid; idx < tb_hi; idx += NTHREADS) {
        const int b = idx >> 11, j = idx & 2047; float s = b_ada[j];
#pragma unroll
        for (int q = 0; q < 8; ++q) s += modp[(size_t)q * 2 * 3072 + b * 3072 + j];
        if (j < 1024) s_tab[b * 1024 + j] = s; else a_tab[b * 1024 + j - 1024] = nw[j - 1024] * (1.f + s);
    }
    if (blockIdx.x == 0) {
        float* modf = (float*)(p.ws + WS_MODF);
        for (int idx = tid; idx < 2 * 1024; idx += NTHREADS) {
            const int b = idx >> 10, j = idx & 1023; float s = b_ada[2048 + j];
#pragma unroll
            for (int q = 0; q < 8; ++q) s += modp[(size_t)q * 2 * 3072 + b * 3072 + 2048 + j];
            modf[b * 1024 + j] = s;
        }
    }
    __syncthreads();
    bf16_t* H = (bf16_t*)(p.ws + 0 * UNIT);
    const bool pmode = row_base >= 0; const int pw = (tid >> 6) * 8;
    for (int m0 = pmode ? row_base + pw : gw; pmode ? (m0 < row_base + pw + 8) : (m0 < M); m0 += pmode ? 2 : 2 * NGW) {
        const int m1 = pmode ? m0 + 1 : (m0 + NGW < M ? m0 + NGW : m0);
        f32x4 v[2][4]; float s[2] = {0.f, 0.f};
#pragma unroll
        for (int u = 0; u < 2; ++u) { const f32x4* xr = (const f32x4*)(p.in[0] + (size_t)(u ? m1 : m0) * D) + lane;
#pragma unroll
            for (int j = 0; j < 4; ++j) v[u][j] = __builtin_nontemporal_load(xr + 64 * j); }
#pragma unroll
        for (int u = 0; u < 2; ++u) {
#pragma unroll
            for (int j = 0; j < 4; ++j) s[u] += (v[u][j].x * v[u][j].x + v[u][j].y * v[u][j].y) + (v[u][j].z * v[u][j].z + v[u][j].w * v[u][j].w);
            const int m = u ? m1 : m0; const int b = m / SEQ;
            const float rstd = rsqrtf(wave_sum(s[u]) * (1.f / D) + NORM_EPS);
            u32x2* o = (u32x2*)(H + (size_t)m * D) + lane;
#pragma unroll
            for (int j = 0; j < 4; ++j) {
                const f32x4 a = *(const f32x4*)(a_tab + b * 1024 + 4 * lane + 256 * j), sh = *(const f32x4*)(s_tab + b * 1024 + 4 * lane + 256 * j);
                const f32x4 hh = v[u][j] * rstd * a + sh;
                u32x2 w; w.x = cvt_pk_bf16(hh.x, hh.y); w.y = cvt_pk_bf16(hh.z, hh.w);
                __hip_atomic_store((unsigned long long*)(o + 64 * j), ((unsigned long long)w.y << 32) | w.x, __ATOMIC_RELAXED, __HIP_MEMORY_SCOPE_AGENT);
            }
        }
    }
    __syncthreads();
}
DI void ab_item(const Params& p, int item, int lane) {
    unsigned char* ws = p.ws; const int il = lane & 15, q = lane >> 4;
    const bf16_t* Hr = (const bf16_t*)(ws + 0 * UNIT) + (size_t)(item * 16 + il) * D + 8 * q;
    const bf16_t* W0 = (const bf16_t*)(ws + WS_WIN) + (size_t)(10240 + il) * D + 8 * q; const bf16_t* W1 = W0 + (size_t)16 * D;
    f32x4 a0 = {0.f, 0.f, 0.f, 0.f}, a1 = {0.f, 0.f, 0.f, 0.f};
#pragma unroll 8
    for (int ks = 0; ks < 32; ++ks) { const bf16x8 hf = *(const bf16x8*)(Hr + 32 * ks);
        a0 = __builtin_amdgcn_mfma_f32_16x16x32_bf16(hf, *(const bf16x8*)(W0 + 32 * ks), a0, 0, 0, 0); a1 = __builtin_amdgcn_mfma_f32_16x16x32_bf16(hf, *(const bf16x8*)(W1 + 32 * ks), a1, 0, 0, 0); }
    float* AB = (float*)(ws + WS_AB) + (size_t)(item * 16 + 4 * q) * 32 + il;
#pragma unroll
    for (int r = 0; r < 4; ++r) { AB[r * 32] = a0[r]; AB[r * 32 + 16] = a1[r]; }
}
DI void phase3_item(const Params& p, int item, int lane) {
    unsigned char* ws = p.ws;
    const bf16_t* Qr = (const bf16_t*)(ws + 1 * UNIT); const bf16_t* Kr = (const bf16_t*)(ws + 2 * UNIT); const bf16_t* Vr = (const bf16_t*)(ws + 3 * UNIT);
    bf16_t* Qn = (bf16_t*)(ws + 4 * UNIT); bf16_t* Kn = (bf16_t*)(ws + 5 * UNIT); bf16_t* Vc = (bf16_t*)p.out;
    const int tg = item & 255, h = (item >> 8) & 7, b = item >> 11; const int t_base = tg * 32; const size_t rb = (size_t)b * SEQ;
    const int col = h * 128 + 2 * lane; const int pcol = h * 128 + permpos(2 * lane);
    const float* cw = p.in[7];
    f32x2 wq[5], wk[5], wv[5];
#pragma unroll
    for (int j = 0; j < 5; ++j) { wq[j] = *(const f32x2*)(cw + j * 3072 + col); wk[j] = *(const f32x2*)(cw + j * 3072 + 1024 + col); wv[j] = *(const f32x2*)(cw + j * 3072 + 2048 + col); }
#pragma unroll
    for (int hf = 0; hf < 2; ++hf) {
        unsigned rq[20], rk[20], rv[20];
#pragma unroll
        for (int j = 0; j < 20; ++j) {
            const int t = t_base + 16 * hf - 2 + j; const bool ok = (t >= 0) && (t < SEQ); const int tc = t < 0 ? 0 : (t >= SEQ ? SEQ - 1 : t);
            const size_t off = (rb + tc) * D + col;
            const unsigned a0 = *(const unsigned*)(Qr + off), a1 = *(const unsigned*)(Kr + off), a2 = *(const unsigned*)(Vr + off);
            rq[j] = ok ? a0 : 0u; rk[j] = ok ? a1 : 0u; rv[j] = ok ? a2 : 0u;
        }
#pragma unroll
        for (int t16 = 0; t16 < 16; ++t16) {
            const int tt = 16 * hf + t16, t = t_base + tt;
            float q0 = 0.f, q1 = 0.f, k0 = 0.f, k1 = 0.f, v0 = 0.f, v1 = 0.f;
#pragma unroll
            for (int j = 0; j < 5; ++j) { q0 += wq[j].x * bf_lo(rq[t16 + j]); q1 += wq[j].y * bf_hi(rq[t16 + j]); k0 += wk[j].x * bf_lo(rk[t16 + j]); k1 += wk[j].y * bf_hi(rk[t16 + j]); v0 += wv[j].x * bf_lo(rv[t16 + j]); v1 += wv[j].y * bf_hi(rv[t16 + j]); }
            q0 = siluf_(q0); q1 = siluf_(q1); k0 = siluf_(k0); k1 = siluf_(k1); v0 = siluf_(v0); v1 = siluf_(v1);
            const float rq_ = rsqrtf(wave_sum(q0 * q0 + q1 * q1) + L2_EPS) * 0.08838834764831845f, rk_ = rsqrtf(wave_sum(k0 * k0 + k1 * k1) + L2_EPS);
            q0 *= rq_; q1 *= rq_; k0 *= rk_; k1 *= rk_;
            const size_t ro = (rb + t) * D;
            *(unsigned*)(Qn + ro + pcol) = cvt_pk_bf16(q0, q1); *(unsigned*)(Kn + ro + pcol) = cvt_pk_bf16(k0, k1); *(unsigned*)(Vc + ro + col) = cvt_pk_bf16(v0, v1);
        }
    }
    { const int i = lane & 31, dir = lane >> 5; const size_t row = rb + t_base + i; const float* AB = (const float*)(ws + WS_AB);
      const float a_raw = AB[row * 32 + dir * 8 + h], b_raw = AB[row * 32 + 16 + dir * 8 + h];
      const float g = -__expf(p.in[8][dir * 8 + h]) * softplusf_(a_raw + p.in[9][dir * 8 + h]);
      ((float*)(ws + WS_G))[row * 16 + dir * 8 + h] = g; ((float*)(ws + WS_BETA))[row * 16 + dir * 8 + h] = sigmoidf_(b_raw); }
}
DI void naive_scan(const Params& p, float* ldsw, int task, int lane) {
    unsigned char* ws = p.ws;
    const bf16_t* Qn = (const bf16_t*)(ws + 4 * UNIT); const bf16_t* Kn = (const bf16_t*)(ws + 5 * UNIT); const bf16_t* Vc = (const bf16_t*)p.out;
    const float* G = (const float*)(ws + WS_G); const float* BE = (const float*)(ws + WS_BETA);
    const int chain = task >> 1, b = chain >> 4, dir = (chain >> 3) & 1, h = chain & 7, e = (task & 1) * 64 + lane;
    bf16_t* O = (dir ? (bf16_t*)(p.out) + (size_t)M * D : (bf16_t*)(ws + 3 * UNIT));
    float* kb = ldsw; float* qb = ldsw + 128;
    float P[128];
#pragma unroll
    for (int d = 0; d < 128; ++d) P[d] = 0.f;
    for (int n = 0; n < SEQ; ++n) {
        const int t = dir ? SEQ - 1 - n : n; const size_t row = (size_t)b * SEQ + t;
        const unsigned ku = *(const unsigned*)(Kn + row * D + h * 128 + 2 * lane), qu = *(const unsigned*)(Qn + row * D + h * 128 + 2 * lane);
        const float v = bf1(Vc[row * D + h * 128 + e]); const float al = __expf(G[row * 16 + dir * 8 + h]), be = BE[row * 16 + dir * 8 + h];
        kb[2 * lane] = bf_lo(ku); kb[2 * lane + 1] = bf_hi(ku); qb[2 * lane] = bf_lo(qu); qb[2 * lane + 1] = bf_hi(qu);
        asm volatile("s_waitcnt lgkmcnt(0)" ::: "memory");
        float sk = 0.f;
#pragma unroll
        for (int d4 = 0; d4 < 32; ++d4) { if ((d4 & 3) == 0) __builtin_amdgcn_sched_barrier(0); const f32x4 k4 = *(const f32x4*)(kb + 4 * d4); sk += P[4 * d4] * k4.x + P[4 * d4 + 1] * k4.y + P[4 * d4 + 2] * k4.z + P[4 * d4 + 3] * k4.w; }
        const float vn = be * (v - al * sk); float o = 0.f;
#pragma unroll
        for (int d4 = 0; d4 < 32; ++d4) { if ((d4 & 3) == 0) __builtin_amdgcn_sched_barrier(0); const f32x4 k4 = *(const f32x4*)(kb + 4 * d4), q4 = *(const f32x4*)(qb + 4 * d4);
            P[4 * d4] = al * P[4 * d4] + k4.x * vn; P[4 * d4 + 1] = al * P[4 * d4 + 1] + k4.y * vn; P[4 * d4 + 2] = al * P[4 * d4 + 2] + k4.z * vn; P[4 * d4 + 3] = al * P[4 * d4 + 3] + k4.w * vn;
            o += P[4 * d4] * q4.x + P[4 * d4 + 1] * q4.y + P[4 * d4 + 2] * q4.z + P[4 * d4 + 3] * q4.w; }
        O[row * D + h * 128 + e] = (bf16_t)(cvt_pk_bf16(o, 0.f) & 0xffffu);
        asm volatile("s_waitcnt lgkmcnt(0)" ::: "memory");
    }
}
DI void ya_acc(float (&acc)[8], const u32x4& pv, const f32x4& wa, const f32x4& wb) {
    acc[0] += wa.x * bf_lo(pv.x); acc[1] += wa.y * bf_hi(pv.x); acc[2] += wa.z * bf_lo(pv.y); acc[3] += wa.w * bf_hi(pv.y);
    acc[4] += wb.x * bf_lo(pv.z); acc[5] += wb.y * bf_hi(pv.z); acc[6] += wb.z * bf_lo(pv.w); acc[7] += wb.w * bf_hi(pv.w);
}
DI void phase7(const Params& p, int gw, int NGW, int lane, int gtid, int NGT) {
    unsigned char* ws = p.ws;
    const bf16_t* Pb = (const bf16_t*)(ws + 1 * UNIT); bf16_t* R = (bf16_t*)(ws + 2 * UNIT); const float* cw = p.in[6];
    for (int it = gtid; it < (M / 4) * 128; it += NGT) {
        const int row0 = (it >> 7) * 4, c8 = (it & 127) * 8, t0 = row0 & (SEQ - 1);
        const u32x4 z = (u32x4){0u, 0u, 0u, 0u};
        u32x4 pv[6], rv[4];
        { const u32x4 t_ = *(const u32x4*)(Pb + (size_t)(t0 > 0 ? row0 - 1 : row0) * D + c8); pv[0] = t0 > 0 ? t_ : z; }
#pragma unroll
        for (int j = 0; j < 4; ++j) { pv[j + 1] = *(const u32x4*)(Pb + (size_t)(row0 + j) * D + c8); rv[j] = *(const u32x4*)(R + (size_t)(row0 + j) * D + c8); }
        { const u32x4 t_ = *(const u32x4*)(Pb + (size_t)(t0 + 4 < SEQ ? row0 + 4 : row0) * D + c8); pv[5] = t0 + 4 < SEQ ? t_ : z; }
        f32x4 wa[3], wb[3];
#pragma unroll
        for (int j = 0; j < 3; ++j) { wa[j] = *(const f32x4*)(cw + j * D + c8); wb[j] = *(const f32x4*)(cw + j * D + c8 + 4); }
#pragma unroll
        for (int j = 0; j < 4; ++j) {
            float acc[8] = {0.f, 0.f, 0.f, 0.f, 0.f, 0.f, 0.f, 0.f};
            ya_acc(acc, pv[j], wa[0], wb[0]); ya_acc(acc, pv[j + 1], wa[1], wb[1]); ya_acc(acc, pv[j + 2], wa[2], wb[2]);
            u32x4 o; const u32x4 r = rv[j];
            o.x = cvt_pk_bf16(bf_lo(r.x) * acc[0], bf_hi(r.x) * acc[1]); o.y = cvt_pk_bf16(bf_lo(r.y) * acc[2], bf_hi(r.y) * acc[3]);
            o.z = cvt_pk_bf16(bf_lo(r.z) * acc[4], bf_hi(r.z) * acc[5]); o.w = cvt_pk_bf16(bf_lo(r.w) * acc[6], bf_hi(r.w) * acc[7]);
            *(u32x4*)(R + (size_t)(row0 + j) * D + c8) = o;
        }
    }
    const bf16_t* Of = (const bf16_t*)(ws + 3 * UNIT); const bf16_t* Ob = (const bf16_t*)p.out + (size_t)M * D; bf16_t* SZ = (bf16_t*)(ws + 6 * UNIT);
    const f32x4 g0 = *(const f32x4*)(p.in[10] + (lane & 15) * 8), g1 = *(const f32x4*)(p.in[10] + (lane & 15) * 8 + 4);
    for (int rp = gw; rp < M / 2; rp += NGW) {
        u32x4 a[4], bb[4], zz[4];
#pragma unroll
        for (int u = 0; u < 4; ++u) { const size_t off = (size_t)(rp * 2 + (u >> 1)) * D + (u & 1) * 512 + lane * 8;
            a[u] = __builtin_nontemporal_load((const u32x4*)(Of + off)); bb[u] = __builtin_nontemporal_load((const u32x4*)(Ob + off)); zz[u] = __builtin_nontemporal_load((const u32x4*)(SZ + off)); }
#pragma unroll
        for (int u = 0; u < 4; ++u) { const size_t off = (size_t)(rp * 2 + (u >> 1)) * D + (u & 1) * 512 + lane * 8;
            float o[8];
            o[0] = bf_lo(a[u].x) + bf_lo(bb[u].x); o[1] = bf_hi(a[u].x) + bf_hi(bb[u].x); o[2] = bf_lo(a[u].y) + bf_lo(bb[u].y); o[3] = bf_hi(a[u].y) + bf_hi(bb[u].y);
            o[4] = bf_lo(a[u].z) + bf_lo(bb[u].z); o[5] = bf_hi(a[u].z) + bf_hi(bb[u].z); o[6] = bf_lo(a[u].w) + bf_lo(bb[u].w); o[7] = bf_hi(a[u].w) + bf_hi(bb[u].w);
            float ss = 0.f;
#pragma unroll
            for (int j = 0; j < 8; ++j) ss += o[j] * o[j];
            ss = row16_sum(ss);
            const float rs = rsqrtf(ss * (1.f / 128.f) + NORM_EPS);
            u32x4 w;
            w.x = cvt_pk_bf16(o[0] * rs * g0.x * bf_lo(zz[u].x), o[1] * rs * g0.y * bf_hi(zz[u].x)); w.y = cvt_pk_bf16(o[2] * rs * g0.z * bf_lo(zz[u].y), o[3] * rs * g0.w * bf_hi(zz[u].y));
            w.z = cvt_pk_bf16(o[4] * rs * g1.x * bf_lo(zz[u].z), o[5] * rs * g1.y * bf_hi(zz[u].z)); w.w = cvt_pk_bf16(o[6] * rs * g1.z * bf_lo(zz[u].w), o[7] * rs * g1.w * bf_hi(zz[u].w));
            *(u32x4*)(SZ + off) = w;
        }
    }
}
DI void phase7_panel(const Params& p, int pm, int pn, int tid, int lane, int wave) {
    unsigned char* ws = p.ws;
    const bf16_t* Pb = (const bf16_t*)(ws + 1 * UNIT); bf16_t* R = (bf16_t*)(ws + 2 * UNIT); const float* cw = p.in[6];
#pragma unroll 1
    for (int i = 0; i < 4; ++i) {
        const int it = tid + NTHREADS * i; const int row0 = 256 * pm + 4 * (it >> 5), c8 = 256 * pn + 8 * (it & 31), t0 = row0 & (SEQ - 1);
        const u32x4 z = (u32x4){0u, 0u, 0u, 0u};
        u32x4 pv[6], rv[4];
        { const u32x4 t_ = *(const u32x4*)(Pb + (size_t)(t0 > 0 ? row0 - 1 : row0) * D + c8); pv[0] = t0 > 0 ? t_ : z; }
#pragma unroll
        for (int j = 0; j < 4; ++j) { pv[j + 1] = *(const u32x4*)(Pb + (size_t)(row0 + j) * D + c8); rv[j] = *(const u32x4*)(R + (size_t)(row0 + j) * D + c8); }
        { const u32x4 t_ = *(const u32x4*)(Pb + (size_t)(t0 + 4 < SEQ ? row0 + 4 : row0) * D + c8); pv[5] = t0 + 4 < SEQ ? t_ : z; }
        f32x4 wa[3], wb[3];
#pragma unroll
        for (int j = 0; j < 3; ++j) { wa[j] = *(const f32x4*)(cw + j * D + c8); wb[j] = *(const f32x4*)(cw + j * D + c8 + 4); }
#pragma unroll
        for (int j = 0; j < 4; ++j) {
            float acc[8] = {0.f, 0.f, 0.f, 0.f, 0.f, 0.f, 0.f, 0.f};
            ya_acc(acc, pv[j], wa[0], wb[0]); ya_acc(acc, pv[j + 1], wa[1], wb[1]); ya_acc(acc, pv[j + 2], wa[2], wb[2]);
            u32x4 o; const u32x4 r = rv[j];
            o.x = cvt_pk_bf16(bf_lo(r.x) * acc[0], bf_hi(r.x) * acc[1]); o.y = cvt_pk_bf16(bf_lo(r.y) * acc[2], bf_hi(r.y) * acc[3]);
            o.z = cvt_pk_bf16(bf_lo(r.z) * acc[4], bf_hi(r.z) * acc[5]); o.w = cvt_pk_bf16(bf_lo(r.w) * acc[6], bf_hi(r.w) * acc[7]);
            store_wt16(R + (size_t)(row0 + j) * D + c8, o);
        }
    }
    const bf16_t* Of = (const bf16_t*)(ws + 3 * UNIT); const bf16_t* Ob = (const bf16_t*)p.out + (size_t)M * D; bf16_t* SZ = (bf16_t*)(ws + 6 * UNIT);
    const f32x4 g0 = *(const f32x4*)(p.in[10] + (lane & 15) * 8), g1 = *(const f32x4*)(p.in[10] + (lane & 15) * 8 + 4);
#pragma unroll 1
    for (int i = 0; i < 4; ++i) {
        u32x4 a[4], bb[4], zz[4];
#pragma unroll
        for (int u = 0; u < 4; ++u) { const size_t off = (size_t)(256 * pm + 32 * wave + 8 * i + 2 * u + (lane >> 5)) * D + 256 * pn + (lane & 31) * 8;
            a[u] = __builtin_nontemporal_load((const u32x4*)(Of + off)); bb[u] = __builtin_nontemporal_load((const u32x4*)(Ob + off)); zz[u] = __builtin_nontemporal_load((const u32x4*)(SZ + off)); }
#pragma unroll
        for (int u = 0; u < 4; ++u) { const size_t off = (size_t)(256 * pm + 32 * wave + 8 * i + 2 * u + (lane >> 5)) * D + 256 * pn + (lane & 31) * 8;
            float o[8];
            o[0] = bf_lo(a[u].x) + bf_lo(bb[u].x); o[1] = bf_hi(a[u].x) + bf_hi(bb[u].x); o[2] = bf_lo(a[u].y) + bf_lo(bb[u].y); o[3] = bf_hi(a[u].y) + bf_hi(bb[u].y);
            o[4] = bf_lo(a[u].z) + bf_lo(bb[u].z); o[5] = bf_hi(a[u].z) + bf_hi(bb[u].z); o[6] = bf_lo(a[u].w) + bf_lo(bb[u].w); o[7] = bf_hi(a[u].w) + bf_hi(bb[u].w);
            float ss = 0.f;
#pragma unroll
            for (int j = 0; j < 8; ++j) ss += o[j] * o[j];
            ss = row16_sum(ss);
            const float rs = rsqrtf(ss * (1.f / 128.f) + NORM_EPS);
            u32x4 w;
            w.x = cvt_pk_bf16(o[0] * rs * g0.x * bf_lo(zz[u].x), o[1] * rs * g0.y * bf_hi(zz[u].x)); w.y = cvt_pk_bf16(o[2] * rs * g0.z * bf_lo(zz[u].y), o[3] * rs * g0.w * bf_hi(zz[u].y));
            w.z = cvt_pk_bf16(o[4] * rs * g1.x * bf_lo(zz[u].z), o[5] * rs * g1.y * bf_hi(zz[u].z)); w.w = cvt_pk_bf16(o[6] * rs * g1.z * bf_lo(zz[u].w), o[7] * rs * g1.w * bf_hi(zz[u].w));
            store_wt16(SZ + off, w);
        }
    }
}
DI void phase10(const Params& p, int gw, int NGW, int lane) {
    const float* XN = (const float*)(p.ws + 0 * UNIT); const float* fw = p.in[14];
    f32x4 w[4];
#pragma unroll
    for (int j = 0; j < 4; ++j) w[j] = *((const f32x4*)fw + lane + 64 * j);
    for (int m = gw; m < M; m += NGW) {
        const f32x4* xr = (const f32x4*)(XN + (size_t)m * D) + lane; f32x4 v[4]; float s = 0.f;
#pragma unroll
        for (int j = 0; j < 4; ++j) { v[j] = xr[64 * j]; s += (v[j].x * v[j].x + v[j].y * v[j].y) + (v[j].z * v[j].z + v[j].w * v[j].w); }
        const float rstd = rsqrtf(wave_sum(s) * (1.f / D) + NORM_EPS);
        f32x4* o = (f32x4*)(p.out + (size_t)m * D) + lane;
#pragma unroll
        for (int j = 0; j < 4; ++j) o[64 * j] = v[j] * rstd * w[j];
    }
}
#define MFMA16(a, b, c) __builtin_amdgcn_mfma_f32_16x16x32_bf16((a), (b), (c), 0, 0, 0)
DI void chunk_prep_item(const Params& p, float* Lm, int item, int lane) {
    unsigned char* ws = p.ws;
    const bf16_t* Qn = (const bf16_t*)(ws + 4 * UNIT); const bf16_t* Kn = (const bf16_t*)(ws + 5 * UNIT);
    bf16_t* TF = (bf16_t*)(ws + 1 * UNIT) + (size_t)item * 4096; bf16_t* AF = (bf16_t*)(ws + 2 * UNIT) + (size_t)item * 4096;
    float* csc = (float*)(ws + WS_CSC) + (size_t)item * 192;
    const int c = item & 127, h = (item >> 7) & 7, dir = (item >> 10) & 1, b = item >> 11;
    const size_t rb = (size_t)b * SEQ + c * 64; const int il = lane & 15, q = lane >> 4;
    const int tl = dir ? 63 - lane : lane;
    const float g = ((const float*)(ws + WS_G))[(rb + tl) * 16 + dir * 8 + h], be = ((const float*)(ws + WS_BETA))[(rb + tl) * 16 + dir * 8 + h];
    float gc = g;
#pragma unroll
    for (int o = 1; o < 64; o <<= 1) { const float v = __shfl_up(gc, o); if (lane >= o) gc += v; }
    const float gl = __shfl(gc, 63);
    csc[tl] = __expf(gc); csc[64 + tl] = be; csc[128 + tl] = __expf(gl - gc);
    float gcr[4][4], ber[4][4], gcc[4];
#pragma unroll
    for (int t = 0; t < 4; ++t) { gcc[t] = __shfl(gc, 16 * t + il);
#pragma unroll
        for (int r = 0; r < 4; ++r) { gcr[t][r] = __shfl(gc, 16 * t + 4 * q + r); ber[t][r] = __shfl(be, 16 * t + 4 * q + r); } }
    bf16x8 Kf[4][4];
#pragma unroll
    for (int rt = 0; rt < 4; ++rt) { const int ip = 16 * rt + il; const size_t ro = (rb + (dir ? 63 - ip : ip)) * D + h * 128 + 8 * q;
#pragma unroll
        for (int ks = 0; ks < 4; ++ks) Kf[rt][ks] = *(const bf16x8*)(Kn + ro + 32 * ks); }
#pragma unroll
    for (int it = 0; it < 4; ++it)
#pragma unroll
        for (int jt = 0; jt <= it; ++jt) {
            f32x4 acc = {0.f, 0.f, 0.f, 0.f};
#pragma unroll
            for (int ks = 0; ks < 4; ++ks) acc = MFMA16(Kf[it][ks], Kf[jt][ks], acc);
#pragma unroll
            for (int r = 0; r < 4; ++r) { const int ip = 16 * it + 4 * q + r, jp = 16 * jt + il;
                Lm[ip * 64 + jp] = ip > jp ? ber[it][r] * acc[r] * __expf(gcr[it][r] - gcc[jt]) : 0.f; }
        }
    __builtin_amdgcn_sched_barrier(0);
    bf16x8 Qnext[4];
    { const int ip = il; const size_t ro = (rb + (dir ? 63 - ip : ip)) * D + h * 128 + 8 * q;
#pragma unroll
      for (int ks = 0; ks < 4; ++ks) Qnext[ks] = *(const bf16x8*)(Qn + ro + 32 * ks); }
#pragma unroll
    for (int mt = 0; mt < 4; ++mt) {
        bf16x8 Qf[4];
#pragma unroll
        for (int ks = 0; ks < 4; ++ks) Qf[ks] = Qnext[ks];
        if (mt < 3) { const int ip = 16 * (mt + 1) + il; const size_t ro = (rb + (dir ? 63 - ip : ip)) * D + h * 128 + 8 * q;
#pragma unroll
          for (int ks = 0; ks < 4; ++ks) Qnext[ks] = *(const bf16x8*)(Qn + ro + 32 * ks); }
#pragma unroll
        for (int ks2 = 0; ks2 < 2; ++ks2) {
            float vals[8];
#pragma unroll
            for (int a = 0; a < 2; ++a) { const int jt = 2 * ks2 + a; f32x4 acc = {0.f, 0.f, 0.f, 0.f};
#pragma unroll
                for (int ks = 0; ks < 4; ++ks) acc = MFMA16(Kf[jt][ks], Qf[ks], acc);
#pragma unroll
                for (int r = 0; r < 4; ++r) { const int jp = 16 * jt + 4 * q + r, ip = 16 * mt + il; vals[4 * a + r] = ip >= jp ? acc[r] * __expf(gcc[mt] - gcr[jt][r]) : 0.f; } }
            u32x4 w;
            if (dir) { w.x = cvt_pk_bf16(vals[7], vals[6]); w.y = cvt_pk_bf16(vals[5], vals[4]); w.z = cvt_pk_bf16(vals[3], vals[2]); w.w = cvt_pk_bf16(vals[1], vals[0]); }
            else { w.x = cvt_pk_bf16(vals[0], vals[1]); w.y = cvt_pk_bf16(vals[2], vals[3]); w.z = cvt_pk_bf16(vals[4], vals[5]); w.w = cvt_pk_bf16(vals[6], vals[7]); }
            const int fi = dir ? ((3 - mt) * 2 + (1 - ks2)) : (mt * 2 + ks2), ln = dir ? ((3 - q) * 16 + (15 - il)) : lane;
            *(u32x4*)(AF + (size_t)(fi * 64 + ln) * 8) = w;
        }
        __builtin_amdgcn_sched_barrier(0);
    }
    asm volatile("s_waitcnt lgkmcnt(0)" ::: "memory");
    __builtin_amdgcn_sched_barrier(0);
    float T[64];
#pragma unroll
    for (int i = 0; i < 64; ++i) {
        float s0 = (lane == i) ? 1.f : 0.f, s1 = 0.f;
#pragma unroll
        for (int m4 = 0; m4 < (i + 3) / 4; ++m4) {
            const f32x4 l4 = *(const f32x4*)(Lm + i * 64 + 4 * m4);
            if (4 * m4 + 0 < i) s0 -= l4.x * T[4 * m4 + 0];
            if (4 * m4 + 1 < i) s1 -= l4.y * T[4 * m4 + 1];
            if (4 * m4 + 2 < i) s0 -= l4.z * T[4 * m4 + 2];
            if (4 * m4 + 3 < i) s1 -= l4.w * T[4 * m4 + 3];
        }
        T[i] = s0 + s1;
        if ((i & 3) == 3) __builtin_amdgcn_sched_barrier(0);
    }
    asm volatile("s_waitcnt lgkmcnt(0)" ::: "memory");
    bf16_t* TL = (bf16_t*)Lm;
#pragma unroll
    for (int i = 0; i < 64; ++i) TL[i * 72 + lane] = (bf16_t)(cvt_pk_bf16(T[i], 0.f) & 0xffffu);
    asm volatile("s_waitcnt lgkmcnt(0)" ::: "memory");
#pragma unroll
    for (int mt = 0; mt < 4; ++mt)
#pragma unroll
        for (int ks2 = 0; ks2 < 2; ++ks2) {
            u32x4 w;
            if (dir) {
                const int row = 63 - 16 * mt - il;
                const u32x2 lo = *(const u32x2*)(TL + row * 72 + (60 - 32 * ks2 - 4 * q)), hi = *(const u32x2*)(TL + row * 72 + (44 - 32 * ks2 - 4 * q));
                w.x = (lo.y >> 16) | (lo.y << 16); w.y = (lo.x >> 16) | (lo.x << 16); w.z = (hi.y >> 16) | (hi.y << 16); w.w = (hi.x >> 16) | (hi.x << 16);
            } else {
                const int row = 16 * mt + il;
                const u32x2 lo = *(const u32x2*)(TL + row * 72 + (32 * ks2 + 4 * q)), hi = *(const u32x2*)(TL + row * 72 + (32 * ks2 + 16 + 4 * q));
                w.x = lo.x; w.y = lo.y; w.z = hi.x; w.w = hi.y;
            }
            *(u32x4*)(TF + (size_t)((mt * 2 + ks2) * 64 + lane) * 8) = w;
        }
    asm volatile("s_waitcnt lgkmcnt(0)" ::: "memory");
}
DI bf16x8 pack8(const f32x4& a, const f32x4& b) {
    u32x4 w; w.x = cvt_pk_bf16(a[0], a[1]); w.y = cvt_pk_bf16(a[2], a[3]); w.z = cvt_pk_bf16(b[0], b[1]); w.w = cvt_pk_bf16(b[2], b[3]);
    return __builtin_bit_cast(bf16x8, w);
}
DI void mfma_scan(const Params& p, int chain, int slice, int lane) {
    unsigned char* ws = p.ws;
    const bf16_t* Qn = (const bf16_t*)(ws + 4 * UNIT); const bf16_t* Kn = (const bf16_t*)(ws + 5 * UNIT); const bf16_t* KT = (const bf16_t*)(ws + 6 * UNIT); const bf16_t* Vc = (const bf16_t*)p.out;
    const bf16_t* TFb = (const bf16_t*)(ws + 1 * UNIT); const bf16_t* AFb = (const bf16_t*)(ws + 2 * UNIT); const float* cscb = (const float*)(ws + WS_CSC);
    const int b = chain >> 4, dir = (chain >> 3) & 1, h = chain & 7, il = lane & 15, q = lane >> 4;
    bf16_t* O = (dir ? (bf16_t*)(p.out) + (size_t)M * D : (bf16_t*)(ws + 3 * UNIT));
    f32x4 S[8];
#pragma unroll
    for (int dt = 0; dt < 8; ++dt) S[dt] = (f32x4){0.f, 0.f, 0.f, 0.f};
    for (int n = 0; n < 128; ++n) {
        const int c = dir ? 127 - n : n; const int item = chain * 128 + c; const size_t rowbase = (size_t)b * SEQ + c * 64;
        const bf16_t* TF = TFb + (size_t)item * 4096 + lane * 8; const bf16_t* AF = AFb + (size_t)item * 4096 + lane * 8; const float* csc = cscb + (size_t)item * 192;
        const float gl = csc[dir ? 0 : 63];
        f32x4 EG[4], BE[4], EK[4], V[4];
#pragma unroll
        for (int mt = 0; mt < 4; ++mt) { EG[mt] = *(const f32x4*)(csc + 16 * mt + 4 * q); BE[mt] = *(const f32x4*)(csc + 64 + 16 * mt + 4 * q); EK[mt] = *(const f32x4*)(csc + 128 + 16 * mt + 4 * q);
#pragma unroll
            for (int r = 0; r < 4; ++r) V[mt][r] = bf1(Vc[(rowbase + 16 * mt + 4 * q + r) * D + h * 128 + 16 * slice + il]); }
        bf16x8 Sb[4];
#pragma unroll
        for (int ks = 0; ks < 4; ++ks) Sb[ks] = pack8(S[2 * ks], S[2 * ks + 1]);
        f32x4 KS[4], QS[4];
#pragma unroll
        for (int mt = 0; mt < 4; ++mt) { const size_t ro = (rowbase + 16 * mt + il) * D + h * 128 + 8 * q;
            KS[mt] = (f32x4){0.f, 0.f, 0.f, 0.f}; QS[mt] = (f32x4){0.f, 0.f, 0.f, 0.f};
#pragma unroll
            for (int ks = 0; ks < 4; ++ks) { KS[mt] = MFMA16(*(const bf16x8*)(Kn + ro + 32 * ks), Sb[ks], KS[mt]); QS[mt] = MFMA16(*(const bf16x8*)(Qn + ro + 32 * ks), Sb[ks], QS[mt]); } }
        f32x4 X[4];
#pragma unroll
        for (int mt = 0; mt < 4; ++mt) X[mt] = BE[mt] * (V[mt] - EG[mt] * KS[mt]);
        bf16x8 Xb[2] = {pack8(X[0], X[1]), pack8(X[2], X[3])};
        f32x4 VN[4];
#pragma unroll
        for (int mt = 0; mt < 4; ++mt) { VN[mt] = (f32x4){0.f, 0.f, 0.f, 0.f};
#pragma unroll
            for (int ks2 = 0; ks2 < 2; ++ks2) VN[mt] = MFMA16(*(const bf16x8*)(TF + (size_t)((mt * 2 + ks2) * 64) * 8), Xb[ks2], VN[mt]); }
        bf16x8 VNb[2] = {pack8(VN[0], VN[1]), pack8(VN[2], VN[3])};
        bf16x8 VNs[2] = {pack8(VN[0] * EK[0], VN[1] * EK[1]), pack8(VN[2] * EK[2], VN[3] * EK[3])};
#pragma unroll
        for (int mt = 0; mt < 4; ++mt) { f32x4 o = EG[mt] * QS[mt];
#pragma unroll
            for (int ks2 = 0; ks2 < 2; ++ks2) o = MFMA16(*(const bf16x8*)(AF + (size_t)((mt * 2 + ks2) * 64) * 8), VNb[ks2], o);
#pragma unroll
            for (int r = 0; r < 4; ++r) O[(rowbase + 16 * mt + 4 * q + r) * D + h * 128 + 16 * slice + il] = (bf16_t)(cvt_pk_bf16(o[r], 0.f) & 0xffffu); }
#pragma unroll
        for (int dt = 0; dt < 8; ++dt) { const bf16_t* kt = KT + ((size_t)((b * 8 + h) * 128 + 16 * dt + il)) * SEQ + c * 64 + 8 * q; f32x4 s = S[dt] * gl;
#pragma unroll
            for (int ks2 = 0; ks2 < 2; ++ks2) s = MFMA16(*(const bf16x8*)(kt + 32 * ks2), VNs[ks2], s);
            S[dt] = s; }
    }
}
constexpr int SC_K = 0, SC_Q = 16384, SC_T = 32768, SC_A = 40960, SC_V = 49152, SC_C = 51200, SC_BUF = 52224, SC_NPIECE = 3248, SC_NLD = 384, SC_PPL = 9;
constexpr int SC_SB = 2 * SC_BUF, SC_VB = SC_SB + 2 * 4096, SC_END = SC_VB + 2 * 2048;
static_assert(SC_END <= LDS_BYTES - 256, "scan LDS");
typedef short s16x4_t __attribute__((ext_vector_type(4)));
#define SC_BAR() do { asm volatile("s_waitcnt lgkmcnt(0)" ::: "memory"); __builtin_amdgcn_s_barrier(); asm volatile("" ::: "memory"); } while (0)
DI void scan_task(const Params& p, PG8_LAS unsigned char* lds, int chain, int slice, int tid, int wave, int lane) {
    unsigned char* ws = p.ws;
    const int b = chain >> 4, dir = (chain >> 3) & 1, h = chain & 7, il = lane & 15, q = lane >> 4;
    const int c0 = dir ? 127 : 0; const long sgn = dir ? -1 : 1;
    if (wave >= 2) {
        const int lt = tid - 128; const int wbase = 64 * (wave - 2);
        const unsigned char* gp[SC_PPL]; int gstride[SC_PPL];
        const size_t rowbase0 = (size_t)b * SEQ + c0 * 64; const size_t item0 = (size_t)chain * 128 + c0;
#pragma unroll
        for (int k = 0; k < SC_PPL; ++k) {
            int pid = lt + SC_NLD * k; if (pid >= SC_NPIECE) pid -= 64;
            const unsigned char* g = ws; int st = 0;
            if (pid < 2048) { const int pp = pid & 1023, row = pp >> 4, ch = (pp & 15) ^ (row & 15);
                g = ws + (pid < 1024 ? 5 : 4) * UNIT + ((rowbase0 + row) * D + h * 128) * 2 + ch * 16; st = 64 * D * 2; }
            else if (pid < 3072) { const int pp = pid & 511; const bool isT = pid < 2560;
                g = ws + (isT ? 1 : 2) * UNIT + item0 * 8192 + pp * 16; st = 8192; }
            else if (pid < 3200) { const int pp = pid - 3072, row = pp >> 1, hf = pp & 1;
                g = (const unsigned char*)p.out + ((rowbase0 + row) * D + h * 128 + slice * 16) * 2 + hf * 16; st = 64 * D * 2; }
            else { const int pp = pid - 3200; g = ws + WS_CSC + item0 * 768 + pp * 16; st = 768; }
            gp[k] = g; gstride[k] = st;
        }
#define SC_DMA(bo) do { _Pragma("unroll") for (int k = 0; k < SC_PPL; ++k) { if (wbase + SC_NLD * k < SC_NPIECE) \
            __builtin_amdgcn_global_load_lds((const unsigned*)gp[k], (PG8_LAS unsigned*)(lds + (bo) + (wbase + SC_NLD * k) * 16), 16, 0, 0); gp[k] += sgn * gstride[k]; } } while (0)
        SC_DMA(0u);
        asm volatile("s_waitcnt vmcnt(0)" ::: "memory");
        SC_BAR();
        for (int n = 0; n < 128; ++n) {
            if (n + 1 < 128) SC_DMA((unsigned)(((n + 1) & 1) * SC_BUF));
            asm volatile("s_waitcnt vmcnt(0)" ::: "memory");
            SC_BAR();
        }
#undef SC_DMA
    } else if (wave == 0) {
        f32x4 S[8];
#pragma unroll
        for (int dt = 0; dt < 8; ++dt) S[dt] = (f32x4){0.f, 0.f, 0.f, 0.f};
        bf16x8 Sb[4];
#pragma unroll
        for (int ks = 0; ks < 4; ++ks) { Sb[ks] = pack8(S[2 * ks], S[2 * ks + 1]); *(PG8_LAS bf16x8*)(lds + SC_SB + (ks * 64 + lane) * 16) = Sb[ks]; }
        SC_BAR();
        for (int n = 0; n < 128; ++n) {
            PG8_LAS unsigned char* L = lds + (n & 1) * SC_BUF;
            bf16x8 Kf[4][4];
#pragma unroll
            for (int mt = 0; mt < 4; ++mt)
#pragma unroll
                for (int ks = 0; ks < 4; ++ks) Kf[mt][ks] = *(PG8_LAS bf16x8*)(L + SC_K + (16 * mt + il) * 256 + (((4 * ks + q) ^ il) << 4));
            f32x4 EG[4], BE[4], V[4]; bf16x8 Tf[4][2];
#pragma unroll
            for (int mt = 0; mt < 4; ++mt) { EG[mt] = *(PG8_LAS f32x4*)(L + SC_C + (16 * mt + 4 * q) * 4); BE[mt] = *(PG8_LAS f32x4*)(L + SC_C + 256 + (16 * mt + 4 * q) * 4);
#pragma unroll
                for (int r = 0; r < 4; ++r) V[mt][r] = bf1(*(PG8_LAS bf16_t*)(L + SC_V + (16 * mt + 4 * q + r) * 32 + il * 2));
#pragma unroll
                for (int ks2 = 0; ks2 < 2; ++ks2) Tf[mt][ks2] = *(PG8_LAS bf16x8*)(L + SC_T + ((mt * 2 + ks2) * 64 + lane) * 16); }
            f32x4 KS[4];
#pragma unroll
            for (int mt = 0; mt < 4; ++mt) KS[mt] = (f32x4){0.f, 0.f, 0.f, 0.f};
#pragma unroll
            for (int ks = 0; ks < 4; ++ks)
#pragma unroll
                for (int mt = 0; mt < 4; ++mt) KS[mt] = MFMA16(Kf[mt][ks], Sb[ks], KS[mt]);
            __builtin_amdgcn_sched_barrier(0);
            bf16x8 KTf[8][2]; f32x4 EK[4];
            { const int rr = il >> 2, pc = il & 3;
              PG8_LAS unsigned char* kb = L + SC_K + (4 * q + rr) * 256;
#pragma unroll
              for (int dt = 0; dt < 8; ++dt) {
                const int cho = (((4 * (dt >> 1) + pc) ^ (4 * q + rr)) << 4) + 8 * (dt & 1);
#pragma unroll
                for (int ks2 = 0; ks2 < 2; ++ks2) {
                    const s16x4_t lo_ = __builtin_amdgcn_ds_read_tr16_b64_v4i16((PG8_LAS s16x4_t*)(kb + (32 * ks2) * 256 + cho));
                    const s16x4_t hi_ = __builtin_amdgcn_ds_read_tr16_b64_v4i16((PG8_LAS s16x4_t*)(kb + (32 * ks2 + 16) * 256 + cho));
                    KTf[dt][ks2] = __builtin_shufflevector(lo_, hi_, 0, 1, 2, 3, 4, 5, 6, 7);
                } } }
#pragma unroll
            for (int mt = 0; mt < 4; ++mt) EK[mt] = *(PG8_LAS f32x4*)(L + SC_C + 512 + (16 * mt + 4 * q) * 4);
            const float gl = *(PG8_LAS float*)(L + SC_C + (dir ? 0 : 63) * 4);
            f32x4 X[4];
#pragma unroll
            for (int mt = 0; mt < 4; ++mt) X[mt] = BE[mt] * (V[mt] - EG[mt] * KS[mt]);
            bf16x8 Xb[2] = {pack8(X[0], X[1]), pack8(X[2], X[3])};
            f32x4 VN[4];
#pragma unroll
            for (int mt = 0; mt < 4; ++mt) VN[mt] = (f32x4){0.f, 0.f, 0.f, 0.f};
#pragma unroll
            for (int ks2 = 0; ks2 < 2; ++ks2)
#pragma unroll
                for (int mt = 0; mt < 4; ++mt) VN[mt] = MFMA16(Tf[mt][ks2], Xb[ks2], VN[mt]);
            *(PG8_LAS bf16x8*)(lds + SC_VB + (n & 1) * 2048 + lane * 16) = pack8(VN[0], VN[1]); *(PG8_LAS bf16x8*)(lds + SC_VB + (n & 1) * 2048 + (64 + lane) * 16) = pack8(VN[2], VN[3]);
            bf16x8 VNs[2] = {pack8(VN[0] * EK[0], VN[1] * EK[1]), pack8(VN[2] * EK[2], VN[3] * EK[3])};
#pragma unroll
            for (int dt = 0; dt < 8; ++dt) S[dt] = S[dt] * gl;
#pragma unroll
            for (int ks2 = 0; ks2 < 2; ++ks2)
#pragma unroll
                for (int dt = 0; dt < 8; ++dt) S[dt] = MFMA16(KTf[dt][ks2], VNs[ks2], S[dt]);
#pragma unroll
            for (int ks = 0; ks < 4; ++ks) { Sb[ks] = pack8(S[2 * ks], S[2 * ks + 1]); *(PG8_LAS bf16x8*)(lds + SC_SB + ((n + 1) & 1) * 4096 + (ks * 64 + lane) * 16) = Sb[ks]; }
            SC_BAR();
        }
    } else {
        bf16_t* O = (dir ? (bf16_t*)(p.out) + (size_t)M * D : (bf16_t*)(ws + 3 * UNIT));
        f32x4 Oa[4]; bf16x8 Af[4][2];
#pragma unroll
        for (int mt = 0; mt < 4; ++mt) { Oa[mt] = (f32x4){0.f, 0.f, 0.f, 0.f}; Af[mt][0] = (bf16x8){0, 0, 0, 0, 0, 0, 0, 0}; Af[mt][1] = Af[mt][0]; }
        SC_BAR();
        for (int n = 0; n <= 128; ++n) {
            if (n > 0) {
                const int c = dir ? 128 - n : n - 1; const size_t rowbase = (size_t)b * SEQ + c * 64;
                PG8_LAS unsigned char* vb = lds + SC_VB + ((n - 1) & 1) * 2048;
                bf16x8 VNb[2] = {*(PG8_LAS bf16x8*)(vb + lane * 16), *(PG8_LAS bf16x8*)(vb + (64 + lane) * 16)};
#pragma unroll
                for (int ks2 = 0; ks2 < 2; ++ks2)
#pragma unroll
                    for (int mt = 0; mt < 4; ++mt) Oa[mt] = MFMA16(Af[mt][ks2], VNb[ks2], Oa[mt]);
#pragma unroll
                for (int mt = 0; mt < 4; ++mt)
#pragma unroll
                    for (int r = 0; r < 4; ++r) __builtin_nontemporal_store((bf16_t)(cvt_pk_bf16(Oa[mt][r], 0.f) & 0xffffu), O + (rowbase + 16 * mt + 4 * q + r) * D + h * 128 + 16 * slice + il);
            }
            if (n < 128) {
                PG8_LAS unsigned char* L = lds + (n & 1) * SC_BUF;
                bf16x8 Qf[4][4], Sb[4]; f32x4 EG[4];
#pragma unroll
                for (int ks = 0; ks < 4; ++ks) Sb[ks] = *(PG8_LAS bf16x8*)(lds + SC_SB + (n & 1) * 4096 + (ks * 64 + lane) * 16);
#pragma unroll
                for (int mt = 0; mt < 4; ++mt) {
#pragma unroll
                    for (int ks = 0; ks < 4; ++ks) Qf[mt][ks] = *(PG8_LAS bf16x8*)(L + SC_Q + (16 * mt + il) * 256 + (((4 * ks + q) ^ il) << 4));
                    EG[mt] = *(PG8_LAS f32x4*)(L + SC_C + (16 * mt + 4 * q) * 4);
#pragma unroll
                    for (int ks2 = 0; ks2 < 2; ++ks2) Af[mt][ks2] = *(PG8_LAS bf16x8*)(L + SC_A + ((mt * 2 + ks2) * 64 + lane) * 16); }
                f32x4 QS[4];
#pragma unroll
                for (int mt = 0; mt < 4; ++mt) QS[mt] = (f32x4){0.f, 0.f, 0.f, 0.f};
#pragma unroll
                for (int ks = 0; ks < 4; ++ks)
#pragma unroll
                    for (int mt = 0; mt < 4; ++mt) QS[mt] = MFMA16(Qf[mt][ks], Sb[ks], QS[mt]);
#pragma unroll
                for (int mt = 0; mt < 4; ++mt) Oa[mt] = EG[mt] * QS[mt];
                SC_BAR();
            }
        }
    }
}


typedef const __attribute__((address_space(4))) Params* kparams_t;
#if defined(__HIP_DEVICE_COMPILE__)
DI Params load_params() { kparams_t pp = (kparams_t)__builtin_amdgcn_kernarg_segment_ptr(); asm volatile("" : "+s"(pp)); return *pp; }
#else
DI Params load_params() { return Params{}; }
#endif
#define PP() load_params()
#define XB_TMO      128
#define XB_XCNT(j)  (256  + 64 * (j))
#define XB_XSUB(j)  (1280 + 64 * (j))
#define XB_XGEN(j)  (2304 + 64 * (j))
#define XB_TOP      3328
#define XB_TOPGEN   3392
#define XCD_BAR_WORDS 3456
#define XB_SPIN_CAP (1u << 18)
#define LAS __attribute__((address_space(3)))

__device__ __forceinline__ unsigned xb_ld(unsigned* p)              { return __hip_atomic_load(p, __ATOMIC_RELAXED, __HIP_MEMORY_SCOPE_AGENT); }
__device__ __forceinline__ unsigned xb_add(unsigned* p, unsigned v) { return __hip_atomic_fetch_add(p, v, __ATOMIC_RELAXED, __HIP_MEMORY_SCOPE_AGENT); }
__device__ __forceinline__ unsigned xb_xcc_id() { return (unsigned)__builtin_amdgcn_s_getreg((3 << 11) | 20) & 0xFu; }
#define XB_SPIN(cond, bar) do { unsigned _sp = 0; while (cond) { __builtin_amdgcn_s_sleep(1); \
    if ((++_sp & 255u) == 0u) { if (xb_ld(&(bar)[XB_TMO])) break; if (_sp > XB_SPIN_CAP) { atomicAdd(&(bar)[XB_TMO], 1u); break; } } } } while (0)

struct XcdBarrier {
    unsigned* bar; unsigned x;
    volatile LAS unsigned* st;
};

__device__ __forceinline__ XcdBarrier xcd_barrier_post(unsigned* bar, volatile LAS unsigned* st) {
    XcdBarrier b; b.bar = bar; b.x = xb_xcc_id(); b.st = st;
    if (threadIdx.x == 0) (void)xb_add(&bar[XB_XCNT(b.x)], 1u);
    return b;
}
__device__ __forceinline__ void xcd_barrier_complete(unsigned* bar, unsigned x, unsigned& nloc, unsigned& nx) {
    const unsigned G = gridDim.x * gridDim.y * gridDim.z;
    unsigned sum, cnt, mine, sp = 0u;
    for (;;) {
        sum = 0u; cnt = 0u; mine = 0u;
#pragma unroll
        for (unsigned j = 0; j < 16; ++j) { const unsigned c = xb_ld(&bar[XB_XCNT(j)]); sum += c; cnt += (c > 0u) ? 1u : 0u; mine = (j == x) ? c : mine; }
        if (sum == G) break;
        __builtin_amdgcn_s_sleep(1);
        if ((++sp & 255u) == 0u) { if (xb_ld(&bar[XB_TMO])) break; if (sp > XB_SPIN_CAP) { atomicAdd(&bar[XB_TMO], 1u); break; } }
    }
    nloc = mine > 0u ? mine : 1u; nx = cnt > 0u ? cnt : 1u;
}

__device__ __forceinline__ void xcd_barrier(const XcdBarrier& b) {
    asm volatile("s_waitcnt vmcnt(0)" ::: "memory");
    __syncthreads();
    if (threadIdx.x == 0) {
        unsigned* bar = b.bar;
        __builtin_amdgcn_s_waitcnt(0);
        unsigned nloc = b.st[0], nx = b.st[1];
        if (nloc == 0u) { xcd_barrier_complete(bar, b.x, nloc, nx); b.st[0] = nloc; b.st[1] = nx; }
        const unsigned old = xb_add(&bar[XB_XSUB(b.x)], 1u);
        const unsigned gen = old / nloc;
        if (old + 1u == (gen + 1u) * nloc) {
            __builtin_amdgcn_fence(__ATOMIC_RELEASE, "agent");
            asm volatile("s_waitcnt vmcnt(0)" ::: "memory");
            const unsigned og = xb_add(&bar[XB_TOP], 1u);
            const unsigned tg = og / nx;
            if (og + 1u == (tg + 1u) * nx) xb_add(&bar[XB_TOPGEN], 1u);
            else XB_SPIN(xb_ld(&bar[XB_TOPGEN]) == tg, bar);
            __builtin_amdgcn_fence(__ATOMIC_ACQUIRE, "agent");
            xb_add(&bar[XB_XGEN(b.x)], 1u);
            asm volatile("s_waitcnt vmcnt(0)" ::: "memory");
        } else {
            XB_SPIN(xb_ld(&bar[XB_XGEN(b.x)]) == gen, bar);
            __builtin_amdgcn_fence(__ATOMIC_ACQUIRE, "agent");
            asm volatile("s_waitcnt vmcnt(0)" ::: "memory");
        }
    }
    __syncthreads();
}


constexpr size_t WS_BAR = 255 * MiB + 320 * 1024;
DI int fresh_tid() { int t = threadIdx.x; asm volatile("" : "+v"(t)); return t; }
#define IDS const int tid = fresh_tid(), lane = tid & 63, wave = __builtin_amdgcn_readfirstlane(tid >> 6); const int G = gridDim.x, bx = blockIdx.x; \
    const int gw = bx * NWAVES + wave, NGW = G * NWAVES, gtid = bx * NTHREADS + tid, NGT = G * NTHREADS; (void)lane; (void)gw; (void)NGW; (void)gtid; (void)NGT; (void)wave;
__global__ void __launch_bounds__(NTHREADS, 2) fwd_kernel(Params p) {
    extern __shared__ __attribute__((aligned(16))) unsigned char lds[];
    cg::grid_group grid = cg::this_grid();
    PG8_LAS unsigned char* ldsl = (PG8_LAS unsigned char*)lds;
    if (threadIdx.x < 4) ((PG8_LAS unsigned*)(ldsl + (LDS_BYTES - 256)))[threadIdx.x] = 0u;
    __syncthreads();
    const XcdBarrier bar = xcd_barrier_post((unsigned*)(PP().ws + WS_BAR), (volatile PG8_LAS unsigned*)(ldsl + (LDS_BYTES - 256)));

    { IDS phase0(PP(), gw, NGW, lane); }
    if (PP().ws == nullptr) grid.sync();
    xcd_barrier(bar);
    if (gridDim.x == 256) {
        IDS
        pg8::StaticOrder S1; S1.init(M, D, G, bx); pg8::Unit u1; (void)S1.next(0, u1);
        phase1(PP(), (float*)lds, gw, NGW, lane, tid, 256 * u1.pm + 64 * u1.pn);
        unsigned* cnt = (unsigned*)(PP().ws + WS_PCNT4) + 64 * u1.pm;
        asm volatile("s_waitcnt vmcnt(0)" ::: "memory");
        __syncthreads();
        if (threadIdx.x == 0) __hip_atomic_fetch_add(cnt, 1u, __ATOMIC_RELAXED, __HIP_MEMORY_SCOPE_AGENT);
        if (threadIdx.x < 64) {
            unsigned sp = 0;
            while ((unsigned)__builtin_amdgcn_readfirstlane(__hip_atomic_load(cnt, __ATOMIC_RELAXED, __HIP_MEMORY_SCOPE_AGENT)) < 4u) { __builtin_amdgcn_s_sleep(2); if (++sp > (1u << 22)) break; }
            __builtin_amdgcn_fence(__ATOMIC_ACQUIRE, "agent");
        }
        asm volatile("s_waitcnt vmcnt(0) lgkmcnt(0)" ::: "memory");
        __syncthreads();
    } else {
        { IDS phase1(PP(), (float*)lds, gw, NGW, lane, tid, -1); }
        xcd_barrier(bar);
    }
    {
        const Params q = PP(); unsigned char* ws = q.ws; bf16_t* WIN = (bf16_t*)(ws + WS_WIN); const int G = gridDim.x, bx = blockIdx.x;
        pg8::Gemm g{(const bf16_t*)(ws + 0 * UNIT), WIN + (size_t)ROWS_A * D, M, NB_TILES * 256, D}; pg8::StaticOrder S; S.init(M, NB_TILES * 256, G, bx);
        EpiB E{(bf16_t*)(ws + 1 * UNIT)};
        pg8::gemm_phase<EpiB, pg8::StaticOrder, true, true>(ldsl, g, S, E);
    }
    if (gridDim.x == 256) {
        IDS
        pg8::StaticOrder S1; S1.init(M, D, G, bx); pg8::Unit u1; (void)S1.next(0, u1);
        if (wave < 4) ab_item(PP(), 16 * u1.pm + 4 * u1.pn + wave, lane);
    } else { IDS for (int it = gw; it < M / 16; it += NGW) ab_item(PP(), it, lane); }
    if (gridDim.x == 256) {
        IDS
        pg8::StaticOrder S3; S3.init(M, D, G, bx); pg8::Unit u3; (void)S3.next(0, u3);
        unsigned* cnt = (unsigned*)(PP().ws + WS_PCNT5);
        asm volatile("s_waitcnt vmcnt(0)" ::: "memory");
        __syncthreads();
        if (threadIdx.x == 0) __hip_atomic_fetch_add(cnt + 16 * (u3.pm * 4 + u3.pn), 1u, __ATOMIC_RELAXED, __HIP_MEMORY_SCOPE_AGENT);
        if (threadIdx.x < 64) {
#pragma unroll 1
            for (int dlt = -1; dlt <= 1; dlt += 2) {
                const int pp = u3.pm + dlt;
                if (pp < 0 || pp > 63 || (pp >> 5) != (u3.pm >> 5)) continue;
                unsigned sp = 0;
                while ((unsigned)__builtin_amdgcn_readfirstlane(__hip_atomic_load(cnt + 16 * (pp * 4 + u3.pn), __ATOMIC_RELAXED, __HIP_MEMORY_SCOPE_AGENT)) < 1u) { __builtin_amdgcn_s_sleep(2); if (++sp > (1u << 22)) break; }
            }
#pragma unroll 1
            for (int jj = 0; jj < 4; ++jj) {
                unsigned sp = 0;
                while ((unsigned)__builtin_amdgcn_readfirstlane(__hip_atomic_load(cnt + 16 * (u3.pm * 4 + jj), __ATOMIC_RELAXED, __HIP_MEMORY_SCOPE_AGENT)) < 1u) { __builtin_amdgcn_s_sleep(2); if (++sp > (1u << 22)) break; }
            }
            __builtin_amdgcn_fence(__ATOMIC_ACQUIRE, "agent");
        }
        asm volatile("s_waitcnt vmcnt(0) lgkmcnt(0)" ::: "memory");
        __syncthreads();
        const int b3 = u3.pm >> 5, tg = (u3.pm & 31) * 8 + wave;
#pragma nounroll
        for (int hh = 0; hh < 2; ++hh) { const int l2 = fresh_tid() & 63; phase3_item(PP(), ((b3 * 8 + 2 * u3.pn + hh) << 8) + tg, l2); }
    } else {
        xcd_barrier(bar);
        { IDS for (int it = gw; it < 4096; it += NGW) phase3_item(PP(), it, lane); }
    }
    xcd_barrier(bar);
    { IDS for (int it = gw; it < 4096; it += NGW) chunk_prep_item(PP(), (float*)(lds + wave * 16384), it, lane); }
    xcd_barrier(bar);
    for (int tk = blockIdx.x; tk < 256; tk += gridDim.x) { const int t2 = fresh_tid(); scan_task(PP(), ldsl, (tk & 7) + 8 * (tk >> 6), (tk >> 3) & 7, t2, __builtin_amdgcn_readfirstlane(t2 >> 6), t2 & 63); __syncthreads(); }
    xcd_barrier(bar);
    {
        const Params q = PP(); unsigned char* ws = q.ws; bf16_t* WIN = (bf16_t*)(ws + WS_WIN); const int G = gridDim.x, bx = blockIdx.x;
        pg8::Gemm g{(const bf16_t*)(ws + 0 * UNIT), WIN, M, NA_TILES * 256, D}; pg8::StaticOrder S; S.init(M, NA_TILES * 256, G, bx);
        EpiA E{(bf16_t*)(ws + 1 * UNIT), (bf16_t*)(ws + 4 * UNIT)};
        pg8::gemm_phase<EpiA, pg8::StaticOrder, true, true>(ldsl, g, S, E);
    }
    if (gridDim.x == 256) {
        IDS
        pg8::StaticOrder S7; S7.init(M, D, G, bx); pg8::Unit u7; (void)S7.next(0, u7);
        unsigned* cntA = (unsigned*)(PP().ws + WS_PCNT3);
        asm volatile("s_waitcnt vmcnt(0)" ::: "memory");
        __syncthreads();
        if (threadIdx.x == 0) __hip_atomic_fetch_add(cntA + 64 * u7.pm, 1u, __ATOMIC_RELAXED, __HIP_MEMORY_SCOPE_AGENT);
        if (threadIdx.x < 64) {
            const int plo = u7.pm > 0 ? u7.pm - 1 : 0, phi = u7.pm < 63 ? u7.pm + 1 : 63;
            for (int pp = plo; pp <= phi; ++pp) { unsigned sp = 0;
                while ((unsigned)__builtin_amdgcn_readfirstlane(__hip_atomic_load(cntA + 64 * pp, __ATOMIC_RELAXED, __HIP_MEMORY_SCOPE_AGENT)) < 4u) { __builtin_amdgcn_s_sleep(2); if (++sp > (1u << 22)) break; } }
            __builtin_amdgcn_fence(__ATOMIC_ACQUIRE, "agent");
        }
        asm volatile("s_waitcnt vmcnt(0) lgkmcnt(0)" ::: "memory");
        __syncthreads();
        phase7_panel(PP(), u7.pm, u7.pn, tid, lane, wave);
        unsigned* cnt6 = (unsigned*)(PP().ws + WS_PCNT6) + 64 * u7.pm;
        asm volatile("s_waitcnt vmcnt(0)" ::: "memory");
        __syncthreads();
        if (threadIdx.x == 0) __hip_atomic_fetch_add(cnt6, 1u, __ATOMIC_RELAXED, __HIP_MEMORY_SCOPE_AGENT);
        if (threadIdx.x < 64) {
            unsigned sp = 0;
            while ((unsigned)__builtin_amdgcn_readfirstlane(__hip_atomic_load(cnt6, __ATOMIC_RELAXED, __HIP_MEMORY_SCOPE_AGENT)) < 4u) { __builtin_amdgcn_s_sleep(2); if (++sp > (1u << 22)) break; }
            __builtin_amdgcn_fence(__ATOMIC_ACQUIRE, "agent");
        }
        asm volatile("s_waitcnt vmcnt(0) lgkmcnt(0)" ::: "memory");
        __syncthreads();
    } else {
        xcd_barrier(bar);
        { IDS phase7(PP(), gw, NGW, lane, gtid, NGT); }
        xcd_barrier(bar);
    }
    if (gridDim.x == 256) {
        const Params q = PP(); unsigned char* ws = q.ws; const int G = gridDim.x, bx = blockIdx.x;
        static_assert(6 * UNIT - 2 * UNIT == (size_t)256 * 256 * D * 2 && WS_WPB - WS_WPA == (size_t)4 * 256 * D * 2, "TwoGemmOrder address arithmetic");
        TwoGemmOrder S; S.so.init(M, D, G, bx);
        pg8::Gemm g{(const bf16_t*)(ws + 2 * UNIT), (const bf16_t*)(ws + WS_WPA), M, D, D}; EpiYaYb E{(bf16_t*)(ws + 4 * UNIT), (const bf16_t*)(ws + 5 * UNIT)};
        pg8::gemm_phase<EpiYaYb, TwoGemmOrder, true, true>(ldsl, g, S, E);
    } else {
        const Params q = PP(); unsigned char* ws = q.ws; const int G = gridDim.x, bx = blockIdx.x;
        pg8::StaticOrder S; S.init(M, D, G, bx);
        { pg8::Gemm g{(const bf16_t*)(ws + 2 * UNIT), (const bf16_t*)(ws + WS_WPA), M, D, D}; EpiYa E{(bf16_t*)(ws + 4 * UNIT)};
          pg8::gemm_phase<EpiYa, pg8::StaticOrder, true, true>(ldsl, g, S, E); }
        { pg8::Gemm g{(const bf16_t*)(ws + 6 * UNIT), (const bf16_t*)(ws + WS_WPB), M, D, D}; EpiYb E{(bf16_t*)(ws + 4 * UNIT), (const bf16_t*)(ws + 5 * UNIT)};
          pg8::gemm_phase<EpiYb, pg8::StaticOrder, true, true>(ldsl, g, S, E); }
    }
    if (gridDim.x == 256) {
        pg8::StaticOrder S; S.init(M, D, (int)gridDim.x, (int)blockIdx.x); pg8::Unit u; (void)S.next(0, u);
        unsigned* cnt = (unsigned*)(PP().ws + WS_PCNT2) + 64 * u.pm;
        asm volatile("s_waitcnt vmcnt(0)" ::: "memory");
        __syncthreads();
        if (threadIdx.x == 0) __hip_atomic_fetch_add(cnt, 1u, __ATOMIC_RELAXED, __HIP_MEMORY_SCOPE_AGENT);
        if (threadIdx.x < 64) {
            unsigned sp = 0;
            while ((unsigned)__builtin_amdgcn_readfirstlane(__hip_atomic_load(cnt, __ATOMIC_RELAXED, __HIP_MEMORY_SCOPE_AGENT)) < 4u) { __builtin_amdgcn_s_sleep(2); if (++sp > (1u << 22)) break; }
            if (u.pm >= 32) {
                unsigned* c6 = (unsigned*)(PP().ws + WS_PCNT6);
#pragma unroll 1
                for (int e = 0; e < 2; ++e) { unsigned sq = 0;
                    while ((unsigned)__builtin_amdgcn_readfirstlane(__hip_atomic_load(c6 + 64 * (2 * (u.pm - 32) + e), __ATOMIC_RELAXED, __HIP_MEMORY_SCOPE_AGENT)) < 4u) { __builtin_amdgcn_s_sleep(2); if (++sq > (1u << 22)) break; } }
            }
            __builtin_amdgcn_fence(__ATOMIC_ACQUIRE, "agent");
        }
        asm volatile("s_waitcnt vmcnt(0) lgkmcnt(0)" ::: "memory");
        __syncthreads();
    } else {
        xcd_barrier(bar);
    }
    if (gridDim.x == 256) {
        const Params q = PP(); unsigned char* ws = q.ws; const int G = gridDim.x, bx = blockIdx.x;
        pg8::Gemm g{(const bf16_t*)(ws + 4 * UNIT), (const bf16_t*)(ws + WS_WO), M, D, D}; pg8::StaticOrder S; S.init(M, D, G, bx);
        EpiOutFused E{q.in[0], (const float*)(ws + WS_MODF), q.in[14], q.out, (float*)(ws + WS_PSS), (unsigned*)(ws + WS_PCNT)};
        pg8::gemm_phase<EpiOutFused, pg8::StaticOrder, true, true>(ldsl, g, S, E);
    } else {
        {
            const Params q = PP(); unsigned char* ws = q.ws; const int G = gridDim.x, bx = blockIdx.x;
            pg8::Gemm g{(const bf16_t*)(ws + 4 * UNIT), (const bf16_t*)(ws + WS_WO), M, D, D}; pg8::StaticOrder S; S.init(M, D, G, bx);
            EpiOut E{q.in[0], (const float*)(ws + WS_MODF), (float*)(ws + 0 * UNIT)};
            pg8::gemm_phase<EpiOut, pg8::StaticOrder, true, true>(ldsl, g, S, E);
        }
        xcd_barrier(bar);
        { IDS phase10(PP(), gw, NGW, lane); }
    }
}

extern "C" void kernel_launch(void* const* d_in, const int* in_sizes, int n_in, void* d_out, int out_size, void* d_ws, size_t ws_size, hipStream_t stream) {
    static int grid = 0;
    if (grid == 0) {
        int dev = 0, cus = 0, per_cu = 0;
        if (n_in != 15 || out_size != M * D || ws_size < 256 * MiB) { fprintf(stderr, "kernel_launch: unexpected shapes (n_in %d out %d ws %zu)\n", n_in, out_size, ws_size); grid = -1; return; }
        hipGetDevice(&dev); hipDeviceGetAttribute(&cus, hipDeviceAttributeMultiprocessorCount, dev);
        if (hipFuncSetAttribute((const void*)fwd_kernel, hipFuncAttributeMaxDynamicSharedMemorySize, LDS_BYTES) != hipSuccess) { fprintf(stderr, "kernel_launch: hipFuncSetAttribute failed\n"); grid = -1; return; }
        hipOccupancyMaxActiveBlocksPerMultiprocessor(&per_cu, (const void*)fwd_kernel, NTHREADS, LDS_BYTES);
        if (per_cu < 1) { fprintf(stderr, "kernel_launch: occupancy query says %d blocks/CU\n", per_cu); per_cu = 1; }
        (void)hipGetLastError();
        grid = cus;
    }
    if (grid < 0) return;
    if (hipMemsetAsync((char*)d_ws + WS_BAR, 0, 114688, stream) != hipSuccess) { fprintf(stderr, "kernel_launch: memset of barrier words failed\n"); return; }
    Params p{};
    for (int i = 0; i < 15; ++i) p.in[i] = (const float*)d_in[i];
    p.out = (float*)d_out; p.ws = (unsigned char*)d_ws;
    void* args[] = {&p};
    hipError_t e = hipLaunchCooperativeKernel((const void*)fwd_kernel, dim3(grid), dim3(NTHREADS), args, LDS_BYTES, stream);
    if (e != hipSuccess) fprintf(stderr, "cooperative launch failed: %s (grid %d)\n", hipGetErrorString(e), grid);
}
```
